# Optimizing an MI355X kernel written in HIP

```python
import math
import jax, jax.numpy as jnp
from jax import lax
import numpy as np

D_MODEL = 1024
BATCH = 2
SEQ = 16384
DEPTH = 4

GRID_W = 64
Q_BLOCK = 128
N_BRANCHES = 4
BRANCH_WIDTH = 256
A_Q_HEADS = 4
A_KV_HEADS = 2
A_HEAD_DIM = 64
ROPE_THETA = 10000.0
SSM_HEADS = 4
SSM_HEAD_DIM = 64
SSM_GROUPS = 2
SSM_STATE = 128
SSM_CONV = 5
SSM_CHUNK = 128
DIFF_HEADS = 4
DIFF_QK_DIM = 32
DIFF_V_DIM = 64
REL_BUCKETS = 32
REL_MAX_DIST = 128
SGU_GROUPS = 4
SGU_GROUP_DIM = 64
SGU_CHUNK = 128
N_EXPERTS = 16
EC_CAPACITY = 2
D_FF_EXPERT = 1024
PLE_DIM = 256
EPS = 1e-6

IN_SIZES = (
    A_Q_HEADS * A_HEAD_DIM, A_KV_HEADS * A_HEAD_DIM, A_KV_HEADS * A_HEAD_DIM,
    SSM_HEADS * SSM_HEAD_DIM, SSM_HEADS * SSM_HEAD_DIM,
    SSM_GROUPS * SSM_STATE, SSM_GROUPS * SSM_STATE, SSM_HEADS, SSM_HEADS,
    DIFF_HEADS * 2 * DIFF_QK_DIM, DIFF_HEADS * 2 * DIFF_QK_DIM, DIFF_HEADS * DIFF_V_DIM,
    2 * SGU_GROUPS * SGU_GROUP_DIM,
)
IN_WIDTH = sum(IN_SIZES)
CONV_CH = SSM_HEADS * SSM_HEAD_DIM + 2 * SSM_GROUPS * SSM_STATE

kernel_name = 'hybrid_gated_parallel_encoder'


def rms_norm(x, g):
    xf = x.astype(jnp.float32)
    y = xf * lax.rsqrt(jnp.mean(xf * xf, axis=-1, keepdims=True) + EPS)
    return (y * g.astype(jnp.float32)).astype(x.dtype)


def rope_1d(xh, pos):
    n = xh.shape[-1]
    freqs = ROPE_THETA ** (-jnp.arange(0, n, 2, dtype=jnp.float32) / n)
    ang = pos.astype(jnp.float32)[:, None] * freqs[None, :]
    cos = jnp.cos(ang)[None, :, None, :]
    sin = jnp.sin(ang)[None, :, None, :]
    x1 = xh[..., : n // 2].astype(jnp.float32)
    x2 = xh[..., n // 2:].astype(jnp.float32)
    return jnp.concatenate([x1 * cos - x2 * sin, x1 * sin + x2 * cos], axis=-1).astype(xh.dtype)


def axial_rope(x, row, col):
    half = x.shape[-1] // 2
    return jnp.concatenate([rope_1d(x[..., :half], row), rope_1d(x[..., half:], col)], axis=-1)


def gqa_block_attention(q, k, v):
    b, s, hq, d = q.shape
    hkv = k.shape[2]
    nblk = s // Q_BLOCK
    scale = d ** -0.5
    qb = jnp.moveaxis(q.reshape(b, nblk, Q_BLOCK, hkv, hq // hkv, d), 1, 0)

    def one_block(qi):
        logits = jnp.einsum('bqgrd,bkgd->bgrqk', qi, k).astype(jnp.float32) * scale
        probs = jax.nn.softmax(logits, axis=-1).astype(v.dtype)
        return jnp.einsum('bgrqk,bkgd->bqgrd', probs, v)

    out = lax.map(one_block, qb)
    return jnp.moveaxis(out, 0, 1).reshape(b, s, hq * d)


def t5_bucket(rel):
    nb = REL_BUCKETS // 2
    max_exact = nb // 2
    ret = jnp.where(rel > 0, nb, 0)
    r = jnp.abs(rel)
    rf = jnp.maximum(r, 1).astype(jnp.float32)
    large = max_exact + (jnp.log(rf / max_exact) / math.log(REL_MAX_DIST / max_exact)
                         * (nb - max_exact)).astype(jnp.int32)
    large = jnp.minimum(large, nb - 1)
    return ret + jnp.where(r < max_exact, r, large)


def diff_block_attention(q1, q2, k1, k2, v, lam, rel_bias):
    b, s, h, d = q1.shape
    nblk = s // Q_BLOCK
    scale = d ** -0.5
    kpos = jnp.arange(s, dtype=jnp.int32)
    starts = jnp.arange(nblk, dtype=jnp.int32) * Q_BLOCK

    def split_blocks(t):
        return jnp.moveaxis(t.reshape(b, nblk, Q_BLOCK, h, d), 1, 0)

    def one_block(args):
        q1i, q2i, start = args
        qpos = start + jnp.arange(Q_BLOCK, dtype=jnp.int32)
        bias = jnp.transpose(rel_bias[t5_bucket(kpos[None, :] - qpos[:, None])], (2, 0, 1)).astype(jnp.float32)
        p1 = jax.nn.softmax(jnp.einsum('bqhd,bkhd->bhqk', q1i, k1).astype(jnp.float32) * scale + bias, axis=-1)
        p2 = jax.nn.softmax(jnp.einsum('bqhd,bkhd->bhqk', q2i, k2).astype(jnp.float32) * scale + bias, axis=-1)
        w = (p1 - lam * p2).astype(v.dtype)
        return jnp.einsum('bhqk,bkhd->bqhd', w, v)

    out = lax.map(one_block, (split_blocks(q1), split_blocks(q2), starts))
    return jnp.moveaxis(out, 0, 1).reshape(b, s, h, v.shape[-1])


def depthwise_conv_centred(x, w, bias):
    k, c = w.shape
    y = lax.conv_general_dilated(x, w[:, None, :].astype(x.dtype), window_strides=(1,),
                                 padding=[((k - 1) // 2, k // 2)],
                                 dimension_numbers=('NWC', 'WIO', 'NWC'), feature_group_count=c)
    return y + bias.astype(x.dtype)


def ssd_chunked(x, dt, a, bm, cm):
    dtype = x.dtype
    f32 = jnp.float32
    b, s, h, pdim = x.shape
    nc = s // SSM_CHUNK
    rep = h // bm.shape[2]
    xc = (x.astype(f32) * dt[..., None]).reshape(b, nc, SSM_CHUNK, h, pdim)
    bc = jnp.repeat(bm.astype(f32), rep, axis=2).reshape(b, nc, SSM_CHUNK, h, -1)
    cc = jnp.repeat(cm.astype(f32), rep, axis=2).reshape(b, nc, SSM_CHUNK, h, -1)
    acs = jnp.cumsum((dt * a[None, None, :]).reshape(b, nc, SSM_CHUNK, h), axis=2)
    causal = jnp.tril(jnp.ones((SSM_CHUNK, SSM_CHUNK), dtype=bool))
    seg = acs[:, :, :, None, :] - acs[:, :, None, :, :]
    decay_in = jnp.exp(jnp.where(causal[None, None, :, :, None], seg, -jnp.inf))
    scores = jnp.einsum('bclhn,bcshn->bclsh', cc, bc) * decay_in
    y_diag = jnp.einsum('bclsh,bcshp->bclhp', scores, xc)
    decay_to_end = jnp.exp(acs[:, :, -1:, :] - acs)
    chunk_states = jnp.einsum('bclhn,bclh,bclhp->bchpn', bc, decay_to_end, xc)
    chunk_decay = jnp.exp(acs[:, :, -1, :])

    def carry_state(state, inp):
        cs, cd = inp
        return state * cd[:, :, None, None] + cs, state

    init = jnp.zeros((b, h, pdim, bc.shape[-1]), f32)
    _, prev = lax.scan(carry_state, init, (jnp.moveaxis(chunk_states, 1, 0), jnp.moveaxis(chunk_decay, 1, 0)))
    prev = jnp.moveaxis(prev, 0, 1)
    y_off = jnp.einsum('bclhn,bchpn,bclh->bclhp', cc, prev, jnp.exp(acs))
    return (y_diag + y_off).reshape(b, s, h, pdim).astype(dtype)


def bidir_ssd(z, xs, bm, cm, dt_f, dt_b, conv_w, conv_b, dtb_f, dtb_b, alog_f, alog_b, d_skip, g_norm):
    f32 = jnp.float32
    b, s, _ = xs.shape
    d_x = SSM_HEADS * SSM_HEAD_DIM
    d_bc = SSM_GROUPS * SSM_STATE
    xbc = jax.nn.silu(depthwise_conv_centred(jnp.concatenate([xs, bm, cm], axis=-1), conv_w, conv_b))
    xh = xbc[..., :d_x].reshape(b, s, SSM_HEADS, SSM_HEAD_DIM)
    bg = xbc[..., d_x:d_x + d_bc].reshape(b, s, SSM_GROUPS, SSM_STATE)
    cg = xbc[..., d_x + d_bc:].reshape(b, s, SSM_GROUPS, SSM_STATE)
    delta_f = jax.nn.softplus(dt_f.astype(f32) + dtb_f.astype(f32))
    delta_b = jax.nn.softplus(dt_b.astype(f32) + dtb_b.astype(f32))
    y_f = ssd_chunked(xh, delta_f, -jnp.exp(alog_f.astype(f32)), bg, cg)
    y_b = jnp.flip(ssd_chunked(jnp.flip(xh, 1), jnp.flip(delta_b, 1), -jnp.exp(alog_b.astype(f32)),
                               jnp.flip(bg, 1), jnp.flip(cg, 1)), 1)
    y = y_f + y_b + d_skip[:, None].astype(xh.dtype) * xh
    y = y.reshape(b, s, d_x) * jax.nn.silu(z)
    return rms_norm(y, g_norm)


def spatial_gating(uv, g_norm, w_s, b_s):
    b, s, _ = uv.shape
    u, v = jnp.split(jax.nn.gelu(uv), 2, axis=-1)
    v = rms_norm(v, g_norm).reshape(b, s // SGU_CHUNK, SGU_CHUNK, SGU_GROUPS, SGU_GROUP_DIM)
    sv = jnp.einsum('gts,bcsgd->bctgd', w_s.astype(v.dtype), v) + b_s.T[None, None, :, :, None].astype(v.dtype)
    return u * sv.reshape(b, s, SGU_GROUPS * SGU_GROUP_DIM)


def expert_choice_moe(h, w_router, w_gate_e, w_up_e, w_down_e):
    b, s, _ = h.shape
    cap = EC_CAPACITY * s // N_EXPERTS
    affinity = jax.nn.softmax((h @ w_router).astype(jnp.float32), axis=-1)
    top_aff, idx = lax.top_k(jnp.swapaxes(affinity, 1, 2), cap)
    bidx = jnp.arange(b)[:, None, None]
    xe = h[bidx, idx]
    hid = jax.nn.silu(jnp.einsum('becd,edf->becf', xe, w_gate_e)) * jnp.einsum('becd,edf->becf', xe, w_up_e)
    ye = jnp.einsum('becf,efd->becd', hid, w_down_e)
    return jnp.zeros_like(h).at[bidx, idx].add(ye * top_aff[..., None].astype(ye.dtype))


def setup_inputs(seed: int = 0) -> dict:
    key = jax.random.key(seed)
    keys = list(jax.random.split(key, 40))

    def nrm(shape, scale):
        return jax.random.normal(keys.pop(), shape, jnp.float32) * scale

    def gain(shape):
        return 1.0 + nrm(shape, 0.05)

    def dt_bias(shape):
        u = jax.random.uniform(keys.pop(), shape, jnp.float32)
        dt = jnp.exp(math.log(1e-3) + u * (math.log(1e-1) - math.log(1e-3)))
        return dt + jnp.log(-jnp.expm1(-dt))

    def a_log(shape):
        return jnp.log(jax.random.uniform(keys.pop(), shape, jnp.float32, 1.0, 16.0))

    L = DEPTH
    return {
        'x': nrm((BATCH, SEQ, D_MODEL), 1.0),
        'p': nrm((DEPTH, BATCH, SEQ, PLE_DIM), 1.0),
        'rel_bias': nrm((REL_BUCKETS, DIFF_HEADS), 0.5),
        'g_mix': gain((L, D_MODEL)),
        'w_in': nrm((L, D_MODEL, IN_WIDTH), D_MODEL ** -0.5),
        'g_qnorm': gain((L, A_HEAD_DIM)),
        'g_knorm': gain((L, A_HEAD_DIM)),
        'conv_w': nrm((L, SSM_CONV, CONV_CH), SSM_CONV ** -0.5),
        'conv_b': nrm((L, CONV_CH), 0.02),
        'dt_bias_f': dt_bias((L, SSM_HEADS)),
        'dt_bias_b': dt_bias((L, SSM_HEADS)),
        'a_log_f': a_log((L, SSM_HEADS)),
        'a_log_b': a_log((L, SSM_HEADS)),
        'd_skip': gain((L, SSM_HEADS)),
        'g_ssm': gain((L, SSM_HEADS * SSM_HEAD_DIM)),
        'lambda_q1': nrm((L, DIFF_QK_DIM), 0.1),
        'lambda_k1': nrm((L, DIFF_QK_DIM), 0.1),
        'lambda_q2': nrm((L, DIFF_QK_DIM), 0.1),
        'lambda_k2': nrm((L, DIFF_QK_DIM), 0.1),
        'g_diff': gain((L, DIFF_V_DIM)),
        'g_sgu': gain((L, SGU_GROUPS * SGU_GROUP_DIM)),
        'w_spatial': nrm((L, SGU_GROUPS, SGU_CHUNK, SGU_CHUNK), SGU_CHUNK ** -0.5),
        'b_spatial': gain((L, SGU_GROUPS, SGU_CHUNK)),
        'w_branch': nrm((L, N_BRANCHES, BRANCH_WIDTH, D_MODEL), BRANCH_WIDTH ** -0.5),
        'w_branch_gate': nrm((L, D_MODEL, N_BRANCHES * D_MODEL), D_MODEL ** -0.5),
        'w_out': nrm((L, D_MODEL, D_MODEL), D_MODEL ** -0.5),
        'g_moe': gain((L, D_MODEL)),
        'w_router': nrm((L, D_MODEL, N_EXPERTS), D_MODEL ** -0.5),
        'w_exp_gate': nrm((L, N_EXPERTS, D_MODEL, D_FF_EXPERT), D_MODEL ** -0.5),
        'w_exp_up': nrm((L, N_EXPERTS, D_MODEL, D_FF_EXPERT), D_MODEL ** -0.5),
        'w_exp_down': nrm((L, N_EXPERTS, D_FF_EXPERT, D_MODEL), D_FF_EXPERT ** -0.5),
        'g_ple': gain((L, D_MODEL)),
        'w_ple_gate': nrm((L, D_MODEL, D_MODEL), D_MODEL ** -0.5),
        'w_ple': nrm((L, PLE_DIM, D_MODEL), PLE_DIM ** -0.5),
        'g_final': gain((D_MODEL,)),
    }


def reference(x, p, rel_bias, g_mix, w_in, g_qnorm, g_knorm, conv_w, conv_b, dt_bias_f, dt_bias_b,
              a_log_f, a_log_b, d_skip, g_ssm, lambda_q1, lambda_k1, lambda_q2, lambda_k2, g_diff,
              g_sgu, w_spatial, b_spatial, w_branch, w_branch_gate, w_out, g_moe, w_router,
              w_exp_gate, w_exp_up, w_exp_down, g_ple, w_ple_gate, w_ple, g_final):
    f32 = jnp.float32
    b, s, _ = x.shape
    rows = s // GRID_W
    row = jnp.repeat(jnp.arange(rows, dtype=jnp.int32), GRID_W)
    col = jnp.tile(jnp.arange(GRID_W, dtype=jnp.int32), rows)
    offsets = [int(o) for o in np.cumsum(IN_SIZES)[:-1]]

    for i in range(DEPTH):
        h = rms_norm(x, g_mix[i])
        (a_q, a_k, a_v, s_z, s_x, s_b, s_c, s_dtf, s_dtb,
         c_q, c_k, c_v, d_uv) = jnp.split(h @ w_in[i], offsets, axis=-1)

        q = axial_rope(rms_norm(a_q.reshape(b, s, A_Q_HEADS, A_HEAD_DIM), g_qnorm[i]), row, col)
        k = axial_rope(rms_norm(a_k.reshape(b, s, A_KV_HEADS, A_HEAD_DIM), g_knorm[i]), row, col)
        o_a = gqa_block_attention(q, k, a_v.reshape(b, s, A_KV_HEADS, A_HEAD_DIM))

        o_b = bidir_ssd(s_z, s_x, s_b, s_c, s_dtf, s_dtb, conv_w[i], conv_b[i], dt_bias_f[i], dt_bias_b[i],
                        a_log_f[i], a_log_b[i], d_skip[i], g_ssm[i])

        lam_init = 0.8 - 0.6 * math.exp(-0.3 * i)
        lam = (jnp.exp(jnp.sum(lambda_q1[i].astype(f32) * lambda_k1[i].astype(f32)))
               - jnp.exp(jnp.sum(lambda_q2[i].astype(f32) * lambda_k2[i].astype(f32))) + lam_init)
        cq = c_q.reshape(b, s, DIFF_HEADS, 2, DIFF_QK_DIM)
        ck = c_k.reshape(b, s, DIFF_HEADS, 2, DIFF_QK_DIM)
        o_c = diff_block_attention(cq[:, :, :, 0], cq[:, :, :, 1], ck[:, :, :, 0], ck[:, :, :, 1],
                                   c_v.reshape(b, s, DIFF_HEADS, DIFF_V_DIM), lam, rel_bias)
        o_c = (rms_norm(o_c, g_diff[i]) * (1.0 - lam_init)).reshape(b, s, DIFF_HEADS * DIFF_V_DIM)

        o_d = spatial_gating(d_uv, g_sgu[i], w_spatial[i], b_spatial[i])

        branches = jnp.stack([o_a, o_b, o_c, o_d], axis=2)
        gates = jax.nn.sigmoid(h @ w_branch_gate[i]).reshape(b, s, N_BRANCHES, D_MODEL)
        merged = jnp.sum(gates * jnp.einsum('bsnc,ncd->bsnd', branches, w_branch[i]), axis=2)
        x = x + merged @ w_out[i]

        x = x + expert_choice_moe(rms_norm(x, g_moe[i]), w_router[i], w_exp_gate[i], w_exp_up[i], w_exp_down[i])

        ple_gate = jax.nn.sigmoid(rms_norm(x, g_ple[i]) @ w_ple_gate[i])
        x = x + ple_gate * (p[i] @ w_ple[i])

    return rms_norm(x, g_final)
```

```cpp
#include <hip/hip_runtime.h>
#include <hip/hip_bf16.h>
#include <cstdio>
#include <cstdint>
#include <cmath>
namespace pg8 {
#define PG8_LAS __attribute__((address_space(3)))
typedef unsigned short bf16_t;
typedef short bf16x8 __attribute__((ext_vector_type(8)));
typedef float f32x4 __attribute__((ext_vector_type(4)));
typedef unsigned u32x4 __attribute__((ext_vector_type(4)));
constexpr int BM = 256, BK = 64, HALF = 128, HTB = HALF * BK * 2  , STAGE_BYTES = 8 * HTB, NXCD = 8, WGM = 8;

__host__ __device__ __forceinline__ int lds_byte(int r, int c) { const int st = (r >> 4) * 2 + (c >> 5), rr = r & 15, cc = c & 31, ob = rr * 64 + cc * 2; return st * 1024 + (ob ^ (((ob >> 9) & 1) << 5)); }
__host__ __device__ __forceinline__ void stage_rc(int b, int& R, int& C) { const int st = b / 1024, sb = b % 1024, swz = sb ^ (((sb >> 9) & 1) << 5); R = (st >> 1) * 16 + swz / 64; C = (st & 1) * 32 + (swz % 64) / 2; }
__host__ __device__ __forceinline__ int perm32(int rho) { const int n = rho >> 4, i = rho & 15; return 8 * (i >> 2) + 4 * n + (i & 3); }

struct Unit { int pm, pn; };
struct Gemm { const bf16_t* A; const bf16_t* Bt; int M, N, K, lda; };

struct StaticOrder {
    int nM, nN, nwg, G, c;
    __host__ __device__ void init(int M, int N, int G_, int c_) { nM = M / BM; nN = N / BM; nwg = nM * nN; G = G_; c = c_; }
    __host__ __device__ bool next(int i, Unit& u) const {
        const long L = (long)i * G + c; if (L >= nwg) return false;
        int wgid = (int)L; { const int q = nwg / NXCD, r = nwg % NXCD, xcd = wgid % NXCD, off = wgid / NXCD; wgid = (xcd < r ? xcd * (q + 1) : r * (q + 1) + (xcd - r) * q) + off; }
        const int nig = WGM * nN, gid = wgid / nig, fm = gid * WGM, gsz = (nM - fm) < WGM ? (nM - fm) : WGM;
        u.pm = fm + ((wgid % nig) % gsz); u.pn = (wgid % nig) / gsz; return true;
    }
    __device__ __forceinline__ void a_ready(const Unit&) const {}
    __device__ __forceinline__ void done(const Unit&) const {}
    __device__ __forceinline__ size_t a_off(const Unit&) const { return 0; }
};

__device__ __forceinline__ unsigned cvt_pk_bf16(float lo, float hi) { unsigned r; asm volatile("v_cvt_pk_bf16_f32 %0, %1, %2" : "=v"(r) : "v"(lo), "v"(hi)); return r; }
typedef float f32x2 __attribute__((ext_vector_type(2)));
__device__ __forceinline__ float bf_lo(unsigned w) { return __builtin_bit_cast(float, w << 16); }
__device__ __forceinline__ float bf_hi(unsigned w) { return __builtin_bit_cast(float, w & 0xffff0000u); }
__device__ __forceinline__ float sigmoid_f(float x) { return __builtin_amdgcn_rcpf(1.0f + __builtin_amdgcn_exp2f(-1.4426950408889634f * x)); }
__device__ __forceinline__ u32x4 pack8(const f32x4 v0, const f32x4 v1) { u32x4 w; w.x = cvt_pk_bf16(v0[0], v0[1]); w.y = cvt_pk_bf16(v0[2], v0[3]); w.z = cvt_pk_bf16(v1[0], v1[1]); w.w = cvt_pk_bf16(v1[2], v1[3]); return w; }

struct ExpertOrder {
    int nNl, G, c;
    __device__ bool next(int i, Unit& u) const {
        const int L = i * G + c, per = 16 * nNl; if (L >= 16 * per) return false;
        const int e = L / per, w = L % per; u.pm = e * 16 + (w % 16); u.pn = e * nNl + (w / 16); return true;
    }
    __device__ __forceinline__ void a_ready(const Unit&) const {}
    __device__ __forceinline__ void done(const Unit&) const {}
    __device__ __forceinline__ size_t a_off(const Unit&) const { return 0; }
};
struct BranchOrder : StaticOrder {
    __device__ __forceinline__ size_t a_off(const Unit& u) const { return (size_t)(u.pn >> 2) * 256 * 2; }
};

struct EpiG1 {
    static constexpr bool PERM = true, AFTER_DRAIN = false, MIDHOOK = false;
    bf16_t* proj; bf16_t* gates; float qscale;
    __device__ __forceinline__ void operator()(const f32x4 (&acc)[2][2][4][2], const Unit& u, int wr, int wc, int fr, int fq) const {
        const int row0 = u.pm * BM + wr * 64 + fr;
        const bool isg = u.pn >= 11;
        bf16_t* base = isg ? gates : proj; const int ldc = isg ? 4096 : 2816; const int colt = isg ? (u.pn - 11) * BM : u.pn * BM;
        const float sc = (u.pn == 2) ? qscale : 1.0f;
        const int col0 = colt + wc * 32 + 8 * fq;
#pragma unroll
        for (int ai = 0; ai < 2; ++ai)
#pragma unroll
            for (int m = 0; m < 4; ++m) { bf16_t* rowp = base + (size_t)(row0 + ai * HALF + m * 16) * ldc + col0;
#pragma unroll
                for (int bj = 0; bj < 2; ++bj) { f32x4 v0 = acc[ai][bj][m][0], v1 = acc[ai][bj][m][1];
                    if (isg) {
#pragma unroll
                        for (int i = 0; i < 4; ++i) { v0[i] = sigmoid_f(v0[i]); v1[i] = sigmoid_f(v1[i]); }
                    } else { v0 = v0 * sc; v1 = v1 * sc; }
                    *(u32x4*)(rowp + bj * HALF) = pack8(v0, v1); } }
    }
};
struct EpiPlain {
    static constexpr bool PERM = true, AFTER_DRAIN = false, MIDHOOK = false;
    bf16_t* O; int ldc;
    __device__ __forceinline__ void operator()(const f32x4 (&acc)[2][2][4][2], const Unit& u, int wr, int wc, int fr, int fq) const {
        const int row0 = u.pm * BM + wr * 64 + fr, col0 = u.pn * BM + wc * 32 + 8 * fq;
#pragma unroll
        for (int ai = 0; ai < 2; ++ai)
#pragma unroll
            for (int m = 0; m < 4; ++m) { bf16_t* rowp = O + (size_t)(row0 + ai * HALF + m * 16) * ldc + col0;
#pragma unroll
                for (int bj = 0; bj < 2; ++bj) *(u32x4*)(rowp + bj * HALF) = pack8(acc[ai][bj][m][0], acc[ai][bj][m][1]); }
    }
};
struct EpiGateMul {
    static constexpr bool PERM = true, AFTER_DRAIN = false, MIDHOOK = false;
    bf16_t* gates; const float* ssq;
    __device__ __forceinline__ void operator()(const f32x4 (&acc)[2][2][4][2], const Unit& u, int wr, int wc, int fr, int fq) const {
        const int row0 = u.pm * BM + wr * 64 + fr, col0 = u.pn * BM + wc * 32 + 8 * fq; const bool isb = (u.pn >> 2) == 1;
#pragma unroll
        for (int ai = 0; ai < 2; ++ai)
#pragma unroll
            for (int m = 0; m < 4; ++m) { const size_t r = (size_t)(row0 + ai * HALF + m * 16); float rf = 1.0f;
                if (isb) { const f32x4 q = *(const f32x4*)(ssq + r * 4); rf = 1.0f / sqrtf(((q[0] + q[1]) + (q[2] + q[3])) * (1.0f / 256.0f) + 1e-6f); }
#pragma unroll
                for (int bj = 0; bj < 2; ++bj) { bf16_t* gp = gates + r * 4096 + col0 + bj * HALF; const u32x4 g = *(const u32x4*)gp;
                    f32x4 v0 = acc[ai][bj][m][0] * rf, v1 = acc[ai][bj][m][1] * rf;
                    v0[0] *= bf_lo(g.x); v0[1] *= bf_hi(g.x); v0[2] *= bf_lo(g.y); v0[3] *= bf_hi(g.y);
                    v1[0] *= bf_lo(g.z); v1[1] *= bf_hi(g.z); v1[2] *= bf_lo(g.w); v1[3] *= bf_hi(g.w);
                    *(u32x4*)gp = pack8(v0, v1); }
                if (m & 1) asm volatile("" ::: "memory"); }
    }
};
struct EpiResid {
    static constexpr bool PERM = false, AFTER_DRAIN = false, MIDHOOK = false;
    const float* xin; float* xout;
    __device__ __forceinline__ void operator()(const f32x4 (&acc)[2][2][4][2], const Unit& u, int wr, int wc, int fr, int fq) const {
        const int row0 = u.pm * BM + wr * 64 + fr, col0 = u.pn * BM + wc * 32 + 4 * fq;
#pragma unroll
        for (int ai = 0; ai < 2; ++ai)
#pragma unroll
            for (int m = 0; m < 4; ++m) { const size_t off = (size_t)(row0 + ai * HALF + m * 16) * 1024 + col0;
#pragma unroll
                for (int bj = 0; bj < 2; ++bj)
#pragma unroll
                    for (int n = 0; n < 2; ++n) { const f32x4 b = *(const f32x4*)(xin + off + bj * HALF + n * 16); *(f32x4*)(xout + off + bj * HALF + n * 16) = b + acc[ai][bj][m][n]; } }
    }
};
struct EpiPle {
    static constexpr bool PERM = false, AFTER_DRAIN = false, MIDHOOK = false;
    float* x; const bf16_t* pl;
    __device__ __forceinline__ void operator()(const f32x4 (&acc)[2][2][4][2], const Unit& u, int wr, int wc, int fr, int fq) const {
        typedef unsigned u32x2 __attribute__((ext_vector_type(2)));
        const int row0 = u.pm * BM + wr * 64 + fr, col0 = u.pn * BM + wc * 32 + 4 * fq;
#pragma unroll
        for (int ai = 0; ai < 2; ++ai)
#pragma unroll
            for (int m = 0; m < 4; ++m) { const size_t off = (size_t)(row0 + ai * HALF + m * 16) * 1024 + col0;
#pragma unroll
                for (int bj = 0; bj < 2; ++bj)
#pragma unroll
                    for (int n = 0; n < 2; ++n) { const size_t o = off + bj * HALF + n * 16; const f32x4 b = *(const f32x4*)(x + o); const u32x2 pv = *(const u32x2*)(pl + o);
                        const f32x4 a = acc[ai][bj][m][n]; f32x4 r;
                        r[0] = b[0] + sigmoid_f(a[0]) * bf_lo(pv.x); r[1] = b[1] + sigmoid_f(a[1]) * bf_hi(pv.x);
                        r[2] = b[2] + sigmoid_f(a[2]) * bf_lo(pv.y); r[3] = b[3] + sigmoid_f(a[3]) * bf_hi(pv.y);
                        *(f32x4*)(x + o) = r; } }
    }
};
struct EpiGU {
    static constexpr bool PERM = true, AFTER_DRAIN = false, MIDHOOK = false;
    bf16_t* hid;
    __device__ __forceinline__ void operator()(const f32x4 (&acc)[2][2][4][2], const Unit& u, int wr, int wc, int fr, int fq) const {
        const int row0 = u.pm * BM + wr * 64 + fr, col0 = (u.pn & 7) * 128 + wc * 32 + 8 * fq;
#pragma unroll
        for (int ai = 0; ai < 2; ++ai)
#pragma unroll
            for (int m = 0; m < 4; ++m) { f32x4 v0, v1; const f32x4 g0 = acc[ai][0][m][0], g1 = acc[ai][0][m][1], u0 = acc[ai][1][m][0], u1 = acc[ai][1][m][1];
#pragma unroll
                for (int i = 0; i < 4; ++i) { v0[i] = g0[i] * sigmoid_f(g0[i]) * u0[i]; v1[i] = g1[i] * sigmoid_f(g1[i]) * u1[i]; }
                *(u32x4*)(hid + (size_t)(row0 + ai * HALF + m * 16) * 1024 + col0) = pack8(v0, v1); }
    }
};
struct EpiDN {
    static constexpr bool PERM = true, AFTER_DRAIN = false, MIDHOOK = false;
    bf16_t* ye; const float* aff;
    __device__ __forceinline__ void operator()(const f32x4 (&acc)[2][2][4][2], const Unit& u, int wr, int wc, int fr, int fq) const {
        const int row0 = u.pm * BM + wr * 64 + fr, col0 = (u.pn & 3) * BM + wc * 32 + 8 * fq;
#pragma unroll
        for (int ai = 0; ai < 2; ++ai)
#pragma unroll
            for (int m = 0; m < 4; ++m) { const size_t r = (size_t)(row0 + ai * HALF + m * 16); const float a = aff[r];
#pragma unroll
                for (int bj = 0; bj < 2; ++bj) *(u32x4*)(ye + r * 1024 + col0 + bj * HALF) = pack8(acc[ai][bj][m][0] * a, acc[ai][bj][m][1] * a); }
    }
};
template <class Epi, class Sched, bool ALIGN_EPI = false, bool SP2 = false>
__device__ __forceinline__ void gemm_phase(PG8_LAS unsigned char* lds, const Gemm g, const Sched& S, const Epi& E, const int tid) {
    const int wid = __builtin_amdgcn_readfirstlane(tid >> 6), lane = tid & 63, wr = wid >> 2, wc = wid & 3, fr = lane & 15, fq = lane >> 4;
    int K = g.K; asm volatile("" : "+s"(K));
    const int nt = K / BK; const int lda = g.lda ? g.lda : K;
    unsigned voffA[2], voffB[2];
#pragma unroll
    for (int i = 0; i < 2; ++i) { int R, C; stage_rc(tid * 16 + i * 8192, R, C); const int Rb = Epi::PERM ? ((R & ~31) + perm32(R & 31)) : R;
        voffA[i] = (unsigned)(R * lda + C) * 2u; voffB[i] = (unsigned)(Rb * K + C) * 2u; }
    const size_t kstep = (size_t)(BK * 2);
    const size_t hstep = (size_t)HALF * K * 2;
    const size_t tstep = 2 * hstep;
    const size_t hstepA = (size_t)HALF * lda * 2, tstepA = 2 * hstepA;
    const unsigned ldsw = (unsigned)wid * 1024u;
    const int aoff = lds_byte(wr * 64 + fr, fq * 8), boff = lds_byte(wc * 32 + fr, fq * 8);
#define PG8_SA(b, h) (((b) * 2 + (h)) * HTB)
#define PG8_SB(b, h) ((4 + (b) * 2 + (h)) * HTB)
#define PG8_STAGE(bufoff, gbase, voff) do { _Pragma("unroll") for (int _i = 0; _i < 2; ++_i) \
        __builtin_amdgcn_global_load_lds((const unsigned*)((const char*)(gbase) + (voff)[_i]), (PG8_LAS unsigned*)(lds + (bufoff) + ldsw + _i * 8192), 16, 0, 0); } while (0)
#define PG8_LDA(dst, b, h) do { _Pragma("unroll") for (int m = 0; m < 4; ++m) _Pragma("unroll") for (int k = 0; k < 2; ++k) dst[m][k] = *(const PG8_LAS bf16x8*)(lds + PG8_SA(b, h) + aoff + m * 2048 + k * 1024); } while (0)
#define PG8_LDB(dst, b, h) do { _Pragma("unroll") for (int n = 0; n < 2; ++n) _Pragma("unroll") for (int k = 0; k < 2; ++k) dst[n][k] = *(const PG8_LAS bf16x8*)(lds + PG8_SB(b, h) + boff + n * 2048 + k * 1024); } while (0)
#define PG8_MMA(ai, bj, At, Bt) do { __builtin_amdgcn_s_setprio(1); _Pragma("unroll") for (int m = 0; m < 4; ++m) _Pragma("unroll") for (int n = 0; n < 2; ++n) _Pragma("unroll") for (int k = 0; k < 2; ++k) \
        acc[ai][bj][m][n] = __builtin_amdgcn_mfma_f32_16x16x32_bf16(Bt[n][k], At[m][k], acc[ai][bj][m][n], 0, 0, 0); __builtin_amdgcn_s_setprio(0); } while (0)
#define PG8_WAIT_V(n) asm volatile("s_waitcnt vmcnt(" #n ")" ::: "memory")
#define PG8_WAIT_L(n) asm volatile("s_waitcnt lgkmcnt(" #n ")" ::: "memory")
#define PG8_BAR __builtin_amdgcn_s_barrier()
#define PG8_SCHED __builtin_amdgcn_sched_barrier(0)
    Unit cur, nxt; int ui = 0;
    if (!S.next(0, cur)) return;
    f32x4 acc[2][2][4][2];
#pragma unroll
    for (int a = 0; a < 2; ++a)
#pragma unroll
        for (int b = 0; b < 2; ++b)
#pragma unroll
            for (int m = 0; m < 4; ++m)
#pragma unroll
                for (int n = 0; n < 2; ++n) acc[a][b][m][n] = (f32x4){0.f, 0.f, 0.f, 0.f};
    bf16x8 At[4][2], B0[2][2], B1[2][2];
    const char* cA = (const char*)g.A + (size_t)cur.pm * tstepA + S.a_off(cur); const char* cB = (const char*)g.Bt + (size_t)cur.pn * tstep;
    S.a_ready(cur);
    if constexpr (SP2) {
        PG8_STAGE(PG8_SB(0, 0), cB, voffB); PG8_STAGE(PG8_SB(0, 1), cB + hstep, voffB); PG8_STAGE(PG8_SA(0, 0), cA, voffA); PG8_STAGE(PG8_SA(0, 1), cA + hstepA, voffA);
        if (wr == 1) PG8_BAR;
        PG8_WAIT_V(2); PG8_BAR;
        PG8_STAGE(PG8_SB(1, 0), cB + kstep, voffB); PG8_STAGE(PG8_SA(1, 0), cA + kstep, voffA); PG8_STAGE(PG8_SB(1, 1), cB + hstep + kstep, voffB);
        PG8_WAIT_V(6); PG8_BAR;
    } else {
        PG8_STAGE(PG8_SB(0, 0), cB, voffB); PG8_STAGE(PG8_SA(0, 0), cA, voffA); PG8_STAGE(PG8_SB(0, 1), cB + hstep, voffB); PG8_STAGE(PG8_SA(0, 1), cA + hstepA, voffA);
        if (wr == 1) PG8_BAR;
        PG8_WAIT_V(4); PG8_BAR;
        PG8_STAGE(PG8_SB(1, 0), cB + kstep, voffB); PG8_STAGE(PG8_SA(1, 0), cA + kstep, voffA); PG8_STAGE(PG8_SB(1, 1), cB + hstep + kstep, voffB);
        PG8_WAIT_V(6); PG8_BAR;
    }
    for (;;) {
        const bool has_next = S.next(ui + 1, nxt);
        const char* nA = has_next ? (const char*)g.A + (size_t)nxt.pm * tstepA + S.a_off(nxt) : cA; const char* nB = has_next ? (const char*)g.Bt + (size_t)nxt.pn * tstep : cB;
        for (int t = 0; t < nt; t += 2) {
            const bool last = (t == nt - 2);
            const char* a1 = cA + (size_t)(t + 1) * kstep;
            const char* a2 = last ? nA : cA + (size_t)(t + 2) * kstep; const char* b2 = last ? nB : cB + (size_t)(t + 2) * kstep;
            const char* a3 = a2 + kstep; const char* b3 = b2 + kstep;
            if (last && has_next) S.a_ready(nxt);
            if constexpr (SP2) {
            PG8_LDB(B0, 0, 0); PG8_LDB(B1, 0, 1); PG8_SCHED; PG8_LDA(At, 0, 0); PG8_STAGE(PG8_SA(1, 1), a1 + hstepA, voffA);
            PG8_WAIT_V(8); PG8_WAIT_L(0); PG8_BAR; PG8_MMA(0, 0, At, B0); PG8_MMA(0, 1, At, B1); PG8_BAR; PG8_SCHED;
            PG8_LDA(At, 0, 1); PG8_STAGE(PG8_SB(0, 0), b2, voffB); PG8_STAGE(PG8_SB(0, 1), b2 + hstep, voffB); PG8_STAGE(PG8_SA(0, 0), a2, voffA);
            PG8_WAIT_V(8); PG8_WAIT_L(0); PG8_BAR; PG8_MMA(1, 0, At, B0); PG8_MMA(1, 1, At, B1); PG8_BAR; PG8_SCHED;
            PG8_LDB(B0, 1, 0); PG8_LDB(B1, 1, 1); PG8_SCHED; PG8_LDA(At, 1, 0); PG8_STAGE(PG8_SA(0, 1), a2 + hstepA, voffA);
            PG8_WAIT_V(8); PG8_WAIT_L(0); PG8_BAR; PG8_MMA(0, 0, At, B0); PG8_MMA(0, 1, At, B1); PG8_BAR; PG8_SCHED;
            PG8_LDA(At, 1, 1); PG8_STAGE(PG8_SB(1, 0), b3, voffB); PG8_STAGE(PG8_SB(1, 1), b3 + hstep, voffB); PG8_STAGE(PG8_SA(1, 0), a3, voffA);
            PG8_WAIT_V(8); PG8_WAIT_L(0); PG8_BAR; PG8_MMA(1, 0, At, B0); PG8_MMA(1, 1, At, B1); PG8_BAR; PG8_SCHED;
            } else {
            PG8_LDB(B0, 0, 0); PG8_SCHED; PG8_LDA(At, 0, 0); PG8_STAGE(PG8_SA(1, 1), a1 + hstepA, voffA);
            PG8_WAIT_L(8); PG8_BAR; PG8_WAIT_L(0); PG8_MMA(0, 0, At, B0); PG8_BAR; PG8_SCHED;
            PG8_LDB(B1, 0, 1); PG8_STAGE(PG8_SB(0, 0), b2, voffB);
            PG8_BAR; PG8_WAIT_L(0); PG8_MMA(0, 1, At, B1); PG8_BAR;
            PG8_LDA(At, 0, 1); PG8_STAGE(PG8_SA(0, 0), a2, voffA);
            PG8_BAR; PG8_WAIT_L(0); PG8_MMA(1, 0, At, B0); PG8_BAR; PG8_SCHED;
            PG8_STAGE(PG8_SB(0, 1), b2 + hstep, voffB);
            PG8_WAIT_V(6); PG8_BAR; PG8_MMA(1, 1, At, B1); PG8_BAR;
            PG8_LDB(B0, 1, 0); PG8_SCHED; PG8_LDA(At, 1, 0); PG8_STAGE(PG8_SA(0, 1), a2 + hstepA, voffA);
            PG8_WAIT_L(8); PG8_BAR; PG8_WAIT_L(0); PG8_MMA(0, 0, At, B0); PG8_BAR; PG8_SCHED;
            PG8_LDB(B1, 1, 1); PG8_STAGE(PG8_SB(1, 0), b3, voffB);
            PG8_BAR; PG8_WAIT_L(0); PG8_MMA(0, 1, At, B1); PG8_BAR;
            PG8_LDA(At, 1, 1); PG8_STAGE(PG8_SA(1, 0), a3, voffA);
            PG8_BAR; PG8_WAIT_L(0); PG8_MMA(1, 0, At, B0); PG8_BAR; PG8_SCHED;
            PG8_STAGE(PG8_SB(1, 1), b3 + hstep, voffB);
            PG8_WAIT_V(6); PG8_BAR; PG8_MMA(1, 1, At, B1); PG8_BAR;
            }
        }
        if constexpr (ALIGN_EPI) { if (wr == 0) PG8_BAR; }
        if constexpr (!Epi::AFTER_DRAIN) { E(acc, cur, wr, wc, fr, fq); S.done(cur); }
        if (!has_next) break;
#pragma unroll
        for (int a = 0; a < 2; ++a)
#pragma unroll
            for (int b = 0; b < 2; ++b)
#pragma unroll
                for (int m = 0; m < 4; ++m)
#pragma unroll
                    for (int n = 0; n < 2; ++n) acc[a][b][m][n] = (f32x4){0.f, 0.f, 0.f, 0.f};
        cur = nxt; cA = nA; cB = nB; ++ui;
        if constexpr (ALIGN_EPI) { if (wr == 1) PG8_BAR; }
    }
    PG8_WAIT_V(0);
    if constexpr (!ALIGN_EPI) { if (wr == 0) PG8_BAR; }
    PG8_BAR;
    if constexpr (Epi::AFTER_DRAIN) { E.fused(acc, cur, wr, wc, fr, fq, lds, wid, lane); S.done(cur); }
#undef PG8_SA
#undef PG8_SB
#undef PG8_STAGE
#undef PG8_LDA
#undef PG8_LDB
#undef PG8_MMA
#undef PG8_WAIT_V
#undef PG8_WAIT_L
#undef PG8_BAR
#undef PG8_SCHED
}
}
namespace attn_body {
using bf16=__hip_bfloat16;
using bf16x8=__attribute__((ext_vector_type(8)))short;
using s16x4=__attribute__((ext_vector_type(4)))short;
using f32x16=__attribute__((ext_vector_type(16)))float;
using u32x4=__attribute__((ext_vector_type(4)))unsigned;
using f32x4a=__attribute__((ext_vector_type(4)))float;
constexpr int SEQ=16384,D=64,LDP=2816,LDO=1024;
constexpr int NW=8,QBLK=32,KVBLK=64,NT=SEQ/KVBLK;
__device__ __forceinline__ int crow(int r,int hi){return (r&3)+8*(r>>2)+4*hi;}
#define SBAR() __builtin_amdgcn_sched_barrier(0)
constexpr int NSLOT=3, SLOTB=8192;
constexpr int LDS_K=0, LDS_V=NSLOT*SLOTB, LDS_WS=2*NSLOT*SLOTB, LDS_OST=LDS_WS+NW*64*4, LDS_TAB=LDS_OST+65536, LDS_BYTES=LDS_TAB+640*4;
constexpr float LOG2E=1.4426950408889634f;
__device__ __forceinline__ void glds16(const void*gsrc,unsigned lds_dst){unsigned keep;
  asm volatile("s_mov_b32 %0, m0\n\ts_mov_b32 m0, %2\n\ts_nop 0\n\tglobal_load_lds_dwordx4 %1, off\n\ts_mov_b32 m0, %0":"=&s"(keep):"v"(gsrc),"s"(lds_dst):"memory");}
__device__ __forceinline__ float max3f(float a,float b,float c){float r;asm("v_max3_f32 %0, %1, %2, %3":"=v"(r):"v"(a),"v"(b),"v"(c));return r;}
__device__ __forceinline__ float max2f(float a,float b){float r;asm("v_max_f32_e32 %0, %1, %2":"=v"(r):"v"(a),"v"(b));return r;}
__device__ __forceinline__ float fadd_s(float a,float b){float r;asm("v_add_f32_e32 %0, %1, %2":"=v"(r):"v"(a),"v"(b));return r;}
__device__ __forceinline__ float fsub_s(float a,float b){float r;asm("v_sub_f32_e32 %0, %1, %2":"=v"(r):"v"(a),"v"(b));return r;}
typedef float f32x2_t __attribute__((ext_vector_type(2))); typedef __bf16 bf16x2_t __attribute__((ext_vector_type(2)));
__device__ __forceinline__ unsigned cvtpk_s(float lo,float hi){f32x2_t v={lo,hi};bf16x2_t b=__builtin_convertvector(v,bf16x2_t);return __builtin_bit_cast(unsigned,b);}
#define WAIT_BAR(N) asm volatile("s_waitcnt vmcnt(" #N ") lgkmcnt(0)\n\ts_barrier":::"memory")

template<int ND> __device__ __forceinline__ void qkt(f32x16&p0,f32x16&p1,const char*Kslot,const bf16x8*qr,const f32x16&negm,int r32,int hi){
  const char*kb=Kslot+hi*1024+r32*16;
  #pragma unroll
  for(int d0=0;d0<ND;++d0){
    const bf16x8 b0=*reinterpret_cast<const bf16x8*>(kb+d0*2048);
    const bf16x8 b1=*reinterpret_cast<const bf16x8*>(kb+d0*2048+512);
    if(d0==0){p0=__builtin_amdgcn_mfma_f32_32x32x16_bf16(b0,qr[0],negm,0,0,0);p1=__builtin_amdgcn_mfma_f32_32x32x16_bf16(b1,qr[0],negm,0,0,0);}
    else{p0=__builtin_amdgcn_mfma_f32_32x32x16_bf16(b0,qr[d0],p0,0,0,0);p1=__builtin_amdgcn_mfma_f32_32x32x16_bf16(b1,qr[d0],p1,0,0,0);}}
}
typedef __attribute__((address_space(3))) const char* lds_cptr;
typedef __attribute__((address_space(3))) const float* lds_fptr;
typedef short v4i16_t __attribute__((ext_vector_type(4)));
__device__ __forceinline__ void kload8(bf16x8*kf,lds_cptr kp){
  kf[0]=*(const __attribute__((address_space(3))) bf16x8*)(kp);      kf[1]=*(const __attribute__((address_space(3))) bf16x8*)(kp+512);
  kf[2]=*(const __attribute__((address_space(3))) bf16x8*)(kp+2048); kf[3]=*(const __attribute__((address_space(3))) bf16x8*)(kp+2560);
  kf[4]=*(const __attribute__((address_space(3))) bf16x8*)(kp+4096); kf[5]=*(const __attribute__((address_space(3))) bf16x8*)(kp+4608);
  kf[6]=*(const __attribute__((address_space(3))) bf16x8*)(kp+6144); kf[7]=*(const __attribute__((address_space(3))) bf16x8*)(kp+6656);
}
__device__ __forceinline__ void kload2(bf16x8*kf,lds_cptr kp,int j){ kf[2*j]=*(const __attribute__((address_space(3))) bf16x8*)(kp+j*2048); kf[2*j+1]=*(const __attribute__((address_space(3))) bf16x8*)(kp+j*2048+512); }
__device__ __forceinline__ s16x4 vtr(lds_cptr p){ return __builtin_bit_cast(s16x4,__builtin_amdgcn_ds_read_tr16_b64_v4i16((__attribute__((address_space(3))) v4i16_t*)p)); }
__device__ __forceinline__ float rowmax(const f32x16&p0,const f32x16&p1){
  float a=max3f(p0[0],p0[1],p1[0]),b=max3f(p0[2],p0[3],p1[1]);a=max3f(a,p1[2],p1[3]);
  #pragma unroll
  for(int r=4;r<16;r+=4){a=max3f(a,p0[r],p0[r+1]);b=max3f(b,p0[r+2],p0[r+3]);a=max3f(a,p1[r],p1[r+1]);b=max3f(b,p1[r+2],p1[r+3]);}
  const float m=max2f(a,b);
  auto rr=__builtin_amdgcn_permlane32_swap(__float_as_uint(m),__float_as_uint(m),false,false);
  return max2f(__uint_as_float(rr[0]),__uint_as_float(rr[1]));
}
__device__ __forceinline__ void pv(f32x16*o,int vb,bf16x8 pa0,bf16x8 pa1,bf16x8 pa2,bf16x8 pa3){
  #pragma unroll
  for(int d0=0;d0<2;++d0){s16x4 lo[4],hi[4];
    #pragma unroll
    for(int ks=0;ks<4;++ks){
      asm volatile("ds_read_b64_tr_b16 %0,%1 offset:%c2":"=&v"(lo[ks]):"v"(vb),"i"(d0*4096+ks*1024):"memory");
      asm volatile("ds_read_b64_tr_b16 %0,%1 offset:%c2":"=&v"(hi[ks]):"v"(vb),"i"(d0*4096+ks*1024+512):"memory");}
    asm volatile("s_waitcnt lgkmcnt(0)":::"memory");SBAR();
    #define PK(k) (bf16x8){lo[k][0],lo[k][1],lo[k][2],lo[k][3],hi[k][0],hi[k][1],hi[k][2],hi[k][3]}
    o[d0]=__builtin_amdgcn_mfma_f32_32x32x16_bf16(pa0,PK(0),o[d0],0,0,0);
    o[d0]=__builtin_amdgcn_mfma_f32_32x32x16_bf16(pa1,PK(1),o[d0],0,0,0);
    o[d0]=__builtin_amdgcn_mfma_f32_32x32x16_bf16(pa2,PK(2),o[d0],0,0,0);
    o[d0]=__builtin_amdgcn_mfma_f32_32x32x16_bf16(pa3,PK(3),o[d0],0,0,0);
    #undef PK
  }
}
__device__ __forceinline__ int t5_bucket(int rel){
  const int r=rel<0?-rel:rel; int v;
  if(r<8)v=r; else if(r<12)v=8; else if(r<16)v=9; else if(r<23)v=10; else if(r<32)v=11; else if(r<46)v=12; else if(r<64)v=13; else if(r<91)v=14; else v=15;
  return (rel>0?16:0)+v;
}

#ifndef ATTN_STORE16
#define ATTN_STORE16(p,v) (*(u32x4*)(p)=(v))
#endif
template<bool CM,int THRL> __device__ __forceinline__ void attn_unit(const bf16*Qb,const bf16*__restrict__ Kb,const bf16*__restrict__ Vb,bf16*Ob,int q0,char*shm,
                                                                       const float*relb,int h,float lam,float osc,const float*gdiff,const int tid){
  const int lane=tid&63,r32=lane&31,hi=lane>>5; const int wid=__builtin_amdgcn_readfirstlane(tid>>6);
  const int wrow=CM?(wid&3)*QBLK:wid*QBLK; const int map=wid>>2;
  const bf16*Qw=Qb+(long)(q0+wrow)*LDP;
  const unsigned lds0=(unsigned)(uintptr_t)shm;
  float*wsf=(float*)(shm+LDS_WS)+wid*64;
  const bf16*ksrc=Kb+(long)lane*LDP+wid*8;
  const bf16*vsrc=Vb+(long)(16*(wid&3)+(lane>>2))*LDP+(wid>>2)*32+(lane&3)*8;
  const unsigned kdst=lds0+LDS_K+wid*1024, vdst=lds0+LDS_V+wid*1024;
  #define DMA_K(t,slot) glds16(ksrc+(long)(t)*KVBLK*LDP,(unsigned)__builtin_amdgcn_readfirstlane(kdst+(slot)))
  #define DMA_V(t,slot) glds16(vsrc+(long)(t)*KVBLK*LDP,(unsigned)__builtin_amdgcn_readfirstlane(vdst+(slot)))
  const int vb0=(int)(lds0+LDS_V)+((lane>>4)&1)*32+(lane&3)*8+(4*hi+((lane&15)>>2))*64;
  const char*Kbase=shm+LDS_K; bf16x8 kf[8];
  const lds_cptr shm3=(lds_cptr)shm; const lds_cptr kp0=shm3+LDS_K+hi*1024+r32*16+(CM?map*4096:0); const lds_cptr vp0=shm3+LDS_V+((lane>>4)&1)*32+(lane&3)*8+(4*hi+((lane&15)>>2))*64;
  const lds_fptr tab3=(lds_fptr)(shm3+LDS_TAB);
    if(CM){ float*tab=(float*)(shm+LDS_TAB); for(int i=tid;i<640;i+=NW*64)tab[i]=LOG2E*relb[t5_bucket(i-320)*4+h]; }
  DMA_K(0,0);DMA_V(0,0);DMA_K(1,SLOTB);
  bf16x8 qr[4];
  #pragma unroll
  for(int d0=0;d0<(CM?2:4);++d0)qr[d0]=*reinterpret_cast<const bf16x8*>(&Qw[(long)r32*LDP+(CM?map*32:0)+d0*16+hi*8]);
  const int jn=q0>>7; const int nlo=2*jn-3, nhi=2*jn+5; const int qabs=q0+wrow+r32;
  bool near=CM&&(nlo<=0); float cside=0.f; if(CM&&!near)cside=LOG2E*relb[15*4+h];
  float mhat=0.f,l_reg=0.f;f32x16 o[2];o[0]=f32x16{};o[1]=f32x16{};asm volatile("":"+v"(o[0]),"+v"(o[1]));f32x16 negm;
  #define NEGM_SET() do{ _Pragma("unroll") for(int r=0;r<16;++r)negm[r]=cside-mhat; asm volatile("":"+v"(negm)); }while(0)
  NEGM_SET();
  #define MODESW(t) do{ if(CM){ if((t)==nlo){near=true;cside=0.f;NEGM_SET();} else if((t)==nhi){near=false;cside=tab3[639];NEGM_SET();} } }while(0)
  #define BIASADD(P0,P1,t) do{ if(CM){ if(near){ const lds_fptr tb_=tab3+(64*(t)-qabs+4*hi+320); \
      _Pragma("unroll") for(int r4=0;r4<4;++r4){ _Pragma("unroll") for(int r=4*r4;r<4*r4+4;++r){P0[r]+=tb_[(r&3)+8*(r>>2)];P1[r]+=tb_[32+(r&3)+8*(r>>2)];} SBAR(); } } } }while(0)
  bool resc=false;
  #define START(P0,P1) do{ const float rm=rowmax(P0,P1); resc=false; \
    { const float dl=rm; mhat=fadd_s(mhat,dl); \
      _Pragma("unroll") for(int r=0;r<16;++r){P0[r]=fsub_s(P0[r],dl);P1[r]=fsub_s(P1[r],dl);} \
      NEGM_SET(); } \
    _Pragma("unroll") for(int r=0;r<16;++r)P0[r]=__builtin_amdgcn_exp2f(P0[r]); }while(0)
  #define RESC() do{ if(resc){ asm volatile("s_waitcnt lgkmcnt(0)":::"memory"); \
      _Pragma("unroll") for(int d_=0;d_<2;++d_) _Pragma("unroll") for(int r=0;r<16;++r)o[d_][r]*=wsf[crow(r,hi)]; } }while(0)
  f32x16 pA0,pA1,pB0,pB1;
  int sl_prev=0,sl_cur=0,sl_next=SLOTB;
  #define ROT() do{sl_prev=sl_cur;sl_cur=sl_next;sl_next=(sl_next==(NSLOT-1)*SLOTB)?0:sl_next+SLOTB;}while(0)
  DMA_K(2,2*SLOTB);
  WAIT_BAR(3);
  qkt<(CM?2:4)>(pA0,pA1,Kbase+(CM?map*4096:0),qr,negm,r32,hi);asm volatile("s_nop 15\n\ts_nop 7":"+v"(pA0),"+v"(pA1));BIASADD(pA0,pA1,0);
  START(pA0,pA1);
  _Pragma("unroll") for(int r=0;r<16;++r)pA1[r]=__builtin_amdgcn_exp2f(pA1[r]);
  WAIT_BAR(0);
  DMA_K(3,0);DMA_V(1,SLOTB);
  ROT();
  if constexpr(CM){ kload2(kf,kp0+sl_cur,0); kload2(kf,kp0+sl_cur,1); } else { kload8(kf,kp0+sl_cur); }
  WAIT_BAR(2);
  s16x4 vlo[8],vhi[8]; u32x4 pw0,pw1,pw2,pw3;
  #define PKW(P,B) cvtpk_s(P[B],P[B+1])
  #define PAF(k) __builtin_bit_cast(bf16x8,pw##k)
  #define VFR(i) (bf16x8){vlo[i][0],vlo[i][1],vlo[i][2],vlo[i][3],vhi[i][0],vhi[i][1],vhi[i][2],vhi[i][3]}
  #define PIN(x) asm volatile("":"+v"(x))
  #define MX3(a,b,c) __builtin_fmaxf(__builtin_fmaxf((a),(b)),(c))
  #define GAPA(MF,A0,A1,A2,A3,W0,W1,PW) do{ MF; sacc+=A0; sacc+=A1; sacc+=A2; sacc+=A3; PIN(sacc); W0; W1; PIN(PW); SBAR(); }while(0)
  #define EX(v) __builtin_amdgcn_exp2f(v)
  #define GAPB(MF,X,B) do{ MF; X[B]=EX(X[B]); X[B+1]=EX(X[B+1]); X[B+2]=EX(X[B+2]); X[B+3]=EX(X[B+3]); PIN(X); SBAR(); }while(0)
  #define VRD(i) do{ vlo[i]=vtr(vp_+(((i)>>2)*4096+((i)&3)*1024)); vhi[i]=vtr(vp_+(((i)>>2)*4096+((i)&3)*1024+512)); }while(0)
  #define KRD(G,j) do{ if((G)&&(!CM||(j)<2)){ kload2(kf,kp0+sl_next,j); SBAR(); } }while(0)
  #define MF58(stmt) do{ if constexpr(!CM){ stmt; } }while(0)
  #define STEP(C0,C1,P0,P1,t,GK,GV,GL) do{ SBAR(); \
    const lds_cptr vp_=vp0+sl_prev; \
    VRD(0); SBAR(); float sacc=(P0[0]+P0[1]); \
    GAPA(C0=__builtin_amdgcn_mfma_f32_32x32x16_bf16(kf[0],qr[0],negm,0,0,0), P0[2],P0[3],P0[4],P0[5],     pw0[0]=PKW(P0,0), pw0[1]=PKW(P0,2), pw0); \
    VRD(4); SBAR(); GAPA(C1=__builtin_amdgcn_mfma_f32_32x32x16_bf16(kf[1],qr[0],negm,0,0,0), P0[6],P0[7],P0[8],P0[9],     pw0[2]=PKW(P0,4), pw0[3]=PKW(P0,6), pw0); \
    VRD(1); SBAR(); GAPA(C0=__builtin_amdgcn_mfma_f32_32x32x16_bf16(kf[2],qr[1],C0,0,0,0),   P0[10],P0[11],P0[12],P0[13], pw1[0]=PKW(P0,8), pw1[1]=PKW(P0,10), pw1); \
    VRD(5); SBAR(); GAPA(C1=__builtin_amdgcn_mfma_f32_32x32x16_bf16(kf[3],qr[1],C1,0,0,0),   P0[14],P0[15],P1[0],P1[1],   pw1[2]=PKW(P0,12),pw1[3]=PKW(P0,14), pw1); \
    VRD(2); SBAR(); GAPA(MF58(C0=__builtin_amdgcn_mfma_f32_32x32x16_bf16(kf[4],qr[2],C0,0,0,0)),   P1[2],P1[3],P1[4],P1[5],     pw2[0]=PKW(P1,0), pw2[1]=PKW(P1,2), pw2); \
    VRD(6); SBAR(); GAPA(MF58(C1=__builtin_amdgcn_mfma_f32_32x32x16_bf16(kf[5],qr[2],C1,0,0,0)),   P1[6],P1[7],P1[8],P1[9],     pw2[2]=PKW(P1,4), pw2[3]=PKW(P1,6), pw2); \
    VRD(3); SBAR(); GAPA(MF58(C0=__builtin_amdgcn_mfma_f32_32x32x16_bf16(kf[6],qr[3],C0,0,0,0)),   P1[10],P1[11],P1[12],P1[13], pw3[0]=PKW(P1,8), pw3[1]=PKW(P1,10), pw3); \
    VRD(7); SBAR(); GAPA(MF58(C1=__builtin_amdgcn_mfma_f32_32x32x16_bf16(kf[7],qr[3],C1,0,0,0)),   P1[14],P1[15],0.f,0.f,       pw3[2]=PKW(P1,12),pw3[3]=PKW(P1,14), pw3); \
    l_reg+=sacc; \
    if(GK){DMA_K((t)+3,sl_cur);} if(GV){DMA_V((t)+1,sl_next);} \
    BIASADD(C0,C1,t); \
    { float a=MX3(C0[0],C0[1],C1[0]),b=MX3(C0[2],C0[3],C1[1]); a=MX3(a,C1[2],C1[3]); \
      _Pragma("unroll") for(int r=4;r<16;r+=4){a=MX3(a,C0[r],C0[r+1]);b=MX3(b,C0[r+2],C0[r+3]);a=MX3(a,C1[r],C1[r+1]);b=MX3(b,C1[r+2],C1[r+3]);} \
      float rm=__builtin_fmaxf(a,b); { auto rr=__builtin_amdgcn_permlane32_swap(__float_as_uint(rm),__float_as_uint(rm),false,false); rm=__builtin_fmaxf(__uint_as_float(rr[0]),__uint_as_float(rr[1])); } \
      resc=false; \
      if(__builtin_expect(__any(rm>(float)THRL),0)){ const float dl=__builtin_fmaxf(rm,0.f); mhat+=dl; \
        _Pragma("unroll") for(int r=0;r<16;++r){C0[r]-=dl;C1[r]-=dl;} \
        NEGM_SET(); \
        const float f=__builtin_amdgcn_exp2f(-dl); l_reg*=f; if(hi==0)wsf[r32]=f; resc=true; } } \
    SBAR(); \
    GAPB(o[0]=__builtin_amdgcn_mfma_f32_32x32x16_bf16(PAF(0),VFR(0),o[0],0,0,0), C0,0); \
    GAPB(o[1]=__builtin_amdgcn_mfma_f32_32x32x16_bf16(PAF(0),VFR(4),o[1],0,0,0), C0,4); \
    KRD(GL,0); GAPB(o[0]=__builtin_amdgcn_mfma_f32_32x32x16_bf16(PAF(1),VFR(1),o[0],0,0,0), C0,8); \
    KRD(GL,1); GAPB(o[1]=__builtin_amdgcn_mfma_f32_32x32x16_bf16(PAF(1),VFR(5),o[1],0,0,0), C0,12); \
    KRD(GL,2); GAPB(o[0]=__builtin_amdgcn_mfma_f32_32x32x16_bf16(PAF(2),VFR(2),o[0],0,0,0), C1,0); \
    KRD(GL,3); GAPB(o[1]=__builtin_amdgcn_mfma_f32_32x32x16_bf16(PAF(2),VFR(6),o[1],0,0,0), C1,4); \
    GAPB(o[0]=__builtin_amdgcn_mfma_f32_32x32x16_bf16(PAF(3),VFR(3),o[0],0,0,0), C1,8); \
    GAPB(o[1]=__builtin_amdgcn_mfma_f32_32x32x16_bf16(PAF(3),VFR(7),o[1],0,0,0), C1,12); \
    }while(0)
  int t=1;
  for(;t+5<NT;t+=2){
    MODESW(t);
    STEP(pB0,pB1,pA0,pA1,t,true,true,true);     WAIT_BAR(2); RESC(); ROT();
    STEP(pA0,pA1,pB0,pB1,t+1,true,true,true);   WAIT_BAR(2); RESC(); ROT();
  }
  #define ENDW(tt) do{ if((tt)+3<NT){WAIT_BAR(2);} else if((tt)+2<NT){WAIT_BAR(1);} else {WAIT_BAR(0);} }while(0)
  for(;t+1<NT;t+=2){
    MODESW(t);
    STEP(pB0,pB1,pA0,pA1,t,(t+3<NT),(t+1<NT),(t+1<NT));       ENDW(t);   RESC(); ROT();
    STEP(pA0,pA1,pB0,pB1,t+1,(t+4<NT),(t+2<NT),(t+2<NT));     ENDW(t+1); RESC(); ROT();
  }
  MODESW(NT-1);
  STEP(pB0,pB1,pA0,pA1,NT-1,false,false,false); RESC();
  { float sacc=pB0[0]+pB0[1]; _Pragma("unroll") for(int r=2;r<16;++r)sacc+=pB0[r]; _Pragma("unroll") for(int r=0;r<16;++r)sacc+=pB1[r]; l_reg+=sacc;
    pw0=(u32x4){PKW(pB0,0),PKW(pB0,2),PKW(pB0,4),PKW(pB0,6)};pw1=(u32x4){PKW(pB0,8),PKW(pB0,10),PKW(pB0,12),PKW(pB0,14)};pw2=(u32x4){PKW(pB1,0),PKW(pB1,2),PKW(pB1,4),PKW(pB1,6)};pw3=(u32x4){PKW(pB1,8),PKW(pB1,10),PKW(pB1,12),PKW(pB1,14)};
    SBAR(); pv(o,vb0+sl_cur,PAF(0),PAF(1),PAF(2),PAF(3)); }
  #undef PKW
  #undef PAF
  #undef VFR
  #undef PIN
  #undef MX3
  #undef GAPA
  #undef GAPB
  #undef EX
  #undef VRD
  #undef KRD
  #undef MF58
  #undef STEP
  #undef ENDW
  {auto rr=__builtin_amdgcn_permlane32_swap(__float_as_uint(l_reg),__float_as_uint(l_reg),false,false);l_reg=__uint_as_float(rr[0])+__uint_as_float(rr[1]);}
  if(hi==0)wsf[32+r32]=l_reg;asm volatile("s_waitcnt lgkmcnt(0)":::"memory");
  float rli[16];
  #pragma unroll
  for(int r=0;r<16;++r)rli[r]=__builtin_amdgcn_rcpf(wsf[32+crow(r,hi)]);
  if(!CM){
    bf16*Ow=Ob+(long)(q0+wid*QBLK)*LDO;
    bf16*stg=(bf16*)(shm+LDS_OST)+wid*2048;
    #pragma unroll
    for(int r=0;r<16;++r){const int orow=crow(r,hi);
      #pragma unroll
      for(int d0=0;d0<2;++d0)stg[orow*64+d0*32+r32]=__float2bfloat16(o[d0][r]*rli[r]);}
    asm volatile("s_waitcnt lgkmcnt(0)":::"memory");
    #pragma unroll
    for(int i=0;i<4;++i){const int row=i*8+(lane>>3),ch=lane&7; const u32x4 v=*(const u32x4*)(stg+row*64+ch*8); ATTN_STORE16(Ow+(long)row*LDO+ch*8,v);}
  } else {
    const float msc=(map==0)?1.f:-lam;
    float*stg=(float*)(shm+LDS_OST)+map*8192+(wid&3)*2048;
    #pragma unroll
    for(int r=0;r<16;++r){const int orow=crow(r,hi); const float sc=rli[r]*msc;
      #pragma unroll
      for(int d0=0;d0<2;++d0)stg[orow*64+d0*32+r32]=o[d0][r]*sc;}
    asm volatile("s_waitcnt lgkmcnt(0)\n\ts_barrier":::"memory");
    const int row=16*wid+(lane>>2),part=lane&3;
    const float*s0=(const float*)(shm+LDS_OST)+row*64+part*16;
    f32x4a a[4]; float ss=0.f;
    #pragma unroll
    for(int i=0;i<4;++i){ a[i]=((const f32x4a*)s0)[i]+((const f32x4a*)(s0+8192))[i]; ss+=a[i][0]*a[i][0]+a[i][1]*a[i][1]+a[i][2]*a[i][2]+a[i][3]*a[i][3]; }
    ss+=__shfl_xor(ss,1); ss+=__shfl_xor(ss,2);
    const float rn=osc/sqrtf(ss*(1.0f/64.0f)+1e-6f);
    unsigned w[8];
    #pragma unroll
    for(int i=0;i<4;++i){ const f32x4a g=((const f32x4a*)(gdiff+part*16))[i]; w[2*i]=cvtpk_s(a[i][0]*rn*g[0],a[i][1]*rn*g[1]); w[2*i+1]=cvtpk_s(a[i][2]*rn*g[2],a[i][3]*rn*g[3]); }
    bf16*op=Ob+(long)(q0+row)*LDO+part*16;
    *(u32x4*)(op)=(u32x4){w[0],w[1],w[2],w[3]}; *(u32x4*)(op+8)=(u32x4){w[4],w[5],w[6],w[7]};
  }
  asm volatile("s_waitcnt lgkmcnt(0)\n\ts_barrier":::"memory");
  #undef DMA_K
  #undef DMA_V
  #undef BIASADD
  #undef MODESW
  #undef NEGM_SET
  #undef START
  #undef RESC
  #undef ROT
}
#undef SBAR
#undef WAIT_BAR
}
#define GAS __attribute__((address_space(1)))
#define LAS __attribute__((address_space(3)))
typedef unsigned short bf16;
typedef unsigned v4u __attribute__((ext_vector_type(4)));
typedef float f32x4 __attribute__((ext_vector_type(4)));
typedef short bf16x8 __attribute__((ext_vector_type(8)));
typedef GAS unsigned gu32;
typedef GAS unsigned long long gu64;
#define RLX_AGENT __ATOMIC_RELAXED, __HIP_MEMORY_SCOPE_AGENT
#define LDS_WAIT() asm volatile("s_waitcnt lgkmcnt(0)" ::: "memory")
#define VM_WAIT() asm volatile("s_waitcnt vmcnt(0)" ::: "memory")
__device__ __forceinline__ unsigned long long rt() { return __builtin_amdgcn_s_memrealtime(); }
__device__ __forceinline__ unsigned f2bf(float f) { unsigned u = __builtin_bit_cast(unsigned, f); return (u + 0x7fffu + ((u >> 16) & 1u)) >> 16; }
__device__ __forceinline__ unsigned pk2(float lo, float hi) { return f2bf(lo) | (f2bf(hi) << 16); }

#define XB_TMO      128
#define XB_XCNT(j)  (256  + 64 * (j))
#define XB_XSUB(j)  (1280 + 64 * (j))
#define XB_XGEN(j)  (2304 + 64 * (j))
#define XB_TOP      3328
#define XB_TOPGEN   3392
#define XCD_BAR_WORDS 3456
#define XB_SPIN_CAP (1u << 18)

__device__ __forceinline__ unsigned xb_ld(unsigned* p)              { return __hip_atomic_load(p, __ATOMIC_RELAXED, __HIP_MEMORY_SCOPE_AGENT); }
__device__ __forceinline__ unsigned xb_add(unsigned* p, unsigned v) { return __hip_atomic_fetch_add(p, v, __ATOMIC_RELAXED, __HIP_MEMORY_SCOPE_AGENT); }
__device__ __forceinline__ unsigned xb_xcc_id() { return (unsigned)__builtin_amdgcn_s_getreg((3 << 11) | 20) & 0xFu; }
#define XB_SPIN(cond, bar) do { unsigned _sp = 0; while (cond) { __builtin_amdgcn_s_sleep(1); \
    if ((++_sp & 255u) == 0u) { if (xb_ld(&(bar)[XB_TMO])) break; if (_sp > XB_SPIN_CAP) { atomicAdd(&(bar)[XB_TMO], 1u); break; } } } } while (0)

struct XcdBarrier {
    unsigned* bar; unsigned x;
    volatile LAS unsigned* st;
};

__device__ __forceinline__ XcdBarrier xcd_barrier_post(unsigned* bar, volatile LAS unsigned* st) {
    XcdBarrier b; b.bar = bar; b.x = xb_xcc_id(); b.st = st;
    if (threadIdx.x == 0) (void)xb_add(&bar[XB_XCNT(b.x)], 1u);
    return b;
}
__device__ __forceinline__ void xcd_barrier_complete(unsigned* bar, unsigned x, unsigned& nloc, unsigned& nx) {
    const unsigned G = gridDim.x * gridDim.y * gridDim.z;
    unsigned sum, cnt, mine, sp = 0u;
    for (;;) {
        sum = 0u; cnt = 0u; mine = 0u;
#pragma unroll
        for (unsigned j = 0; j < 16; ++j) { const unsigned c = xb_ld(&bar[XB_XCNT(j)]); sum += c; cnt += (c > 0u) ? 1u : 0u; mine = (j == x) ? c : mine; }
        if (sum == G) break;
        __builtin_amdgcn_s_sleep(1);
        if ((++sp & 255u) == 0u) { if (xb_ld(&bar[XB_TMO])) break; if (sp > XB_SPIN_CAP) { atomicAdd(&bar[XB_TMO], 1u); break; } }
    }
    nloc = mine > 0u ? mine : 1u; nx = cnt > 0u ? cnt : 1u;
}

__device__ __forceinline__ void xcd_barrier(const XcdBarrier& b) {
    asm volatile("s_waitcnt vmcnt(0)" ::: "memory");
    __syncthreads();
    if (threadIdx.x == 0) {
        unsigned* bar = b.bar;
        __builtin_amdgcn_s_waitcnt(0);
        unsigned nloc = b.st[0], nx = b.st[1];
        if (nloc == 0u) { xcd_barrier_complete(bar, b.x, nloc, nx); b.st[0] = nloc; b.st[1] = nx; }
        const unsigned old = xb_add(&bar[XB_XSUB(b.x)], 1u);
        const unsigned gen = old / nloc;
        if (old + 1u == (gen + 1u) * nloc) {
            __builtin_amdgcn_fence(__ATOMIC_RELEASE, "agent");
            asm volatile("s_waitcnt vmcnt(0)" ::: "memory");
            const unsigned og = xb_add(&bar[XB_TOP], 1u);
            const unsigned tg = og / nx;
            if (og + 1u == (tg + 1u) * nx) xb_add(&bar[XB_TOPGEN], 1u);
            else XB_SPIN(xb_ld(&bar[XB_TOPGEN]) == tg, bar);
            __builtin_amdgcn_fence(__ATOMIC_ACQUIRE, "agent");
            xb_add(&bar[XB_XGEN(b.x)], 1u);
            asm volatile("s_waitcnt vmcnt(0)" ::: "memory");
        } else {
            XB_SPIN(xb_ld(&bar[XB_XGEN(b.x)]) == gen, bar);
            __builtin_amdgcn_fence(__ATOMIC_ACQUIRE, "agent");
            asm volatile("s_waitcnt vmcnt(0)" ::: "memory");
        }
    }
    __syncthreads();
}
constexpr int NWAVES = 8, NTHR = 512;
constexpr int NB = 2, S = 16384, T = NB * S, D = 1024, DEPTH = 4, NE = 16, CAP = 2048;
constexpr int NPROJ = 2816, NGATE = 4096, NCAT = NPROJ + NGATE, LDP = NPROJ;
constexpr int PC_AQ = 0, PC_AK = 256, PC_AV = 384, PC_CQ = 512, PC_CK = 768, PC_CV = 1024, PC_Z = 1280, PC_XS = 1536, PC_BM = 1792, PC_CM = 2048, PC_UV = 2304;
constexpr float EPS = 1e-6f, LOG2E = 1.4426950408889634f;
constexpr int NPH = 14;
constexpr int NGP = DEPTH * NPH + 1;

constexpr size_t MiB = 1u << 20;
constexpr size_t WS_CTL = 0, CTL_ZERO_BYTES = 1 * MiB;
constexpr size_t WS_DT = 1 * MiB;
constexpr size_t WS_AFF = 2 * MiB;
constexpr size_t WS_SELIDX = 4 * MiB;
constexpr size_t WS_SELAFF = 4 * MiB + 256 * 1024;
constexpr size_t WS_INV = 5 * MiB;
constexpr size_t WS_TAB = 6 * MiB;
constexpr size_t WS_CD = 8 * MiB;
constexpr size_t WS_WSP = 8 * MiB + 512 * 1024;
constexpr size_t WS_SSQ = 9 * MiB;
constexpr size_t WS_WCAT = 10 * MiB;
constexpr size_t WS_WBR = 24 * MiB, WS_WPG = 26 * MiB, WS_WPLE = 28 * MiB;
constexpr size_t WS_WGU = 32 * MiB;
constexpr size_t WS_WDN = 96 * MiB;
constexpr size_t WS_H = 128 * MiB;
constexpr size_t WS_PROJ = 192 * MiB;
constexpr size_t WS_GATES = 368 * MiB;
constexpr size_t WS_XE = 192 * MiB, WS_HID = 320 * MiB, WS_YE = 448 * MiB;
constexpr size_t WS_BR = 624 * MiB;
constexpr size_t WS_PL = 688 * MiB;
constexpr size_t WS_PBF = 752 * MiB;
constexpr size_t WS_ST = 768 * MiB;
constexpr size_t WS_SB = 832 * MiB;
constexpr size_t WS_XBC = 864 * MiB;
constexpr size_t WS_WOUT = 912 * MiB;
constexpr size_t WS_END = 920 * MiB;
constexpr int CW_TMO = 0, CW_BAR = 4096;

constexpr int RING_BYTES = 131072, LDSCTL_OFF = RING_BYTES, MISC_OFF = LDSCTL_OFF + 320, LDS_BYTES = 147456;

struct P {
    const float *x, *p, *rel_bias, *g_mix, *w_in, *g_qnorm, *g_knorm, *conv_w, *conv_b, *dt_bias_f, *dt_bias_b, *a_log_f, *a_log_b, *d_skip, *g_ssm,
                *lambda_q1, *lambda_k1, *lambda_q2, *lambda_k2, *g_diff, *g_sgu, *w_spatial, *b_spatial, *w_branch, *w_branch_gate, *w_out, *g_moe, *w_router,
                *w_exp_gate, *w_exp_up, *w_exp_down, *g_ple, *w_ple_gate, *w_ple, *g_final;
    float* out; unsigned char* ws;
    int gp_lo, gp_hi;
};

__device__ __forceinline__ float wave_sum(float v) {
#pragma unroll
    for (int o = 1; o < 64; o <<= 1) v += __shfl_xor(v, o);
    return v;
}
__device__ __forceinline__ float bf2f(unsigned short u) { return __builtin_bit_cast(float, (unsigned)u << 16); }
__device__ __forceinline__ float silu_f(float x) { return x * __builtin_amdgcn_rcpf(1.0f + __builtin_amdgcn_exp2f(-LOG2E * x)); }
__device__ __forceinline__ float gelu_tanh(float x) { const float y = 0.7978845608028654f * (x + 0.044715f * x * x * x); const float e = __builtin_amdgcn_exp2f(2.0f * LOG2E * y); return 0.5f * x * (2.0f - 2.0f * __builtin_amdgcn_rcpf(e + 1.0f)); }
__device__ __forceinline__ float softplus_f(float x) { return fmaxf(x, 0.f) + log1pf(__expf(-fabsf(x))); }
__device__ __forceinline__ f32x4 mfma16(bf16x8 a, bf16x8 b, f32x4 c) { return __builtin_amdgcn_mfma_f32_16x16x32_bf16(a, b, c, 0, 0, 0); }
typedef short bf16x4 __attribute__((ext_vector_type(4)));
typedef unsigned v2u __attribute__((ext_vector_type(2)));

__device__ __forceinline__ void tr_item(const float* W, int ldw, int k0, int scol0, bf16* WT, int ldk, int drow0, LAS float* scr, int lane) {
#pragma unroll 8
    for (int i = 0; i < 32; ++i) { const int kk = 2 * i + (lane >> 5); scr[kk * 33 + (lane & 31)] = W[(size_t)(k0 + kk) * ldw + scol0 + (lane & 31)]; }
    LDS_WAIT(); asm volatile("" ::: "memory");
    const int c = lane & 7;
#pragma unroll
    for (int j = 0; j < 4; ++j) { const int n = (lane >> 3) + 8 * j; const LAS float* s = scr + (8 * c) * 33 + n;
        v4u o; o.x = pk2(s[0 * 33], s[1 * 33]); o.y = pk2(s[2 * 33], s[3 * 33]); o.z = pk2(s[4 * 33], s[5 * 33]); o.w = pk2(s[6 * 33], s[7 * 33]);
        *(GAS v4u*)(WT + (size_t)(drow0 + n) * ldk + k0 + 8 * c) = o; }
    LDS_WAIT(); asm volatile("" ::: "memory");
}
__device__ __forceinline__ int win_src(int drow) {
    return drow < 512 ? drow : drow < 1280 ? 1544 + (drow - 512) : drow < 2304 ? 512 + (drow - 1280) : 2312 + (drow - 2304);
}

__device__ __forceinline__ void ph_convert(const P& a, int L, unsigned char* lds, int gw, int NGW, int wave, int lane, int tid, int gtid, int GT) {
    unsigned char* ws = a.ws;
    LAS float* scr = (LAS float*)((LAS unsigned char*)lds + wave * 16384);
    constexpr int I1 = 16 * 88, I2 = 16 * 128, I3 = 512, I4 = 2048, I5 = 512, I6 = 4 * 32, I7 = NE * 2 * 512, I8 = NE * 512;
    constexpr int NIT = I1 + I2 + I3 + I4 + I5 + I6 + I7 + I8;
    for (int it = gw; it < NIT; it += NGW) {
        int r = it;
        if (r < I1) { const int kb = r / 88, nb = r % 88; tr_item(a.w_in + (size_t)L * 1024 * 2824, 2824, 64 * kb, win_src(32 * nb), (bf16*)(ws + WS_WCAT), 1024, 32 * nb, scr, lane); continue; } r -= I1;
        if (r < I2) { const int kb = r / 128, nb = r % 128; tr_item(a.w_branch_gate + (size_t)L * 1024 * 4096, 4096, 64 * kb, 32 * nb, (bf16*)(ws + WS_WCAT), 1024, NPROJ + 32 * nb, scr, lane); continue; } r -= I2;
        if (r < I3) { const int n = r / 128, rr = r % 128, kb = rr / 32, nb = rr % 32; tr_item(a.w_branch + ((size_t)L * 4 + n) * 256 * 1024, 1024, 64 * kb, 32 * nb, (bf16*)(ws + WS_WBR), 256, n * 1024 + 32 * nb, scr, lane); continue; } r -= I3;
        if (r < I4) { const int n = r / 512, rr = r % 512, kb = rr / 32, nb = rr % 32; tr_item(a.w_out + (size_t)L * 1024 * 1024, 1024, 64 * kb, 32 * nb, (bf16*)(ws + WS_WOUT) + n * 1024, 4096, 32 * nb, scr, lane); continue; } r -= I4;
        if (r < I5) { const int kb = r / 32, nb = r % 32; tr_item(a.w_ple_gate + (size_t)L * 1024 * 1024, 1024, 64 * kb, 32 * nb, (bf16*)(ws + WS_WPG), 1024, 32 * nb, scr, lane); continue; } r -= I5;
        if (r < I6) { const int kb = r / 32, nb = r % 32; tr_item(a.w_ple + (size_t)L * 256 * 1024, 1024, 64 * kb, 32 * nb, (bf16*)(ws + WS_WPLE), 256, 32 * nb, scr, lane); continue; } r -= I6;
        if (r < I7) { const int e = r / 1024, up = (r / 512) & 1, rr = r % 512, kb = rr / 32, nb = rr % 32;
            const float* W = (up ? a.w_exp_up : a.w_exp_gate) + ((size_t)L * NE + e) * 1024 * 1024;
            const int drow = e * 2048 + ((32 * nb) / 128) * 256 + up * 128 + ((32 * nb) % 128);
            tr_item(W, 1024, 64 * kb, 32 * nb, (bf16*)(ws + WS_WGU), 1024, drow, scr, lane); continue; } r -= I7;
        { const int e = r / 512, rr = r % 512, kb = rr / 32, nb = rr % 32;
            tr_item(a.w_exp_down + ((size_t)L * NE + e) * 1024 * 1024, 1024, 64 * kb, 32 * nb, (bf16*)(ws + WS_WDN), 1024, e * 1024 + 32 * nb, scr, lane); }
    }
    {
        const float* ps = a.p + (size_t)L * T * 256; bf16* pd = (bf16*)(ws + WS_PBF);
        for (int i = gtid; i < T * 256 / 8; i += GT) { const f32x4 v0 = ((const f32x4*)ps)[2 * i], v1 = ((const f32x4*)ps)[2 * i + 1];
            v4u o; o.x = pk2(v0[0], v0[1]); o.y = pk2(v0[2], v0[3]); o.z = pk2(v1[0], v1[1]); o.w = pk2(v1[2], v1[3]); ((v4u*)pd)[i] = o; }
        const float* ss = a.w_spatial + (size_t)L * 4 * 128 * 128; bf16* sd = (bf16*)(ws + WS_WSP);
        for (int i = gtid; i < 4 * 128 * 128 / 8; i += GT) { const f32x4 v0 = ((const f32x4*)ss)[2 * i], v1 = ((const f32x4*)ss)[2 * i + 1];
            v4u o; o.x = pk2(v0[0], v0[1]); o.y = pk2(v0[2], v0[3]); o.z = pk2(v1[0], v1[1]); o.w = pk2(v1[2], v1[3]); ((v4u*)sd)[i] = o; }
    }
    __syncthreads();
    LAS float* wdt = (LAS float*)lds;
    { const float* wi = a.w_in + (size_t)L * 1024 * 2824 + 1536;
      for (int i = tid; i < 1024 * 8; i += NTHR) wdt[i] = wi[(size_t)(i >> 3) * 2824 + (i & 7)]; }
    __syncthreads();
    const float* xin = (L == 0) ? a.x : a.out;
    const float* gm = a.g_mix + L * D; bf16* H = (bf16*)(ws + WS_H); float* DT = (float*)(ws + WS_DT);
    f32x4 gv[4];
#pragma unroll
    for (int j = 0; j < 4; ++j) gv[j] = ((const f32x4*)gm)[lane + 64 * j];
    const float bias_l = (lane < 4) ? a.dt_bias_f[L * 4 + (lane & 3)] : a.dt_bias_b[L * 4 + (lane & 3)];
    for (int m = gw; m < T; m += NGW) {
        asm volatile("" ::: "memory");
        const GAS f32x4* xr = (const GAS f32x4*)(xin + (size_t)m * D) + lane;
        f32x4 v[4]; float ss = 0.f;
#pragma unroll
        for (int j = 0; j < 4; ++j) { v[j] = xr[64 * j]; ss += (v[j][0] * v[j][0] + v[j][1] * v[j][1]) + (v[j][2] * v[j][2] + v[j][3] * v[j][3]); }
        const float rs = 1.0f / sqrtf(wave_sum(ss) * (1.0f / D) + EPS);
        float d8[8] = {0.f, 0.f, 0.f, 0.f, 0.f, 0.f, 0.f, 0.f};
        GAS unsigned long long* o8 = (GAS unsigned long long*)(H + (size_t)m * D) + lane;
#pragma unroll
        for (int j = 0; j < 4; ++j) { v[j] = v[j] * rs * gv[j];
            o8[64 * j] = (unsigned long long)pk2(v[j][0], v[j][1]) | ((unsigned long long)pk2(v[j][2], v[j][3]) << 32);
#pragma unroll
            for (int c = 0; c < 4; ++c) { const LAS f32x4* wr = (const LAS f32x4*)(wdt + (256 * j + 4 * lane + c) * 8); const f32x4 w0 = wr[0], w1 = wr[1];
                d8[0] += v[j][c] * w0[0]; d8[1] += v[j][c] * w0[1]; d8[2] += v[j][c] * w0[2]; d8[3] += v[j][c] * w0[3];
                d8[4] += v[j][c] * w1[0]; d8[5] += v[j][c] * w1[1]; d8[6] += v[j][c] * w1[2]; d8[7] += v[j][c] * w1[3]; } }
#pragma unroll
        for (int i = 0; i < 8; ++i) d8[i] = wave_sum(d8[i]);
        const float mine = lane == 0 ? d8[0] : lane == 1 ? d8[1] : lane == 2 ? d8[2] : lane == 3 ? d8[3] : lane == 4 ? d8[4] : lane == 5 ? d8[5] : lane == 6 ? d8[6] : d8[7];
        if (lane < 8) DT[(size_t)m * 8 + lane] = softplus_f(mine + bias_l);
    }
    __syncthreads();
}

__device__ __forceinline__ void ph_rope(const P& a, int L, int gw, int NGW, int lane) {
    bf16* PROJ = (bf16*)(a.ws + WS_PROJ);
    const int head = lane >> 3, j8 = lane & 7; const bool act = head < 6;
    const int hc = act ? head : 5;
    const float* gsrc = (hc < 4 ? a.g_qnorm : a.g_knorm) + L * 64 + j8 * 8;
    float g[8], fr[8];
#pragma unroll
    for (int i = 0; i < 8; ++i) { g[i] = gsrc[i]; fr[i] = __builtin_amdgcn_exp2f(-(float)(8 * (j8 & 1) + i) * (13.287712379549449f / 16.0f)) * 0.15915494309189535f; }
    const float osc = hc < 4 ? 0.125f * LOG2E : 1.0f;
    for (int m = gw; m < T; m += NGW) {
        const int s = m & (S - 1); const float pos = (float)((j8 & 4) ? (s & 63) : (s >> 6));
        bf16* ptr = PROJ + (size_t)m * LDP + hc * 64 + j8 * 8;
        const v4u raw = *(const v4u*)ptr;
        float v[8]; v[0] = pg8::bf_lo(raw.x); v[1] = pg8::bf_hi(raw.x); v[2] = pg8::bf_lo(raw.y); v[3] = pg8::bf_hi(raw.y); v[4] = pg8::bf_lo(raw.z); v[5] = pg8::bf_hi(raw.z); v[6] = pg8::bf_lo(raw.w); v[7] = pg8::bf_hi(raw.w);
        float ss = 0.f;
#pragma unroll
        for (int i = 0; i < 8; ++i) ss += v[i] * v[i];
        ss += __shfl_xor(ss, 1); ss += __shfl_xor(ss, 2); ss += __shfl_xor(ss, 4);
        const float rn = 1.0f / sqrtf(ss * (1.0f / 64.0f) + EPS);
        float o[8];
#pragma unroll
        for (int i = 0; i < 8; ++i) { const float y = v[i] * rn * g[i]; const float pr = __shfl_xor(y, 2);
            const float rev = __builtin_amdgcn_fractf(pos * fr[i]); const float sn = __builtin_amdgcn_sinf(rev), cs = __builtin_amdgcn_cosf(rev);
            o[i] = ((j8 & 2) ? (pr * sn + y * cs) : (y * cs - pr * sn)) * osc; }
        if (act) { v4u w; w.x = pk2(o[0], o[1]); w.y = pk2(o[2], o[3]); w.z = pk2(o[4], o[5]); w.w = pk2(o[6], o[7]); *(v4u*)ptr = w; }
    }
}
__device__ __forceinline__ float wave_incl_scan(float v, int lane) {
#pragma unroll
    for (int o = 1; o < 64; o <<= 1) { const float t = __shfl_up(v, o); if (lane >= o) v += t; }
    return v;
}
constexpr int LP = 136;
__device__ __forceinline__ void ssd1_unit(const P& a, int L, int u, unsigned char* ldsg, int wave, int lane, int tid) {
    LAS unsigned char* lds = (LAS unsigned char*)ldsg;
    LAS bf16* XW = (LAS bf16*)lds;
    LAS bf16* BT = (LAS bf16*)(lds + 69632);
    LAS f32x4* TABL = (LAS f32x4*)(lds + 104448);
    LAS float* WV = (LAS float*)(lds + 108544);
    LAS float* DTL = (LAS float*)(lds + 110592);
    const int g = u & 1, c = (u >> 1) & 127, b = u >> 8;
    const size_t t0 = (size_t)b * S + c * 128; const int s0 = c * 128;
    const bf16* PROJ = (const bf16*)(a.ws + WS_PROJ); bf16* XBC = (bf16*)(a.ws + WS_XBC);
    if (tid < 256) ((LAS f32x4*)DTL)[tid] = ((const f32x4*)((const float*)(a.ws + WS_DT) + t0 * 8))[tid];
    __syncthreads();
    if (wave < 4) {
        const int hl = wave >> 1, dir = wave & 1, h = 2 * g + hl;
        const float av = -__expf((dir ? a.a_log_b : a.a_log_f)[L * 4 + h]);
        const float d0 = DTL[(2 * lane) * 8 + dir * 4 + h], d1 = DTL[(2 * lane + 1) * 8 + dir * 4 + h];
        const float e0 = d0 * av, e1 = d1 * av, sm = e0 + e1;
        const float incl = wave_incl_scan(sm, lane), excl = incl - sm, tot = __shfl(incl, 63);
        const float P0 = excl + e0, P1 = incl;
        LAS float* tl0 = (LAS float*)&TABL[hl * 128 + 2 * lane]; LAS float* tl1 = (LAS float*)&TABL[hl * 128 + 2 * lane + 1];
        if (dir == 0) { tl0[0] = P0; tl1[0] = P1; tl0[2] = d0; tl1[2] = d1;
            WV[wave * 128 + 2 * lane] = d0 * __expf(tot - P0); WV[wave * 128 + 2 * lane + 1] = d1 * __expf(tot - P1); }
        else { tl0[1] = tot - P0 + e0; tl1[1] = tot - P1 + e1; tl0[3] = d0; tl1[3] = d1;
            WV[wave * 128 + 2 * lane] = d0 * __expf(P0 - e0); WV[wave * 128 + 2 * lane + 1] = d1 * __expf(P1 - e1); }
        if (lane == 0) ((float*)(a.ws + WS_CD))[(((size_t)b * 128 + c) * 4 + h) * 2 + dir] = __expf(tot);
    }
    __syncthreads();
    if (tid < 256) ((f32x4*)(a.ws + WS_TAB))[(((size_t)b * 128 + c) * 4 + 2 * g) * 128 + tid] = TABL[tid];
    const int cg = tid & 15, seg = tid >> 4, l0 = 4 * seg;
#pragma unroll 1
    for (int pass = 0; pass < 3; ++pass) {
        const int ch0 = pass * 256 + g * 128 + cg * 8;
        const float* cw = a.conv_w + (size_t)L * 5 * 768 + ch0; const float* cb = a.conv_b + (size_t)L * 768 + ch0;
        float w[5][8], bs[8];
#pragma unroll
        for (int j = 0; j < 5; ++j) { const f32x4 w0 = *(const f32x4*)(cw + j * 768), w1 = *(const f32x4*)(cw + j * 768 + 4);
            w[j][0] = w0[0]; w[j][1] = w0[1]; w[j][2] = w0[2]; w[j][3] = w0[3]; w[j][4] = w1[0]; w[j][5] = w1[1]; w[j][6] = w1[2]; w[j][7] = w1[3]; }
        { const f32x4 b0 = *(const f32x4*)cb, b1 = *(const f32x4*)(cb + 4); bs[0] = b0[0]; bs[1] = b0[1]; bs[2] = b0[2]; bs[3] = b0[3]; bs[4] = b1[0]; bs[5] = b1[1]; bs[6] = b1[2]; bs[7] = b1[3]; }
        float acc[4][8];
#pragma unroll
        for (int tk = 0; tk < 4; ++tk)
#pragma unroll
            for (int i = 0; i < 8; ++i) acc[tk][i] = bs[i];
#pragma unroll
        for (int rr = 0; rr < 8; ++rr) {
            const int pos = s0 + l0 - 2 + rr; v4u raw = (v4u){0u, 0u, 0u, 0u};
            if (pos >= 0 && pos < S) raw = *(const v4u*)(PROJ + ((size_t)b * S + pos) * LDP + PC_XS + ch0);
            float in[8]; in[0] = pg8::bf_lo(raw.x); in[1] = pg8::bf_hi(raw.x); in[2] = pg8::bf_lo(raw.y); in[3] = pg8::bf_hi(raw.y); in[4] = pg8::bf_lo(raw.z); in[5] = pg8::bf_hi(raw.z); in[6] = pg8::bf_lo(raw.w); in[7] = pg8::bf_hi(raw.w);
#pragma unroll
            for (int tk = 0; tk < 4; ++tk) { const int j = rr - tk; if (j >= 0 && j < 5) {
#pragma unroll
                for (int i = 0; i < 8; ++i) acc[tk][i] += w[j][i] * in[i]; } }
        }
#pragma unroll
        for (int tk = 0; tk < 4; ++tk) {
#pragma unroll
            for (int i = 0; i < 8; ++i) acc[tk][i] = silu_f(acc[tk][i]);
            v4u o; o.x = pk2(acc[tk][0], acc[tk][1]); o.y = pk2(acc[tk][2], acc[tk][3]); o.z = pk2(acc[tk][4], acc[tk][5]); o.w = pk2(acc[tk][6], acc[tk][7]);
            *(v4u*)(XBC + (t0 + l0 + tk) * 768 + ch0) = o; }
        if (pass == 0) {
            const int hl = cg >> 3, p0 = (cg & 7) * 8;
#pragma unroll
            for (int dir = 0; dir < 2; ++dir) { const int hd = hl * 2 + dir; const f32x4 wv = *(const LAS f32x4*)(WV + hd * 128 + l0);
#pragma unroll
                for (int i = 0; i < 8; ++i) { v2u o; o.x = pk2(acc[0][i] * wv[0], acc[1][i] * wv[1]); o.y = pk2(acc[2][i] * wv[2], acc[3][i] * wv[3]);
                    *(LAS v2u*)(XW + (hd * 64 + p0 + i) * LP + l0) = o; } }
        } else if (pass == 1) {
#pragma unroll
            for (int i = 0; i < 8; ++i) { v2u o; o.x = pk2(acc[0][i], acc[1][i]); o.y = pk2(acc[2][i], acc[3][i]); *(LAS v2u*)(BT + (cg * 8 + i) * LP + l0) = o; }
        }
    }
    __syncthreads();
    {
        const int hd = wave >> 1, ph = wave & 1, fr = lane & 15, fq = lane >> 4;
        f32x4 acc[2][8];
#pragma unroll
        for (int mt = 0; mt < 2; ++mt)
#pragma unroll
            for (int nt = 0; nt < 8; ++nt) acc[mt][nt] = (f32x4){0.f, 0.f, 0.f, 0.f};
#pragma unroll
        for (int ks = 0; ks < 4; ++ks) {
            bf16x8 af[2];
#pragma unroll
            for (int mt = 0; mt < 2; ++mt) af[mt] = *(const LAS bf16x8*)(XW + (hd * 64 + ph * 32 + mt * 16 + fr) * LP + 32 * ks + 8 * fq);
#pragma unroll
            for (int nt = 0; nt < 8; ++nt) { const bf16x8 bfr = *(const LAS bf16x8*)(BT + (16 * nt + fr) * LP + 32 * ks + 8 * fq);
#pragma unroll
                for (int mt = 0; mt < 2; ++mt) acc[mt][nt] = mfma16(af[mt], bfr, acc[mt][nt]); }
        }
        const int hl = hd >> 1, dir = hd & 1, h = 2 * g + hl;
        float* ST = (float*)(a.ws + WS_ST) + ((((size_t)b * 128 + c) * 4 + h) * 2 + dir) * 8192;
#pragma unroll
        for (int mt = 0; mt < 2; ++mt)
#pragma unroll
            for (int nt = 0; nt < 8; ++nt)
#pragma unroll
                for (int ii = 0; ii < 4; ++ii) ST[(ph * 32 + mt * 16 + 4 * fq + ii) * 128 + 16 * nt + fr] = acc[mt][nt][ii];
    }
    __syncthreads();
}

__device__ __forceinline__ void ph_scan(const P& a, int gtid, int GT) {
    const float* ST = (const float*)(a.ws + WS_ST); bf16* SB = (bf16*)(a.ws + WS_SB); const float* CD = (const float*)(a.ws + WS_CD);
    for (int e = gtid; e < NB * 4 * 2 * 8192; e += GT) {
        const int b = e >> 16, rem = e & 65535, dir = (rem >> 13) & 1, h = rem >> 14;
        float st = 0.f;
#pragma unroll 1
        for (int c8 = 0; c8 < 128; c8 += 8) {
            float cs[8], cd[8];
#pragma unroll
            for (int k = 0; k < 8; ++k) { const int c = dir ? 127 - (c8 + k) : (c8 + k); cs[k] = ST[((size_t)b * 128 + c) * 65536 + rem]; cd[k] = CD[(((size_t)b * 128 + c) * 4 + h) * 2 + dir]; }
#pragma unroll
            for (int k = 0; k < 8; ++k) { const int c = dir ? 127 - (c8 + k) : (c8 + k); SB[((size_t)b * 128 + c) * 65536 + rem] = (bf16)f2bf(st); st = st * cd[k] + cs[k]; }
        }
    }
}

__device__ __forceinline__ void ssd3_unit(const P& a, int L, int u, unsigned char* ldsg, int wave, int lane, int tid) {
    LAS unsigned char* lds = (LAS unsigned char*)ldsg;
    LAS bf16* CG = (LAS bf16*)lds;
    LAS bf16* BG = (LAS bf16*)(lds + 34816);
    LAS bf16* XT = (LAS bf16*)(lds + 69632);
    LAS f32x4* TB = (LAS f32x4*)(lds + 87040);
    const int h = u & 3, c = (u >> 2) & 127, b = u >> 9, g = h >> 1; const size_t t0 = (size_t)b * S + c * 128;
    const bf16* XBC = (const bf16*)(a.ws + WS_XBC); const bf16* SB = (const bf16*)(a.ws + WS_SB); const bf16* PROJ = (const bf16*)(a.ws + WS_PROJ);
    const int fr = lane & 15, fq = lane >> 4, w = wave;
#pragma unroll
    for (int i = 0; i < 4; ++i) { const int q = tid + 512 * i, row = q >> 4, pc = q & 15;
        const bf16* src = XBC + (t0 + row) * 768 + g * 128 + pc * 8;
        *(LAS v4u*)(CG + row * LP + pc * 8) = *(const v4u*)(src + 512);
        *(LAS v4u*)(BG + row * LP + pc * 8) = *(const v4u*)(src + 256); }
#pragma unroll
    for (int i = 0; i < 2; ++i) { const int q = tid + 512 * i, row = q >> 3, pc = q & 7;
        const v4u xr = *(const v4u*)(XBC + (t0 + row) * 768 + h * 64 + pc * 8);
        LAS bf16* xd = XT + (pc * 8) * LP + row;
        xd[0 * LP] = (bf16)(xr.x & 0xffffu); xd[1 * LP] = (bf16)(xr.x >> 16); xd[2 * LP] = (bf16)(xr.y & 0xffffu); xd[3 * LP] = (bf16)(xr.y >> 16);
        xd[4 * LP] = (bf16)(xr.z & 0xffffu); xd[5 * LP] = (bf16)(xr.z >> 16); xd[6 * LP] = (bf16)(xr.w & 0xffffu); xd[7 * LP] = (bf16)(xr.w >> 16); }
    if (tid < 128) TB[tid] = ((const f32x4*)(a.ws + WS_TAB))[(((size_t)b * 128 + c) * 4 + h) * 128 + tid];
    __syncthreads();
    f32x4 Y[4];
#pragma unroll
    for (int pt = 0; pt < 4; ++pt) Y[pt] = (f32x4){0.f, 0.f, 0.f, 0.f};
    bf16x8 cf[4];
#pragma unroll
    for (int ks = 0; ks < 4; ++ks) cf[ks] = *(const LAS bf16x8*)(CG + (16 * w + fr) * LP + 32 * ks + 8 * fq);
    {
        f32x4 Gt[8];
#pragma unroll
        for (int j = 0; j < 8; ++j) { Gt[j] = (f32x4){0.f, 0.f, 0.f, 0.f};
#pragma unroll
            for (int ks = 0; ks < 4; ++ks) Gt[j] = mfma16(*(const LAS bf16x8*)(BG + (16 * j + fr) * LP + 32 * ks + 8 * fq), cf[ks], Gt[j]); }
        const int lrow = 16 * w + fr;
        const f32x4 tl = TB[lrow];
        bf16x8 wf[4];
#pragma unroll
        for (int ks = 0; ks < 4; ++ks) { float wv[8];
#pragma unroll
            for (int hf = 0; hf < 2; ++hf)
#pragma unroll
                for (int ii = 0; ii < 4; ++ii) { const int j = 2 * ks + hf, s = 16 * j + 4 * fq + ii; const f32x4 ts = TB[s];
                    const float mf = ts[2] * __expf(fminf(tl[0] - ts[0], 0.f)), mb = ts[3] * __expf(fminf(tl[1] - ts[1], 0.f));
                    const float mm = (s < lrow) ? mf : (s > lrow) ? mb : (ts[2] + ts[3]);
                    wv[hf * 4 + ii] = Gt[j][ii] * mm; }
            v4u pk; pk.x = pk2(wv[0], wv[1]); pk.y = pk2(wv[2], wv[3]); pk.z = pk2(wv[4], wv[5]); pk.w = pk2(wv[6], wv[7]); wf[ks] = __builtin_bit_cast(bf16x8, pk); }
#pragma unroll
        for (int pt = 0; pt < 4; ++pt)
#pragma unroll
            for (int ks = 0; ks < 4; ++ks) { const LAS bf16* xp = XT + (16 * pt + fr) * LP + 32 * ks + 4 * fq;
                const v2u x0 = *(const LAS v2u*)xp, x1 = *(const LAS v2u*)(xp + 16); const v4u xx = (v4u){x0.x, x0.y, x1.x, x1.y};
                Y[pt] = mfma16(wf[ks], __builtin_bit_cast(bf16x8, xx), Y[pt]); }
    }
#pragma unroll
    for (int dir = 0; dir < 2; ++dir) {
        const bf16* Sp = SB + ((((size_t)b * 128 + c) * 4 + h) * 2 + dir) * 8192;
        f32x4 Tt[4];
#pragma unroll
        for (int pt = 0; pt < 4; ++pt) { Tt[pt] = (f32x4){0.f, 0.f, 0.f, 0.f};
#pragma unroll
            for (int ks = 0; ks < 4; ++ks) Tt[pt] = mfma16(cf[ks], *(const bf16x8*)(Sp + (16 * pt + fr) * 128 + 32 * ks + 8 * fq), Tt[pt]); }
#pragma unroll
        for (int ii = 0; ii < 4; ++ii) { const f32x4 tr = TB[16 * w + 4 * fq + ii]; const float e = __expf(dir ? tr[1] : tr[0]);
#pragma unroll
            for (int pt = 0; pt < 4; ++pt) Y[pt][ii] += e * Tt[pt][ii]; }
    }
    const float dsk = a.d_skip[L * 4 + h];
#pragma unroll
    for (int pt = 0; pt < 4; ++pt) { const v2u xv = *(const LAS v2u*)(XT + (16 * pt + fr) * LP + 16 * w + 4 * fq);
        Y[pt][0] += dsk * pg8::bf_lo(xv.x); Y[pt][1] += dsk * pg8::bf_hi(xv.x); Y[pt][2] += dsk * pg8::bf_lo(xv.y); Y[pt][3] += dsk * pg8::bf_hi(xv.y); }
    float ss[4] = {0.f, 0.f, 0.f, 0.f};
    bf16* BR = (bf16*)(a.ws + WS_BR);
#pragma unroll
    for (int pt = 0; pt < 4; ++pt) { const int ch = h * 64 + 16 * pt + fr; const float gn = a.g_ssm[L * 256 + ch];
#pragma unroll
        for (int ii = 0; ii < 4; ++ii) { const size_t t = t0 + 16 * w + 4 * fq + ii;
            const float z = bf2f(PROJ[t * LDP + PC_Z + ch]); const float y = Y[pt][ii] * silu_f(z); ss[ii] += y * y;
            BR[t * 1024 + 256 + ch] = (bf16)f2bf(y * gn); } }
    float* SSQ = (float*)(a.ws + WS_SSQ);
#pragma unroll
    for (int ii = 0; ii < 4; ++ii) { float s = ss[ii]; s += __shfl_xor(s, 1); s += __shfl_xor(s, 2); s += __shfl_xor(s, 4); s += __shfl_xor(s, 8);
        if (fr == 0) SSQ[(t0 + 16 * w + 4 * fq + ii) * 4 + h] = s; }
    __syncthreads();
}

__device__ __forceinline__ void sgu_unit(const P& a, int L, int u, unsigned char* ldsg, int wave, int lane, int tid) {
    LAS bf16* VT = (LAS bf16*)(LAS unsigned char*)ldsg;
    const int b = u >> 7, c = u & 127; const size_t t0 = (size_t)b * S + c * 128;
    const bf16* PROJ = (const bf16*)(a.ws + WS_PROJ); bf16* BR = (bf16*)(a.ws + WS_BR); const bf16* WSP = (const bf16*)(a.ws + WS_WSP);
    const f32x4 gs = *(const f32x4*)(a.g_sgu + L * 256 + 4 * lane);
#pragma unroll 1
    for (int k = 0; k < 16; ++k) { const int s = 16 * wave + k;
        const v2u raw = *(const v2u*)(PROJ + (t0 + s) * LDP + PC_UV + 256 + 4 * lane);
        float v[4]; v[0] = gelu_tanh(pg8::bf_lo(raw.x)); v[1] = gelu_tanh(pg8::bf_hi(raw.x)); v[2] = gelu_tanh(pg8::bf_lo(raw.y)); v[3] = gelu_tanh(pg8::bf_hi(raw.y));
        const float rn = 1.0f / sqrtf(wave_sum(v[0] * v[0] + v[1] * v[1] + v[2] * v[2] + v[3] * v[3]) * (1.0f / 256.0f) + EPS);
#pragma unroll
        for (int i = 0; i < 4; ++i) VT[(4 * lane + i) * LP + s] = (bf16)f2bf(v[i] * rn * gs[i]); }
    __syncthreads();
    const int g = wave >> 1, th = wave & 1, fr = lane & 15, fq = lane >> 4;
    f32x4 acc[4][4];
#pragma unroll
    for (int mt = 0; mt < 4; ++mt)
#pragma unroll
        for (int nt = 0; nt < 4; ++nt) acc[mt][nt] = (f32x4){0.f, 0.f, 0.f, 0.f};
#pragma unroll
    for (int ks = 0; ks < 4; ++ks) {
        bf16x8 af[4];
#pragma unroll
        for (int mt = 0; mt < 4; ++mt) af[mt] = *(const bf16x8*)(WSP + (size_t)(g * 128 + 64 * th + 16 * mt + fr) * 128 + 32 * ks + 8 * fq);
#pragma unroll
        for (int nt = 0; nt < 4; ++nt) { const bf16x8 bfr = *(const LAS bf16x8*)(VT + (g * 64 + 16 * nt + fr) * LP + 32 * ks + 8 * fq);
#pragma unroll
            for (int mt = 0; mt < 4; ++mt) acc[mt][nt] = mfma16(af[mt], bfr, acc[mt][nt]); }
    }
#pragma unroll
    for (int mt = 0; mt < 4; ++mt)
#pragma unroll
        for (int ii = 0; ii < 4; ++ii) { const int tl = 64 * th + 16 * mt + 4 * fq + ii; const float bsv = a.b_spatial[(L * 4 + g) * 128 + tl];
#pragma unroll
            for (int nt = 0; nt < 4; ++nt) { const int ch = g * 64 + 16 * nt + fr;
                const float uu = gelu_tanh(bf2f(PROJ[(t0 + tl) * LDP + PC_UV + ch]));
                BR[(t0 + tl) * 1024 + 768 + ch] = (bf16)f2bf(uu * (acc[mt][nt][ii] + bsv)); } }
    __syncthreads();
}
__device__ __forceinline__ void ph_r1(const P& a, int L, unsigned char* ldsg, int gw, int NGW, int lane, int tid) {
    LAS float* wrt = (LAS float*)(LAS unsigned char*)ldsg;
    { const float* wr = a.w_router + (size_t)L * 1024 * 16; for (int i = tid; i < 1024 * 16 / 4; i += NTHR) ((LAS f32x4*)wrt)[i] = ((const f32x4*)wr)[i]; }
    __syncthreads();
    const float* gm = a.g_moe + L * D; bf16* H = (bf16*)(a.ws + WS_H); float* AFF = (float*)(a.ws + WS_AFF); short* INV = (short*)(a.ws + WS_INV);
    f32x4 gv[4];
#pragma unroll
    for (int j = 0; j < 4; ++j) gv[j] = ((const f32x4*)gm)[lane + 64 * j];
    for (int m = gw; m < T; m += NGW) {
        asm volatile("" ::: "memory");
        const GAS f32x4* xr = (const GAS f32x4*)(a.out + (size_t)m * D) + lane;
        f32x4 v[4]; float ss = 0.f;
#pragma unroll
        for (int j = 0; j < 4; ++j) { v[j] = xr[64 * j]; ss += (v[j][0] * v[j][0] + v[j][1] * v[j][1]) + (v[j][2] * v[j][2] + v[j][3] * v[j][3]); }
        const float rs = 1.0f / sqrtf(wave_sum(ss) * (1.0f / D) + EPS);
        float lg[16];
#pragma unroll
        for (int i = 0; i < 16; ++i) lg[i] = 0.f;
        GAS unsigned long long* o8 = (GAS unsigned long long*)(H + (size_t)m * D) + lane;
#pragma unroll
        for (int j = 0; j < 4; ++j) { v[j] = v[j] * rs * gv[j];
            o8[64 * j] = (unsigned long long)pk2(v[j][0], v[j][1]) | ((unsigned long long)pk2(v[j][2], v[j][3]) << 32);
#pragma unroll
            for (int c = 0; c < 4; ++c) { const LAS f32x4* wr = (const LAS f32x4*)(wrt + (256 * j + 4 * lane + c) * 16);
#pragma unroll
                for (int q = 0; q < 4; ++q) { const f32x4 w4 = wr[q]; lg[4 * q] += v[j][c] * w4[0]; lg[4 * q + 1] += v[j][c] * w4[1]; lg[4 * q + 2] += v[j][c] * w4[2]; lg[4 * q + 3] += v[j][c] * w4[3]; } } }
        float mx = -3.0e38f;
#pragma unroll
        for (int i = 0; i < 16; ++i) { lg[i] = wave_sum(lg[i]); mx = fmaxf(mx, lg[i]); }
        float sum = 0.f;
#pragma unroll
        for (int i = 0; i < 16; ++i) { lg[i] = __expf(lg[i] - mx); sum += lg[i]; }
        float mine = lg[0];
#pragma unroll
        for (int i = 1; i < 16; ++i) mine = (lane == i) ? lg[i] : mine;
        const int b = m / S, s = m % S;
        if (lane < 16) AFF[((size_t)b * NE + lane) * S + s] = mine / sum;
        if (lane < 2) ((GAS v4u*)(INV + (size_t)m * NE))[lane] = (v4u){0xffffffffu, 0xffffffffu, 0xffffffffu, 0xffffffffu};
    }
    __syncthreads();
}

__device__ __forceinline__ void sel_unit(const P& a, int q, unsigned char* ldsg, int wave, int lane, int tid) {
    LAS unsigned* vals = (LAS unsigned*)(LAS unsigned char*)ldsg;
    LAS unsigned* hist = vals + S;
    LAS unsigned* sc = hist + 256;
    const int b = q / NE, e = q % NE;
    const float* AFF = (const float*)(a.ws + WS_AFF) + ((size_t)b * NE + e) * S;
    for (int i = tid; i < S; i += NTHR) vals[i] = __float_as_uint(AFF[i]);
    unsigned prefix = 0u, mask = 0u, kk = CAP;
#pragma unroll 1
    for (int pass = 0; pass < 4; ++pass) {
        const int shift = 24 - 8 * pass;
        if (tid < 256) hist[tid] = 0u;
        __syncthreads();
        for (int i = tid; i < S; i += NTHR) { const unsigned v = vals[i]; if ((v & mask) == prefix) __hip_atomic_fetch_add(&hist[(v >> shift) & 255u], 1u, __ATOMIC_RELAXED, __HIP_MEMORY_SCOPE_WORKGROUP); }
        __syncthreads();
        if (wave == 0) {
            unsigned c4[4]; unsigned s4 = 0u;
#pragma unroll
            for (int j = 0; j < 4; ++j) { c4[j] = hist[4 * lane + j]; s4 += c4[j]; }
            unsigned suf = s4;
#pragma unroll
            for (int o = 1; o < 64; o <<= 1) { const unsigned t = __shfl_down(suf, o); if (lane + o < 64) suf += t; }
            unsigned cum = suf - s4;
#pragma unroll
            for (int j = 3; j >= 0; --j) { if (cum < kk && cum + c4[j] >= kk) { sc[0] = prefix | ((unsigned)(4 * lane + j) << shift); sc[1] = kk - cum; } cum += c4[j]; }
        }
        __syncthreads();
        prefix = sc[0]; kk = sc[1]; mask |= 255u << shift;
        __syncthreads();
    }
    const unsigned thr = prefix, need_eq = kk, total_gt = CAP - kk;
    unsigned cg = 0u, ce = 0u;
    for (int j = 0; j < 32; ++j) { const unsigned v = vals[32 * tid + ((j + tid) & 31)]; cg += (v > thr) ? 1u : 0u; ce += (v == thr) ? 1u : 0u; }
    unsigned pk = (cg << 16) | ce, inc = pk;
#pragma unroll
    for (int o = 1; o < 64; o <<= 1) { const unsigned t = __shfl_up(inc, o); if (lane >= o) inc += t; }
    if (lane == 63) sc[8 + wave] = inc;
    __syncthreads();
    unsigned base = 0u;
    for (int w2 = 0; w2 < wave; ++w2) base += sc[8 + w2];
    const unsigned exc = base + inc - pk; unsigned pg = exc >> 16, pe = exc & 0xffffu;
    int* SELIDX = (int*)(a.ws + WS_SELIDX) + (size_t)e * (NB * CAP) + b * CAP; float* SELAFF = (float*)(a.ws + WS_SELAFF) + (size_t)e * (NB * CAP) + b * CAP;
    short* INV = (short*)(a.ws + WS_INV);
    for (int j = 0; j < 32; ++j) { const int idx = 32 * tid + j; const unsigned v = vals[idx]; int slot = -1;
        if (v > thr) { slot = (int)pg; ++pg; } else if (v == thr) { if (pe < need_eq) slot = (int)(total_gt + pe); ++pe; }
        if (slot >= 0) { SELIDX[slot] = idx; SELAFF[slot] = __uint_as_float(v); INV[((size_t)b * S + idx) * NE + e] = (short)slot; } }
    __syncthreads();
}

__device__ __forceinline__ void ph_gather(const P& a, int gw, int NGW, int lane) {
    const int* SELIDX = (const int*)(a.ws + WS_SELIDX); const bf16* H = (const bf16*)(a.ws + WS_H); bf16* XE = (bf16*)(a.ws + WS_XE);
    for (int r = gw; r < NE * NB * CAP; r += NGW) { const int b = (r >> 11) & 1; const int tok = SELIDX[r];
        const v4u* src = (const v4u*)(H + ((size_t)b * S + tok) * D); v4u* dst = (v4u*)(XE + (size_t)r * D);
        const v4u v0 = src[lane], v1 = src[lane + 64]; dst[lane] = v0; dst[lane + 64] = v1; }
}

__device__ __forceinline__ void ph_r2(const P& a, int L, int gw, int NGW, int lane) {
    const float* gm = a.g_ple + L * D; bf16* H = (bf16*)(a.ws + WS_H); const short* INV = (const short*)(a.ws + WS_INV); const bf16* YE = (const bf16*)(a.ws + WS_YE);
    f32x4 gv[4];
#pragma unroll
    for (int j = 0; j < 4; ++j) gv[j] = ((const f32x4*)gm)[lane + 64 * j];
    for (int m = gw; m < T; m += NGW) {
        GAS f32x4* xr = (GAS f32x4*)(a.out + (size_t)m * D) + lane;
        f32x4 v[4];
#pragma unroll
        for (int j = 0; j < 4; ++j) v[j] = xr[64 * j];
        const int b = m / S;
        const short myinv = INV[(size_t)m * NE + (lane & 15)];
#pragma unroll 1
        for (int e = 0; e < NE; ++e) { const int slot = __builtin_amdgcn_readfirstlane((int)__shfl((int)myinv, e));
            if (slot >= 0) { const v2u* yr = (const v2u*)(YE + ((size_t)e * (NB * CAP) + b * CAP + slot) * D) + lane;
#pragma unroll
                for (int j = 0; j < 4; ++j) { const v2u y = yr[64 * j]; v[j][0] += pg8::bf_lo(y.x); v[j][1] += pg8::bf_hi(y.x); v[j][2] += pg8::bf_lo(y.y); v[j][3] += pg8::bf_hi(y.y); } } }
        float ss = 0.f;
#pragma unroll
        for (int j = 0; j < 4; ++j) { xr[64 * j] = v[j]; ss += (v[j][0] * v[j][0] + v[j][1] * v[j][1]) + (v[j][2] * v[j][2] + v[j][3] * v[j][3]); }
        const float rs = 1.0f / sqrtf(wave_sum(ss) * (1.0f / D) + EPS);
        GAS unsigned long long* o8 = (GAS unsigned long long*)(H + (size_t)m * D) + lane;
#pragma unroll
        for (int j = 0; j < 4; ++j) { const f32x4 hv = v[j] * rs * gv[j]; o8[64 * j] = (unsigned long long)pk2(hv[0], hv[1]) | ((unsigned long long)pk2(hv[2], hv[3]) << 32); }
    }
}
__device__ __forceinline__ void ph_final(const P& a, int gw, int NGW, int lane) {
    f32x4 gv[4];
#pragma unroll
    for (int j = 0; j < 4; ++j) gv[j] = ((const f32x4*)a.g_final)[lane + 64 * j];
    for (int m = gw; m < T; m += NGW) {
        GAS f32x4* xr = (GAS f32x4*)(a.out + (size_t)m * D) + lane;
        f32x4 v[4]; float ss = 0.f;
#pragma unroll
        for (int j = 0; j < 4; ++j) { v[j] = xr[64 * j]; ss += (v[j][0] * v[j][0] + v[j][1] * v[j][1]) + (v[j][2] * v[j][2] + v[j][3] * v[j][3]); }
        const float rs = 1.0f / sqrtf(wave_sum(ss) * (1.0f / D) + EPS);
#pragma unroll
        for (int j = 0; j < 4; ++j) xr[64 * j] = v[j] * rs * gv[j];
    }
}

#ifndef PHMASK
#define PHMASK 0xFFFFu
#endif
__global__ void __launch_bounds__(NTHR, 2) mk_fwd(P a) {
    extern __shared__ __attribute__((aligned(16))) unsigned char lds[];
    const int G = gridDim.x, bx = blockIdx.x, NGW = G * NWAVES, GT = G * NTHR;
    unsigned char* ws = a.ws;
    gu32* ctl = (gu32*)(ws + WS_CTL);
    volatile LAS unsigned* MISC = (volatile LAS unsigned*)((LAS unsigned char*)lds + MISC_OFF);
    for (int u = threadIdx.x; u < (LDS_BYTES - LDSCTL_OFF) / 4; u += NTHR) ((LAS unsigned*)((LAS unsigned char*)lds + LDSCTL_OFF))[u] = 0u;
    __syncthreads();
    const bool multi = (a.gp_hi - a.gp_lo) > 1;
    XcdBarrier bar; bar.bar = (unsigned*)(ctl + CW_BAR); bar.x = 0; bar.st = nullptr;
    if (multi) bar = xcd_barrier_post((unsigned*)(ctl + CW_BAR), MISC + 8);
    const int lo = a.gp_lo, hi = a.gp_hi;
#define IN(k) (((PHMASK >> (((k) < DEPTH * NPH) ? ((k) % NPH) : 14)) & 1u) && lo <= (k) && (k) < hi)
#define SEAM(k) do { if (IN(k) && IN((k) + 1)) xcd_barrier(bar); } while (0)
#define PHASE_IDS() int tid = threadIdx.x; asm volatile("" : "+v"(tid)); const int lane = tid & 63; const int wave = __builtin_amdgcn_readfirstlane(tid >> 6); \
    const int gw = bx * NWAVES + wave; const int gtid = bx * NTHR + tid; (void)lane; (void)gw; (void)gtid
    bf16* H = (bf16*)(ws + WS_H); bf16* PROJ = (bf16*)(ws + WS_PROJ); bf16* GATES = (bf16*)(ws + WS_GATES); bf16* BR = (bf16*)(ws + WS_BR);
    LAS unsigned char* ldsl = (LAS unsigned char*)lds;

#pragma unroll 1
    for (int L = 0; L < DEPTH; ++L) {
        const int g0 = L * NPH;
        if (IN(g0 + 0)) { PHASE_IDS(); ph_convert(a, L, lds, gw, NGW, wave, lane, tid, gtid, GT); } SEAM(g0 + 0);
        if (IN(g0 + 1)) { PHASE_IDS();
            pg8::Gemm g{H, (const bf16*)(ws + WS_WCAT), T, NCAT, D, 0}; pg8::StaticOrder So; So.init(T, NCAT, G, bx);
            pg8::EpiG1 E{PROJ, GATES, 0.17677669529663687f * LOG2E};
            pg8::gemm_phase<pg8::EpiG1, pg8::StaticOrder, true, true>(ldsl, g, So, E, tid);
        } SEAM(g0 + 1);
        if (IN(g0 + 2)) {
            { PHASE_IDS(); ph_rope(a, L, gw, NGW, lane); }
            { PHASE_IDS(); for (int u = bx; u < 512; u += G) ssd1_unit(a, L, u, lds, wave, lane, tid); }
            { PHASE_IDS(); for (int u = bx; u < 256; u += G) sgu_unit(a, L, u, lds, wave, lane, tid); }
        } SEAM(g0 + 2);
        if (IN(g0 + 3)) {
            { PHASE_IDS(); ph_scan(a, gtid, GT); }
            { PHASE_IDS();
              pg8::Gemm g{(const bf16*)(ws + WS_PBF), (const bf16*)(ws + WS_WPLE), T, D, 256, 0}; pg8::StaticOrder So; So.init(T, D, G, bx);
              pg8::EpiPlain E{(bf16*)(ws + WS_PL), D};
              pg8::gemm_phase<pg8::EpiPlain, pg8::StaticOrder, true, true>(ldsl, g, So, E, tid); }
        } SEAM(g0 + 3);
        if (IN(g0 + 4)) {
            { PHASE_IDS(); for (int u = bx; u < 1024; u += G) ssd3_unit(a, L, u, lds, wave, lane, tid); }
            const attn_body::bf16* Pj = (const attn_body::bf16*)PROJ; attn_body::bf16* Bo = (attn_body::bf16*)BR;
            { PHASE_IDS();
              for (int u = bx; u < 512; u += G) {
                const int rnd = u >> 8, cc = u & 255, xc = cc & 7, rr = cc >> 3;
                const int b = xc >> 2, hq = xc & 3, qb = rr + 32 * rnd; const size_t rb = (size_t)b * S;
                attn_body::attn_unit<false, 8>(Pj + rb * LDP + PC_AQ + hq * 64, Pj + rb * LDP + PC_AK + (hq >> 1) * 64, Pj + rb * LDP + PC_AV + (hq >> 1) * 64, Bo + rb * 1024 + hq * 64,
                                               qb * 256, (char*)lds, nullptr, 0, 0.f, 0.f, nullptr, tid); } }
            { PHASE_IDS();
              float lam;
              { float t1 = (lane < 32) ? a.lambda_q1[L * 32 + (lane & 31)] * a.lambda_k1[L * 32 + (lane & 31)] : 0.f; float t2 = (lane < 32) ? a.lambda_q2[L * 32 + (lane & 31)] * a.lambda_k2[L * 32 + (lane & 31)] : 0.f;
                t1 = wave_sum(t1); t2 = wave_sum(t2);
                lam = __expf(t1) - __expf(t2) + (0.8f - 0.6f * __expf(-0.3f * (float)L)); }
              const float osc = 1.0f - (0.8f - 0.6f * __expf(-0.3f * (float)L));
              for (int u = bx; u < 1024; u += G) {
                const int rnd = u >> 8, cc = u & 255, xc = cc & 7, rr = cc >> 3;
                const int b = xc >> 2, h = xc & 3, qb = rr + 32 * rnd; const size_t rb = (size_t)b * S;
                attn_body::attn_unit<true, 8>(Pj + rb * LDP + PC_CQ + h * 64, Pj + rb * LDP + PC_CK + h * 64, Pj + rb * LDP + PC_CV + h * 64, Bo + rb * 1024 + 512 + h * 64,
                                              qb * 128, (char*)lds, a.rel_bias, h, lam, osc, a.g_diff + L * 64, tid); } }
        } SEAM(g0 + 4);
        if (IN(g0 + 5)) { PHASE_IDS();
            pg8::Gemm g{BR, (const bf16*)(ws + WS_WBR), T, NGATE, 256, 1024}; pg8::BranchOrder So; So.init(T, NGATE, G, bx);
            pg8::EpiGateMul E{GATES, (const float*)(ws + WS_SSQ)};
            pg8::gemm_phase<pg8::EpiGateMul, pg8::BranchOrder, true, true>(ldsl, g, So, E, tid);
        } SEAM(g0 + 5);
        if (IN(g0 + 6)) { PHASE_IDS();
            pg8::Gemm g{GATES, (const bf16*)(ws + WS_WOUT), T, D, NGATE, 0}; pg8::StaticOrder So; So.init(T, D, G, bx);
            pg8::EpiResid E{(L == 0) ? a.x : a.out, a.out};
            pg8::gemm_phase<pg8::EpiResid, pg8::StaticOrder, true, true>(ldsl, g, So, E, tid);
        } SEAM(g0 + 6);
        if (IN(g0 + 7)) { PHASE_IDS(); ph_r1(a, L, lds, gw, NGW, lane, tid); } SEAM(g0 + 7);
        if (IN(g0 + 8)) { PHASE_IDS(); for (int q = bx; q < NB * NE; q += G) sel_unit(a, q, lds, wave, lane, tid); } SEAM(g0 + 8);
        if (IN(g0 + 9)) { PHASE_IDS(); ph_gather(a, gw, NGW, lane); } SEAM(g0 + 9);
        if (IN(g0 + 10)) { PHASE_IDS();
            pg8::Gemm g{(const bf16*)(ws + WS_XE), (const bf16*)(ws + WS_WGU), NE * NB * CAP, NE * 2048, D, 0}; pg8::ExpertOrder So{8, G, bx};
            pg8::EpiGU E{(bf16*)(ws + WS_HID)};
            pg8::gemm_phase<pg8::EpiGU, pg8::ExpertOrder, true, true>(ldsl, g, So, E, tid);
        } SEAM(g0 + 10);
        if (IN(g0 + 11)) { PHASE_IDS();
            pg8::Gemm g{(const bf16*)(ws + WS_HID), (const bf16*)(ws + WS_WDN), NE * NB * CAP, NE * 1024, D, 0}; pg8::ExpertOrder So{4, G, bx};
            pg8::EpiDN E{(bf16*)(ws + WS_YE), (const float*)(ws + WS_SELAFF)};
            pg8::gemm_phase<pg8::EpiDN, pg8::ExpertOrder, true, true>(ldsl, g, So, E, tid);
        } SEAM(g0 + 11);
        if (IN(g0 + 12)) { PHASE_IDS(); ph_r2(a, L, gw, NGW, lane); } SEAM(g0 + 12);
        if (IN(g0 + 13)) { PHASE_IDS();
            pg8::Gemm g{H, (const bf16*)(ws + WS_WPG), T, D, D, 0}; pg8::StaticOrder So; So.init(T, D, G, bx);
            pg8::EpiPle E{a.out, (const bf16*)(ws + WS_PL)};
            pg8::gemm_phase<pg8::EpiPle, pg8::StaticOrder, true, true>(ldsl, g, So, E, tid);
        } SEAM(g0 + 13);
    }
    if (IN(DEPTH * NPH)) { PHASE_IDS(); ph_final(a, gw, NGW, lane); }
#undef IN
#undef SEAM
#undef PHASE_IDS
}

#ifndef MK_ONE_LAUNCH
#define MK_ONE_LAUNCH 0
#endif
extern "C" void kernel_launch(void* const* d_in, const int* in_sizes, int n_in, void* d_out, int out_size, void* d_ws, size_t ws_size, hipStream_t stream) {
    static int grid = 0;
    if (grid == 0) {
        if (n_in != 35 || in_sizes[0] != T * D || out_size != T * D || ws_size < WS_END) { fprintf(stderr, "kernel_launch: unexpected shapes (n_in %d, in0 %d, out %d, ws %zu)\n", n_in, n_in > 0 ? in_sizes[0] : -1, out_size, ws_size); grid = -1; return; }
        int dev = 0, cus = 0, per_cu = 0;
        if (hipGetDevice(&dev) != hipSuccess || hipDeviceGetAttribute(&cus, hipDeviceAttributeMultiprocessorCount, dev) != hipSuccess) { grid = -1; return; }
        if (hipFuncSetAttribute((const void*)mk_fwd, hipFuncAttributeMaxDynamicSharedMemorySize, LDS_BYTES) != hipSuccess) { fprintf(stderr, "kernel_launch: hipFuncSetAttribute failed\n"); grid = -1; return; }
        if (hipOccupancyMaxActiveBlocksPerMultiprocessor(&per_cu, (const void*)mk_fwd, NTHR, LDS_BYTES) != hipSuccess || per_cu < 1) { fprintf(stderr, "kernel_launch: occupancy query says %d\n", per_cu); }
        (void)hipGetLastError();
        grid = cus;
    }
    if (grid < 0) return;
    (void)hipMemsetAsync((char*)d_ws + WS_CTL, 0, CTL_ZERO_BYTES, stream);
    P a{};
    const float** pp = (const float**)&a;
    for (int i = 0; i < 35; ++i) pp[i] = (const float*)d_in[i];
    a.out = (float*)d_out; a.ws = (unsigned char*)d_ws;
#if MK_ONE_LAUNCH
    a.gp_lo = 0; a.gp_hi = NGP;
    hipLaunchKernelGGL(mk_fwd, dim3(grid), dim3(NTHR), LDS_BYTES, stream, a);
#else
    for (int gp = 0; gp < NGP; ++gp) { a.gp_lo = gp; a.gp_hi = gp + 1; hipLaunchKernelGGL(mk_fwd, dim3(grid), dim3(NTHR), LDS_BYTES, stream, a); }
#endif
}
```

```cpp
#include <hip/hip_runtime.h>
#include <hip/hip_bf16.h>
#include <cstdio>
#include <cstdint>
#include <cmath>
#ifndef REPMASK
#define REPMASK 0u
#endif
#define MK_PROBE_BUILD ((REPMASK) != 0u)
namespace pg8 {
#define PG8_LAS __attribute__((address_space(3)))
typedef unsigned short bf16_t;
typedef short bf16x8 __attribute__((ext_vector_type(8)));
typedef float f32x4 __attribute__((ext_vector_type(4)));
typedef unsigned u32x4 __attribute__((ext_vector_type(4)));
constexpr int BM = 256, BK = 64, HALF = 128, HTB = HALF * BK * 2  , STAGE_BYTES = 8 * HTB, NXCD = 8, WGM = 8;

__host__ __device__ __forceinline__ int lds_byte(int r, int c) { const int st = (r >> 4) * 2 + (c >> 5), rr = r & 15, cc = c & 31, ob = rr * 64 + cc * 2; return st * 1024 + (ob ^ (((ob >> 9) & 1) << 5)); }
__host__ __device__ __forceinline__ void stage_rc(int b, int& R, int& C) { const int st = b / 1024, sb = b % 1024, swz = sb ^ (((sb >> 9) & 1) << 5); R = (st >> 1) * 16 + swz / 64; C = (st & 1) * 32 + (swz % 64) / 2; }
__host__ __device__ __forceinline__ int perm32(int rho) { const int n = rho >> 4, i = rho & 15; return 8 * (i >> 2) + 4 * n + (i & 3); }

struct Unit { int pm, pn; };
struct Gemm { const bf16_t* A; const bf16_t* Bt; int M, N, K, lda; };

struct StaticOrder {
    int nM, nN, nwg, G, c;
    __host__ __device__ void init(int M, int N, int G_, int c_) { nM = M / BM; nN = N / BM; nwg = nM * nN; G = G_; c = c_; }
    __host__ __device__ __forceinline__ bool next(int i, Unit& u) const {
        const long L = (long)i * G + c; if (L >= nwg) return false;
        int wgid = (int)L; { const int q = nwg / NXCD, r = nwg % NXCD, xcd = wgid % NXCD, off = wgid / NXCD; wgid = (xcd < r ? xcd * (q + 1) : r * (q + 1) + (xcd - r) * q) + off; }
        const int nig = WGM * nN, gid = wgid / nig, fm = gid * WGM, gsz = (nM - fm) < WGM ? (nM - fm) : WGM;
        u.pm = fm + ((wgid % nig) % gsz); u.pn = (wgid % nig) / gsz; return true;
    }
    __device__ __forceinline__ void a_ready(const Unit&) const {}
    __device__ __forceinline__ void done(const Unit&) const {}
    __device__ __forceinline__ size_t a_off(const Unit&) const { return 0; }
};

__device__ __forceinline__ unsigned cvt_pk_bf16(float lo, float hi) { unsigned r; asm volatile("v_cvt_pk_bf16_f32 %0, %1, %2" : "=v"(r) : "v"(lo), "v"(hi)); return r; }
typedef float f32x2 __attribute__((ext_vector_type(2)));
__device__ __forceinline__ float ub0(unsigned w) { return (float)(w & 0xffu); }
__device__ __forceinline__ float ub1(unsigned w) { return (float)((w >> 8) & 0xffu); }
__device__ __forceinline__ float ub2(unsigned w) { return (float)((w >> 16) & 0xffu); }
__device__ __forceinline__ float ub3(unsigned w) { return (float)(w >> 24); }
__device__ __forceinline__ float bf_lo(unsigned w) { return __builtin_bit_cast(float, w << 16); }
__device__ __forceinline__ float bf_hi(unsigned w) { return __builtin_bit_cast(float, w & 0xffff0000u); }
__device__ __forceinline__ float sigmoid_f(float x) { return __builtin_amdgcn_rcpf(1.0f + __builtin_amdgcn_exp2f(-1.4426950408889634f * x)); }
__device__ __forceinline__ u32x4 pack8(const f32x4 v0, const f32x4 v1) { u32x4 w; w.x = cvt_pk_bf16(v0[0], v0[1]); w.y = cvt_pk_bf16(v0[2], v0[3]); w.z = cvt_pk_bf16(v1[0], v1[1]); w.w = cvt_pk_bf16(v1[2], v1[3]); return w; }

struct ExpertOrder {
    int nNl, G, c;
    __device__ __forceinline__ bool next(int i, Unit& u) const {
        const int L = i * G + c, per = 16 * nNl; if (L >= 16 * per) return false;
        const int e = L / per, w = L % per; u.pm = e * 16 + (w % 16); u.pn = e * nNl + (w / 16); return true;
    }
    __device__ __forceinline__ void a_ready(const Unit&) const {}
    __device__ __forceinline__ void done(const Unit&) const {}
    __device__ __forceinline__ size_t a_off(const Unit&) const { return 0; }
};
struct BranchOrder : StaticOrder {
    __device__ __forceinline__ size_t a_off(const Unit& u) const { return (size_t)(u.pn >> 2) * 256 * 2; }
};

struct EpiG1 {
    static constexpr bool PERM = true, AFTER_DRAIN = false, MIDHOOK = false;
    bf16_t* proj; bf16_t* gates; float qscale; int dry;
    __device__ __forceinline__ void operator()(const f32x4 (&acc)[2][2][4][2], const Unit& u, int wr, int wc, int fr, int fq) const {
        if (dry) return;
        int row0 = u.pm * BM + wr * 64 + fr; asm volatile("" : "+v"(row0));
        const bool isg = u.pn >= 11;
        if (isg) {
            unsigned char* base = (unsigned char*)gates + ((size_t)(u.pm * 16 + (u.pn - 11)) << 16) + ((wr * 4 + wc) * 64 + fq * 16 + fr) * 8;
#pragma unroll
            for (int ai = 0; ai < 2; ++ai)
#pragma unroll
                for (int m = 0; m < 4; ++m)
#pragma unroll
                    for (int bj = 0; bj < 2; ++bj) { f32x4 v0 = acc[ai][bj][m][0], v1 = acc[ai][bj][m][1];
#pragma unroll
                        for (int i = 0; i < 4; ++i) { v0[i] = fmaxf(255.0f * sigmoid_f(v0[i]), 1.0f); v1[i] = fmaxf(255.0f * sigmoid_f(v1[i]), 1.0f); }
                        unsigned w0 = 0u, w1 = 0u;
                        w0 = __builtin_amdgcn_cvt_pk_u8_f32(v0[0], 0, w0); w0 = __builtin_amdgcn_cvt_pk_u8_f32(v0[1], 1, w0); w0 = __builtin_amdgcn_cvt_pk_u8_f32(v0[2], 2, w0); w0 = __builtin_amdgcn_cvt_pk_u8_f32(v0[3], 3, w0);
                        w1 = __builtin_amdgcn_cvt_pk_u8_f32(v1[0], 0, w1); w1 = __builtin_amdgcn_cvt_pk_u8_f32(v1[1], 1, w1); w1 = __builtin_amdgcn_cvt_pk_u8_f32(v1[2], 2, w1); w1 = __builtin_amdgcn_cvt_pk_u8_f32(v1[3], 3, w1);
                        typedef unsigned u32x2g __attribute__((ext_vector_type(2)));
                        *(u32x2g*)(base + (((ai * 4 + m) * 2 + bj) << 12)) = (u32x2g){w0, w1}; }
        } else {
            const float sc = (u.pn == 2) ? qscale : 1.0f;
            const int col0 = u.pn * BM + wc * 32 + 8 * fq;
#pragma unroll
            for (int ai = 0; ai < 2; ++ai)
#pragma unroll
                for (int m = 0; m < 4; ++m) { bf16_t* rowp = proj + (size_t)(row0 + ai * HALF + m * 16) * 2816 + col0;
#pragma unroll
                    for (int bj = 0; bj < 2; ++bj) *(u32x4*)(rowp + bj * HALF) = pack8(acc[ai][bj][m][0] * sc, acc[ai][bj][m][1] * sc); }
        }
    }
};
struct EpiProjI8 {
    static constexpr bool PERM = true, AFTER_DRAIN = false, MIDHOOK = false;
    bf16_t* proj; const float* sa; const float* sw; int cbase; float qscale; int dry;
    __device__ __forceinline__ void operator()(const f32x4 (&acc)[2][2][4][2], const Unit& u, int wr, int wc, int fr, int fq) const {
        if (dry) return;
        typedef int i32x4e __attribute__((ext_vector_type(4)));
        int row0 = u.pm * BM + wr * 64 + fr; asm volatile("" : "+v"(row0));
        const int col0 = u.pn * BM + wc * 32 + 8 * fq;
        f32x4 cw[2][2]; const float sc = ((cbase >> 8) + u.pn == 2) ? qscale : 1.0f;
#pragma unroll
        for (int bj = 0; bj < 2; ++bj) { cw[bj][0] = *(const f32x4*)(sw + col0 + bj * HALF) * sc; cw[bj][1] = *(const f32x4*)(sw + col0 + bj * HALF + 4) * sc; }
        float RS[2][4];
#pragma unroll
        for (int ai = 0; ai < 2; ++ai)
#pragma unroll
            for (int m = 0; m < 4; ++m) RS[ai][m] = sa[row0 + ai * HALF + m * 16];
        __builtin_amdgcn_sched_barrier(0);
#pragma unroll
        for (int ai = 0; ai < 2; ++ai)
#pragma unroll
            for (int m = 0; m < 4; ++m) { const int r = row0 + ai * HALF + m * 16; const float rsc = RS[ai][m]; bf16_t* rowp = proj + (size_t)r * 2816 + cbase + col0;
#pragma unroll
                for (int bj = 0; bj < 2; ++bj) { const i32x4e a0 = __builtin_bit_cast(i32x4e, acc[ai][bj][m][0]), a1 = __builtin_bit_cast(i32x4e, acc[ai][bj][m][1]); f32x4 v0, v1;
#pragma unroll
                    for (int i = 0; i < 4; ++i) { v0[i] = (float)a0[i] * rsc * cw[bj][0][i]; v1[i] = (float)a1[i] * rsc * cw[bj][1][i]; }
                    *(u32x4*)(rowp + bj * HALF) = pack8(v0, v1); } }
    }
};
struct EpiGateI8 {
    static constexpr bool PERM = true, AFTER_DRAIN = false, MIDHOOK = false;
    bf16_t* gates; const float* sa; const float* sw; int dry;
    __device__ __forceinline__ void operator()(const f32x4 (&acc)[2][2][4][2], const Unit& u, int wr, int wc, int fr, int fq) const {
        if (dry) return;
        typedef unsigned u32x2g __attribute__((ext_vector_type(2))); typedef int i32x4e __attribute__((ext_vector_type(4)));
        int row0 = u.pm * BM + wr * 64 + fr; asm volatile("" : "+v"(row0));
        unsigned char* base = (unsigned char*)gates + ((size_t)(u.pm * 16 + u.pn) << 16) + ((wr * 4 + wc) * 64 + fq * 16 + fr) * 8;
        const int colb = u.pn * BM + wc * 32 + 8 * fq;
        f32x4 cw[2][2];
#pragma unroll
        for (int bj = 0; bj < 2; ++bj) { cw[bj][0] = *(const f32x4*)(sw + colb + bj * HALF); cw[bj][1] = *(const f32x4*)(sw + colb + bj * HALF + 4); }
        float RS[2][4];
#pragma unroll
        for (int ai = 0; ai < 2; ++ai)
#pragma unroll
            for (int m = 0; m < 4; ++m) RS[ai][m] = sa[row0 + ai * HALF + m * 16];
        __builtin_amdgcn_sched_barrier(0);
#pragma unroll
        for (int ai = 0; ai < 2; ++ai)
#pragma unroll
            for (int m = 0; m < 4; ++m) { const float rsn = RS[ai][m] * -1.4426950408889634f;
#pragma unroll
                for (int bj = 0; bj < 2; ++bj) { const i32x4e a0 = __builtin_bit_cast(i32x4e, acc[ai][bj][m][0]), a1 = __builtin_bit_cast(i32x4e, acc[ai][bj][m][1]); f32x4 v0, v1;
#pragma unroll
                    for (int i = 0; i < 4; ++i) { v0[i] = fmaxf(__builtin_amdgcn_rcpf(__builtin_fmaf(__builtin_amdgcn_exp2f((float)a0[i] * rsn * cw[bj][0][i]), 1.0f / 255.0f, 1.0f / 255.0f)), 1.0f);
                                                  v1[i] = fmaxf(__builtin_amdgcn_rcpf(__builtin_fmaf(__builtin_amdgcn_exp2f((float)a1[i] * rsn * cw[bj][1][i]), 1.0f / 255.0f, 1.0f / 255.0f)), 1.0f); }
                    unsigned w0 = 0u, w1 = 0u;
                    w0 = __builtin_amdgcn_cvt_pk_u8_f32(v0[0], 0, w0); w0 = __builtin_amdgcn_cvt_pk_u8_f32(v0[1], 1, w0); w0 = __builtin_amdgcn_cvt_pk_u8_f32(v0[2], 2, w0); w0 = __builtin_amdgcn_cvt_pk_u8_f32(v0[3], 3, w0);
                    w1 = __builtin_amdgcn_cvt_pk_u8_f32(v1[0], 0, w1); w1 = __builtin_amdgcn_cvt_pk_u8_f32(v1[1], 1, w1); w1 = __builtin_amdgcn_cvt_pk_u8_f32(v1[2], 2, w1); w1 = __builtin_amdgcn_cvt_pk_u8_f32(v1[3], 3, w1);
                    *(u32x2g*)(base + (((ai * 4 + m) * 2 + bj) << 12)) = (u32x2g){w0, w1}; } }
    }
};
struct EpiPlain {
    static constexpr bool PERM = true, AFTER_DRAIN = false, MIDHOOK = false;
    bf16_t* O; int ldc;
    __device__ __forceinline__ void operator()(const f32x4 (&acc)[2][2][4][2], const Unit& u, int wr, int wc, int fr, int fq) const {
        int row0 = u.pm * BM + wr * 64 + fr, col0 = u.pn * BM + wc * 32 + 8 * fq; asm volatile("" : "+v"(row0));
#pragma unroll
        for (int ai = 0; ai < 2; ++ai)
#pragma unroll
            for (int m = 0; m < 4; ++m) { bf16_t* rowp = O + (size_t)(row0 + ai * HALF + m * 16) * ldc + col0;
#pragma unroll
                for (int bj = 0; bj < 2; ++bj) *(u32x4*)(rowp + bj * HALF) = pack8(acc[ai][bj][m][0], acc[ai][bj][m][1]); }
    }
};
struct TileOrder {
    int t, nNl;
    __device__ __forceinline__ bool next(int i, Unit& u) const { if (i >= nNl) return false; u.pm = t; u.pn = (t >> 4) * nNl + i; return true; }
    __device__ __forceinline__ void a_ready(const Unit&) const {}
    __device__ __forceinline__ void done(const Unit&) const {}
    __device__ __forceinline__ size_t a_off(const Unit&) const { return 0; }
};
struct TailOrder {
    int G, c, part;
    __device__ __forceinline__ bool next(int i, Unit& u) const { const int hG = G >> 1; const bool lo = c < hG; const int n = lo ? 1 : 3, nf = lo ? (c & 1) : (c & 3);
        const int idx = (part == 0) ? i : nf + i; if ((part == 0) ? (i >= nf) : (idx >= n)) return false;
        const int L = lo ? 3 * hG + c : (c - hG) + hG * idx; if (L >= 512) return false; u.pm = L >> 2; u.pn = L & 3; return true; }
    __device__ __forceinline__ void a_ready(const Unit&) const {}
    __device__ __forceinline__ void done(const Unit&) const {}
    __device__ __forceinline__ size_t a_off(const Unit&) const { return 0; }
};
struct MergeOrder {
    int G, c;
    __device__ __forceinline__ bool next(int i, Unit& u) const { const int tile = (i >> 2) * G + c; if (tile >= 512) return false; u.pm = tile >> 2; u.pn = (i & 3) * 4 + (tile & 3); return true; }
    __device__ __forceinline__ void a_ready(const Unit&) const {}
    __device__ __forceinline__ void done(const Unit&) const {}
    __device__ __forceinline__ size_t a_off(const Unit& u) const { return (size_t)(u.pn >> 2) * 256 * 2; }
};
struct EpiMergeHorner {
    static constexpr bool PERM = true, AFTER_DRAIN = false, MIDHOOK = true;
    static constexpr int NSTORE = 0;
    const bf16_t* gates; bf16_t* O; const __attribute__((address_space(3))) float* rrt; int pm0; int dry;
    typedef unsigned u32x2q __attribute__((ext_vector_type(2)));
    struct Carry { u32x2q g[4][2]; };
    __device__ __forceinline__ bool mut(f32x4 (&acc)[2][2][4][2], const Unit& u, int wr, int wc, int fr, int fq, Carry& cy) const {
        const int n = u.pn >> 2, pd = u.pn & 3;
        if (dry) return n != 3;
        int row0 = u.pm * BM + wr * 64 + fr, col0 = pd * BM + wc * 32 + 8 * fq; asm volatile("" : "+v"(row0));
        const unsigned char* gp0 = (const unsigned char*)gates + ((size_t)(u.pm * 16 + u.pn) << 16) + ((wr * 4 + wc) * 64 + fq * 16 + fr) * 8;
        u32x2q GA[2][4][2], GB[2][4][2];
#pragma unroll
        for (int ai = 0; ai < 2; ++ai)
#pragma unroll
            for (int m = 0; m < 4; ++m)
#pragma unroll
                for (int bj = 0; bj < 2; ++bj) { const unsigned char* gp = gp0 + (((ai * 4 + m) * 2 + bj) << 12);
                    if (ai == 0) GA[ai][m][bj] = (n == 0) ? *(const u32x2q*)gp : cy.g[m][bj];
                    else         GA[ai][m][bj] = *(const u32x2q*)gp;
                    GB[ai][m][bj] = (n != 3) ? *(const u32x2q*)(gp + (4 << 16)) : (u32x2q){0u, 0u}; }
        const __attribute__((address_space(3))) float* rt = rrt + ((u.pm != pm0) ? 512 : 0) + (wr * 64 + fr) * 2 + ((n == 0) ? 0 : 1);
#pragma unroll
        for (int ai = 0; ai < 2; ++ai)
#pragma unroll
            for (int m = 0; m < 4; ++m) { const size_t r = (size_t)(row0 + ai * HALF + m * 16);
                const float rs = (n < 2) ? rt[(ai * HALF + m * 16) * 2] : 1.0f;
#pragma unroll
                for (int bj = 0; bj < 2; ++bj) { const u32x2q ga = GA[ai][m][bj];
                    if (n == 3) {
                        f32x4 v0 = acc[ai][bj][m][0] * (1.0f / 255.0f), v1 = acc[ai][bj][m][1] * (1.0f / 255.0f);
                        v0[0] *= ub0(ga.x); v0[1] *= ub1(ga.x); v0[2] *= ub2(ga.x); v0[3] *= ub3(ga.x);
                        v1[0] *= ub0(ga.y); v1[1] *= ub1(ga.y); v1[2] *= ub2(ga.y); v1[3] *= ub3(ga.y);
                        *(u32x4*)(O + r * 1024 + col0 + bj * HALF) = pack8(v0, v1);
                    } else { const u32x2q gb = GB[ai][m][bj]; f32x4 r0, r1;
                        r0[0] = rs * ub0(ga.x) * __builtin_amdgcn_rcpf(ub0(gb.x)); r0[1] = rs * ub1(ga.x) * __builtin_amdgcn_rcpf(ub1(gb.x));
                        r0[2] = rs * ub2(ga.x) * __builtin_amdgcn_rcpf(ub2(gb.x)); r0[3] = rs * ub3(ga.x) * __builtin_amdgcn_rcpf(ub3(gb.x));
                        r1[0] = rs * ub0(ga.y) * __builtin_amdgcn_rcpf(ub0(gb.y)); r1[1] = rs * ub1(ga.y) * __builtin_amdgcn_rcpf(ub1(gb.y));
                        r1[2] = rs * ub2(ga.y) * __builtin_amdgcn_rcpf(ub2(gb.y)); r1[3] = rs * ub3(ga.y) * __builtin_amdgcn_rcpf(ub3(gb.y));
                        acc[ai][bj][m][0] = acc[ai][bj][m][0] * r0; acc[ai][bj][m][1] = acc[ai][bj][m][1] * r1; } } }
#pragma unroll
        for (int m = 0; m < 4; ++m)
#pragma unroll
            for (int bj = 0; bj < 2; ++bj) cy.g[m][bj] = GB[0][m][bj];
        return n != 3;
    }
};
struct EpiResid {
    static constexpr bool PERM = false, AFTER_DRAIN = false, MIDHOOK = false;
    const float* xin; float* xout; int dry;
    __device__ __forceinline__ void operator()(const f32x4 (&acc)[2][2][4][2], const Unit& u, int wr, int wc, int fr, int fq) const {
        if (dry) return;
        int row0 = u.pm * BM + wr * 64 + fr, col0 = u.pn * BM + wc * 32 + 4 * fq; asm volatile("" : "+v"(row0));
#pragma unroll
        for (int ai = 0; ai < 2; ++ai)
#pragma unroll
            for (int m = 0; m < 4; ++m) { const size_t off = (size_t)(row0 + ai * HALF + m * 16) * 1024 + col0;
#pragma unroll
                for (int bj = 0; bj < 2; ++bj)
#pragma unroll
                    for (int n = 0; n < 2; ++n) { const f32x4 b = *(const f32x4*)(xin + off + bj * HALF + n * 16); *(f32x4*)(xout + off + bj * HALF + n * 16) = b + acc[ai][bj][m][n]; } }
    }
};
struct EpiResidB {
    static constexpr bool PERM = true, AFTER_DRAIN = false, MIDHOOK = false;
    bf16_t* x; int dry;
    __device__ __forceinline__ void operator()(const f32x4 (&acc)[2][2][4][2], const Unit& u, int wr, int wc, int fr, int fq) const {
        if (dry) return;
        int row0 = u.pm * BM + wr * 64 + fr; asm volatile("" : "+v"(row0)); const int col0 = u.pn * BM + wc * 32 + 8 * fq;
        u32x4 XT[2][4][2];
#pragma unroll
        for (int ai = 0; ai < 2; ++ai)
#pragma unroll
            for (int m = 0; m < 4; ++m)
#pragma unroll
                for (int bj = 0; bj < 2; ++bj) XT[ai][m][bj] = *(const u32x4*)(x + (size_t)(row0 + ai * HALF + m * 16) * 1024 + col0 + bj * HALF);
        __builtin_amdgcn_sched_barrier(0);
#pragma unroll
        for (int ai = 0; ai < 2; ++ai)
#pragma unroll
            for (int m = 0; m < 4; ++m) { bf16_t* rowp = x + (size_t)(row0 + ai * HALF + m * 16) * 1024 + col0;
#pragma unroll
                for (int bj = 0; bj < 2; ++bj) { const u32x4 b = XT[ai][m][bj]; f32x4 r0, r1;
                    r0[0] = bf_lo(b.x) + acc[ai][bj][m][0][0]; r0[1] = bf_hi(b.x) + acc[ai][bj][m][0][1]; r0[2] = bf_lo(b.y) + acc[ai][bj][m][0][2]; r0[3] = bf_hi(b.y) + acc[ai][bj][m][0][3];
                    r1[0] = bf_lo(b.z) + acc[ai][bj][m][1][0]; r1[1] = bf_hi(b.z) + acc[ai][bj][m][1][1]; r1[2] = bf_lo(b.w) + acc[ai][bj][m][1][2]; r1[3] = bf_hi(b.w) + acc[ai][bj][m][1][3];
                    *(u32x4*)(rowp + bj * HALF) = pack8(r0, r1); } }
    }
};
struct EpiPle {
    static constexpr bool PERM = false, AFTER_DRAIN = false, MIDHOOK = false;
    float* x; const bf16_t* pl; int dry;
    __device__ __forceinline__ void operator()(const f32x4 (&acc)[2][2][4][2], const Unit& u, int wr, int wc, int fr, int fq) const {
        if (dry) return;
        typedef unsigned u32x2 __attribute__((ext_vector_type(2)));
        int row0 = u.pm * BM + wr * 64 + fr, col0 = u.pn * BM + wc * 32 + 4 * fq; asm volatile("" : "+v"(row0));
#pragma unroll
        for (int ai = 0; ai < 2; ++ai)
#pragma unroll
            for (int m = 0; m < 4; ++m) { const size_t off = (size_t)(row0 + ai * HALF + m * 16) * 1024 + col0;
#pragma unroll
                for (int bj = 0; bj < 2; ++bj)
#pragma unroll
                    for (int n = 0; n < 2; ++n) { const size_t o = off + bj * HALF + n * 16; const f32x4 b = *(const f32x4*)(x + o); const u32x2 pv = *(const u32x2*)(pl + o);
                        const f32x4 a = acc[ai][bj][m][n]; f32x4 r;
                        r[0] = b[0] + sigmoid_f(a[0]) * bf_lo(pv.x); r[1] = b[1] + sigmoid_f(a[1]) * bf_hi(pv.x);
                        r[2] = b[2] + sigmoid_f(a[2]) * bf_lo(pv.y); r[3] = b[3] + sigmoid_f(a[3]) * bf_hi(pv.y);
                        *(f32x4*)(x + o) = r; } }
    }
};
struct EpiPleI8 {
    static constexpr bool PERM = false, AFTER_DRAIN = false, MIDHOOK = false;
    float* x; const bf16_t* pl; const float* sa; const float* sw; int dry;
    __device__ __forceinline__ void operator()(const f32x4 (&acc)[2][2][4][2], const Unit& u, int wr, int wc, int fr, int fq) const {
        if (dry) return;
        typedef unsigned u32x2 __attribute__((ext_vector_type(2))); typedef int i32x4e __attribute__((ext_vector_type(4)));
        int row0 = u.pm * BM + wr * 64 + fr; asm volatile("" : "+v"(row0)); const int col0 = u.pn * BM + wc * 32 + 4 * fq;
        f32x4 cw[2][2];
#pragma unroll
        for (int bj = 0; bj < 2; ++bj)
#pragma unroll
            for (int n = 0; n < 2; ++n) cw[bj][n] = *(const f32x4*)(sw + col0 + bj * HALF + n * 16);
#pragma unroll
        for (int ai = 0; ai < 2; ++ai)
#pragma unroll
            for (int m = 0; m < 4; ++m) { const int r = row0 + ai * HALF + m * 16; const size_t off = (size_t)r * 1024 + col0; const float rsc = sa[r];
#pragma unroll
                for (int bj = 0; bj < 2; ++bj)
#pragma unroll
                    for (int n = 0; n < 2; ++n) { const size_t o = off + bj * HALF + n * 16; const f32x4 b = *(const f32x4*)(x + o); const u32x2 pv = *(const u32x2*)(pl + o);
                        const i32x4e ai4 = __builtin_bit_cast(i32x4e, acc[ai][bj][m][n]); f32x4 r4;
                        r4[0] = b[0] + sigmoid_f((float)ai4[0] * rsc * cw[bj][n][0]) * bf_lo(pv.x); r4[1] = b[1] + sigmoid_f((float)ai4[1] * rsc * cw[bj][n][1]) * bf_hi(pv.x);
                        r4[2] = b[2] + sigmoid_f((float)ai4[2] * rsc * cw[bj][n][2]) * bf_lo(pv.y); r4[3] = b[3] + sigmoid_f((float)ai4[3] * rsc * cw[bj][n][3]) * bf_hi(pv.y);
                        *(f32x4*)(x + o) = r4; } }
    }
};
struct EpiPleI8B {
    static constexpr bool PERM = true, AFTER_DRAIN = false, MIDHOOK = false;
    static constexpr int NSTORE = 16;
    bf16_t* x; const bf16_t* pl; const float* sa; const float* sw; int dry;
    __device__ __forceinline__ void operator()(const f32x4 (&acc)[2][2][4][2], const Unit& u, int wr, int wc, int fr, int fq) const {
        if (dry) return;
        typedef int i32x4e __attribute__((ext_vector_type(4)));
#define SG(t) __builtin_amdgcn_rcpf(1.0f + __builtin_amdgcn_exp2f(t))
        int row0 = u.pm * BM + wr * 64 + fr; asm volatile("" : "+v"(row0)); int col0 = u.pn * BM + wc * 32 + 8 * fq; asm volatile("" : "+v"(col0));
        f32x4 cw[2][2];
#pragma unroll
        for (int bj = 0; bj < 2; ++bj)
#pragma unroll
            for (int n = 0; n < 2; ++n) cw[bj][n] = *(const f32x4*)(sw + col0 + bj * HALF + n * 4);
#pragma unroll
        for (int ai = 0; ai < 2; ++ai)
#pragma unroll
        for (int mh = 0; mh < 2; ++mh) {
            u32x4 XT[2][2], PT[2][2]; float RS[2];
#pragma unroll
            for (int mm = 0; mm < 2; ++mm) { const int m = 2 * mh + mm; const int r = row0 + ai * HALF + m * 16; const size_t off = (size_t)r * 1024 + col0; RS[mm] = sa[r];
#pragma unroll
                for (int bj = 0; bj < 2; ++bj) { XT[mm][bj] = *(const u32x4*)(x + off + bj * HALF); PT[mm][bj] = *(const u32x4*)(pl + off + bj * HALF); } }
            __builtin_amdgcn_sched_barrier(0);
#pragma unroll
            for (int mm = 0; mm < 2; ++mm) { const int m = 2 * mh + mm; const int r = row0 + ai * HALF + m * 16; const size_t off = (size_t)r * 1024 + col0; const float rsc = RS[mm] * -1.4426950408889634f;
#pragma unroll
                for (int bj = 0; bj < 2; ++bj) { const u32x4 b = XT[mm][bj]; const u32x4 pv = PT[mm][bj];
                    const i32x4e a0 = __builtin_bit_cast(i32x4e, acc[ai][bj][m][0]), a1 = __builtin_bit_cast(i32x4e, acc[ai][bj][m][1]); f32x4 r0, r1;
                    r0[0] = bf_lo(b.x) + SG((float)a0[0] * rsc * cw[bj][0][0]) * bf_lo(pv.x); r0[1] = bf_hi(b.x) + SG((float)a0[1] * rsc * cw[bj][0][1]) * bf_hi(pv.x);
                    r0[2] = bf_lo(b.y) + SG((float)a0[2] * rsc * cw[bj][0][2]) * bf_lo(pv.y); r0[3] = bf_hi(b.y) + SG((float)a0[3] * rsc * cw[bj][0][3]) * bf_hi(pv.y);
                    r1[0] = bf_lo(b.z) + SG((float)a1[0] * rsc * cw[bj][1][0]) * bf_lo(pv.z); r1[1] = bf_hi(b.z) + SG((float)a1[1] * rsc * cw[bj][1][1]) * bf_hi(pv.z);
                    r1[2] = bf_lo(b.w) + SG((float)a1[2] * rsc * cw[bj][1][2]) * bf_lo(pv.w); r1[3] = bf_hi(b.w) + SG((float)a1[3] * rsc * cw[bj][1][3]) * bf_hi(pv.w);
                    *(u32x4*)(x + off + bj * HALF) = pack8(r0, r1); } }
            __builtin_amdgcn_sched_barrier(0);
        }
    }
};
#undef SG
struct EpiGU {
    static constexpr bool PERM = true, AFTER_DRAIN = false, MIDHOOK = false;
    bf16_t* hid; int dry; float wscale;
    __device__ __forceinline__ void operator()(const f32x4 (&acc)[2][2][4][2], const Unit& u, int wr, int wc, int fr, int fq) const {
        if (dry) return;
        int row0 = u.pm * BM + wr * 64 + fr, col0 = (u.pn & 7) * 128 + wc * 32 + 8 * fq; asm volatile("" : "+v"(row0));
#pragma unroll
        for (int ai = 0; ai < 2; ++ai)
#pragma unroll
            for (int m = 0; m < 4; ++m) { f32x4 v0, v1; const f32x4 g0 = acc[ai][0][m][0] * wscale, g1 = acc[ai][0][m][1] * wscale, u0 = acc[ai][1][m][0] * wscale, u1 = acc[ai][1][m][1] * wscale;
#pragma unroll
                for (int i = 0; i < 4; ++i) { v0[i] = g0[i] * sigmoid_f(g0[i]) * u0[i]; v1[i] = g1[i] * sigmoid_f(g1[i]) * u1[i]; }
                *(u32x4*)(hid + (size_t)(row0 + ai * HALF + m * 16) * 1024 + col0) = pack8(v0, v1); }
    }
};
struct EpiGU8 {
    static constexpr bool PERM = true, AFTER_DRAIN = false, MIDHOOK = false;
    unsigned char* hid; int dry;
    __device__ __forceinline__ void operator()(const f32x4 (&acc)[2][2][4][2], const Unit& u, int wr, int wc, int fr, int fq) const {
        if (dry == 1) return;
        typedef unsigned u32x2h __attribute__((ext_vector_type(2)));
        int row0 = u.pm * BM + wr * 64 + fr; asm volatile("" : "+v"(row0)); const int col0 = (u.pn & 7) * 128 + wc * 32 + 8 * fq;
#pragma unroll
        for (int ai = 0; ai < 2; ++ai)
#pragma unroll
            for (int m = 0; m < 4; ++m) { f32x4 v0, v1; const f32x4 g0 = acc[ai][0][m][0] * 0.03125f, g1 = acc[ai][0][m][1] * 0.03125f, u0 = acc[ai][1][m][0] * 0.03125f, u1 = acc[ai][1][m][1] * 0.03125f;
#pragma unroll
                for (int i = 0; i < 4; ++i) { v0[i] = g0[i] * sigmoid_f(g0[i]) * u0[i]; v1[i] = g1[i] * sigmoid_f(g1[i]) * u1[i]; }
                int w0 = 0, w1 = 0;
                w0 = __builtin_amdgcn_cvt_pk_fp8_f32(v0[0], v0[1], w0, false); w0 = __builtin_amdgcn_cvt_pk_fp8_f32(v0[2], v0[3], w0, true);
                w1 = __builtin_amdgcn_cvt_pk_fp8_f32(v1[0], v1[1], w1, false); w1 = __builtin_amdgcn_cvt_pk_fp8_f32(v1[2], v1[3], w1, true);
                if (dry != 2 || row0 < -5) *(u32x2h*)(hid + (size_t)(row0 + ai * HALF + m * 16) * 1024 + col0) = (u32x2h){(unsigned)w0, (unsigned)w1}; }
    }
};
struct EpiDNP {
    static constexpr bool PERM = true, AFTER_DRAIN = false, MIDHOOK = false;
    bf16_t* ye; int dry;
    __device__ __forceinline__ void operator()(const f32x4 (&acc)[2][2][4][2], const Unit& u, int wr, int wc, int fr, int fq) const {
        if (dry == 1) return;
        int row0 = u.pm * BM + wr * 64 + fr; asm volatile("" : "+v"(row0)); const int col0 = (u.pn & 3) * BM + wc * 32 + 8 * fq;
#pragma unroll
        for (int ai = 0; ai < 2; ++ai)
#pragma unroll
            for (int m = 0; m < 4; ++m) { bf16_t* rowp = ye + (size_t)(row0 + ai * HALF + m * 16) * 1024 + col0;
#pragma unroll
                for (int bj = 0; bj < 2; ++bj) if (dry != 2 || row0 < -5) *(u32x4*)(rowp + bj * HALF) = pack8(acc[ai][bj][m][0], acc[ai][bj][m][1]); }
    }
};
struct EpiDNP8 {
    static constexpr bool PERM = true, AFTER_DRAIN = false, MIDHOOK = false;
    unsigned char* ye; int dry;
    __device__ __forceinline__ void operator()(const f32x4 (&acc)[2][2][4][2], const Unit& u, int wr, int wc, int fr, int fq) const {
        if (dry == 1) return;
        typedef unsigned u32x2h __attribute__((ext_vector_type(2)));
        int row0 = u.pm * BM + wr * 64 + fr; asm volatile("" : "+v"(row0)); const int col0 = (u.pn & 3) * BM + wc * 32 + 8 * fq;
#pragma unroll
        for (int ai = 0; ai < 2; ++ai)
#pragma unroll
            for (int m = 0; m < 4; ++m) { unsigned char* rowp = ye + (size_t)(row0 + ai * HALF + m * 16) * 1024 + col0;
#pragma unroll
                for (int bj = 0; bj < 2; ++bj) { const f32x4 v0 = acc[ai][bj][m][0] * 0.125f, v1 = acc[ai][bj][m][1] * 0.125f; int w0 = 0, w1 = 0;
                    w0 = __builtin_amdgcn_cvt_pk_fp8_f32(v0[0], v0[1], w0, false); w0 = __builtin_amdgcn_cvt_pk_fp8_f32(v0[2], v0[3], w0, true);
                    w1 = __builtin_amdgcn_cvt_pk_fp8_f32(v1[0], v1[1], w1, false); w1 = __builtin_amdgcn_cvt_pk_fp8_f32(v1[2], v1[3], w1, true);
                    if (dry != 2 || row0 < -5) *(u32x2h*)(rowp + bj * HALF) = (u32x2h){(unsigned)w0, (unsigned)w1}; } }
    }
};
struct EpiDN {
    static constexpr bool PERM = true, AFTER_DRAIN = false, MIDHOOK = false;
    bf16_t* ye; const float* aff; int dry; float wscale;
    __device__ __forceinline__ void operator()(const f32x4 (&acc)[2][2][4][2], const Unit& u, int wr, int wc, int fr, int fq) const {
        if (dry) return;
        int row0 = u.pm * BM + wr * 64 + fr, col0 = (u.pn & 3) * BM + wc * 32 + 8 * fq; asm volatile("" : "+v"(row0));
#pragma unroll
        for (int ai = 0; ai < 2; ++ai)
#pragma unroll
            for (int m = 0; m < 4; ++m) { const size_t r = (size_t)(row0 + ai * HALF + m * 16); const float a = aff[r] * wscale;
#pragma unroll
                for (int bj = 0; bj < 2; ++bj) *(u32x4*)(ye + r * 1024 + col0 + bj * HALF) = pack8(acc[ai][bj][m][0] * a, acc[ai][bj][m][1] * a); }
    }
};
struct NoCarry {};
template <class E, bool M = E::MIDHOOK> struct CarryOf { typedef NoCarry type; };
template <class E> struct CarryOf<E, true> { typedef typename E::Carry type; };
template <class Epi, class Sched, bool ALIGN_EPI = false, bool SP2 = false, bool GATHER = false, bool F8 = false, bool I8 = false, int PADN = 0>
__device__ __forceinline__ void gemm_phase(PG8_LAS unsigned char* lds, const Gemm g, const Sched& S, const Epi& E, const int tid, const PG8_LAS unsigned* gtab = nullptr) {
    typedef int i32x4q __attribute__((ext_vector_type(4)));
    static_assert(!GATHER || SP2, "GATHER is wired into the SP2 loop only");
    const int wid = __builtin_amdgcn_readfirstlane(tid >> 6), lane = tid & 63, wr = wid >> 2, wc = wid & 3, fr = lane & 15, fq = lane >> 4;
    int K = g.K; asm volatile("" : "+s"(K));
    const int nt = K / BK; const int lda = g.lda ? g.lda : K;
    unsigned voffA[2], voffB[2]; int gR[2]; unsigned gC[2];
#pragma unroll
    for (int i = 0; i < 2; ++i) { int R, C; stage_rc(tid * 16 + i * 8192, R, C); const int Rb = Epi::PERM ? ((R & ~31) + perm32(R & 31)) : R;
        voffA[i] = (unsigned)(R * lda + C) * 2u; voffB[i] = (unsigned)(Rb * K + C) * 2u; gR[i] = R; gC[i] = (unsigned)C * 2u; }
    unsigned cvo[2][2] = {{0u, 0u}, {0u, 0u}};
#define PG8_GLOAD(vo, uidx) do { _Pragma("unroll") for (int h_ = 0; h_ < 2; ++h_) _Pragma("unroll") for (int i_ = 0; i_ < 2; ++i_) vo[h_][i_] = gtab[(uidx) * 256 + h_ * 128 + gR[i_]] + gC[i_]; } while (0)
#define PG8_STA0(bufoff, gbase, h) do { unsigned vs_[2]; if constexpr (GATHER) { vs_[0] = cvo[h][0]; vs_[1] = cvo[h][1]; } else { vs_[0] = voffA[0]; vs_[1] = voffA[1]; } PG8_STAGE(bufoff, gbase, vs_); } while (0)
#define PG8_STAN(bufoff, gbase, h) do { unsigned vs_[2]; if constexpr (GATHER) { const int nu_ = has_next ? ui + 1 : ui; vs_[0] = last ? gtab[nu_ * 256 + (h) * 128 + gR[0]] + gC[0] : cvo[h][0]; vs_[1] = last ? gtab[nu_ * 256 + (h) * 128 + gR[1]] + gC[1] : cvo[h][1]; } else { vs_[0] = voffA[0]; vs_[1] = voffA[1]; } PG8_STAGE(bufoff, gbase, vs_); } while (0)
    const size_t kstep = (size_t)(BK * 2);
    const size_t hstep = (size_t)HALF * K * 2;
    const size_t tstep = 2 * hstep;
    const size_t hstepA = GATHER ? 0 : (size_t)HALF * lda * 2, tstepA = 2 * hstepA;
    const unsigned ldsw = (unsigned)wid * 1024u;
    const int aoff = lds_byte(wr * 64 + fr, fq * 8), boff = lds_byte(wc * 32 + fr, fq * 8);
#define PG8_SA(b, h) (((b) * 2 + (h)) * HTB)
#define PG8_SB(b, h) ((4 + (b) * 2 + (h)) * HTB)
#define PG8_STAGE(bufoff, gbase, voff) do { _Pragma("unroll") for (int _i = 0; _i < 2; ++_i) \
        __builtin_amdgcn_global_load_lds((const unsigned*)((const char*)(gbase) + (voff)[_i]), (PG8_LAS unsigned*)(lds + (bufoff) + ldsw + _i * 8192), 16, 0, 0); } while (0)
#define PG8_LD32(p) __builtin_shufflevector(*(const PG8_LAS i32x4q*)(p), *(const PG8_LAS i32x4q*)((p) + 1024), 0, 1, 2, 3, 4, 5, 6, 7)
#define PG8_LDA(dst, b, h) do { _Pragma("unroll") for (int m = 0; m < 4; ++m) { if constexpr (F8) dst##8[m] = PG8_LD32(lds + PG8_SA(b, h) + aoff + m * 2048); else { _Pragma("unroll") for (int k = 0; k < 2; ++k) dst[m][k] = *(const PG8_LAS bf16x8*)(lds + PG8_SA(b, h) + aoff + m * 2048 + k * 1024); } } } while (0)
#define PG8_LDB(dst, b, h) do { _Pragma("unroll") for (int n = 0; n < 2; ++n) { if constexpr (F8) dst##8[n] = PG8_LD32(lds + PG8_SB(b, h) + boff + n * 2048); else { _Pragma("unroll") for (int k = 0; k < 2; ++k) dst[n][k] = *(const PG8_LAS bf16x8*)(lds + PG8_SB(b, h) + boff + n * 2048 + k * 1024); } } } while (0)
#define PG8_MMA(ai, bj, At, Bt) do { __builtin_amdgcn_s_setprio(1); _Pragma("unroll") for (int m = 0; m < 4; ++m) _Pragma("unroll") for (int n = 0; n < 2; ++n) { \
        if constexpr (F8) acc[ai][bj][m][n] = __builtin_amdgcn_mfma_scale_f32_16x16x128_f8f6f4(Bt##8[n], At##8[m], acc[ai][bj][m][n], 0, 0, 0, 0, 0, 0); \
        else if constexpr (I8) { _Pragma("unroll") for (int k = 0; k < 2; ++k) acc[ai][bj][m][n] = __builtin_bit_cast(f32x4, __builtin_amdgcn_mfma_i32_16x16x64_i8(__builtin_bit_cast(i32x4q, Bt[n][k]), __builtin_bit_cast(i32x4q, At[m][k]), __builtin_bit_cast(i32x4q, acc[ai][bj][m][n]), 0, 0, 0)); } \
        else { _Pragma("unroll") for (int k = 0; k < 2; ++k) acc[ai][bj][m][n] = __builtin_amdgcn_mfma_f32_16x16x32_bf16(Bt[n][k], At[m][k], acc[ai][bj][m][n], 0, 0, 0); } } \
        __builtin_amdgcn_s_setprio(0); } while (0)
#define PG8_WAIT_V(n) asm volatile("s_waitcnt vmcnt(" #n ")" ::: "memory")
#define PG8_WAIT_L(n) asm volatile("s_waitcnt lgkmcnt(" #n ")" ::: "memory")
#define PG8_BAR __builtin_amdgcn_s_barrier()
#define PG8_SCHED __builtin_amdgcn_sched_barrier(0)
    Unit cur, nxt; int ui = 0;
    if (!S.next(0, cur)) return;
    f32x4 acc[2][2][4][2];
#pragma unroll
    for (int a = 0; a < 2; ++a)
#pragma unroll
        for (int b = 0; b < 2; ++b)
#pragma unroll
            for (int m = 0; m < 4; ++m)
#pragma unroll
                for (int n = 0; n < 2; ++n) acc[a][b][m][n] = (f32x4){0.f, 0.f, 0.f, 0.f};
    typename CarryOf<Epi>::type carry;
    bf16x8 At[4][2], B0[2][2], B1[2][2];
    typedef int i32x8q __attribute__((ext_vector_type(8))); i32x8q At8[4], B08[2], B18[2];
    const char* cA = (const char*)g.A + (size_t)cur.pm * tstepA + S.a_off(cur); if constexpr (GATHER) PG8_GLOAD(cvo, 0);
    const char* cB = (const char*)g.Bt + (size_t)cur.pn * tstep;
    S.a_ready(cur);
    if constexpr (SP2) {
        PG8_STAGE(PG8_SB(0, 0), cB, voffB); PG8_STAGE(PG8_SB(0, 1), cB + hstep, voffB); PG8_STA0(PG8_SA(0, 0), cA, 0); PG8_STA0(PG8_SA(0, 1), cA + hstepA, 1);
        if (wr == 1) PG8_BAR;
        PG8_WAIT_V(2); PG8_BAR;
        PG8_STAGE(PG8_SB(1, 0), cB + kstep, voffB); PG8_STA0(PG8_SA(1, 0), cA + kstep, 0); PG8_STAGE(PG8_SB(1, 1), cB + hstep + kstep, voffB);
        PG8_WAIT_V(6); PG8_BAR;
    } else {
        PG8_STAGE(PG8_SB(0, 0), cB, voffB); PG8_STAGE(PG8_SA(0, 0), cA, voffA); PG8_STAGE(PG8_SB(0, 1), cB + hstep, voffB); PG8_STAGE(PG8_SA(0, 1), cA + hstepA, voffA);
        if (wr == 1) PG8_BAR;
        PG8_WAIT_V(4); PG8_BAR;
        PG8_STAGE(PG8_SB(1, 0), cB + kstep, voffB); PG8_STAGE(PG8_SA(1, 0), cA + kstep, voffA); PG8_STAGE(PG8_SB(1, 1), cB + hstep + kstep, voffB);
        PG8_WAIT_V(6); PG8_BAR;
    }
    for (;;) {
        const bool has_next = S.next(ui + 1, nxt);
        const char* nA = has_next ? (const char*)g.A + (size_t)nxt.pm * tstepA + S.a_off(nxt) : cA; const char* nB = has_next ? (const char*)g.Bt + (size_t)nxt.pn * tstep : cB;
        asm volatile(".p2align 6\n\t.rept %c0\n\ts_nop 0\n\t.endr" :: "i"(PADN) : "memory");
        for (int t = 0; t < nt; t += 2) {
            const bool last = (t == nt - 2);
            const char* a1 = cA + (size_t)(t + 1) * kstep;
            const char* a2 = last ? nA : cA + (size_t)(t + 2) * kstep; const char* b2 = last ? nB : cB + (size_t)(t + 2) * kstep;
            const char* a3 = a2 + kstep; const char* b3 = b2 + kstep;
            if (last && has_next) S.a_ready(nxt);
            if constexpr (SP2) {
            PG8_LDB(B0, 0, 0); PG8_LDB(B1, 0, 1); PG8_SCHED; PG8_LDA(At, 0, 0); PG8_STA0(PG8_SA(1, 1), a1 + hstepA, 1);
            PG8_WAIT_V(8); PG8_WAIT_L(0); PG8_BAR; PG8_MMA(0, 0, At, B0); PG8_MMA(0, 1, At, B1); PG8_BAR; PG8_SCHED;
            PG8_LDA(At, 0, 1); PG8_STAGE(PG8_SB(0, 0), b2, voffB); PG8_STAGE(PG8_SB(0, 1), b2 + hstep, voffB); PG8_STAN(PG8_SA(0, 0), a2, 0);
            PG8_WAIT_V(8); PG8_WAIT_L(0); PG8_BAR; PG8_MMA(1, 0, At, B0); PG8_MMA(1, 1, At, B1); PG8_BAR; PG8_SCHED;
            PG8_LDB(B0, 1, 0); PG8_LDB(B1, 1, 1); PG8_SCHED; PG8_LDA(At, 1, 0); PG8_STAN(PG8_SA(0, 1), a2 + hstepA, 1);
            PG8_WAIT_V(8); PG8_WAIT_L(0); PG8_BAR; PG8_MMA(0, 0, At, B0); PG8_MMA(0, 1, At, B1); PG8_BAR; PG8_SCHED;
            PG8_LDA(At, 1, 1); PG8_STAGE(PG8_SB(1, 0), b3, voffB); PG8_STAGE(PG8_SB(1, 1), b3 + hstep, voffB); PG8_STAN(PG8_SA(1, 0), a3, 0);
            PG8_WAIT_V(8); PG8_WAIT_L(0); PG8_BAR; PG8_MMA(1, 0, At, B0); PG8_MMA(1, 1, At, B1); PG8_BAR; PG8_SCHED;
            } else {
            PG8_LDB(B0, 0, 0); PG8_SCHED; PG8_LDA(At, 0, 0); PG8_STAGE(PG8_SA(1, 1), a1 + hstepA, voffA);
            PG8_WAIT_L(8); PG8_BAR; PG8_WAIT_L(0); PG8_MMA(0, 0, At, B0); PG8_BAR; PG8_SCHED;
            PG8_LDB(B1, 0, 1); PG8_STAGE(PG8_SB(0, 0), b2, voffB);
            PG8_BAR; PG8_WAIT_L(0); PG8_MMA(0, 1, At, B1); PG8_BAR;
            PG8_LDA(At, 0, 1); PG8_STAGE(PG8_SA(0, 0), a2, voffA);
            PG8_BAR; PG8_WAIT_L(0); PG8_MMA(1, 0, At, B0); PG8_BAR; PG8_SCHED;
            PG8_STAGE(PG8_SB(0, 1), b2 + hstep, voffB);
            PG8_WAIT_V(6); PG8_BAR; PG8_MMA(1, 1, At, B1); PG8_BAR;
            PG8_LDB(B0, 1, 0); PG8_SCHED; PG8_LDA(At, 1, 0); PG8_STAGE(PG8_SA(0, 1), a2 + hstepA, voffA);
            PG8_WAIT_L(8); PG8_BAR; PG8_WAIT_L(0); PG8_MMA(0, 0, At, B0); PG8_BAR; PG8_SCHED;
            PG8_LDB(B1, 1, 1); PG8_STAGE(PG8_SB(1, 0), b3, voffB);
            PG8_BAR; PG8_WAIT_L(0); PG8_MMA(0, 1, At, B1); PG8_BAR;
            PG8_LDA(At, 1, 1); PG8_STAGE(PG8_SA(1, 0), a3, voffA);
            PG8_BAR; PG8_WAIT_L(0); PG8_MMA(1, 0, At, B0); PG8_BAR; PG8_SCHED;
            PG8_STAGE(PG8_SB(1, 1), b3 + hstep, voffB);
            PG8_WAIT_V(6); PG8_BAR; PG8_MMA(1, 1, At, B1); PG8_BAR;
            }
        }
        if constexpr (ALIGN_EPI) { if (wr == 0) PG8_BAR; }
        bool keep_acc = false;
        if constexpr (Epi::MIDHOOK) { keep_acc = E.mut(acc, cur, wr, wc, fr, fq, carry); S.done(cur); }
        else if constexpr (!Epi::AFTER_DRAIN) { E(acc, cur, wr, wc, fr, fq); S.done(cur); }
        if (!has_next) break;
        if (!keep_acc)
#pragma unroll
        for (int a = 0; a < 2; ++a)
#pragma unroll
            for (int b = 0; b < 2; ++b)
#pragma unroll
                for (int m = 0; m < 4; ++m)
#pragma unroll
                    for (int n = 0; n < 2; ++n) acc[a][b][m][n] = (f32x4){0.f, 0.f, 0.f, 0.f};
        cur = nxt; cA = nA; cB = nB; ++ui;
        if constexpr (GATHER) PG8_GLOAD(cvo, ui);
        if constexpr (ALIGN_EPI) { if (wr == 1) PG8_BAR; }
    }
    PG8_WAIT_V(0);
    if constexpr (!ALIGN_EPI) { if (wr == 0) PG8_BAR; }
    PG8_BAR;
    if constexpr (Epi::AFTER_DRAIN) { E.fused(acc, cur, wr, wc, fr, fq, lds, wid, lane); S.done(cur); }
#undef PG8_SA
#undef PG8_SB
#undef PG8_STAGE
#undef PG8_GLOAD
#undef PG8_STA0
#undef PG8_STAN
#undef PG8_LDA
#undef PG8_LDB
#undef PG8_MMA
#undef PG8_LD32
#undef PG8_WAIT_V
#undef PG8_WAIT_L
#undef PG8_BAR
#undef PG8_SCHED
}
}
namespace attn_body {
using bf16=__hip_bfloat16;
using bf16x8=__attribute__((ext_vector_type(8)))short;
using s16x4=__attribute__((ext_vector_type(4)))short;
using f32x16=__attribute__((ext_vector_type(16)))float;
using u32x4=__attribute__((ext_vector_type(4)))unsigned;
using f32x4a=__attribute__((ext_vector_type(4)))float;
constexpr int SEQ=16384,D=64,LDP=2816,LDO=1024;
constexpr int NW=8,QBLK=32,KVBLK=64,NT=SEQ/KVBLK;
__device__ __forceinline__ int crow(int r,int hi){return (r&3)+8*(r>>2)+4*hi;}
#define SBAR() __builtin_amdgcn_sched_barrier(0)
constexpr int NSLOT=3, SLOTB=8192;
constexpr int LDS_K=0, LDS_V=NSLOT*SLOTB, LDS_WS=2*NSLOT*SLOTB, LDS_OST=LDS_WS+NW*64*4, LDS_TAB=LDS_OST+65536, LDS_RED=LDS_TAB+640*4, LDS_BYTES=LDS_RED+64*4;
constexpr float LOG2E=1.4426950408889634f;
constexpr int PAD_AF=6,PAD_AS=0,PAD_CF=13,PAD_CS=4;
__device__ __forceinline__ void glds16(const void*gsrc,unsigned lds_dst){unsigned keep;
  asm volatile("s_mov_b32 %0, m0\n\ts_mov_b32 m0, %2\n\ts_nop 0\n\tglobal_load_lds_dwordx4 %1, off\n\ts_mov_b32 m0, %0":"=&s"(keep):"v"(gsrc),"s"(lds_dst):"memory");}
__device__ __forceinline__ float max3f(float a,float b,float c){float r;asm("v_max3_f32 %0, %1, %2, %3":"=v"(r):"v"(a),"v"(b),"v"(c));return r;}
__device__ __forceinline__ float max2f(float a,float b){float r;asm("v_max_f32_e32 %0, %1, %2":"=v"(r):"v"(a),"v"(b));return r;}
__device__ __forceinline__ float fadd_s(float a,float b){float r;asm("v_add_f32_e32 %0, %1, %2":"=v"(r):"v"(a),"v"(b));return r;}
__device__ __forceinline__ float fsub_s(float a,float b){float r;asm("v_sub_f32_e32 %0, %1, %2":"=v"(r):"v"(a),"v"(b));return r;}
typedef float f32x2_t __attribute__((ext_vector_type(2))); typedef __bf16 bf16x2_t __attribute__((ext_vector_type(2)));
__device__ __forceinline__ unsigned cvtpk_s(float lo,float hi){f32x2_t v={lo,hi};bf16x2_t b=__builtin_convertvector(v,bf16x2_t);return __builtin_bit_cast(unsigned,b);}
#define WAIT_BAR(N) asm volatile("s_waitcnt vmcnt(" #N ") lgkmcnt(0)\n\ts_barrier":::"memory")

template<int ND> __device__ __forceinline__ void qkt(f32x16&p0,f32x16&p1,const char*Kslot,const bf16x8*qr,const f32x16&negm,int r32,int hi){
  const char*kb=Kslot+hi*1024+r32*16;
  #pragma unroll
  for(int d0=0;d0<ND;++d0){
    const bf16x8 b0=*reinterpret_cast<const bf16x8*>(kb+d0*2048);
    const bf16x8 b1=*reinterpret_cast<const bf16x8*>(kb+d0*2048+512);
    if(d0==0){p0=__builtin_amdgcn_mfma_f32_32x32x16_bf16(b0,qr[0],negm,0,0,0);p1=__builtin_amdgcn_mfma_f32_32x32x16_bf16(b1,qr[0],negm,0,0,0);}
    else{p0=__builtin_amdgcn_mfma_f32_32x32x16_bf16(b0,qr[d0],p0,0,0,0);p1=__builtin_amdgcn_mfma_f32_32x32x16_bf16(b1,qr[d0],p1,0,0,0);}}
}
typedef __attribute__((address_space(3))) const char* lds_cptr;
typedef __attribute__((address_space(3))) const float* lds_fptr;
typedef short v4i16_t __attribute__((ext_vector_type(4)));
__device__ __forceinline__ void kload8(bf16x8*kf,lds_cptr kp){
  kf[0]=*(const __attribute__((address_space(3))) bf16x8*)(kp);      kf[1]=*(const __attribute__((address_space(3))) bf16x8*)(kp+512);
  kf[2]=*(const __attribute__((address_space(3))) bf16x8*)(kp+2048); kf[3]=*(const __attribute__((address_space(3))) bf16x8*)(kp+2560);
  kf[4]=*(const __attribute__((address_space(3))) bf16x8*)(kp+4096); kf[5]=*(const __attribute__((address_space(3))) bf16x8*)(kp+4608);
  kf[6]=*(const __attribute__((address_space(3))) bf16x8*)(kp+6144); kf[7]=*(const __attribute__((address_space(3))) bf16x8*)(kp+6656);
}
__device__ __forceinline__ void kload2(bf16x8*kf,lds_cptr kp,int j){ kf[2*j]=*(const __attribute__((address_space(3))) bf16x8*)(kp+j*2048); kf[2*j+1]=*(const __attribute__((address_space(3))) bf16x8*)(kp+j*2048+512); }
__device__ __forceinline__ s16x4 vtr(lds_cptr p){ return __builtin_bit_cast(s16x4,__builtin_amdgcn_ds_read_tr16_b64_v4i16((__attribute__((address_space(3))) v4i16_t*)p)); }
__device__ __forceinline__ float rowmax(const f32x16&p0,const f32x16&p1){
  float a=max3f(p0[0],p0[1],p1[0]),b=max3f(p0[2],p0[3],p1[1]);a=max3f(a,p1[2],p1[3]);
  #pragma unroll
  for(int r=4;r<16;r+=4){a=max3f(a,p0[r],p0[r+1]);b=max3f(b,p0[r+2],p0[r+3]);a=max3f(a,p1[r],p1[r+1]);b=max3f(b,p1[r+2],p1[r+3]);}
  const float m=max2f(a,b);
  auto rr=__builtin_amdgcn_permlane32_swap(__float_as_uint(m),__float_as_uint(m),false,false);
  return max2f(__uint_as_float(rr[0]),__uint_as_float(rr[1]));
}
__device__ __forceinline__ void pv(f32x16*o,int vb,bf16x8 pa0,bf16x8 pa1,bf16x8 pa2,bf16x8 pa3){
  #pragma unroll
  for(int d0=0;d0<2;++d0){s16x4 lo[4],hi[4];
    #pragma unroll
    for(int ks=0;ks<4;++ks){
      asm volatile("ds_read_b64_tr_b16 %0,%1 offset:%c2":"=&v"(lo[ks]):"v"(vb),"i"(d0*4096+ks*1024):"memory");
      asm volatile("ds_read_b64_tr_b16 %0,%1 offset:%c2":"=&v"(hi[ks]):"v"(vb),"i"(d0*4096+ks*1024+512):"memory");}
    asm volatile("s_waitcnt lgkmcnt(0)":::"memory");SBAR();
    #define PK(k) (bf16x8){lo[k][0],lo[k][1],lo[k][2],lo[k][3],hi[k][0],hi[k][1],hi[k][2],hi[k][3]}
    o[d0]=__builtin_amdgcn_mfma_f32_32x32x16_bf16(pa0,PK(0),o[d0],0,0,0);
    o[d0]=__builtin_amdgcn_mfma_f32_32x32x16_bf16(pa1,PK(1),o[d0],0,0,0);
    o[d0]=__builtin_amdgcn_mfma_f32_32x32x16_bf16(pa2,PK(2),o[d0],0,0,0);
    o[d0]=__builtin_amdgcn_mfma_f32_32x32x16_bf16(pa3,PK(3),o[d0],0,0,0);
    #undef PK
  }
}
__device__ __forceinline__ int t5_bucket(int rel){
  const int r=rel<0?-rel:rel; int v;
  if(r<8)v=r; else if(r<12)v=8; else if(r<16)v=9; else if(r<23)v=10; else if(r<32)v=11; else if(r<46)v=12; else if(r<64)v=13; else if(r<91)v=14; else v=15;
  return (rel>0?16:0)+v;
}

#ifndef ATTN_STORE16
#define ATTN_STORE16(p,v) (*(u32x4*)(p)=(v))
#endif
template<bool CM> __device__ __forceinline__ float attn_qnorm2(const bf16*Qb,int q0,int wid,int r32,int hi){
  const int wrow=CM?(wid&3)*QBLK:wid*QBLK; const int map=wid>>2; const bf16*Qw=Qb+(long)(q0+wrow)*LDP; float s=0.f;
  #pragma unroll
  for(int d0=0;d0<(CM?2:4);++d0){ const bf16x8 q=*reinterpret_cast<const bf16x8*>(&Qw[(long)r32*LDP+(CM?map*32:0)+d0*16+hi*8]);
    #pragma unroll
    for(int i=0;i<8;++i){ const float f=__uint_as_float((unsigned)(unsigned short)q[i]<<16); s+=f*f; } }
  auto rr=__builtin_amdgcn_permlane32_swap(__float_as_uint(s),__float_as_uint(s),false,false); return __uint_as_float(rr[0])+__uint_as_float(rr[1]);
}
template<bool CM> __device__ __forceinline__ bool attn_bound(const bf16*Qb,int q0,char*shm,const float*kmaxp,float bmax,const int tid){
  const int lane=tid&63,r32=lane&31,hi=lane>>5; const int wid=__builtin_amdgcn_readfirstlane(tid>>6);
  float*red=(float*)(shm+LDS_RED);
  float km=kmaxp[32*(tid&255)+(CM?(tid>>8):0)];
  #pragma unroll
  for(int o=1;o<64;o<<=1)km=fmaxf(km,__shfl_xor(km,o));
  if(lane==0)red[wid]=km;
  const float qn2=attn_qnorm2<CM>(Qb,q0,wid,r32,hi);
  asm volatile("s_waitcnt lgkmcnt(0)\n\ts_barrier":::"memory");
  const int ro=CM?4*(wid>>2):0; const float kmax2=fmaxf(fmaxf(red[ro],red[ro+1]),fmaxf(red[ro+2],red[ro+3]));
  const float bound=sqrtf(qn2*kmax2)*1.0005f+bmax+0.01f;
  const bool bad=__any(!(bound<=60.f));
  if(lane==0)red[8+wid]=bad?1.f:0.f;
  asm volatile("s_waitcnt lgkmcnt(0)\n\ts_barrier":::"memory");
  float f=0.f;
  #pragma unroll
  for(int w=0;w<8;++w)f+=red[8+w];
  return f==0.f;
}
template<bool CM,int THRL,bool FAST,bool LMA=false> __device__ __forceinline__ void attn_unit(const bf16*Qb,const bf16*__restrict__ Kb,const bf16*__restrict__ Vb,bf16*Ob,int q0,char*shm,
                                                                       const float*relb,int h,float lam,float osc,const float*gdiff,float bmax,const int tid){
  const int lane=tid&63,r32=lane&31,hi=lane>>5; const int wid=__builtin_amdgcn_readfirstlane(tid>>6);
  const int wrow=CM?(wid&3)*QBLK:wid*QBLK; const int map=wid>>2;
  const bf16*Qw=Qb+(long)(q0+wrow)*LDP;
  const unsigned lds0=(unsigned)(uintptr_t)shm;
  float*wsf=(float*)(shm+LDS_WS)+wid*64;
  const bf16*ksrc=Kb+(long)lane*LDP+wid*8;
  const bf16*vsrc=Vb+(long)(16*(wid&3)+(lane>>2))*LDP+(wid>>2)*32+(lane&3)*8;
  const unsigned kdst=lds0+LDS_K+wid*1024, vdst=lds0+LDS_V+wid*1024;
  #define DMA_K(t,slot) glds16(ksrc+(long)(t)*KVBLK*LDP,(unsigned)__builtin_amdgcn_readfirstlane(kdst+(slot)))
  #define DMA_V(t,slot) glds16(vsrc+(long)(t)*KVBLK*LDP,(unsigned)__builtin_amdgcn_readfirstlane(vdst+(slot)))
  const int vb0=(int)(lds0+LDS_V)+((lane>>4)&1)*32+(lane&3)*8+(4*hi+((lane&15)>>2))*64;
  const char*Kbase=shm+LDS_K; bf16x8 kf[8];
  const lds_cptr shm3=(lds_cptr)shm; const lds_cptr kp0=shm3+LDS_K+hi*1024+r32*16+(CM?map*4096:0); const lds_cptr vp0=shm3+LDS_V+((lane>>4)&1)*32+(lane&3)*8+(4*hi+((lane&15)>>2))*64;
  const lds_fptr tab3=(lds_fptr)(shm3+LDS_TAB);
    if(CM){ float*tab=(float*)(shm+LDS_TAB); for(int i=tid;i<640;i+=NW*64)tab[i]=LOG2E*relb[t5_bucket(i-320)*4+h]; }
  DMA_K(0,0);DMA_V(0,0);DMA_K(1,SLOTB);
  bf16x8 qr[4];
  #pragma unroll
  for(int d0=0;d0<(CM?2:4);++d0)qr[d0]=*reinterpret_cast<const bf16x8*>(&Qw[(long)r32*LDP+(CM?map*32:0)+d0*16+hi*8]);
  const int jn=q0>>7; const int nlo=2*jn-3, nhi=2*jn+5; const int qabs=q0+wrow+r32;
  bool near=CM&&(nlo<=0); float cside=0.f; if(CM&&!near)cside=LOG2E*relb[15*4+h];
  float mhat=0.f,l_reg=0.f;f32x16 o[2];o[0]=f32x16{};o[1]=f32x16{};asm volatile("":"+v"(o[0]),"+v"(o[1]));f32x16 negm;
  constexpr bool LM=FAST&&LMA;
  f32x16 lacc=f32x16{}; unsigned one_=0x3F803F80u; if constexpr(LM){ asm volatile("":"+v"(lacc),"+v"(one_)); }
  const bf16x8 ONES=__builtin_bit_cast(bf16x8,(u32x4){one_,one_,one_,one_});
  #define NEGM_SET() do{ _Pragma("unroll") for(int r=0;r<16;++r)negm[r]=cside-mhat; asm volatile("":"+v"(negm)); }while(0)
  NEGM_SET();
  #define MODESW(t) do{ if(CM){ if((t)==nlo){near=true;cside=0.f;NEGM_SET();} else if((t)==nhi){near=false;cside=tab3[639];NEGM_SET();} } }while(0)
  #define BIASADD(P0,P1,t) do{ if(CM){ if(near){ const lds_fptr tb_=tab3+(64*(t)-qabs+4*hi+320); \
      _Pragma("unroll") for(int r4=0;r4<4;++r4){ _Pragma("unroll") for(int r=4*r4;r<4*r4+4;++r){P0[r]+=tb_[(r&3)+8*(r>>2)];P1[r]+=tb_[32+(r&3)+8*(r>>2)];} SBAR(); } } } }while(0)
  bool resc=false;
  #define START(P0,P1) do{ if constexpr(!FAST){ const float rm=rowmax(P0,P1); resc=false; \
    { const float dl=rm; mhat=fadd_s(mhat,dl); \
      _Pragma("unroll") for(int r=0;r<16;++r){P0[r]=fsub_s(P0[r],dl);P1[r]=fsub_s(P1[r],dl);} \
      NEGM_SET(); } } \
    _Pragma("unroll") for(int r=0;r<16;++r)P0[r]=__builtin_amdgcn_exp2f(P0[r]); }while(0)
  #define RESC() do{ if constexpr(!FAST) if(resc){ asm volatile("s_waitcnt lgkmcnt(0)":::"memory"); \
      _Pragma("unroll") for(int d_=0;d_<2;++d_) _Pragma("unroll") for(int r=0;r<16;++r)o[d_][r]*=wsf[crow(r,hi)]; } }while(0)
  f32x16 pA0,pA1,pB0,pB1;
  int sl_prev=0,sl_cur=0,sl_next=SLOTB;
  #define ROT() do{sl_prev=sl_cur;sl_cur=sl_next;sl_next=(sl_next==(NSLOT-1)*SLOTB)?0:sl_next+SLOTB;}while(0)
  DMA_K(2,2*SLOTB);
  float qn2_=0.f; if constexpr(FAST)qn2_=attn_qnorm2<CM>(Qb,q0,wid,r32,hi);
  WAIT_BAR(3);
  if constexpr(FAST){ const float*red=(const float*)(shm+LDS_RED); const int ro=CM?4*map:0; const float kmax2=fmaxf(fmaxf(red[ro],red[ro+1]),fmaxf(red[ro+2],red[ro+3]));
    mhat=sqrtf(qn2_*kmax2)*1.0005f+bmax+0.01f; NEGM_SET(); }
  qkt<(CM?2:4)>(pA0,pA1,Kbase+(CM?map*4096:0),qr,negm,r32,hi);asm volatile("s_nop 15\n\ts_nop 7":"+v"(pA0),"+v"(pA1));BIASADD(pA0,pA1,0);
  START(pA0,pA1);
  _Pragma("unroll") for(int r=0;r<16;++r)pA1[r]=__builtin_amdgcn_exp2f(pA1[r]);
  WAIT_BAR(0);
  DMA_K(3,0);DMA_V(1,SLOTB);
  ROT();
  if constexpr(CM){ kload2(kf,kp0+sl_cur,0); kload2(kf,kp0+sl_cur,1); } else { kload8(kf,kp0+sl_cur); }
  WAIT_BAR(2);
  s16x4 vlo[8],vhi[8]; u32x4 pw0,pw1,pw2,pw3;
  #define PKW(P,B) cvtpk_s(P[B],P[B+1])
  #define PAF(k) __builtin_bit_cast(bf16x8,pw##k)
  #define VFR(i) (bf16x8){vlo[i][0],vlo[i][1],vlo[i][2],vlo[i][3],vhi[i][0],vhi[i][1],vhi[i][2],vhi[i][3]}
  #define PIN(x) asm volatile("":"+v"(x))
  #define MX3(a,b,c) __builtin_fmaxf(__builtin_fmaxf((a),(b)),(c))
  #define GAPA(MF,A0,A1,A2,A3,W0,W1,PW) do{ MF; if constexpr(!LM){ sacc+=A0; sacc+=A1; sacc+=A2; sacc+=A3; PIN(sacc); } W0; W1; PIN(PW); SBAR(); }while(0)
  #define LS(k) do{ if constexpr(LM) lacc=__builtin_amdgcn_mfma_f32_32x32x16_bf16(PAF(k),ONES,lacc,0,0,0); }while(0)
  #define EX(v) __builtin_amdgcn_exp2f(v)
  #define GAPB(MF,X,B) do{ MF; X[B]=EX(X[B]); X[B+1]=EX(X[B+1]); X[B+2]=EX(X[B+2]); X[B+3]=EX(X[B+3]); PIN(X); SBAR(); }while(0)
  #define VRD(i) do{ vlo[i]=vtr(vp_+(((i)>>2)*4096+((i)&3)*1024)); vhi[i]=vtr(vp_+(((i)>>2)*4096+((i)&3)*1024+512)); }while(0)
  #define KRD(G,j) do{ if((G)&&(!CM||(j)<2)){ kload2(kf,kp0+sl_next,j); SBAR(); } }while(0)
  #define MF58(stmt) do{ if constexpr(!CM){ stmt; } }while(0)
  #define STEP(C0,C1,P0,P1,t,GK,GV,GL) do{ SBAR(); \
    const lds_cptr vp_=vp0+sl_prev; \
    VRD(0); SBAR(); float sacc=(P0[0]+P0[1]); \
    GAPA(C0=__builtin_amdgcn_mfma_f32_32x32x16_bf16(kf[0],qr[0],negm,0,0,0), P0[2],P0[3],P0[4],P0[5],     pw0[0]=PKW(P0,0), pw0[1]=PKW(P0,2), pw0); \
    VRD(4); SBAR(); GAPA(C1=__builtin_amdgcn_mfma_f32_32x32x16_bf16(kf[1],qr[0],negm,0,0,0), P0[6],P0[7],P0[8],P0[9],     pw0[2]=PKW(P0,4), pw0[3]=PKW(P0,6), pw0); \
    VRD(1); SBAR(); GAPA(C0=__builtin_amdgcn_mfma_f32_32x32x16_bf16(kf[2],qr[1],C0,0,0,0),   P0[10],P0[11],P0[12],P0[13], pw1[0]=PKW(P0,8), pw1[1]=PKW(P0,10), pw1); \
    VRD(5); SBAR(); GAPA(C1=__builtin_amdgcn_mfma_f32_32x32x16_bf16(kf[3],qr[1],C1,0,0,0),   P0[14],P0[15],P1[0],P1[1],   pw1[2]=PKW(P0,12),pw1[3]=PKW(P0,14), pw1); \
    VRD(2); SBAR(); GAPA(MF58(C0=__builtin_amdgcn_mfma_f32_32x32x16_bf16(kf[4],qr[2],C0,0,0,0)),   P1[2],P1[3],P1[4],P1[5],     pw2[0]=PKW(P1,0), pw2[1]=PKW(P1,2), pw2); \
    VRD(6); SBAR(); GAPA(MF58(C1=__builtin_amdgcn_mfma_f32_32x32x16_bf16(kf[5],qr[2],C1,0,0,0)),   P1[6],P1[7],P1[8],P1[9],     pw2[2]=PKW(P1,4), pw2[3]=PKW(P1,6), pw2); \
    VRD(3); SBAR(); GAPA(MF58(C0=__builtin_amdgcn_mfma_f32_32x32x16_bf16(kf[6],qr[3],C0,0,0,0)),   P1[10],P1[11],P1[12],P1[13], pw3[0]=PKW(P1,8), pw3[1]=PKW(P1,10), pw3); \
    VRD(7); SBAR(); GAPA(MF58(C1=__builtin_amdgcn_mfma_f32_32x32x16_bf16(kf[7],qr[3],C1,0,0,0)),   P1[14],P1[15],0.f,0.f,       pw3[2]=PKW(P1,12),pw3[3]=PKW(P1,14), pw3); \
    if constexpr(!LM) l_reg+=sacc; \
    if(GK){DMA_K((t)+3,sl_cur);} if(GV){DMA_V((t)+1,sl_next);} \
    BIASADD(C0,C1,t); \
    if constexpr(!FAST){ float a=MX3(C0[0],C0[1],C1[0]),b=MX3(C0[2],C0[3],C1[1]); a=MX3(a,C1[2],C1[3]); \
      _Pragma("unroll") for(int r=4;r<16;r+=4){a=MX3(a,C0[r],C0[r+1]);b=MX3(b,C0[r+2],C0[r+3]);a=MX3(a,C1[r],C1[r+1]);b=MX3(b,C1[r+2],C1[r+3]);} \
      float rm=__builtin_fmaxf(a,b); { auto rr=__builtin_amdgcn_permlane32_swap(__float_as_uint(rm),__float_as_uint(rm),false,false); rm=__builtin_fmaxf(__uint_as_float(rr[0]),__uint_as_float(rr[1])); } \
      resc=false; \
      if(__builtin_expect(__any(rm>(float)THRL),0)){ const float dl=__builtin_fmaxf(rm,0.f); mhat+=dl; \
        _Pragma("unroll") for(int r=0;r<16;++r){C0[r]-=dl;C1[r]-=dl;} \
        NEGM_SET(); \
        const float f=__builtin_amdgcn_exp2f(-dl); l_reg*=f; if(hi==0)wsf[r32]=f; resc=true; } } \
    SBAR(); \
    GAPB(o[0]=__builtin_amdgcn_mfma_f32_32x32x16_bf16(PAF(0),VFR(0),o[0],0,0,0), C0,0); \
    GAPB(o[1]=__builtin_amdgcn_mfma_f32_32x32x16_bf16(PAF(0),VFR(4),o[1],0,0,0); LS(0), C0,4); \
    KRD(GL,0); GAPB(o[0]=__builtin_amdgcn_mfma_f32_32x32x16_bf16(PAF(1),VFR(1),o[0],0,0,0), C0,8); \
    KRD(GL,1); GAPB(o[1]=__builtin_amdgcn_mfma_f32_32x32x16_bf16(PAF(1),VFR(5),o[1],0,0,0); LS(1), C0,12); \
    KRD(GL,2); GAPB(o[0]=__builtin_amdgcn_mfma_f32_32x32x16_bf16(PAF(2),VFR(2),o[0],0,0,0), C1,0); \
    KRD(GL,3); GAPB(o[1]=__builtin_amdgcn_mfma_f32_32x32x16_bf16(PAF(2),VFR(6),o[1],0,0,0); LS(2), C1,4); \
    GAPB(o[0]=__builtin_amdgcn_mfma_f32_32x32x16_bf16(PAF(3),VFR(3),o[0],0,0,0), C1,8); \
    GAPB(o[1]=__builtin_amdgcn_mfma_f32_32x32x16_bf16(PAF(3),VFR(7),o[1],0,0,0); LS(3), C1,12); \
    }while(0)
  int t=1;
  { constexpr int PADN=CM?(FAST?PAD_CF:PAD_CS):(FAST?PAD_AF:PAD_AS); asm volatile(".p2align 6\n\t.rept %c0\n\ts_nop 0\n\t.endr"::"i"(PADN):"memory"); }
  for(;t+5<NT;t+=2){
    MODESW(t);
    STEP(pB0,pB1,pA0,pA1,t,true,true,true);     WAIT_BAR(2); RESC(); ROT();
    STEP(pA0,pA1,pB0,pB1,t+1,true,true,true);   WAIT_BAR(2); RESC(); ROT();
  }
  #define ENDW(tt) do{ if((tt)+3<NT){WAIT_BAR(2);} else if((tt)+2<NT){WAIT_BAR(1);} else {WAIT_BAR(0);} }while(0)
  for(;t+1<NT;t+=2){
    MODESW(t);
    STEP(pB0,pB1,pA0,pA1,t,(t+3<NT),(t+1<NT),(t+1<NT));       ENDW(t);   RESC(); ROT();
    STEP(pA0,pA1,pB0,pB1,t+1,(t+4<NT),(t+2<NT),(t+2<NT));     ENDW(t+1); RESC(); ROT();
  }
  MODESW(NT-1);
  STEP(pB0,pB1,pA0,pA1,NT-1,false,false,false); RESC();
  { if constexpr(!LM){ float sacc=pB0[0]+pB0[1]; _Pragma("unroll") for(int r=2;r<16;++r)sacc+=pB0[r]; _Pragma("unroll") for(int r=0;r<16;++r)sacc+=pB1[r]; l_reg+=sacc; }
    pw0=(u32x4){PKW(pB0,0),PKW(pB0,2),PKW(pB0,4),PKW(pB0,6)};pw1=(u32x4){PKW(pB0,8),PKW(pB0,10),PKW(pB0,12),PKW(pB0,14)};pw2=(u32x4){PKW(pB1,0),PKW(pB1,2),PKW(pB1,4),PKW(pB1,6)};pw3=(u32x4){PKW(pB1,8),PKW(pB1,10),PKW(pB1,12),PKW(pB1,14)};
    SBAR(); pv(o,vb0+sl_cur,PAF(0),PAF(1),PAF(2),PAF(3)); LS(0); LS(1); LS(2); LS(3); }
  #undef PKW
  #undef PAF
  #undef VFR
  #undef PIN
  #undef MX3
  #undef GAPA
  #undef LS
  #undef GAPB
  #undef EX
  #undef VRD
  #undef KRD
  #undef MF58
  #undef STEP
  #undef ENDW
  float rli[16];
  if constexpr(LM){
    #pragma unroll
    for(int r=0;r<16;++r)rli[r]=__builtin_amdgcn_rcpf(lacc[r]);
  } else {
    {auto rr=__builtin_amdgcn_permlane32_swap(__float_as_uint(l_reg),__float_as_uint(l_reg),false,false);l_reg=__uint_as_float(rr[0])+__uint_as_float(rr[1]);}
    if(hi==0)wsf[32+r32]=l_reg;asm volatile("s_waitcnt lgkmcnt(0)":::"memory");
    #pragma unroll
    for(int r=0;r<16;++r)rli[r]=__builtin_amdgcn_rcpf(wsf[32+crow(r,hi)]);
  }
  if(!CM){
    bf16*Ow=Ob+(long)(q0+wid*QBLK)*LDO;
    bf16*stg=(bf16*)(shm+LDS_OST)+wid*2048;
    #pragma unroll
    for(int r=0;r<16;++r){const int orow=crow(r,hi);
      #pragma unroll
      for(int d0=0;d0<2;++d0)stg[orow*64+d0*32+r32]=__float2bfloat16(o[d0][r]*rli[r]);}
    asm volatile("s_waitcnt lgkmcnt(0)":::"memory");
    #pragma unroll
    for(int i=0;i<4;++i){const int row=i*8+(lane>>3),ch=lane&7; const u32x4 v=*(const u32x4*)(stg+row*64+ch*8); ATTN_STORE16(Ow+(long)row*LDO+ch*8,v);}
  } else {
    const float msc=(map==0)?1.f:-lam;
    float*stg=(float*)(shm+LDS_OST)+map*8192+(wid&3)*2048;
    #pragma unroll
    for(int r=0;r<16;++r){const int orow=crow(r,hi); const float sc=rli[r]*msc;
      #pragma unroll
      for(int d0=0;d0<2;++d0)stg[orow*64+d0*32+r32]=o[d0][r]*sc;}
    asm volatile("s_waitcnt lgkmcnt(0)\n\ts_barrier":::"memory");
    const int row=16*wid+(lane>>2),part=lane&3;
    const float*s0=(const float*)(shm+LDS_OST)+row*64+part*16;
    f32x4a a[4]; float ss=0.f;
    #pragma unroll
    for(int i=0;i<4;++i){ a[i]=((const f32x4a*)s0)[i]+((const f32x4a*)(s0+8192))[i]; ss+=a[i][0]*a[i][0]+a[i][1]*a[i][1]+a[i][2]*a[i][2]+a[i][3]*a[i][3]; }
    ss+=__shfl_xor(ss,1); ss+=__shfl_xor(ss,2);
    const float rn=osc/sqrtf(ss*(1.0f/64.0f)+1e-6f);
    unsigned w[8];
    #pragma unroll
    for(int i=0;i<4;++i){ const f32x4a g=((const f32x4a*)(gdiff+part*16))[i]; w[2*i]=cvtpk_s(a[i][0]*rn*g[0],a[i][1]*rn*g[1]); w[2*i+1]=cvtpk_s(a[i][2]*rn*g[2],a[i][3]*rn*g[3]); }
    bf16*op=Ob+(long)(q0+row)*LDO+part*16;
    *(u32x4*)(op)=(u32x4){w[0],w[1],w[2],w[3]}; *(u32x4*)(op+8)=(u32x4){w[4],w[5],w[6],w[7]};
  }
  asm volatile("s_waitcnt lgkmcnt(0)\n\ts_barrier":::"memory");
  #undef DMA_K
  #undef DMA_V
  #undef BIASADD
  #undef MODESW
  #undef NEGM_SET
  #undef START
  #undef RESC
  #undef ROT
}
#undef SBAR
#undef WAIT_BAR
}
#define GAS __attribute__((address_space(1)))
#define LAS __attribute__((address_space(3)))
typedef unsigned short bf16;
typedef unsigned v4u __attribute__((ext_vector_type(4)));
typedef float f32x4 __attribute__((ext_vector_type(4)));
typedef short bf16x8 __attribute__((ext_vector_type(8)));
typedef GAS unsigned gu32;
typedef GAS unsigned long long gu64;
#define RLX_AGENT __ATOMIC_RELAXED, __HIP_MEMORY_SCOPE_AGENT
#define LDS_WAIT() asm volatile("s_waitcnt lgkmcnt(0)" ::: "memory")
#define VM_WAIT() asm volatile("s_waitcnt vmcnt(0)" ::: "memory")
__device__ __forceinline__ unsigned long long rt() { return __builtin_amdgcn_s_memrealtime(); }
__device__ __forceinline__ unsigned f2bf(float f) { unsigned u = __builtin_bit_cast(unsigned, f); return (u + 0x7fffu + ((u >> 16) & 1u)) >> 16; }
__device__ __forceinline__ unsigned pk2(float lo, float hi) { return f2bf(lo) | (f2bf(hi) << 16); }

#define XB_TMO      128
#define XB_XCNT(j)  (256  + 64 * (j))
#define XB_XSUB(j)  (1280 + 64 * (j))
#define XB_XGEN(j)  (2304 + 64 * (j))
#define XB_TOP      3328
#define XB_TOPGEN   3392
#define XCD_BAR_WORDS 3456
#define XB_SPIN_CAP (1u << 18)

__device__ __forceinline__ unsigned xb_ld(unsigned* p)              { return __hip_atomic_load(p, __ATOMIC_RELAXED, __HIP_MEMORY_SCOPE_AGENT); }
__device__ __forceinline__ unsigned xb_add(unsigned* p, unsigned v) { return __hip_atomic_fetch_add(p, v, __ATOMIC_RELAXED, __HIP_MEMORY_SCOPE_AGENT); }
__device__ __forceinline__ unsigned xb_xcc_id() { return (unsigned)__builtin_amdgcn_s_getreg((3 << 11) | 20) & 0xFu; }
#define XB_SPIN(cond, bar) do { unsigned _sp = 0; while (cond) { __builtin_amdgcn_s_sleep(1); \
    if ((++_sp & 255u) == 0u) { if (xb_ld(&(bar)[XB_TMO])) break; if (_sp > XB_SPIN_CAP) { atomicAdd(&(bar)[XB_TMO], 1u); break; } } } } while (0)

struct XcdBarrier {
    unsigned* bar; unsigned x;
    volatile LAS unsigned* st;
};

__device__ __forceinline__ XcdBarrier xcd_barrier_post(unsigned* bar, volatile LAS unsigned* st, int tid_) {
    XcdBarrier b; b.bar = bar; b.x = xb_xcc_id(); b.st = st;
    if (tid_ == 0) (void)xb_add(&bar[XB_XCNT(b.x)], 1u);
    return b;
}
__device__ __forceinline__ void xcd_barrier_complete(unsigned* bar, unsigned x, unsigned& nloc, unsigned& nx) {
    const unsigned G = gridDim.x * gridDim.y * gridDim.z;
    unsigned sum, cnt, mine, sp = 0u;
    for (;;) {
        sum = 0u; cnt = 0u; mine = 0u;
#pragma unroll
        for (unsigned j = 0; j < 16; ++j) { const unsigned c = xb_ld(&bar[XB_XCNT(j)]); sum += c; cnt += (c > 0u) ? 1u : 0u; mine = (j == x) ? c : mine; }
        if (sum == G) break;
        __builtin_amdgcn_s_sleep(1);
        if ((++sp & 255u) == 0u) { if (xb_ld(&bar[XB_TMO])) break; if (sp > XB_SPIN_CAP) { atomicAdd(&bar[XB_TMO], 1u); break; } }
    }
    nloc = mine > 0u ? mine : 1u; nx = cnt > 0u ? cnt : 1u;
}

__device__ __forceinline__ void xcd_barrier(const XcdBarrier& b, int tid_) {
    asm volatile("s_waitcnt vmcnt(0)" ::: "memory");
    __syncthreads();
    if (tid_ == 0) {
        unsigned* bar = b.bar;
        __builtin_amdgcn_s_waitcnt(0);
        unsigned nloc = b.st[0], nx = b.st[1];
        if (nloc == 0u) { xcd_barrier_complete(bar, b.x, nloc, nx); b.st[0] = nloc; b.st[1] = nx; }
        const unsigned old = xb_add(&bar[XB_XSUB(b.x)], 1u);
        const unsigned gen = old / nloc;
        if (old + 1u == (gen + 1u) * nloc) {
            __builtin_amdgcn_fence(__ATOMIC_RELEASE, "agent");
            asm volatile("s_waitcnt vmcnt(0)" ::: "memory");
            const unsigned og = xb_add(&bar[XB_TOP], 1u);
            const unsigned tg = og / nx;
            if (og + 1u == (tg + 1u) * nx) xb_add(&bar[XB_TOPGEN], 1u);
            else XB_SPIN(xb_ld(&bar[XB_TOPGEN]) == tg, bar);
            __builtin_amdgcn_fence(__ATOMIC_ACQUIRE, "agent");
            xb_add(&bar[XB_XGEN(b.x)], 1u);
            asm volatile("s_waitcnt vmcnt(0)" ::: "memory");
        } else {
            XB_SPIN(xb_ld(&bar[XB_XGEN(b.x)]) == gen, bar);
            __builtin_amdgcn_fence(__ATOMIC_ACQUIRE, "agent");
            asm volatile("s_waitcnt vmcnt(0)" ::: "memory");
        }
    }
    __syncthreads();
}
constexpr int NWAVES = 8, NTHR = 512;
constexpr int NB = 2, S = 16384, T = NB * S, D = 1024, DEPTH = 4, NE = 16, CAP = 2048;
constexpr int NPROJ = 2816, NGATE = 4096, NCAT = NPROJ + NGATE, LDP = NPROJ;
constexpr int NPROJ_BF = 0, NPROJ_I8 = NPROJ - NPROJ_BF;
constexpr int PC_AQ = 0, PC_AK = 256, PC_AV = 384, PC_CQ = 512, PC_CK = 768, PC_CV = 1024, PC_Z = 1280, PC_XS = 1536, PC_BM = 1792, PC_CM = 2048, PC_UV = 2304;
constexpr float EPS = 1e-6f, LOG2E = 1.4426950408889634f;
constexpr int PAD_PL0 = 5, PAD_PROJ = 7, PAD_PL = 5, PAD_GATE = 8, PAD_P5 = 0, PAD_P6 = 5, PAD_GU = 8, PAD_DN = 8, PAD_PLE = 8;
constexpr int NPH = 14;
constexpr int NGP = DEPTH * NPH + 1;

constexpr size_t MiB = 1u << 20;
constexpr size_t WS_CTL = 0, CTL_ZERO_BYTES = 1 * MiB;
constexpr size_t WS_DT = 1 * MiB;
constexpr size_t WS_AFF = 2 * MiB;
constexpr size_t WS_SELIDX = 4 * MiB;
constexpr size_t WS_SELAFF = 4 * MiB + 256 * 1024;
constexpr size_t WS_INV = 5 * MiB;
constexpr size_t WS_TAB = 6 * MiB;
constexpr size_t WS_CD = 8 * MiB;
constexpr size_t WS_WSP = 8 * MiB + 512 * 1024;
constexpr size_t WS_SSQ = 9 * MiB;
constexpr size_t WS_KMAX = 9 * MiB + 512 * 1024;
constexpr size_t WS_SA = 9 * MiB + 576 * 1024;
constexpr size_t WS_SW = 9 * MiB + 768 * 1024;
constexpr size_t WS_WCAT = 10 * MiB;
constexpr size_t WS_WBR = 24 * MiB, WS_WPG = 26 * MiB, WS_WPLE = 28 * MiB;
constexpr size_t WS_WGU = 32 * MiB;
constexpr size_t WS_WDN = 96 * MiB;
constexpr size_t WS_H = 128 * MiB;
constexpr size_t WS_PROJ = 192 * MiB;
constexpr size_t WS_GATES = 368 * MiB;
constexpr size_t WS_XE = 192 * MiB, WS_HID = 320 * MiB, WS_YE = 448 * MiB;
constexpr size_t WS_BR = 624 * MiB;
constexpr size_t WS_PL = 688 * MiB;
constexpr size_t WS_PBF = 752 * MiB;
constexpr size_t WS_ST = 768 * MiB;
constexpr size_t WS_SB = 832 * MiB;
constexpr size_t WS_XBC = 864 * MiB;
constexpr size_t WS_WOUT = 912 * MiB;
constexpr size_t WS_H8 = 914 * MiB;
constexpr size_t WS_XB = 946 * MiB;
constexpr size_t WS_END = 1010 * MiB;
constexpr int CW_TMO = 0, CW_BAR = 4096;

constexpr int RING_BYTES = 131072, LDSCTL_OFF = RING_BYTES, MISC_OFF = LDSCTL_OFF + 320, LDS_BYTES = 147456;

struct P {
    const float *x, *p, *rel_bias, *g_mix, *w_in, *g_qnorm, *g_knorm, *conv_w, *conv_b, *dt_bias_f, *dt_bias_b, *a_log_f, *a_log_b, *d_skip, *g_ssm,
                *lambda_q1, *lambda_k1, *lambda_q2, *lambda_k2, *g_diff, *g_sgu, *w_spatial, *b_spatial, *w_branch, *w_branch_gate, *w_out, *g_moe, *w_router,
                *w_exp_gate, *w_exp_up, *w_exp_down, *g_ple, *w_ple_gate, *w_ple, *g_final;
    float* out; unsigned char* ws;
    int gp_lo, gp_hi;
};

__device__ __forceinline__ float wave_sum(float v) {
#pragma unroll
    for (int o = 1; o < 64; o <<= 1) v += __shfl_xor(v, o);
    return v;
}
__device__ __forceinline__ float bf2f(unsigned short u) { return __builtin_bit_cast(float, (unsigned)u << 16); }
__device__ __forceinline__ float silu_f(float x) { return x * __builtin_amdgcn_rcpf(1.0f + __builtin_amdgcn_exp2f(-LOG2E * x)); }
__device__ __forceinline__ float gelu_tanh(float x) { const float y = 0.7978845608028654f * (x + 0.044715f * x * x * x); const float e = __builtin_amdgcn_exp2f(2.0f * LOG2E * y); return 0.5f * x * (2.0f - 2.0f * __builtin_amdgcn_rcpf(e + 1.0f)); }
__device__ __forceinline__ float softplus_f(float x) {
    const float e = __builtin_amdgcn_exp2f(-LOG2E * fabsf(x));
    const float l = (e < 0.03125f) ? e * (1.0f - e * (0.5f - e * (0.33333334f - 0.25f * e))) : 0.6931471805599453f * __builtin_amdgcn_logf(1.0f + e);
    return fmaxf(x, 0.f) + l; }
__device__ __forceinline__ f32x4 mfma16(bf16x8 a, bf16x8 b, f32x4 c) { return __builtin_amdgcn_mfma_f32_16x16x32_bf16(a, b, c, 0, 0, 0); }
typedef short bf16x4 __attribute__((ext_vector_type(4)));
typedef unsigned v2u __attribute__((ext_vector_type(2)));
__device__ __forceinline__ f32x4 xb_unpack(const v2u w) { return (f32x4){__builtin_bit_cast(float, w.x << 16), __builtin_bit_cast(float, w.x & 0xffff0000u), __builtin_bit_cast(float, w.y << 16), __builtin_bit_cast(float, w.y & 0xffff0000u)}; }

__device__ __forceinline__ void tr_item(const float* W, int ldw, int k0, int scol0, bf16* WT, int ldk, int drow0, LAS float* scr, int lane) {
#pragma unroll 8
    for (int i = 0; i < 32; ++i) { const int kk = 2 * i + (lane >> 5); scr[kk * 33 + (lane & 31)] = W[(size_t)(k0 + kk) * ldw + scol0 + (lane & 31)]; }
    LDS_WAIT(); asm volatile("" ::: "memory");
    const int c = lane & 7;
#pragma unroll
    for (int j = 0; j < 4; ++j) { const int n = (lane >> 3) + 8 * j; const LAS float* s = scr + (8 * c) * 33 + n;
        v4u o; o.x = pk2(s[0 * 33], s[1 * 33]); o.y = pk2(s[2 * 33], s[3 * 33]); o.z = pk2(s[4 * 33], s[5 * 33]); o.w = pk2(s[6 * 33], s[7 * 33]);
        *(GAS v4u*)(WT + (size_t)(drow0 + n) * ldk + k0 + 8 * c) = o; }
    LDS_WAIT(); asm volatile("" ::: "memory");
}
__device__ __forceinline__ void tr_item8(const float* W, int ldw, int k0, int scol0, unsigned char* WT, int ldk, int drow0, float scale, LAS float* scr, int lane) {
#pragma unroll 8
    for (int i = 0; i < 32; ++i) { const int kk = 2 * i + (lane >> 5); scr[kk * 33 + (lane & 31)] = W[(size_t)(k0 + kk) * ldw + scol0 + (lane & 31)]; }
    LDS_WAIT(); asm volatile("" ::: "memory");
    const int c = lane & 3;
#pragma unroll
    for (int j = 0; j < 2; ++j) { const int n = (lane >> 2) + 16 * j; const LAS float* s = scr + (16 * c) * 33 + n; int w[4];
#pragma unroll
        for (int q = 0; q < 4; ++q) { int t = 0; t = __builtin_amdgcn_cvt_pk_fp8_f32(scale * s[(4 * q) * 33], scale * s[(4 * q + 1) * 33], t, false); t = __builtin_amdgcn_cvt_pk_fp8_f32(scale * s[(4 * q + 2) * 33], scale * s[(4 * q + 3) * 33], t, true); w[q] = t; }
        *(GAS v4u*)(WT + (size_t)(drow0 + n) * ldk + k0 + 16 * c) = (v4u){(unsigned)w[0], (unsigned)w[1], (unsigned)w[2], (unsigned)w[3]}; }
    LDS_WAIT(); asm volatile("" ::: "memory");
}
__device__ __forceinline__ void tr_item_i8(const float* W, int ldw, int k0, int scol0, unsigned char* WT, int ldk, int drow0, const LAS float* inv, LAS float* scr, int lane) {
#pragma unroll 8
    for (int i = 0; i < 32; ++i) { const int kk = 2 * i + (lane >> 5); scr[kk * 33 + (lane & 31)] = W[(size_t)(k0 + kk) * ldw + scol0 + (lane & 31)]; }
    LDS_WAIT(); asm volatile("" ::: "memory");
    const int c = lane & 3;
#pragma unroll
    for (int j = 0; j < 2; ++j) { const int n = (lane >> 2) + 16 * j; const LAS float* s = scr + (16 * c) * 33 + n; const float iv = inv[n]; unsigned w[4];
#pragma unroll
        for (int q = 0; q < 4; ++q) { const int b0 = (int)rintf(iv * s[(4 * q) * 33]), b1 = (int)rintf(iv * s[(4 * q + 1) * 33]), b2 = (int)rintf(iv * s[(4 * q + 2) * 33]), b3 = (int)rintf(iv * s[(4 * q + 3) * 33]);
            w[q] = (unsigned)(b0 & 0xff) | ((unsigned)(b1 & 0xff) << 8) | ((unsigned)(b2 & 0xff) << 16) | ((unsigned)(b3 & 0xff) << 24); }
        *(GAS v4u*)(WT + (size_t)(drow0 + n) * ldk + k0 + 16 * c) = (v4u){w[0], w[1], w[2], w[3]}; }
    LDS_WAIT(); asm volatile("" ::: "memory");
}
__device__ __forceinline__ void gatew_item(const float* W, int ldw, int scol, int nb, unsigned char* WT, float* SWo, unsigned char* ldsg, int wave, int lane, int tid) {
    LAS unsigned char* lds = (LAS unsigned char*)ldsg;
    LAS float* scr = (LAS float*)(lds + wave * 16384);
    LAS float* cmax = (LAS float*)(lds + RING_BYTES + 512);
    LAS float* inv = cmax + 256;
    float mx = 0.f;
#pragma unroll 1
    for (int kb2 = 0; kb2 < 2; ++kb2) { const int k0 = 64 * (2 * wave + kb2);
#pragma unroll 8
        for (int i = 0; i < 32; ++i) { const int kk = 2 * i + (lane >> 5); mx = fmaxf(mx, fabsf(W[(size_t)(k0 + kk) * ldw + scol + (lane & 31)])); } }
    mx = fmaxf(mx, __shfl_xor(mx, 32));
    if (lane < 32) cmax[wave * 32 + lane] = mx;
    __syncthreads();
    if (tid < 32) { float m2 = 0.f;
#pragma unroll
        for (int w = 0; w < 8; ++w) m2 = fmaxf(m2, cmax[w * 32 + tid]);
        m2 = fmaxf(m2, 1e-30f); inv[tid] = 127.0f / m2; SWo[32 * nb + tid] = m2 * (1.0f / 127.0f); }
    __syncthreads();
#pragma unroll 1
    for (int kb2 = 0; kb2 < 2; ++kb2) tr_item_i8(W, ldw, 64 * (2 * wave + kb2), scol, WT, 1024, 32 * nb, inv, scr, lane);
    __syncthreads();
}
__device__ __forceinline__ int win_src(int drow) {
    return drow < 512 ? drow : drow < 1280 ? 1544 + (drow - 512) : drow < 2304 ? 512 + (drow - 1280) : 2312 + (drow - 2304);
}

__device__ __forceinline__ void ph_convw(const P& a, int L, unsigned char* lds, int gw, int NGW, int wave, int lane, int tid, int gtid, int GT, int wgi, int nwg, int part) {
    unsigned char* ws = a.ws;
    LAS float* scr = (LAS float*)((LAS unsigned char*)lds + wave * 16384);
    constexpr int I1 = 16 * (NPROJ_BF / 32), I2 = 0, I3 = 512, I4 = 512, I5 = 0, I6 = 4 * 32, I7 = NE * 2 * 512, I8 = NE * 512;
    constexpr int NIT = I1 + I2 + I3 + I4 + I5 + I6 + I7 + I8, NEARLY = I1 + I2 + I3 + I4 + I5 + I6;
    const int it0 = (part == 2) ? NEARLY : 0, it1 = (part == 1) ? NEARLY : NIT;
    for (int it = it0 + gw; it < it1; it += NGW) {
        int r = it;
        if constexpr (I1 > 0) if (r < I1) { constexpr int NBB = (NPROJ_BF > 0) ? NPROJ_BF / 32 : 1; const int kb = r / NBB, nb = r % NBB; tr_item(a.w_in + (size_t)L * 1024 * 2824, 2824, 64 * kb, win_src(32 * nb), (bf16*)(ws + WS_WCAT), 1024, 32 * nb, scr, lane); continue; } r -= I1;
        if (r < I3) { const int n = r / 128, rr = r % 128, kb = rr / 32, nb = rr % 32; tr_item(a.w_branch + ((size_t)L * 4 + n) * 256 * 1024, 1024, 64 * kb, 32 * nb, (bf16*)(ws + WS_WBR), 256, n * 1024 + 32 * nb, scr, lane); continue; } r -= I3;
        if (r < I4) { const int kb = r / 32, nb = r % 32; tr_item(a.w_out + (size_t)L * 1024 * 1024, 1024, 64 * kb, 32 * nb, (bf16*)(ws + WS_WOUT), 1024, 32 * nb, scr, lane); continue; } r -= I4;
        if (r < I6) { const int kb = r / 32, nb = r % 32; tr_item(a.w_ple + (size_t)L * 256 * 1024, 1024, 64 * kb, 32 * nb, (bf16*)(ws + WS_WPLE), 256, 32 * nb, scr, lane); continue; } r -= I6;
        if (r < I7) { const int e = r / 1024, up = (r / 512) & 1, rr = r % 512, kb = rr / 32, nb = rr % 32;
            const float* W = (up ? a.w_exp_up : a.w_exp_gate) + ((size_t)L * NE + e) * 1024 * 1024;
            const int drow = e * 2048 + ((32 * nb) / 128) * 256 + up * 128 + ((32 * nb) % 128);
            tr_item8(W, 1024, 64 * kb, 32 * nb, (unsigned char*)(ws + WS_WGU), 1024, drow, 32.0f, scr, lane); continue; } r -= I7;
        { const int e = r / 512, rr = r % 512, kb = rr / 32, nb = rr % 32;
            tr_item8(a.w_exp_down + ((size_t)L * NE + e) * 1024 * 1024, 1024, 64 * kb, 32 * nb, (unsigned char*)(ws + WS_WDN), 1024, e * 1024 + 32 * nb, 32.0f, scr, lane); }
    }
    __syncthreads();
    for (int it = wgi; it < 160 + NPROJ_I8 / 32; it += nwg) {
        const bool late = (it >= 128 && it < 160);
        if ((part == 1 && late) || (part == 2 && !late)) continue;
        if (it < 128) gatew_item(a.w_branch_gate + (size_t)L * 1024 * 4096, 4096, 32 * it, it, (unsigned char*)(ws + WS_WCAT) + (size_t)NPROJ * 2048, (float*)(ws + WS_SW), lds, wave, lane, tid);
        else if (it < 160) gatew_item(a.w_ple_gate + (size_t)L * 1024 * 1024, 1024, 32 * (it - 128), it - 128, (unsigned char*)(ws + WS_WPG), (float*)(ws + WS_SW) + 4096, lds, wave, lane, tid);
        else gatew_item(a.w_in + (size_t)L * 1024 * 2824, 2824, win_src(NPROJ_BF + 32 * (it - 160)), it - 160, (unsigned char*)(ws + WS_WCAT) + (size_t)NPROJ_BF * 2048, (float*)(ws + WS_SW) + 5120, lds, wave, lane, tid); }
    if (part != 2) {
        const float* ps = a.p + (size_t)L * T * 256; bf16* pd = (bf16*)(ws + WS_PBF);
        for (int i = gtid; i < T * 256 / 8; i += GT) { const f32x4 v0 = ((const f32x4*)ps)[2 * i], v1 = ((const f32x4*)ps)[2 * i + 1];
            v4u o; o.x = pk2(v0[0], v0[1]); o.y = pk2(v0[2], v0[3]); o.z = pk2(v1[0], v1[1]); o.w = pk2(v1[2], v1[3]); ((v4u*)pd)[i] = o; }
        const float* ss = a.w_spatial + (size_t)L * 4 * 128 * 128; bf16* sd = (bf16*)(ws + WS_WSP);
        for (int i = gtid; i < 4 * 128 * 128 / 8; i += GT) { const f32x4 v0 = ((const f32x4*)ss)[2 * i], v1 = ((const f32x4*)ss)[2 * i + 1];
            v4u o; o.x = pk2(v0[0], v0[1]); o.y = pk2(v0[2], v0[3]); o.z = pk2(v1[0], v1[1]); o.w = pk2(v1[2], v1[3]); ((v4u*)sd)[i] = o; }
    }
    __syncthreads();
}
__device__ __forceinline__ void ph_r0(const P& a, int L, unsigned char* lds, int gw, int NGW, int lane, int tid) {
    unsigned char* ws = a.ws;
    LAS float* wdt = (LAS float*)lds;
    { const float* wi = a.w_in + (size_t)L * 1024 * 2824 + 1536;
      for (int i = tid; i < 1024 * 8; i += NTHR) { const int kq = i >> 3, e8 = i & 7, pos = ((kq >> 8) * 4 + (kq & 3)) * 64 + ((kq >> 2) & 63);
          wdt[((e8 >> 2) * 1024 + pos) * 4 + (e8 & 3)] = wi[(size_t)kq * 2824 + e8]; } }
    __syncthreads();
    const float* xin = a.x; bf16* XB = (bf16*)(ws + WS_XB); const bool l0 = (L == 0);
    const float* gm = a.g_mix + L * D; bf16* H = (bf16*)(ws + WS_H); float* DT = (float*)(ws + WS_DT);
    f32x4 gv[4];
#pragma unroll
    for (int j = 0; j < 4; ++j) gv[j] = ((const f32x4*)gm)[lane + 64 * j];
    const float bias_l = (((lane >> 3) & 7) < 4) ? a.dt_bias_f[L * 4 + ((lane >> 3) & 3)] : a.dt_bias_b[L * 4 + ((lane >> 3) & 3)];
    f32x4 nv[4]; v2u nb[4];
#pragma unroll
    for (int j = 0; j < 4; ++j) { nv[j] = (f32x4){0.f, 0.f, 0.f, 0.f}; nb[j] = (v2u){0u, 0u}; }
    if (gw < T) {
        if (l0) { const GAS f32x4* xr = (const GAS f32x4*)(xin + (size_t)gw * D) + lane;
#pragma unroll
            for (int j = 0; j < 4; ++j) nv[j] = xr[64 * j]; }
        else { const GAS v2u* xr = (const GAS v2u*)(XB + (size_t)gw * D) + lane;
#pragma unroll
            for (int j = 0; j < 4; ++j) nb[j] = xr[64 * j]; } }
    for (int m = gw; m < T; m += NGW) {
        asm volatile("" ::: "memory");
        f32x4 v[4]; float ss = 0.f;
        if (l0) { GAS v2u* xo = (GAS v2u*)(XB + (size_t)m * D) + lane;
#pragma unroll
            for (int j = 0; j < 4; ++j) { v[j] = nv[j]; xo[64 * j] = (v2u){pk2(v[j][0], v[j][1]), pk2(v[j][2], v[j][3])}; } }
        else {
#pragma unroll
            for (int j = 0; j < 4; ++j) v[j] = xb_unpack(nb[j]); }
        if (m + NGW < T) {
            if (l0) { const GAS f32x4* xr = (const GAS f32x4*)(xin + (size_t)(m + NGW) * D) + lane;
#pragma unroll
                for (int j = 0; j < 4; ++j) nv[j] = xr[64 * j]; }
            else { const GAS v2u* xr = (const GAS v2u*)(XB + (size_t)(m + NGW) * D) + lane;
#pragma unroll
                for (int j = 0; j < 4; ++j) nb[j] = xr[64 * j]; } }
#pragma unroll
        for (int j = 0; j < 4; ++j) { ss += (v[j][0] * v[j][0] + v[j][1] * v[j][1]) + (v[j][2] * v[j][2] + v[j][3] * v[j][3]); }
        const float rs = 1.0f / sqrtf(wave_sum(ss) * (1.0f / D) + EPS);
        float d8[8] = {0.f, 0.f, 0.f, 0.f, 0.f, 0.f, 0.f, 0.f};
        GAS unsigned long long* o8 = (GAS unsigned long long*)(H + (size_t)m * D) + lane; GAS unsigned* o4 = (GAS unsigned*)(ws + WS_H8 + (size_t)m * D) + lane;
        float amx = 0.f;
#pragma unroll
        for (int j = 0; j < 4; ++j) { v[j] = v[j] * rs * gv[j]; amx = fmaxf(fmaxf(amx, fmaxf(fabsf(v[j][0]), fabsf(v[j][1]))), fmaxf(fabsf(v[j][2]), fabsf(v[j][3]))); }
#pragma unroll
        for (int o = 1; o < 64; o <<= 1) amx = fmaxf(amx, __shfl_xor(amx, o));
        amx = fmaxf(amx, 1e-30f); const float qinv = 127.0f / amx;
        if (lane == 0) ((float*)(ws + WS_SA))[m] = amx * (1.0f / 127.0f);
#pragma unroll
        for (int j = 0; j < 4; ++j) {
            if constexpr (NPROJ_BF > 0) o8[64 * j] = (unsigned long long)pk2(v[j][0], v[j][1]) | ((unsigned long long)pk2(v[j][2], v[j][3]) << 32);
            { const int b0 = (int)rintf(qinv * v[j][0]), b1 = (int)rintf(qinv * v[j][1]), b2 = (int)rintf(qinv * v[j][2]), b3 = (int)rintf(qinv * v[j][3]);
              o4[64 * j] = (unsigned)(b0 & 0xff) | ((unsigned)(b1 & 0xff) << 8) | ((unsigned)(b2 & 0xff) << 16) | ((unsigned)(b3 & 0xff) << 24); }
#pragma unroll
            for (int c = 0; c < 4; ++c) { const LAS f32x4* wr = (const LAS f32x4*)wdt + (j * 4 + c) * 64 + lane; const f32x4 w0 = wr[0], w1 = wr[1024];
                d8[0] += v[j][c] * w0[0]; d8[1] += v[j][c] * w0[1]; d8[2] += v[j][c] * w0[2]; d8[3] += v[j][c] * w0[3];
                d8[4] += v[j][c] * w1[0]; d8[5] += v[j][c] * w1[1]; d8[6] += v[j][c] * w1[2]; d8[7] += v[j][c] * w1[3]; } }
        float c4[4], c2[2], c1;
        { const bool hb = (lane & 32) != 0;
#pragma unroll
          for (int i = 0; i < 4; ++i) { const float snd = hb ? d8[i] : d8[i + 4], kp = hb ? d8[i + 4] : d8[i]; c4[i] = kp + __shfl_xor(snd, 32); } }
        { const bool hb = (lane & 16) != 0;
#pragma unroll
          for (int i = 0; i < 2; ++i) { const float snd = hb ? c4[i] : c4[i + 2], kp = hb ? c4[i + 2] : c4[i]; c2[i] = kp + __shfl_xor(snd, 16); } }
        { const bool hb = (lane & 8) != 0; const float snd = hb ? c2[0] : c2[1], kp = hb ? c2[1] : c2[0]; c1 = kp + __shfl_xor(snd, 8); }
        c1 += __shfl_xor(c1, 4); c1 += __shfl_xor(c1, 2); c1 += __shfl_xor(c1, 1);
        if ((lane & 7) == 0) DT[(size_t)m * 8 + ((lane >> 3) & 7)] = softplus_f(c1 + bias_l);
    }
    __syncthreads();
}

__device__ __forceinline__ void ph_rope(const P& a, int L, unsigned char* ldsg, int gw, int NGW, int wave, int lane, int tid, int bx, bool dry) {
    bf16* PROJ = (bf16*)(a.ws + WS_PROJ);
    const int head = lane >> 3, j8 = lane & 7; const bool act = head < 6;
    const int hc = act ? head : 5;
    const float* gsrc = (hc < 4 ? a.g_qnorm : a.g_knorm) + L * 64 + j8 * 8;
    float g[8], fr[8];
#pragma unroll
    for (int i = 0; i < 8; ++i) { g[i] = gsrc[i]; fr[i] = __builtin_amdgcn_exp2f(-(float)(8 * (j8 & 1) + i) * (13.287712379549449f / 16.0f)) * 0.15915494309189535f; }
    const float osc = hc < 4 ? 0.125f * LOG2E : 1.0f;
    float kmx0 = 0.f, kmx1 = 0.f;
    float cmx0 = 0.f, cmx1 = 0.f;
    v4u nraw = (v4u){0u, 0u, 0u, 0u};
    if (gw < T) nraw = *(const v4u*)(PROJ + (size_t)gw * LDP + hc * 64 + j8 * 8);
    for (int m = gw; m < T; m += NGW) {
        const int s = m & (S - 1); const float pos = (float)((j8 & 4) ? (s & 63) : (s >> 6));
        bf16* ptr = PROJ + (size_t)m * LDP + hc * 64 + j8 * 8;
        const v4u raw = nraw;
        if (m + NGW < T) nraw = *(const v4u*)(PROJ + (size_t)(m + NGW) * LDP + hc * 64 + j8 * 8);
        float v[8]; v[0] = pg8::bf_lo(raw.x); v[1] = pg8::bf_hi(raw.x); v[2] = pg8::bf_lo(raw.y); v[3] = pg8::bf_hi(raw.y); v[4] = pg8::bf_lo(raw.z); v[5] = pg8::bf_hi(raw.z); v[6] = pg8::bf_lo(raw.w); v[7] = pg8::bf_hi(raw.w);
        float ss = 0.f;
#pragma unroll
        for (int i = 0; i < 8; ++i) ss += v[i] * v[i];
        ss += __shfl_xor(ss, 1); ss += __shfl_xor(ss, 2); ss += __shfl_xor(ss, 4);
        const float rn = 1.0f / sqrtf(ss * (1.0f / 64.0f) + EPS);
        float o[8];
#pragma unroll
        for (int i = 0; i < 8; ++i) { const float y = v[i] * rn * g[i]; const float pr = __shfl_xor(y, 2);
            const float rev = __builtin_amdgcn_fractf(pos * fr[i]); const float sn = __builtin_amdgcn_sinf(rev), cs = __builtin_amdgcn_cosf(rev);
            o[i] = ((j8 & 2) ? (pr * sn + y * cs) : (y * cs - pr * sn)) * osc; }
        v4u w; w.x = pk2(o[0], o[1]); w.y = pk2(o[2], o[3]); w.z = pk2(o[4], o[5]); w.w = pk2(o[6], o[7]);
        if (act && !dry) *(v4u*)ptr = w;
        float so = pg8::bf_lo(w.x) * pg8::bf_lo(w.x) + pg8::bf_hi(w.x) * pg8::bf_hi(w.x) + pg8::bf_lo(w.y) * pg8::bf_lo(w.y) + pg8::bf_hi(w.y) * pg8::bf_hi(w.y)
                 + pg8::bf_lo(w.z) * pg8::bf_lo(w.z) + pg8::bf_hi(w.z) * pg8::bf_hi(w.z) + pg8::bf_lo(w.w) * pg8::bf_lo(w.w) + pg8::bf_hi(w.w) * pg8::bf_hi(w.w);
        so += __shfl_xor(so, 1); so += __shfl_xor(so, 2); so += __shfl_xor(so, 4);
        if (m < S) kmx0 = fmaxf(kmx0, so); else kmx1 = fmaxf(kmx1, so);
        { const v2u cr = *(const v2u*)(PROJ + (size_t)m * LDP + PC_CK + lane * 4);
          float cs = pg8::bf_lo(cr.x) * pg8::bf_lo(cr.x) + pg8::bf_hi(cr.x) * pg8::bf_hi(cr.x) + pg8::bf_lo(cr.y) * pg8::bf_lo(cr.y) + pg8::bf_hi(cr.y) * pg8::bf_hi(cr.y);
          cs += __shfl_xor(cs, 1); cs += __shfl_xor(cs, 2); cs += __shfl_xor(cs, 4);
          if (m < S) cmx0 = fmaxf(cmx0, cs); else cmx1 = fmaxf(cmx1, cs); }
    }
    LAS float* red = (LAS float*)(LAS unsigned char*)ldsg;
    if (head >= 4 && head < 6 && j8 == 0) { red[wave * 24 + (head - 4)] = kmx0; red[wave * 24 + 2 + (head - 4)] = kmx1; }
    if ((lane & 7) == 0) { red[wave * 24 + 4 + (lane >> 3)] = cmx0; red[wave * 24 + 12 + (lane >> 3)] = cmx1; }
    __syncthreads();
    if (tid < 20) { float mx = 0.f;
#pragma unroll
        for (int w = 0; w < 8; ++w) mx = fmaxf(mx, red[w * 24 + tid]);
        ((float*)(a.ws + WS_KMAX))[bx * 32 + tid] = mx; }
    __syncthreads();
}
__device__ __forceinline__ float wave_incl_scan(float v, int lane) {
#pragma unroll
    for (int o = 1; o < 64; o <<= 1) { const float t = __shfl_up(v, o); if (lane >= o) v += t; }
    return v;
}
constexpr int LP = 136;
__device__ __forceinline__ void ssd1_unit(const P& a, int L, int u, unsigned char* ldsg, int wave, int lane, int tid) {
    LAS unsigned char* lds = (LAS unsigned char*)ldsg;
    LAS bf16* XW = (LAS bf16*)lds;
    LAS bf16* BT = (LAS bf16*)(lds + 69632);
    LAS f32x4* TABL = (LAS f32x4*)(lds + 104448);
    LAS float* WV = (LAS float*)(lds + 108544);
    LAS float* DTL = (LAS float*)(lds + 110592);
    const int g = u & 1, c = (u >> 1) & 127, b = u >> 8;
    const size_t t0 = (size_t)b * S + c * 128; const int s0 = c * 128;
    const bf16* PROJ = (const bf16*)(a.ws + WS_PROJ); bf16* XBC = (bf16*)(a.ws + WS_XBC);
    if (tid < 256) ((LAS f32x4*)DTL)[tid] = ((const f32x4*)((const float*)(a.ws + WS_DT) + t0 * 8))[tid];
    __syncthreads();
    if (wave < 4) {
        const int hl = wave >> 1, dir = wave & 1, h = 2 * g + hl;
        const float av = -__expf((dir ? a.a_log_b : a.a_log_f)[L * 4 + h]);
        const float d0 = DTL[(2 * lane) * 8 + dir * 4 + h], d1 = DTL[(2 * lane + 1) * 8 + dir * 4 + h];
        const float e0 = d0 * av, e1 = d1 * av, sm = e0 + e1;
        const float incl = wave_incl_scan(sm, lane), excl = incl - sm, tot = __shfl(incl, 63);
        const float P0 = excl + e0, P1 = incl;
        LAS float* tl0 = (LAS float*)&TABL[hl * 128 + 2 * lane]; LAS float* tl1 = (LAS float*)&TABL[hl * 128 + 2 * lane + 1];
        if (dir == 0) { tl0[0] = P0; tl1[0] = P1; tl0[2] = d0; tl1[2] = d1;
            WV[wave * 128 + 2 * lane] = d0 * __expf(tot - P0); WV[wave * 128 + 2 * lane + 1] = d1 * __expf(tot - P1); }
        else { tl0[1] = tot - P0 + e0; tl1[1] = tot - P1 + e1; tl0[3] = d0; tl1[3] = d1;
            WV[wave * 128 + 2 * lane] = d0 * __expf(P0 - e0); WV[wave * 128 + 2 * lane + 1] = d1 * __expf(P1 - e1); }
        if (lane == 0) ((float*)(a.ws + WS_CD))[(((size_t)b * 128 + c) * 4 + h) * 2 + dir] = __expf(tot);
    }
    __syncthreads();
    if (tid < 256) ((f32x4*)(a.ws + WS_TAB))[(((size_t)b * 128 + c) * 4 + 2 * g) * 128 + tid] = TABL[tid];
    const int cg = tid & 15, seg = tid >> 4, l0 = 4 * seg;
#pragma unroll 1
    for (int pass = 0; pass < 3; ++pass) {
        const int ch0 = pass * 256 + g * 128 + cg * 8;
        const float* cw = a.conv_w + (size_t)L * 5 * 768 + ch0; const float* cb = a.conv_b + (size_t)L * 768 + ch0;
        float w[5][8], bs[8];
#pragma unroll
        for (int j = 0; j < 5; ++j) { const f32x4 w0 = *(const f32x4*)(cw + j * 768), w1 = *(const f32x4*)(cw + j * 768 + 4);
            w[j][0] = w0[0]; w[j][1] = w0[1]; w[j][2] = w0[2]; w[j][3] = w0[3]; w[j][4] = w1[0]; w[j][5] = w1[1]; w[j][6] = w1[2]; w[j][7] = w1[3]; }
        { const f32x4 b0 = *(const f32x4*)cb, b1 = *(const f32x4*)(cb + 4); bs[0] = b0[0]; bs[1] = b0[1]; bs[2] = b0[2]; bs[3] = b0[3]; bs[4] = b1[0]; bs[5] = b1[1]; bs[6] = b1[2]; bs[7] = b1[3]; }
        float acc[4][8];
#pragma unroll
        for (int tk = 0; tk < 4; ++tk)
#pragma unroll
            for (int i = 0; i < 8; ++i) acc[tk][i] = bs[i];
#pragma unroll
        for (int rr = 0; rr < 8; ++rr) {
            const int pos = s0 + l0 - 2 + rr; v4u raw = (v4u){0u, 0u, 0u, 0u};
            if (pos >= 0 && pos < S) raw = *(const v4u*)(PROJ + ((size_t)b * S + pos) * LDP + PC_XS + ch0);
            float in[8]; in[0] = pg8::bf_lo(raw.x); in[1] = pg8::bf_hi(raw.x); in[2] = pg8::bf_lo(raw.y); in[3] = pg8::bf_hi(raw.y); in[4] = pg8::bf_lo(raw.z); in[5] = pg8::bf_hi(raw.z); in[6] = pg8::bf_lo(raw.w); in[7] = pg8::bf_hi(raw.w);
#pragma unroll
            for (int tk = 0; tk < 4; ++tk) { const int j = rr - tk; if (j >= 0 && j < 5) {
#pragma unroll
                for (int i = 0; i < 8; ++i) acc[tk][i] += w[j][i] * in[i]; } }
        }
#pragma unroll
        for (int tk = 0; tk < 4; ++tk) {
#pragma unroll
            for (int i = 0; i < 8; ++i) acc[tk][i] = silu_f(acc[tk][i]);
            v4u o; o.x = pk2(acc[tk][0], acc[tk][1]); o.y = pk2(acc[tk][2], acc[tk][3]); o.z = pk2(acc[tk][4], acc[tk][5]); o.w = pk2(acc[tk][6], acc[tk][7]);
            *(v4u*)(XBC + (t0 + l0 + tk) * 768 + ch0) = o; }
        if (pass == 0) {
            const int hl = cg >> 3, p0 = (cg & 7) * 8;
#pragma unroll
            for (int dir = 0; dir < 2; ++dir) { const int hd = hl * 2 + dir; const f32x4 wv = *(const LAS f32x4*)(WV + hd * 128 + l0);
#pragma unroll
                for (int i = 0; i < 8; ++i) { v2u o; o.x = pk2(acc[0][i] * wv[0], acc[1][i] * wv[1]); o.y = pk2(acc[2][i] * wv[2], acc[3][i] * wv[3]);
                    *(LAS v2u*)(XW + (hd * 64 + p0 + i) * LP + l0) = o; } }
        } else if (pass == 1) {
#pragma unroll
            for (int i = 0; i < 8; ++i) { v2u o; o.x = pk2(acc[0][i], acc[1][i]); o.y = pk2(acc[2][i], acc[3][i]); *(LAS v2u*)(BT + (cg * 8 + i) * LP + l0) = o; }
        }
    }
    __syncthreads();
    {
        const int hd = wave >> 1, ph = wave & 1, fr = lane & 15, fq = lane >> 4;
        f32x4 acc[2][8];
#pragma unroll
        for (int mt = 0; mt < 2; ++mt)
#pragma unroll
            for (int nt = 0; nt < 8; ++nt) acc[mt][nt] = (f32x4){0.f, 0.f, 0.f, 0.f};
#pragma unroll
        for (int ks = 0; ks < 4; ++ks) {
            bf16x8 af[2];
#pragma unroll
            for (int mt = 0; mt < 2; ++mt) af[mt] = *(const LAS bf16x8*)(XW + (hd * 64 + ph * 32 + mt * 16 + fr) * LP + 32 * ks + 8 * fq);
#pragma unroll
            for (int nt = 0; nt < 8; ++nt) { const bf16x8 bfr = *(const LAS bf16x8*)(BT + (16 * nt + fr) * LP + 32 * ks + 8 * fq);
#pragma unroll
                for (int mt = 0; mt < 2; ++mt) acc[mt][nt] = mfma16(af[mt], bfr, acc[mt][nt]); }
        }
        const int hl = hd >> 1, dir = hd & 1, h = 2 * g + hl;
        bf16* ST = (bf16*)(a.ws + WS_ST) + ((((size_t)b * 128 + c) * 4 + h) * 2 + dir) * 8192;
#pragma unroll
        for (int mt = 0; mt < 2; ++mt)
#pragma unroll
            for (int nt = 0; nt < 8; ++nt)
#pragma unroll
                for (int ii = 0; ii < 4; ++ii) ST[(ph * 32 + mt * 16 + 4 * fq + ii) * 128 + 16 * nt + fr] = (bf16)f2bf(acc[mt][nt][ii]);
    }
    __syncthreads();
}

__device__ __forceinline__ void ph_scan(const P& a, int gtid, int GT) {
    const unsigned* ST2 = (const unsigned*)(a.ws + WS_ST); unsigned* SB2 = (unsigned*)(a.ws + WS_SB); const float* CD = (const float*)(a.ws + WS_CD);
    for (int e2 = gtid; e2 < NB * 4 * 2 * 8192 / 2; e2 += GT) {
        const int e = 2 * e2, b = e >> 16, rem = e & 65535, dir = (rem >> 13) & 1, h = rem >> 14;
        float s0 = 0.f, s1 = 0.f;
#pragma unroll 1
        for (int c8 = 0; c8 < 128; c8 += 8) {
            unsigned cs[8]; float cd[8];
#pragma unroll
            for (int k = 0; k < 8; ++k) { const int c = dir ? 127 - (c8 + k) : (c8 + k); cs[k] = ST2[(((size_t)b * 128 + c) * 65536 + rem) >> 1]; cd[k] = CD[(((size_t)b * 128 + c) * 4 + h) * 2 + dir]; }
#pragma unroll
            for (int k = 0; k < 8; ++k) { const int c = dir ? 127 - (c8 + k) : (c8 + k); SB2[(((size_t)b * 128 + c) * 65536 + rem) >> 1] = pk2(s0, s1);
                s0 = s0 * cd[k] + __builtin_bit_cast(float, cs[k] << 16); s1 = s1 * cd[k] + __builtin_bit_cast(float, cs[k] & 0xffff0000u); }
        }
    }
}

__device__ __forceinline__ void ssd3_unit(const P& a, int L, int u, unsigned char* ldsg, int wave, int lane, int tid) {
    LAS unsigned char* lds = (LAS unsigned char*)ldsg;
    LAS bf16* CG = (LAS bf16*)lds;
    LAS bf16* BG = (LAS bf16*)(lds + 34816);
    LAS bf16* XT = (LAS bf16*)(lds + 69632);
    LAS f32x4* TB = (LAS f32x4*)(lds + 104448);
    const int g = u & 1, c = (u >> 1) & 127, b = u >> 8; const size_t t0 = (size_t)b * S + c * 128;
    const bf16* XBC = (const bf16*)(a.ws + WS_XBC); const bf16* SB = (const bf16*)(a.ws + WS_SB); const bf16* PROJ = (const bf16*)(a.ws + WS_PROJ);
    const int fr = lane & 15, fq = lane >> 4, w = wave;
#pragma unroll
    for (int i = 0; i < 4; ++i) { const int q = tid + 512 * i, row = q >> 4, pc = q & 15;
        const bf16* src = XBC + (t0 + row) * 768 + g * 128 + pc * 8;
        *(LAS v4u*)(CG + row * LP + pc * 8) = *(const v4u*)(src + 512);
        *(LAS v4u*)(BG + row * LP + pc * 8) = *(const v4u*)(src + 256);
        const v4u xr = *(const v4u*)src; const int hl = pc >> 3, p = (pc & 7) * 8;
        LAS bf16* xd = XT + (hl * 64 + p) * LP + row;
        xd[0 * LP] = (bf16)(xr.x & 0xffffu); xd[1 * LP] = (bf16)(xr.x >> 16); xd[2 * LP] = (bf16)(xr.y & 0xffffu); xd[3 * LP] = (bf16)(xr.y >> 16);
        xd[4 * LP] = (bf16)(xr.z & 0xffffu); xd[5 * LP] = (bf16)(xr.z >> 16); xd[6 * LP] = (bf16)(xr.w & 0xffffu); xd[7 * LP] = (bf16)(xr.w >> 16); }
    if (tid < 256) TB[tid] = ((const f32x4*)(a.ws + WS_TAB))[(((size_t)b * 128 + c) * 4 + 2 * g) * 128 + tid];
    __syncthreads();
    bf16x8 cf[4];
#pragma unroll
    for (int ks = 0; ks < 4; ++ks) cf[ks] = *(const LAS bf16x8*)(CG + (16 * w + fr) * LP + 32 * ks + 8 * fq);
    f32x4 Gt[8];
#pragma unroll
    for (int j = 0; j < 8; ++j) { Gt[j] = (f32x4){0.f, 0.f, 0.f, 0.f};
#pragma unroll
        for (int ks = 0; ks < 4; ++ks) Gt[j] = mfma16(*(const LAS bf16x8*)(BG + (16 * j + fr) * LP + 32 * ks + 8 * fq), cf[ks], Gt[j]); }
    __syncthreads();
    LAS bf16* ZS = CG; LAS bf16* SS = BG;
#pragma unroll
    for (int i = 0; i < 4; ++i) { const int q = tid + 512 * i, row = q >> 4, pc = q & 15;
        *(LAS v4u*)(ZS + row * LP + pc * 8) = *(const v4u*)(PROJ + (t0 + row) * LDP + PC_Z + g * 128 + pc * 8); }
    float* SSQ = (float*)(a.ws + WS_SSQ);
    const int lrow = 16 * w + fr;
#pragma unroll 1
    for (int hl = 0; hl < 2; ++hl) {
        const int h = 2 * g + hl;
        if (hl) __syncthreads();
        { const bf16* Sp = SB + (((size_t)b * 128 + c) * 4 + h) * 2 * 8192;
#pragma unroll
          for (int i = 0; i < 4; ++i) { const int q = tid + 512 * i, row = q >> 4, pc = q & 15;
              *(LAS v4u*)(SS + row * LP + pc * 8) = *(const v4u*)(Sp + (size_t)row * 128 + pc * 8); } }
        __syncthreads();
        f32x4 Y[4];
#pragma unroll
        for (int pt = 0; pt < 4; ++pt) Y[pt] = (f32x4){0.f, 0.f, 0.f, 0.f};
        {
            const f32x4 tl = TB[hl * 128 + lrow];
            bf16x8 wf[4];
#pragma unroll
            for (int ks = 0; ks < 4; ++ks) { float wv[8];
#pragma unroll
                for (int hf = 0; hf < 2; ++hf)
#pragma unroll
                    for (int ii = 0; ii < 4; ++ii) { const int j = 2 * ks + hf, s = 16 * j + 4 * fq + ii; const f32x4 ts = TB[hl * 128 + s];
                        const float mf = ts[2] * __expf(fminf(tl[0] - ts[0], 0.f)), mb = ts[3] * __expf(fminf(tl[1] - ts[1], 0.f));
                        const float mm = (s < lrow) ? mf : (s > lrow) ? mb : (ts[2] + ts[3]);
                        wv[hf * 4 + ii] = Gt[j][ii] * mm; }
                v4u pk; pk.x = pk2(wv[0], wv[1]); pk.y = pk2(wv[2], wv[3]); pk.z = pk2(wv[4], wv[5]); pk.w = pk2(wv[6], wv[7]); wf[ks] = __builtin_bit_cast(bf16x8, pk); }
#pragma unroll
            for (int pt = 0; pt < 4; ++pt)
#pragma unroll
                for (int ks = 0; ks < 4; ++ks) { const LAS bf16* xp = XT + (hl * 64 + 16 * pt + fr) * LP + 32 * ks + 4 * fq;
                    const v2u x0 = *(const LAS v2u*)xp, x1 = *(const LAS v2u*)(xp + 16); const v4u xx = (v4u){x0.x, x0.y, x1.x, x1.y};
                    Y[pt] = mfma16(wf[ks], __builtin_bit_cast(bf16x8, xx), Y[pt]); }
        }
#pragma unroll
        for (int dir = 0; dir < 2; ++dir) {
            f32x4 Tt[4];
#pragma unroll
            for (int pt = 0; pt < 4; ++pt) { Tt[pt] = (f32x4){0.f, 0.f, 0.f, 0.f};
#pragma unroll
                for (int ks = 0; ks < 4; ++ks) Tt[pt] = mfma16(cf[ks], *(const LAS bf16x8*)(SS + (dir * 64 + 16 * pt + fr) * LP + 32 * ks + 8 * fq), Tt[pt]); }
#pragma unroll
            for (int ii = 0; ii < 4; ++ii) { const f32x4 tr = TB[hl * 128 + 16 * w + 4 * fq + ii]; const float e = __expf(dir ? tr[1] : tr[0]);
#pragma unroll
                for (int pt = 0; pt < 4; ++pt) Y[pt][ii] += e * Tt[pt][ii]; }
        }
        const float dsk = a.d_skip[L * 4 + h];
#pragma unroll
        for (int pt = 0; pt < 4; ++pt) { const v2u xv = *(const LAS v2u*)(XT + (hl * 64 + 16 * pt + fr) * LP + 16 * w + 4 * fq);
            Y[pt][0] += dsk * pg8::bf_lo(xv.x); Y[pt][1] += dsk * pg8::bf_hi(xv.x); Y[pt][2] += dsk * pg8::bf_lo(xv.y); Y[pt][3] += dsk * pg8::bf_hi(xv.y); }
        float ss[4] = {0.f, 0.f, 0.f, 0.f};
#pragma unroll
        for (int pt = 0; pt < 4; ++pt) { const int chl = hl * 64 + 16 * pt + fr; const float gn = a.g_ssm[L * 256 + g * 128 + chl];
#pragma unroll
            for (int ii = 0; ii < 4; ++ii) { LAS bf16* zp = ZS + (16 * w + 4 * fq + ii) * LP + chl;
                const float z = bf2f(*zp); const float y = Y[pt][ii] * silu_f(z); ss[ii] += y * y; *zp = (bf16)f2bf(y * gn); } }
#pragma unroll
        for (int ii = 0; ii < 4; ++ii) { float sq = ss[ii]; sq += __shfl_xor(sq, 1); sq += __shfl_xor(sq, 2); sq += __shfl_xor(sq, 4); sq += __shfl_xor(sq, 8);
            if (fr == 0) SSQ[(t0 + 16 * w + 4 * fq + ii) * 4 + h] = sq; }
    }
    __syncthreads();
    bf16* BR = (bf16*)(a.ws + WS_BR);
#pragma unroll
    for (int i = 0; i < 4; ++i) { const int q = tid + 512 * i, row = q >> 4, pc = q & 15;
        *(v4u*)(BR + (t0 + row) * 1024 + 256 + g * 128 + pc * 8) = *(const LAS v4u*)(ZS + row * LP + pc * 8); }
    __syncthreads();
}

__device__ __forceinline__ void sgu_unit(const P& a, int L, int u, unsigned char* ldsg, int wave, int lane, int tid) {
    LAS bf16* VT = (LAS bf16*)(LAS unsigned char*)ldsg;
    const int b = u >> 7, c = u & 127; const size_t t0 = (size_t)b * S + c * 128;
    const bf16* PROJ = (const bf16*)(a.ws + WS_PROJ); bf16* BR = (bf16*)(a.ws + WS_BR); const bf16* WSP = (const bf16*)(a.ws + WS_WSP);
    const f32x4 gs = *(const f32x4*)(a.g_sgu + L * 256 + 4 * lane);
#pragma unroll 1
    for (int k = 0; k < 16; ++k) { const int s = 16 * wave + k;
        const v2u raw = *(const v2u*)(PROJ + (t0 + s) * LDP + PC_UV + 256 + 4 * lane);
        float v[4]; v[0] = gelu_tanh(pg8::bf_lo(raw.x)); v[1] = gelu_tanh(pg8::bf_hi(raw.x)); v[2] = gelu_tanh(pg8::bf_lo(raw.y)); v[3] = gelu_tanh(pg8::bf_hi(raw.y));
        const float rn = 1.0f / sqrtf(wave_sum(v[0] * v[0] + v[1] * v[1] + v[2] * v[2] + v[3] * v[3]) * (1.0f / 256.0f) + EPS);
#pragma unroll
        for (int i = 0; i < 4; ++i) VT[(4 * lane + i) * LP + s] = (bf16)f2bf(v[i] * rn * gs[i]); }
    __syncthreads();
    const int g = wave >> 1, th = wave & 1, fr = lane & 15, fq = lane >> 4;
    f32x4 acc[4][4];
#pragma unroll
    for (int mt = 0; mt < 4; ++mt)
#pragma unroll
        for (int nt = 0; nt < 4; ++nt) acc[mt][nt] = (f32x4){0.f, 0.f, 0.f, 0.f};
#pragma unroll
    for (int ks = 0; ks < 4; ++ks) {
        bf16x8 af[4];
#pragma unroll
        for (int mt = 0; mt < 4; ++mt) af[mt] = *(const bf16x8*)(WSP + (size_t)(g * 128 + 64 * th + 16 * mt + fr) * 128 + 32 * ks + 8 * fq);
#pragma unroll
        for (int nt = 0; nt < 4; ++nt) { const bf16x8 bfr = *(const LAS bf16x8*)(VT + (g * 64 + 16 * nt + fr) * LP + 32 * ks + 8 * fq);
#pragma unroll
            for (int mt = 0; mt < 4; ++mt) acc[mt][nt] = mfma16(af[mt], bfr, acc[mt][nt]); }
    }
#pragma unroll
    for (int mt = 0; mt < 4; ++mt)
#pragma unroll
        for (int ii = 0; ii < 4; ++ii) { const int tl = 64 * th + 16 * mt + 4 * fq + ii; const float bsv = a.b_spatial[(L * 4 + g) * 128 + tl];
#pragma unroll
            for (int nt = 0; nt < 4; ++nt) { const int ch = g * 64 + 16 * nt + fr;
                const float uu = gelu_tanh(bf2f(PROJ[(t0 + tl) * LDP + PC_UV + ch]));
                BR[(t0 + tl) * 1024 + 768 + ch] = (bf16)f2bf(uu * (acc[mt][nt][ii] + bsv)); } }
    __syncthreads();
}
__device__ __forceinline__ void ph_r1(const P& a, int L, unsigned char* ldsg, int gw, int NGW, int lane, int tid) {
    LAS float* wrt = (LAS float*)(LAS unsigned char*)ldsg;
    { const float* wr = a.w_router + (size_t)L * 1024 * 16;
      for (int i = tid; i < 1024 * 16 / 4; i += NTHR) { const int kq = i >> 2, q = i & 3, pos = ((kq >> 8) * 4 + (kq & 3)) * 64 + ((kq >> 2) & 63); ((LAS f32x4*)wrt)[q * 1024 + pos] = ((const f32x4*)wr)[i]; } }
    __syncthreads();
    const float* gm = a.g_moe + L * D; bf16* H = (bf16*)(a.ws + WS_H); float* AFF = (float*)(a.ws + WS_AFF); short* INV = (short*)(a.ws + WS_INV);
    f32x4 gv[4];
#pragma unroll
    for (int j = 0; j < 4; ++j) gv[j] = ((const f32x4*)gm)[lane + 64 * j];
    const bf16* XB = (const bf16*)(a.ws + WS_XB);
    v2u nv[4];
    if (gw < T) { const GAS v2u* xr = (const GAS v2u*)(XB + (size_t)gw * D) + lane;
#pragma unroll
        for (int j = 0; j < 4; ++j) nv[j] = xr[64 * j]; }
    for (int m = gw; m < T; m += NGW) {
        asm volatile("" ::: "memory");
        f32x4 v[4]; float ss = 0.f;
#pragma unroll
        for (int j = 0; j < 4; ++j) v[j] = xb_unpack(nv[j]);
        if (m + NGW < T) { const GAS v2u* xr = (const GAS v2u*)(XB + (size_t)(m + NGW) * D) + lane;
#pragma unroll
            for (int j = 0; j < 4; ++j) nv[j] = xr[64 * j]; }
#pragma unroll
        for (int j = 0; j < 4; ++j) { ss += (v[j][0] * v[j][0] + v[j][1] * v[j][1]) + (v[j][2] * v[j][2] + v[j][3] * v[j][3]); }
        const float rs = 1.0f / sqrtf(wave_sum(ss) * (1.0f / D) + EPS);
        float lg[16];
#pragma unroll
        for (int i = 0; i < 16; ++i) lg[i] = 0.f;
        GAS unsigned* o4 = (GAS unsigned*)((unsigned char*)H + (size_t)m * D) + lane;
#pragma unroll
        for (int j = 0; j < 4; ++j) { v[j] = v[j] * rs * gv[j];
            { int t = 0; t = __builtin_amdgcn_cvt_pk_fp8_f32(v[j][0], v[j][1], t, false); t = __builtin_amdgcn_cvt_pk_fp8_f32(v[j][2], v[j][3], t, true); o4[64 * j] = (unsigned)t; }
#pragma unroll
            for (int c = 0; c < 4; ++c) { const LAS f32x4* wr = (const LAS f32x4*)wrt + (j * 4 + c) * 64 + lane;
#pragma unroll
                for (int q = 0; q < 4; ++q) { const f32x4 w4 = wr[q * 1024]; lg[4 * q] += v[j][c] * w4[0]; lg[4 * q + 1] += v[j][c] * w4[1]; lg[4 * q + 2] += v[j][c] * w4[2]; lg[4 * q + 3] += v[j][c] * w4[3]; } } }
        float a8[8], a4[4], a2[2], a1;
        { const bool hb = (lane & 32) != 0;
#pragma unroll
          for (int i = 0; i < 8; ++i) { const float snd = hb ? lg[i] : lg[i + 8], kp = hb ? lg[i + 8] : lg[i]; a8[i] = kp + __shfl_xor(snd, 32); } }
        { const bool hb = (lane & 16) != 0;
#pragma unroll
          for (int i = 0; i < 4; ++i) { const float snd = hb ? a8[i] : a8[i + 4], kp = hb ? a8[i + 4] : a8[i]; a4[i] = kp + __shfl_xor(snd, 16); } }
        { const bool hb = (lane & 8) != 0;
#pragma unroll
          for (int i = 0; i < 2; ++i) { const float snd = hb ? a4[i] : a4[i + 2], kp = hb ? a4[i + 2] : a4[i]; a2[i] = kp + __shfl_xor(snd, 8); } }
        { const bool hb = (lane & 4) != 0; const float snd = hb ? a2[0] : a2[1], kp = hb ? a2[1] : a2[0]; a1 = kp + __shfl_xor(snd, 4); }
        a1 += __shfl_xor(a1, 2); a1 += __shfl_xor(a1, 1);
        float mx = a1; mx = fmaxf(mx, __shfl_xor(mx, 4)); mx = fmaxf(mx, __shfl_xor(mx, 8)); mx = fmaxf(mx, __shfl_xor(mx, 16)); mx = fmaxf(mx, __shfl_xor(mx, 32));
        const float ex = __expf(a1 - mx); float sum = ex; sum += __shfl_xor(sum, 4); sum += __shfl_xor(sum, 8); sum += __shfl_xor(sum, 16); sum += __shfl_xor(sum, 32);
        const int b = m / S, s = m % S;
        if ((lane & 3) == 0) AFF[((size_t)b * NE + ((lane >> 2) & 15)) * S + s] = ex / sum;
        if (lane < 2) { unsigned m1 = 0xffffffffu; asm volatile("" : "+v"(m1)); ((GAS v4u*)(INV + (size_t)m * NE))[lane] = (v4u){m1, m1, m1, m1}; }
    }
    __syncthreads();
}

__device__ __forceinline__ void sel_unit(const P& a, int q, unsigned char* ldsg, int wave, int lane, int tid) {
    LAS unsigned* vals = (LAS unsigned*)(LAS unsigned char*)ldsg;
    LAS unsigned* hist = vals + S;
    LAS unsigned* sc = hist + 256;
    const int b = q / NE, e = q % NE;
    const float* AFF = (const float*)(a.ws + WS_AFF) + ((size_t)b * NE + e) * S;
    for (int i = tid; i < S; i += NTHR) vals[i] = __float_as_uint(AFF[i]);
    unsigned prefix = 0u, mask = 0u, kk = CAP;
#pragma unroll 1
    for (int pass = 0; pass < 4; ++pass) {
        const int shift = 24 - 8 * pass;
        if (tid < 256) hist[tid] = 0u;
        __syncthreads();
        for (int i = tid; i < S; i += NTHR) { const unsigned v = vals[i]; if ((v & mask) == prefix) __hip_atomic_fetch_add(&hist[(v >> shift) & 255u], 1u, __ATOMIC_RELAXED, __HIP_MEMORY_SCOPE_WORKGROUP); }
        __syncthreads();
        if (wave == 0) {
            unsigned c4[4]; unsigned s4 = 0u;
#pragma unroll
            for (int j = 0; j < 4; ++j) { c4[j] = hist[4 * lane + j]; s4 += c4[j]; }
            unsigned suf = s4;
#pragma unroll
            for (int o = 1; o < 64; o <<= 1) { const unsigned t = __shfl_down(suf, o); if (lane + o < 64) suf += t; }
            unsigned cum = suf - s4;
#pragma unroll
            for (int j = 3; j >= 0; --j) { if (cum < kk && cum + c4[j] >= kk) { sc[0] = prefix | ((unsigned)(4 * lane + j) << shift); sc[1] = kk - cum; } cum += c4[j]; }
        }
        __syncthreads();
        prefix = sc[0]; kk = sc[1]; mask |= 255u << shift;
        __syncthreads();
    }
    const unsigned thr = prefix, need_eq = kk, total_gt = CAP - kk;
    unsigned cg = 0u, ce = 0u;
    for (int j = 0; j < 32; ++j) { const unsigned v = vals[32 * tid + ((j + tid) & 31)]; cg += (v > thr) ? 1u : 0u; ce += (v == thr) ? 1u : 0u; }
    unsigned pk = (cg << 16) | ce, inc = pk;
#pragma unroll
    for (int o = 1; o < 64; o <<= 1) { const unsigned t = __shfl_up(inc, o); if (lane >= o) inc += t; }
    if (lane == 63) sc[8 + wave] = inc;
    __syncthreads();
    unsigned base = 0u;
    for (int w2 = 0; w2 < wave; ++w2) base += sc[8 + w2];
    const unsigned exc = base + inc - pk; unsigned pg = exc >> 16, pe = exc & 0xffffu;
    int* SELIDX = (int*)(a.ws + WS_SELIDX) + (size_t)e * (NB * CAP) + b * CAP; float* SELAFF = (float*)(a.ws + WS_SELAFF) + (size_t)e * (NB * CAP) + b * CAP;
    short* INV = (short*)(a.ws + WS_INV);
    for (int j = 0; j < 32; ++j) { const int idx = 32 * tid + j; const unsigned v = vals[idx]; int slot = -1;
        if (v > thr) { slot = (int)pg; ++pg; } else if (v == thr) { if (pe < need_eq) slot = (int)(total_gt + pe); ++pe; }
        if (slot >= 0) { SELIDX[slot] = idx; SELAFF[slot] = __uint_as_float(v); INV[((size_t)b * S + idx) * NE + e] = (short)slot; } }
    __syncthreads();
}

__device__ __forceinline__ void ph_gather(const P& a, int gw, int NGW, int lane) {
    const int* SELIDX = (const int*)(a.ws + WS_SELIDX); const bf16* H = (const bf16*)(a.ws + WS_H); bf16* XE = (bf16*)(a.ws + WS_XE);
    for (int r = gw; r < NE * NB * CAP; r += NGW) { const int b = (r >> 11) & 1; const int tok = SELIDX[r];
        const v4u* src = (const v4u*)(H + ((size_t)b * S + tok) * D); v4u* dst = (v4u*)(XE + (size_t)r * D);
        const v4u v0 = src[lane], v1 = src[lane + 64]; dst[lane] = v0; dst[lane + 64] = v1; }
}

__device__ __forceinline__ void ph_r2(const P& a, int L, int gw, int NGW, int lane, bool dry) {
    const float* gm = a.g_ple + L * D; bf16* H = (bf16*)(a.ws + WS_H); const short* INV = (const short*)(a.ws + WS_INV); const unsigned char* YE = (const unsigned char*)(a.ws + WS_YE); const float* SAFF = (const float*)(a.ws + WS_SELAFF);
    f32x4 gv[4];
#pragma unroll
    for (int j = 0; j < 4; ++j) gv[j] = ((const f32x4*)gm)[lane + 64 * j];
    bf16* XB = (bf16*)(a.ws + WS_XB);
    v2u nv[4]; short ninv = -1;
    if (gw < T) { const GAS v2u* xq = (const GAS v2u*)(XB + (size_t)gw * D) + lane;
#pragma unroll
        for (int j = 0; j < 4; ++j) nv[j] = xq[64 * j];
        ninv = INV[(size_t)gw * NE + (lane & 15)]; }
    for (int m = gw; m < T; m += NGW) {
        GAS v2u* xr = (GAS v2u*)(XB + (size_t)m * D) + lane;
        f32x4 v[4];
#pragma unroll
        for (int j = 0; j < 4; ++j) v[j] = xb_unpack(nv[j]);
        const int b = m / S;
        const short myinv = ninv;
        if (m + NGW < T) { const GAS v2u* xq = (const GAS v2u*)(XB + (size_t)(m + NGW) * D) + lane;
#pragma unroll
            for (int j = 0; j < 4; ++j) nv[j] = xq[64 * j];
            ninv = INV[(size_t)(m + NGW) * NE + (lane & 15)]; }
        unsigned em = (unsigned)__builtin_amdgcn_readfirstlane((int)(__ballot(myinv >= 0) & 0xffffull));
#pragma unroll 1
        while (em) {
            unsigned y[4][4]; int ee[4]; float af[4] = {0.f, 0.f, 0.f, 0.f};
#pragma unroll
            for (int q = 0; q < 4; ++q) { ee[q] = em ? (int)__builtin_ctz(em) : -1; if (em) em &= em - 1u;
                if (ee[q] >= 0) { const int slot = __builtin_amdgcn_readfirstlane((int)__shfl((int)myinv, ee[q]));
                    af[q] = 0.25f * SAFF[(size_t)ee[q] * (NB * CAP) + b * CAP + slot];
                    const unsigned* yr = (const unsigned*)(YE + ((size_t)ee[q] * (NB * CAP) + b * CAP + slot) * D) + lane;
#pragma unroll
                    for (int j = 0; j < 4; ++j) y[q][j] = yr[64 * j]; } }
#pragma unroll
            for (int q = 0; q < 4; ++q) if (ee[q] >= 0) {
#pragma unroll
                for (int j = 0; j < 4; ++j) { typedef float f32x2r __attribute__((ext_vector_type(2)));
                    const f32x2r lo = __builtin_amdgcn_cvt_pk_f32_fp8((int)y[q][j], false), hi = __builtin_amdgcn_cvt_pk_f32_fp8((int)y[q][j], true);
                    v[j][0] += af[q] * lo[0]; v[j][1] += af[q] * lo[1]; v[j][2] += af[q] * hi[0]; v[j][3] += af[q] * hi[1]; } }
        }
        float ss = 0.f;
#pragma unroll
        for (int j = 0; j < 4; ++j) { if (!dry) xr[64 * j] = (v2u){pk2(v[j][0], v[j][1]), pk2(v[j][2], v[j][3])}; ss += (v[j][0] * v[j][0] + v[j][1] * v[j][1]) + (v[j][2] * v[j][2] + v[j][3] * v[j][3]); }
        const float rs = 1.0f / sqrtf(wave_sum(ss) * (1.0f / D) + EPS);
        GAS unsigned* o4 = (GAS unsigned*)(a.ws + WS_H8 + (size_t)m * D) + lane;
        float amx = 0.f;
#pragma unroll
        for (int j = 0; j < 4; ++j) { v[j] = v[j] * rs * gv[j]; amx = fmaxf(fmaxf(amx, fmaxf(fabsf(v[j][0]), fabsf(v[j][1]))), fmaxf(fabsf(v[j][2]), fabsf(v[j][3]))); }
#pragma unroll
        for (int o = 1; o < 64; o <<= 1) amx = fmaxf(amx, __shfl_xor(amx, o));
        amx = fmaxf(amx, 1e-30f); const float qinv = 127.0f / amx;
        if (lane == 0 && !dry) ((float*)(a.ws + WS_SA))[m] = amx * (1.0f / 127.0f);
#pragma unroll
        for (int j = 0; j < 4; ++j) { const int b0 = (int)rintf(qinv * v[j][0]), b1 = (int)rintf(qinv * v[j][1]), b2 = (int)rintf(qinv * v[j][2]), b3 = (int)rintf(qinv * v[j][3]);
            if (!dry) o4[64 * j] = (unsigned)(b0 & 0xff) | ((unsigned)(b1 & 0xff) << 8) | ((unsigned)(b2 & 0xff) << 16) | ((unsigned)(b3 & 0xff) << 24); }
    }
}
__device__ __forceinline__ void ph_final(const P& a, int gw, int NGW, int lane, float oscale) {
    f32x4 gv[4];
#pragma unroll
    for (int j = 0; j < 4; ++j) gv[j] = ((const f32x4*)a.g_final)[lane + 64 * j];
    const bf16* XB = (const bf16*)(a.ws + WS_XB);
    v2u nv[4];
    if (gw < T) { const GAS v2u* xq = (const GAS v2u*)(XB + (size_t)gw * D) + lane;
#pragma unroll
        for (int j = 0; j < 4; ++j) nv[j] = xq[64 * j]; }
    for (int m = gw; m < T; m += NGW) {
        GAS f32x4* xr = (GAS f32x4*)(a.out + (size_t)m * D) + lane;
        f32x4 v[4]; float ss = 0.f;
#pragma unroll
        for (int j = 0; j < 4; ++j) v[j] = xb_unpack(nv[j]);
        if (m + NGW < T) { const GAS v2u* xq = (const GAS v2u*)(XB + (size_t)(m + NGW) * D) + lane;
#pragma unroll
            for (int j = 0; j < 4; ++j) nv[j] = xq[64 * j]; }
#pragma unroll
        for (int j = 0; j < 4; ++j) { ss += (v[j][0] * v[j][0] + v[j][1] * v[j][1]) + (v[j][2] * v[j][2] + v[j][3] * v[j][3]); }
        const float rs = 1.0f / sqrtf(wave_sum(ss) * (1.0f / D) + EPS);
#pragma unroll
        for (int j = 0; j < 4; ++j) xr[64 * j] = v[j] * (rs * oscale) * gv[j];
    }
}

typedef const __attribute__((address_space(4))) P* kargp_t;
__device__ __forceinline__ P load_args(kargp_t p) { P a; a.x = p->x; a.p = p->p; a.rel_bias = p->rel_bias; a.g_mix = p->g_mix; a.w_in = p->w_in; a.g_qnorm = p->g_qnorm; a.g_knorm = p->g_knorm; a.conv_w = p->conv_w; a.conv_b = p->conv_b; a.dt_bias_f = p->dt_bias_f; a.dt_bias_b = p->dt_bias_b; a.a_log_f = p->a_log_f; a.a_log_b = p->a_log_b; a.d_skip = p->d_skip; a.g_ssm = p->g_ssm; a.lambda_q1 = p->lambda_q1; a.lambda_k1 = p->lambda_k1; a.lambda_q2 = p->lambda_q2; a.lambda_k2 = p->lambda_k2; a.g_diff = p->g_diff; a.g_sgu = p->g_sgu; a.w_spatial = p->w_spatial; a.b_spatial = p->b_spatial; a.w_branch = p->w_branch; a.w_branch_gate = p->w_branch_gate; a.w_out = p->w_out; a.g_moe = p->g_moe; a.w_router = p->w_router; a.w_exp_gate = p->w_exp_gate; a.w_exp_up = p->w_exp_up; a.w_exp_down = p->w_exp_down; a.g_ple = p->g_ple; a.w_ple_gate = p->w_ple_gate; a.w_ple = p->w_ple; a.g_final = p->g_final; a.out = p->out; a.ws = p->ws; a.gp_lo = p->gp_lo; a.gp_hi = p->gp_hi; return a; }
__device__ __forceinline__ int my_lane_volatile() { int l; asm volatile("v_mbcnt_lo_u32_b32 %0, -1, 0\n\tv_mbcnt_hi_u32_b32 %0, -1, %0" : "=v"(l)); return l; }
#ifndef PROBE_PH
#define PROBE_PH -1
#endif
#ifndef REPMASK
#define REPMASK 0u
#endif
#define NREP(bit) (((REPMASK >> (bit)) & 1u) ? 2 : 1)
#define REPEAT(bit) _Pragma("unroll 1") for (int rep_ = 0; rep_ < NREP(bit); ++rep_)
#ifndef PHMASK
#define PHMASK 0xFFFFu
#endif
__global__ void __launch_bounds__(NTHR, 2) mk_fwd(P a_in) {
    extern __shared__ __attribute__((aligned(16))) unsigned char lds[];
    const int G = gridDim.x, bx = blockIdx.x, NGW = G * NWAVES, GT = G * NTHR;
    gu32* ctl = (gu32*)(a_in.ws + WS_CTL);
    volatile LAS unsigned* MISC = (volatile LAS unsigned*)((LAS unsigned char*)lds + MISC_OFF);
    for (int u = threadIdx.x; u < (LDS_BYTES - LDSCTL_OFF) / 4; u += NTHR) ((LAS unsigned*)((LAS unsigned char*)lds + LDSCTL_OFF))[u] = 0u;
    __syncthreads();
    const bool multi = (a_in.gp_hi - a_in.gp_lo) > 1;
    XcdBarrier bar; bar.bar = (unsigned*)(ctl + CW_BAR); bar.x = 0; bar.st = nullptr;
    const int wave0 = __builtin_amdgcn_readfirstlane((int)threadIdx.x >> 6);
    if (multi) bar = xcd_barrier_post((unsigned*)(ctl + CW_BAR), MISC + 8, (int)threadIdx.x);
    const int lo = a_in.gp_lo, hi = a_in.gp_hi;
    unsigned long long tacc = 0ull, tic0 = 0ull; (void)tic0;
#define TIC(ph) do { if (PROBE_PH == (ph)) tic0 = __builtin_amdgcn_s_memrealtime(); } while (0)
#define TOC(ph) do { if (PROBE_PH == (ph)) tacc += __builtin_amdgcn_s_memrealtime() - tic0; } while (0)
#define IN(k) (((PHMASK >> (((k) < DEPTH * NPH) ? ((k) % NPH) : 14)) & 1u) && lo <= (k) && (k) < hi)
#define MY_TID() ((wave0 << 6) | my_lane_volatile())
#define SEAM(k) do { if (IN(k) && IN((k) + 1)) { XcdBarrier b2_ = bar; asm volatile("" : "+s"(b2_.bar)); xcd_barrier(b2_, MY_TID()); if ((REPMASK >> 21) & 1u) xcd_barrier(b2_, MY_TID()); } } while (0)
#define PHASE_IDS() int tid = MY_TID(); asm volatile("" : "+v"(tid)); const int lane = tid & 63; const int wave = __builtin_amdgcn_readfirstlane(tid >> 6); \
    const int gw = bx * NWAVES + wave; const int gtid = bx * NTHR + tid; (void)lane; (void)gw; (void)gtid; \
    kargp_t ap_ = (kargp_t)__builtin_amdgcn_kernarg_segment_ptr(); asm volatile("" : "+s"(ap_)); const P a = load_args(ap_); \
    unsigned char* const ws = a.ws; bf16* const H = (bf16*)(ws + WS_H); bf16* const PROJ = (bf16*)(ws + WS_PROJ); bf16* const GATES = (bf16*)(ws + WS_GATES); bf16* const BR = (bf16*)(ws + WS_BR); \
    LAS unsigned char* const ldsl = (LAS unsigned char*)lds; (void)H; (void)PROJ; (void)GATES; (void)BR; (void)ldsl

#pragma unroll 1
    for (int L = 0; L < DEPTH; ++L) {
        const int g0 = L * NPH;
        TIC(0);
        if (IN(g0 + 0)) REPEAT(0) { PHASE_IDS(); ph_convw(a, L, lds, gw, NGW, wave, lane, tid, gtid, GT, bx, G, 0); }
        if (IN(g0 + 0)) { PHASE_IDS(); ph_r0(a, L, lds, gw, NGW, lane, tid); } SEAM(g0 + 0); TOC(0);
        TIC(1);
        if (NPROJ_BF > 0 && IN(g0 + 1)) REPEAT(1) { PHASE_IDS();
            pg8::Gemm g{H, (const bf16*)(ws + WS_WCAT), T, NPROJ_BF, D, 0}; pg8::StaticOrder So; So.init(T, NPROJ_BF, G, bx);
            pg8::EpiG1 E{PROJ, GATES, 0.17677669529663687f * LOG2E, rep_ + 1 < NREP(1)};
            pg8::gemm_phase<pg8::EpiG1, pg8::StaticOrder, true, true>(ldsl, g, So, E, tid);
        }
        if (IN(g0 + 1)) { PHASE_IDS();
            pg8::Gemm g{(const bf16*)(ws + WS_PBF), (const bf16*)(ws + WS_WPLE), T, D, 256, 0}; pg8::TailOrder So{G, bx, 0};
            pg8::EpiPlain E{(bf16*)(ws + WS_PL), D};
            pg8::gemm_phase<pg8::EpiPlain, pg8::TailOrder, true, true, false, false, false, PAD_PL0>(ldsl, g, So, E, tid);
        }
        if (IN(g0 + 1)) { PHASE_IDS();
            pg8::StaticOrder So; So.init(T, NGATE, G, bx);
            LAS unsigned* gtab = (LAS unsigned*)(ldsl + RING_BYTES + 512);
            {
#pragma unroll 1
              for (int ui = 0; ui < 8; ++ui) { pg8::Unit uu; const bool okk = So.next(ui, uu); const int rb = okk ? uu.pm * 256 : 0; if (tid < 256) gtab[ui * 256 + tid] = (unsigned)(rb + tid) * (unsigned)D; }
              __syncthreads(); }
            pg8::Gemm g{(const bf16*)(ws + WS_H8), (const bf16*)(ws + WS_WCAT + (size_t)NPROJ * 2048), T, NGATE, D / 2, 0};
            pg8::EpiGateI8 E{GATES, (const float*)(ws + WS_SA), (const float*)(ws + WS_SW), 0};
            pg8::gemm_phase<pg8::EpiGateI8, pg8::StaticOrder, true, true, true, false, true, PAD_GATE>(ldsl, g, So, E, tid, gtab);
        }
        if (IN(g0 + 1)) REPEAT(1) { PHASE_IDS();
            pg8::StaticOrder So; So.init(T, NPROJ_I8, G, bx);
            LAS unsigned* gtab = (LAS unsigned*)(ldsl + RING_BYTES + 512);
            {
#pragma unroll 1
              for (int ui = 0; ui < 6; ++ui) { pg8::Unit uu; const bool okk = So.next(ui, uu); const int rb = okk ? uu.pm * 256 : 0; if (tid < 256) gtab[ui * 256 + tid] = (unsigned)(rb + tid) * (unsigned)D; }
              __syncthreads(); }
            pg8::Gemm g{(const bf16*)(ws + WS_H8), (const bf16*)(ws + WS_WCAT + (size_t)NPROJ_BF * 2048), T, NPROJ_I8, D / 2, 0};
            pg8::EpiProjI8 E{PROJ, (const float*)(ws + WS_SA), (const float*)(ws + WS_SW) + 5120, NPROJ_BF, 0.17677669529663687f * LOG2E, rep_ + 1 < NREP(1)};
            pg8::gemm_phase<pg8::EpiProjI8, pg8::StaticOrder, true, true, true, false, true, PAD_PROJ>(ldsl, g, So, E, tid, gtab);
        }
        if (IN(g0 + 1)) { PHASE_IDS();
            pg8::Gemm g{(const bf16*)(ws + WS_PBF), (const bf16*)(ws + WS_WPLE), T, D, 256, 0}; pg8::TailOrder So{G, bx, 1};
            pg8::EpiPlain E{(bf16*)(ws + WS_PL), D};
            pg8::gemm_phase<pg8::EpiPlain, pg8::TailOrder, true, true, false, false, false, PAD_PL>(ldsl, g, So, E, tid);
        } SEAM(g0 + 1); TOC(1);
        TIC(2);
        if (IN(g0 + 2)) {
            REPEAT(16) { PHASE_IDS(); ph_rope(a, L, lds, gw, NGW, wave, lane, tid, bx, rep_ + 1 < NREP(16)); }
            REPEAT(2) { PHASE_IDS(); for (int u = bx; u < 512; u += G) ssd1_unit(a, L, u, lds, wave, lane, tid); }
            REPEAT(2) { PHASE_IDS(); for (int u = bx; u < 256; u += G) sgu_unit(a, L, u, lds, wave, lane, tid); }
        } SEAM(g0 + 2); TOC(2);
        TIC(3);
        if (IN(g0 + 3)) {
            REPEAT(3) { PHASE_IDS(); ph_scan(a, gtid, GT); }
        } SEAM(g0 + 3); TOC(3);
        TIC(4);
        if (IN(g0 + 4)) {
            REPEAT(4) { PHASE_IDS(); for (int u = bx; u < 512; u += G) ssd3_unit(a, L, u, lds, wave, lane, tid); }
            REPEAT(14) { PHASE_IDS(); const attn_body::bf16* Pj = (const attn_body::bf16*)PROJ; attn_body::bf16* Bo = (attn_body::bf16*)BR;
              for (int u = bx; u < 512; u += G) {
                const int rnd = u >> 8, cc = u & 255, xc = cc & 7, rr = cc >> 3;
                const int b = xc >> 2, hq = xc & 3, qb = rr + 32 * rnd; const size_t rb = (size_t)b * S;
                const attn_body::bf16 *qp = Pj + rb * LDP + PC_AQ + hq * 64, *kp = Pj + rb * LDP + PC_AK + (hq >> 1) * 64, *vp = Pj + rb * LDP + PC_AV + (hq >> 1) * 64; attn_body::bf16* op = Bo + rb * 1024 + hq * 64;
                const bool ok = attn_body::attn_bound<false>(qp, qb * 256, (char*)lds, (const float*)(ws + WS_KMAX) + b * 2 + (hq >> 1), 0.f, tid);
                if (ok) attn_body::attn_unit<false, 8, true, false>(qp, kp, vp, op, qb * 256, (char*)lds, nullptr, 0, 0.f, 0.f, nullptr, 0.f, tid);
                else    attn_body::attn_unit<false, 8, false>(qp, kp, vp, op, qb * 256, (char*)lds, nullptr, 0, 0.f, 0.f, nullptr, 0.f, tid); }
              if ((REPMASK >> 23) & 1u) { XcdBarrier b2_ = bar; asm volatile("" : "+s"(b2_.bar)); xcd_barrier(b2_, MY_TID()); } }
            REPEAT(15) { PHASE_IDS(); const attn_body::bf16* Pj = (const attn_body::bf16*)PROJ; attn_body::bf16* Bo = (attn_body::bf16*)BR;
              float lam;
              { float t1 = (lane < 32) ? a.lambda_q1[L * 32 + (lane & 31)] * a.lambda_k1[L * 32 + (lane & 31)] : 0.f; float t2 = (lane < 32) ? a.lambda_q2[L * 32 + (lane & 31)] * a.lambda_k2[L * 32 + (lane & 31)] : 0.f;
                t1 = wave_sum(t1); t2 = wave_sum(t2);
                lam = __expf(t1) - __expf(t2) + (0.8f - 0.6f * __expf(-0.3f * (float)L)); }
              const float osc = 1.0f - (0.8f - 0.6f * __expf(-0.3f * (float)L));
              for (int u = bx; u < 1024; u += G) {
                const int rnd = u >> 8, cc = u & 255, xc = cc & 7, rr = cc >> 3;
                const int b = xc >> 2, h = xc & 3, qb = rr + 32 * rnd; const size_t rb = (size_t)b * S;
                const attn_body::bf16 *qp = Pj + rb * LDP + PC_CQ + h * 64, *kp = Pj + rb * LDP + PC_CK + h * 64, *vp = Pj + rb * LDP + PC_CV + h * 64; attn_body::bf16* op = Bo + rb * 1024 + 512 + h * 64;
                float bmax = -3.0e38f;
                for (int bk = 0; bk < 32; ++bk) bmax = fmaxf(bmax, LOG2E * a.rel_bias[bk * 4 + h]);
                const bool ok = attn_body::attn_bound<true>(qp, qb * 128, (char*)lds, (const float*)(ws + WS_KMAX) + 4 + b * 8 + h * 2, bmax, tid);
                if (ok) attn_body::attn_unit<true, 8, true>(qp, kp, vp, op, qb * 128, (char*)lds, a.rel_bias, h, lam, osc, a.g_diff + L * 64, bmax, tid);
                else    attn_body::attn_unit<true, 8, false>(qp, kp, vp, op, qb * 128, (char*)lds, a.rel_bias, h, lam, osc, a.g_diff + L * 64, bmax, tid); }
              if ((REPMASK >> 23) & 1u) { XcdBarrier b2_ = bar; asm volatile("" : "+s"(b2_.bar)); xcd_barrier(b2_, MY_TID()); } }
        } SEAM(g0 + 4); TOC(4);
        TIC(5);
        if (IN(g0 + 5)) REPEAT(5) { PHASE_IDS();
            pg8::Gemm g{BR, (const bf16*)(ws + WS_WBR), T, NGATE, 256, 1024}; pg8::MergeOrder So{G, bx};
            LAS float* rrt = (LAS float*)(ldsl + RING_BYTES + 512);
            { const int k = tid >> 8, rl = tid & 255; const int tile = k * G + bx; if (tile < 512) { const f32x4 q = *(const f32x4*)((const float*)(ws + WS_SSQ) + ((size_t)(tile >> 2) * 256 + rl) * 4);
                  const float ms = ((q[0] + q[1]) + (q[2] + q[3])) * (1.0f / 256.0f) + 1e-6f; const float sq = sqrtf(ms); rrt[(k * 256 + rl) * 2] = sq; rrt[(k * 256 + rl) * 2 + 1] = 1.0f / sq; }
              __syncthreads(); }
            pg8::EpiMergeHorner E{GATES, H, rrt, bx >> 2, (rep_ + 1 < NREP(5)) && !((REPMASK >> 22) & 1u)};
            pg8::gemm_phase<pg8::EpiMergeHorner, pg8::MergeOrder, true, true, false, false, false, PAD_P5>(ldsl, g, So, E, tid);
        } SEAM(g0 + 5); TOC(5);
        TIC(6);
        if (IN(g0 + 6)) REPEAT(6) { PHASE_IDS();
            pg8::Gemm g{H, (const bf16*)(ws + WS_WOUT), T, D, D, 0}; pg8::StaticOrder So; So.init(T, D, G, bx);
            pg8::EpiResidB E{(bf16*)(ws + WS_XB), rep_ + 1 < NREP(6)};
            pg8::gemm_phase<pg8::EpiResidB, pg8::StaticOrder, true, true, false, false, false, PAD_P6>(ldsl, g, So, E, tid);
        } SEAM(g0 + 6); TOC(6);
        TIC(7);
        if (IN(g0 + 7)) REPEAT(7) { PHASE_IDS(); ph_r1(a, L, lds, gw, NGW, lane, tid); } SEAM(g0 + 7); TOC(7);
        TIC(8);
        if (IN(g0 + 8)) REPEAT(8) { PHASE_IDS(); for (int q = bx; q < NB * NE; q += G) sel_unit(a, q, lds, wave, lane, tid); }
        SEAM(g0 + 8); TOC(8);
        TIC(9);
        TIC(10);
        if (IN(g0 + 10)) REPEAT(10) { PHASE_IDS();
            pg8::ExpertOrder So{8, G, bx};
            LAS unsigned* gtab = (LAS unsigned*)(ldsl + RING_BYTES + 512);
            { const int* SELIDX = (const int*)(ws + WS_SELIDX);
#pragma unroll 1
              for (int ui = 0; ui < 8; ++ui) { pg8::Unit uu; const bool okk = So.next(ui, uu);
                  if (tid < 256) { unsigned off = 0u; if (okk) { const int r = uu.pm * 256 + tid, b = (r >> 11) & 1; off = (unsigned)((b * S + SELIDX[r]) * D); }
                      gtab[ui * 256 + tid] = off; } }
              __syncthreads(); }
            pg8::Gemm g{H, (const bf16*)(ws + WS_WGU), NE * NB * CAP, NE * 2048, D / 2, 0};
            pg8::EpiGU8 E{(unsigned char*)(ws + WS_HID), (rep_ + 1 < NREP(10)) ? (int)(((REPMASK >> 20) & 1u) + 2 * ((REPMASK >> 24) & 1u)) : 0};
            pg8::gemm_phase<pg8::EpiGU8, pg8::ExpertOrder, true, true, true, true, false, PAD_GU>(ldsl, g, So, E, tid, gtab);
        } SEAM(g0 + 10); TOC(10);
        TIC(11);
        if (IN(g0 + 11)) REPEAT(11) { PHASE_IDS();
            pg8::ExpertOrder So{4, G, bx};
            LAS unsigned* gtab = (LAS unsigned*)(ldsl + RING_BYTES + 512);
            {
#pragma unroll 1
              for (int ui = 0; ui < 4; ++ui) { pg8::Unit uu; const bool okk = So.next(ui, uu); const int rb = okk ? uu.pm * 256 : 0; if (tid < 256) gtab[ui * 256 + tid] = (unsigned)(rb + tid) * (unsigned)D; }
              __syncthreads(); }
            pg8::Gemm g{(const bf16*)(ws + WS_HID), (const bf16*)(ws + WS_WDN), NE * NB * CAP, NE * 1024, D / 2, 0};
            pg8::EpiDNP8 E{(unsigned char*)(ws + WS_YE), (rep_ + 1 < NREP(11)) ? (int)(((REPMASK >> 20) & 1u) + 2 * ((REPMASK >> 24) & 1u)) : 0};
            pg8::gemm_phase<pg8::EpiDNP8, pg8::ExpertOrder, true, true, true, true, false, PAD_DN>(ldsl, g, So, E, tid, gtab);
        } SEAM(g0 + 11); TOC(11);
        TIC(12);
        if (IN(g0 + 12)) REPEAT(12) { PHASE_IDS(); ph_r2(a, L, gw, NGW, lane, rep_ + 1 < NREP(12)); } SEAM(g0 + 12); TOC(12);
        TIC(13);
        if (IN(g0 + 13)) REPEAT(13) { PHASE_IDS();
            pg8::StaticOrder So; So.init(T, D, G, bx);
            LAS unsigned* gtab = (LAS unsigned*)(ldsl + RING_BYTES + 512);
            {
#pragma unroll 1
              for (int ui = 0; ui < 2; ++ui) { pg8::Unit uu; const bool okk = So.next(ui, uu); const int rb = okk ? uu.pm * 256 : 0; if (tid < 256) gtab[ui * 256 + tid] = (unsigned)(rb + tid) * (unsigned)D; }
              __syncthreads(); }
            pg8::Gemm g{(const bf16*)(ws + WS_H8), (const bf16*)(ws + WS_WPG), T, D, D / 2, 0};
            pg8::EpiPleI8B E{(bf16*)(ws + WS_XB), (const bf16*)(ws + WS_PL), (const float*)(ws + WS_SA), (const float*)(ws + WS_SW) + 4096, rep_ + 1 < NREP(13)};
            pg8::gemm_phase<pg8::EpiPleI8B, pg8::StaticOrder, true, true, true, false, true, PAD_PLE>(ldsl, g, So, E, tid, gtab);
        } SEAM(g0 + 13); TOC(13);
    }
    float oscale = 1.0f;
#if PROBE_PH >= 0
    oscale = 1.0f + sqrtf((float)tacc * 1e-6f);
#endif
    if (IN(DEPTH * NPH)) { PHASE_IDS(); ph_final(a, gw, NGW, lane, oscale); }
#undef IN
#undef SEAM
#undef PHASE_IDS
}

#ifndef MK_ONE_LAUNCH
#define MK_ONE_LAUNCH 1
#endif
extern "C" void kernel_launch(void* const* d_in, const int* in_sizes, int n_in, void* d_out, int out_size, void* d_ws, size_t ws_size, hipStream_t stream) {
    static int grid = 0;
    if (grid == 0) {
        if (n_in != 35 || in_sizes[0] != T * D || out_size != T * D || ws_size < WS_END) { fprintf(stderr, "kernel_launch: unexpected shapes (n_in %d, in0 %d, out %d, ws %zu)\n", n_in, n_in > 0 ? in_sizes[0] : -1, out_size, ws_size); grid = -1; return; }
        int dev = 0, cus = 0, per_cu = 0;
        if (hipGetDevice(&dev) != hipSuccess || hipDeviceGetAttribute(&cus, hipDeviceAttributeMultiprocessorCount, dev) != hipSuccess) { grid = -1; return; }
        if (hipFuncSetAttribute((const void*)mk_fwd, hipFuncAttributeMaxDynamicSharedMemorySize, LDS_BYTES) != hipSuccess) { fprintf(stderr, "kernel_launch: hipFuncSetAttribute failed\n"); grid = -1; return; }
        if (hipOccupancyMaxActiveBlocksPerMultiprocessor(&per_cu, (const void*)mk_fwd, NTHR, LDS_BYTES) != hipSuccess || per_cu < 1) { fprintf(stderr, "kernel_launch: occupancy query says %d\n", per_cu); }
        (void)hipGetLastError();
        if (cus < 256) { fprintf(stderr, "kernel_launch: built for a 256-CU device (got %d)\n", cus); grid = -1; return; }
        grid = 256;
    }
    if (grid < 0) return;
    (void)hipMemsetAsync((char*)d_ws + WS_CTL, 0, CTL_ZERO_BYTES, stream);
    P a{};
    const float** pp = (const float**)&a;
    for (int i = 0; i < 35; ++i) pp[i] = (const float*)d_in[i];
    a.out = (float*)d_out; a.ws = (unsigned char*)d_ws;
#if MK_ONE_LAUNCH
    a.gp_lo = 0; a.gp_hi = NGP;
    hipLaunchKernelGGL(mk_fwd, dim3(grid), dim3(NTHR), LDS_BYTES, stream, a);
#else
    for (int gp = 0; gp < NGP; ++gp) { a.gp_lo = gp; a.gp_hi = gp + 1; hipLaunchKernelGGL(mk_fwd, dim3(grid), dim3(NTHR), LDS_BYTES, stream, a); }
#endif
}
```

```cpp
#include <hip/hip_runtime.h>
#include <hip/hip_bf16.h>
#include <cstdio>
#include <cstdint>
#include <cmath>
#ifndef REPMASK
#define REPMASK 0u
#endif
#define MK_PROBE_BUILD ((REPMASK) != 0u)
namespace pg8 {
#define PG8_LAS __attribute__((address_space(3)))
typedef unsigned short bf16_t;
typedef short bf16x8 __attribute__((ext_vector_type(8)));
typedef float f32x4 __attribute__((ext_vector_type(4)));
typedef unsigned u32x4 __attribute__((ext_vector_type(4)));
constexpr int BM = 256, BK = 64, HALF = 128, HTB = HALF * BK * 2  , STAGE_BYTES = 8 * HTB, NXCD = 8, WGM = 8;

__host__ __device__ __forceinline__ int lds_byte(int r, int c) { const int st = (r >> 4) * 2 + (c >> 5), rr = r & 15, cc = c & 31, ob = rr * 64 + cc * 2; return st * 1024 + (ob ^ (((ob >> 9) & 1) << 5)); }
__host__ __device__ __forceinline__ void stage_rc(int b, int& R, int& C) { const int st = b / 1024, sb = b % 1024, swz = sb ^ (((sb >> 9) & 1) << 5); R = (st >> 1) * 16 + swz / 64; C = (st & 1) * 32 + (swz % 64) / 2; }
__host__ __device__ __forceinline__ int perm32(int rho) { const int n = rho >> 4, i = rho & 15; return 8 * (i >> 2) + 4 * n + (i & 3); }

struct Unit { int pm, pn; };
struct Gemm { const bf16_t* A; const bf16_t* Bt; int M, N, K, lda; };

struct StaticOrder {
    int nM, nN, nwg, G, c;
    __host__ __device__ void init(int M, int N, int G_, int c_) { nM = M / BM; nN = N / BM; nwg = nM * nN; G = G_; c = c_; }
    __host__ __device__ __forceinline__ bool next(int i, Unit& u) const {
        const long L = (long)i * G + c; if (L >= nwg) return false;
        int wgid = (int)L; { const int q = nwg / NXCD, r = nwg % NXCD, xcd = wgid % NXCD, off = wgid / NXCD; wgid = (xcd < r ? xcd * (q + 1) : r * (q + 1) + (xcd - r) * q) + off; }
        const int nig = WGM * nN, gid = wgid / nig, fm = gid * WGM, gsz = (nM - fm) < WGM ? (nM - fm) : WGM;
        u.pm = fm + ((wgid % nig) % gsz); u.pn = (wgid % nig) / gsz; return true;
    }
    __device__ __forceinline__ void a_ready(const Unit&) const {}
    __device__ __forceinline__ void done(const Unit&) const {}
    __device__ __forceinline__ size_t a_off(const Unit&) const { return 0; }
};

__device__ __forceinline__ unsigned cvt_pk_bf16(float lo, float hi) { unsigned r; asm volatile("v_cvt_pk_bf16_f32 %0, %1, %2" : "=v"(r) : "v"(lo), "v"(hi)); return r; }
typedef float f32x2 __attribute__((ext_vector_type(2)));
__device__ __forceinline__ float ub0(unsigned w) { return (float)(w & 0xffu); }
__device__ __forceinline__ float ub1(unsigned w) { return (float)((w >> 8) & 0xffu); }
__device__ __forceinline__ float ub2(unsigned w) { return (float)((w >> 16) & 0xffu); }
__device__ __forceinline__ float ub3(unsigned w) { return (float)(w >> 24); }
__device__ __forceinline__ float bf_lo(unsigned w) { return __builtin_bit_cast(float, w << 16); }
__device__ __forceinline__ float bf_hi(unsigned w) { return __builtin_bit_cast(float, w & 0xffff0000u); }
__device__ __forceinline__ float sigmoid_f(float x) { return __builtin_amdgcn_rcpf(1.0f + __builtin_amdgcn_exp2f(-1.4426950408889634f * x)); }
__device__ __forceinline__ u32x4 pack8(const f32x4 v0, const f32x4 v1) { u32x4 w; w.x = cvt_pk_bf16(v0[0], v0[1]); w.y = cvt_pk_bf16(v0[2], v0[3]); w.z = cvt_pk_bf16(v1[0], v1[1]); w.w = cvt_pk_bf16(v1[2], v1[3]); return w; }

struct ExpertOrder {
    int nNl, G, c;
    __device__ __forceinline__ bool next(int i, Unit& u) const {
        const int L = i * G + c, per = 16 * nNl; if (L >= 16 * per) return false;
        const int e = L / per, w = L % per; u.pm = e * 16 + (w % 16); u.pn = e * nNl + (w / 16); return true;
    }
    __device__ __forceinline__ void a_ready(const Unit&) const {}
    __device__ __forceinline__ void done(const Unit&) const {}
    __device__ __forceinline__ size_t a_off(const Unit&) const { return 0; }
};
struct BranchOrder : StaticOrder {
    __device__ __forceinline__ size_t a_off(const Unit& u) const { return (size_t)(u.pn >> 2) * 256 * 2; }
};

struct EpiG1 {
    static constexpr bool PERM = true, AFTER_DRAIN = false, MIDHOOK = false;
    bf16_t* proj; bf16_t* gates; float qscale; int dry;
    __device__ __forceinline__ void operator()(const f32x4 (&acc)[2][2][4][2], const Unit& u, int wr, int wc, int fr, int fq) const {
        if (dry) return;
        int row0 = u.pm * BM + wr * 64 + fr; asm volatile("" : "+v"(row0));
        const bool isg = u.pn >= 11;
        if (isg) {
            unsigned char* base = (unsigned char*)gates + ((size_t)(u.pm * 16 + (u.pn - 11)) << 16) + ((wr * 4 + wc) * 64 + fq * 16 + fr) * 8;
#pragma unroll
            for (int ai = 0; ai < 2; ++ai)
#pragma unroll
                for (int m = 0; m < 4; ++m)
#pragma unroll
                    for (int bj = 0; bj < 2; ++bj) { f32x4 v0 = acc[ai][bj][m][0], v1 = acc[ai][bj][m][1];
#pragma unroll
                        for (int i = 0; i < 4; ++i) { v0[i] = fmaxf(255.0f * sigmoid_f(v0[i]), 1.0f); v1[i] = fmaxf(255.0f * sigmoid_f(v1[i]), 1.0f); }
                        unsigned w0 = 0u, w1 = 0u;
                        w0 = __builtin_amdgcn_cvt_pk_u8_f32(v0[0], 0, w0); w0 = __builtin_amdgcn_cvt_pk_u8_f32(v0[1], 1, w0); w0 = __builtin_amdgcn_cvt_pk_u8_f32(v0[2], 2, w0); w0 = __builtin_amdgcn_cvt_pk_u8_f32(v0[3], 3, w0);
                        w1 = __builtin_amdgcn_cvt_pk_u8_f32(v1[0], 0, w1); w1 = __builtin_amdgcn_cvt_pk_u8_f32(v1[1], 1, w1); w1 = __builtin_amdgcn_cvt_pk_u8_f32(v1[2], 2, w1); w1 = __builtin_amdgcn_cvt_pk_u8_f32(v1[3], 3, w1);
                        typedef unsigned u32x2g __attribute__((ext_vector_type(2)));
                        *(u32x2g*)(base + (((ai * 4 + m) * 2 + bj) << 12)) = (u32x2g){w0, w1}; }
        } else {
            const float sc = (u.pn == 2) ? qscale : 1.0f;
            const int col0 = u.pn * BM + wc * 32 + 8 * fq;
#pragma unroll
            for (int ai = 0; ai < 2; ++ai)
#pragma unroll
                for (int m = 0; m < 4; ++m) { bf16_t* rowp = proj + (size_t)(row0 + ai * HALF + m * 16) * 2816 + col0;
#pragma unroll
                    for (int bj = 0; bj < 2; ++bj) *(u32x4*)(rowp + bj * HALF) = pack8(acc[ai][bj][m][0] * sc, acc[ai][bj][m][1] * sc); }
        }
    }
};
struct EpiProjI8 {
    static constexpr bool PERM = true, AFTER_DRAIN = false, MIDHOOK = false;
    bf16_t* proj; const float* sa; const float* sw; int cbase; float qscale; int dry;
    static constexpr int STAGE_OFF = 131072 + 512 + 8192;
    __device__ __forceinline__ void stage(const Unit& u, __attribute__((address_space(3))) unsigned char* slot, int tid) const {
        int tq = tid; asm volatile("" : "+v"(tq));
        const int t = tq & 255; const float* src = (tq < 256) ? (sw + u.pn * BM + t) : (sa + u.pm * BM + t);
        __builtin_amdgcn_global_load_lds((const unsigned*)src, (__attribute__((address_space(3))) unsigned*)(slot + __builtin_amdgcn_readfirstlane(tid >> 6) * 256), 4, 0, 0);
    }
    __device__ __forceinline__ void operator()(const f32x4 (&acc)[2][2][4][2], const Unit& u, int wr, int wc, int fr, int fq, const __attribute__((address_space(3))) float* sl) const {
        if (dry) return;
        typedef int i32x4e __attribute__((ext_vector_type(4)));
        typedef __attribute__((address_space(3))) const f32x4* lds_f4;
        int row0 = u.pm * BM + wr * 64 + fr; asm volatile("" : "+v"(row0));
        const int col0 = u.pn * BM + wc * 32 + 8 * fq, coll = wc * 32 + 8 * fq, rowl = wr * 64 + fr;
        f32x4 cw[2][2]; const float sc = ((cbase >> 8) + u.pn == 2) ? qscale : 1.0f;
#pragma unroll
        for (int bj = 0; bj < 2; ++bj) { cw[bj][0] = *(lds_f4)(sl + coll + bj * HALF) * sc; cw[bj][1] = *(lds_f4)(sl + coll + bj * HALF + 4) * sc; }
        float RS[2][4];
#pragma unroll
        for (int ai = 0; ai < 2; ++ai)
#pragma unroll
            for (int m = 0; m < 4; ++m) RS[ai][m] = sl[256 + rowl + ai * HALF + m * 16];
        __builtin_amdgcn_sched_barrier(0);
#pragma unroll
        for (int ai = 0; ai < 2; ++ai)
#pragma unroll
            for (int m = 0; m < 4; ++m) { const int r = row0 + ai * HALF + m * 16; const float rsc = RS[ai][m]; bf16_t* rowp = proj + (size_t)r * 2816 + cbase + col0;
#pragma unroll
                for (int bj = 0; bj < 2; ++bj) { const i32x4e a0 = __builtin_bit_cast(i32x4e, acc[ai][bj][m][0]), a1 = __builtin_bit_cast(i32x4e, acc[ai][bj][m][1]); f32x4 v0, v1;
#pragma unroll
                    for (int i = 0; i < 4; ++i) { v0[i] = (float)a0[i] * rsc * cw[bj][0][i]; v1[i] = (float)a1[i] * rsc * cw[bj][1][i]; }
                    *(u32x4*)(rowp + bj * HALF) = pack8(v0, v1); } }
    }
};
struct EpiGateI8 {
    static constexpr bool PERM = true, AFTER_DRAIN = false, MIDHOOK = false;
    bf16_t* gates; const float* sa; const float* sw; int dry;
    static constexpr int STAGE_OFF = 131072 + 512 + 8192;
    __device__ __forceinline__ void stage(const Unit& u, __attribute__((address_space(3))) unsigned char* slot, int tid) const {
        int tq = tid; asm volatile("" : "+v"(tq));
        const int t = tq & 255; const float* src = (tq < 256) ? (sw + u.pn * BM + t) : (sa + u.pm * BM + t);
        __builtin_amdgcn_global_load_lds((const unsigned*)src, (__attribute__((address_space(3))) unsigned*)(slot + __builtin_amdgcn_readfirstlane(tid >> 6) * 256), 4, 0, 0);
    }
    __device__ __forceinline__ void operator()(const f32x4 (&acc)[2][2][4][2], const Unit& u, int wr, int wc, int fr, int fq, const __attribute__((address_space(3))) float* sl) const {
        if (dry) return;
        typedef unsigned u32x2g __attribute__((ext_vector_type(2))); typedef int i32x4e __attribute__((ext_vector_type(4)));
        typedef __attribute__((address_space(3))) const f32x4* lds_f4;
        unsigned char* base = (unsigned char*)gates + ((size_t)(u.pm * 16 + u.pn) << 16) + ((wr * 4 + wc) * 64 + fq * 16 + fr) * 8;
        const int colb = wc * 32 + 8 * fq, rowl = wr * 64 + fr;
        f32x4 cw[2][2];
#pragma unroll
        for (int bj = 0; bj < 2; ++bj) { cw[bj][0] = *(lds_f4)(sl + colb + bj * HALF); cw[bj][1] = *(lds_f4)(sl + colb + bj * HALF + 4); }
        float RS[2][4];
#pragma unroll
        for (int ai = 0; ai < 2; ++ai)
#pragma unroll
            for (int m = 0; m < 4; ++m) RS[ai][m] = sl[256 + rowl + ai * HALF + m * 16];
        __builtin_amdgcn_sched_barrier(0);
#pragma unroll
        for (int ai = 0; ai < 2; ++ai)
#pragma unroll
            for (int m = 0; m < 4; ++m) { const float rsn = RS[ai][m] * -1.4426950408889634f;
#pragma unroll
                for (int bj = 0; bj < 2; ++bj) { const i32x4e a0 = __builtin_bit_cast(i32x4e, acc[ai][bj][m][0]), a1 = __builtin_bit_cast(i32x4e, acc[ai][bj][m][1]); f32x4 v0, v1;
#pragma unroll
                    for (int i = 0; i < 4; ++i) { v0[i] = fmaxf(__builtin_amdgcn_rcpf(__builtin_fmaf(__builtin_amdgcn_exp2f((float)a0[i] * rsn * cw[bj][0][i]), 1.0f / 255.0f, 1.0f / 255.0f)), 1.0f);
                                                  v1[i] = fmaxf(__builtin_amdgcn_rcpf(__builtin_fmaf(__builtin_amdgcn_exp2f((float)a1[i] * rsn * cw[bj][1][i]), 1.0f / 255.0f, 1.0f / 255.0f)), 1.0f); }
                    unsigned w0 = 0u, w1 = 0u;
                    w0 = __builtin_amdgcn_cvt_pk_u8_f32(v0[0], 0, w0); w0 = __builtin_amdgcn_cvt_pk_u8_f32(v0[1], 1, w0); w0 = __builtin_amdgcn_cvt_pk_u8_f32(v0[2], 2, w0); w0 = __builtin_amdgcn_cvt_pk_u8_f32(v0[3], 3, w0);
                    w1 = __builtin_amdgcn_cvt_pk_u8_f32(v1[0], 0, w1); w1 = __builtin_amdgcn_cvt_pk_u8_f32(v1[1], 1, w1); w1 = __builtin_amdgcn_cvt_pk_u8_f32(v1[2], 2, w1); w1 = __builtin_amdgcn_cvt_pk_u8_f32(v1[3], 3, w1);
                    *(u32x2g*)(base + (((ai * 4 + m) * 2 + bj) << 12)) = (u32x2g){w0, w1}; } }
    }
};
struct EpiPlain {
    static constexpr bool PERM = true, AFTER_DRAIN = false, MIDHOOK = false;
    bf16_t* O; int ldc;
    __device__ __forceinline__ void operator()(const f32x4 (&acc)[2][2][4][2], const Unit& u, int wr, int wc, int fr, int fq) const {
        int row0 = u.pm * BM + wr * 64 + fr, col0 = u.pn * BM + wc * 32 + 8 * fq; asm volatile("" : "+v"(row0));
#pragma unroll
        for (int ai = 0; ai < 2; ++ai)
#pragma unroll
            for (int m = 0; m < 4; ++m) { bf16_t* rowp = O + (size_t)(row0 + ai * HALF + m * 16) * ldc + col0;
#pragma unroll
                for (int bj = 0; bj < 2; ++bj) *(u32x4*)(rowp + bj * HALF) = pack8(acc[ai][bj][m][0], acc[ai][bj][m][1]); }
    }
};
struct TileOrder {
    int t, nNl;
    __device__ __forceinline__ bool next(int i, Unit& u) const { if (i >= nNl) return false; u.pm = t; u.pn = (t >> 4) * nNl + i; return true; }
    __device__ __forceinline__ void a_ready(const Unit&) const {}
    __device__ __forceinline__ void done(const Unit&) const {}
    __device__ __forceinline__ size_t a_off(const Unit&) const { return 0; }
};
struct TailOrder {
    int G, c, part;
    __device__ __forceinline__ bool next(int i, Unit& u) const { const int hG = G >> 1; const bool lo = c < hG; const int n = lo ? 1 : 3, nf = lo ? (c & 1) : (c & 3);
        const int idx = (part == 0) ? i : nf + i; if ((part == 0) ? (i >= nf) : (idx >= n)) return false;
        const int L = lo ? 3 * hG + c : (c - hG) + hG * idx; if (L >= 512) return false; u.pm = L >> 2; u.pn = L & 3; return true; }
    __device__ __forceinline__ void a_ready(const Unit&) const {}
    __device__ __forceinline__ void done(const Unit&) const {}
    __device__ __forceinline__ size_t a_off(const Unit&) const { return 0; }
};
struct MergeOrder {
    int G, c;
    __device__ __forceinline__ bool next(int i, Unit& u) const { const int tile = (i >> 2) * G + c; if (tile >= 512) return false; u.pm = tile >> 2; u.pn = (i & 3) * 4 + (tile & 3); return true; }
    __device__ __forceinline__ void a_ready(const Unit&) const {}
    __device__ __forceinline__ void done(const Unit&) const {}
    __device__ __forceinline__ size_t a_off(const Unit& u) const { return (size_t)(u.pn >> 2) * 256 * 2; }
};
struct EpiMergeHorner {
    static constexpr bool PERM = true, AFTER_DRAIN = false, MIDHOOK = true;
    static constexpr int NSTORE = 0;
    const bf16_t* gates; bf16_t* O; const __attribute__((address_space(3))) float* rrt; int pm0; int dry;
    typedef unsigned u32x2q __attribute__((ext_vector_type(2)));
    struct Carry { u32x2q g[4][2]; };
    __device__ __forceinline__ bool mut(f32x4 (&acc)[2][2][4][2], const Unit& u, int wr, int wc, int fr, int fq, Carry& cy) const {
        const int n = u.pn >> 2, pd = u.pn & 3;
        if (dry) return n != 3;
        int row0 = u.pm * BM + wr * 64 + fr, col0 = pd * BM + wc * 32 + 8 * fq; asm volatile("" : "+v"(row0));
        const unsigned char* gp0 = (const unsigned char*)gates + ((size_t)(u.pm * 16 + u.pn) << 16) + ((wr * 4 + wc) * 64 + fq * 16 + fr) * 8;
        u32x2q GA[2][4][2], GB[2][4][2];
#pragma unroll
        for (int ai = 0; ai < 2; ++ai)
#pragma unroll
            for (int m = 0; m < 4; ++m)
#pragma unroll
                for (int bj = 0; bj < 2; ++bj) { const unsigned char* gp = gp0 + (((ai * 4 + m) * 2 + bj) << 12);
                    if (ai == 0) GA[ai][m][bj] = (n == 0) ? *(const u32x2q*)gp : cy.g[m][bj];
                    else         GA[ai][m][bj] = *(const u32x2q*)gp;
                    GB[ai][m][bj] = (n != 3) ? *(const u32x2q*)(gp + (4 << 16)) : (u32x2q){0u, 0u}; }
        const __attribute__((address_space(3))) float* rt = rrt + ((u.pm != pm0) ? 512 : 0) + (wr * 64 + fr) * 2 + ((n == 0) ? 0 : 1);
#pragma unroll
        for (int ai = 0; ai < 2; ++ai)
#pragma unroll
            for (int m = 0; m < 4; ++m) { const size_t r = (size_t)(row0 + ai * HALF + m * 16);
                const float rs = (n < 2) ? rt[(ai * HALF + m * 16) * 2] : 1.0f;
#pragma unroll
                for (int bj = 0; bj < 2; ++bj) { const u32x2q ga = GA[ai][m][bj];
                    if (n == 3) {
                        f32x4 v0 = acc[ai][bj][m][0] * (1.0f / 255.0f), v1 = acc[ai][bj][m][1] * (1.0f / 255.0f);
                        v0[0] *= ub0(ga.x); v0[1] *= ub1(ga.x); v0[2] *= ub2(ga.x); v0[3] *= ub3(ga.x);
                        v1[0] *= ub0(ga.y); v1[1] *= ub1(ga.y); v1[2] *= ub2(ga.y); v1[3] *= ub3(ga.y);
                        *(u32x4*)(O + r * 1024 + col0 + bj * HALF) = pack8(v0, v1);
                    } else { const u32x2q gb = GB[ai][m][bj]; f32x4 r0, r1;
                        r0[0] = rs * ub0(ga.x) * __builtin_amdgcn_rcpf(ub0(gb.x)); r0[1] = rs * ub1(ga.x) * __builtin_amdgcn_rcpf(ub1(gb.x));
                        r0[2] = rs * ub2(ga.x) * __builtin_amdgcn_rcpf(ub2(gb.x)); r0[3] = rs * ub3(ga.x) * __builtin_amdgcn_rcpf(ub3(gb.x));
                        r1[0] = rs * ub0(ga.y) * __builtin_amdgcn_rcpf(ub0(gb.y)); r1[1] = rs * ub1(ga.y) * __builtin_amdgcn_rcpf(ub1(gb.y));
                        r1[2] = rs * ub2(ga.y) * __builtin_amdgcn_rcpf(ub2(gb.y)); r1[3] = rs * ub3(ga.y) * __builtin_amdgcn_rcpf(ub3(gb.y));
                        acc[ai][bj][m][0] = acc[ai][bj][m][0] * r0; acc[ai][bj][m][1] = acc[ai][bj][m][1] * r1; } } }
#pragma unroll
        for (int m = 0; m < 4; ++m)
#pragma unroll
            for (int bj = 0; bj < 2; ++bj) cy.g[m][bj] = GB[0][m][bj];
        return n != 3;
    }
};
struct EpiResid {
    static constexpr bool PERM = false, AFTER_DRAIN = false, MIDHOOK = false;
    const float* xin; float* xout; int dry;
    __device__ __forceinline__ void operator()(const f32x4 (&acc)[2][2][4][2], const Unit& u, int wr, int wc, int fr, int fq) const {
        if (dry) return;
        int row0 = u.pm * BM + wr * 64 + fr, col0 = u.pn * BM + wc * 32 + 4 * fq; asm volatile("" : "+v"(row0));
#pragma unroll
        for (int ai = 0; ai < 2; ++ai)
#pragma unroll
            for (int m = 0; m < 4; ++m) { const size_t off = (size_t)(row0 + ai * HALF + m * 16) * 1024 + col0;
#pragma unroll
                for (int bj = 0; bj < 2; ++bj)
#pragma unroll
                    for (int n = 0; n < 2; ++n) { const f32x4 b = *(const f32x4*)(xin + off + bj * HALF + n * 16); *(f32x4*)(xout + off + bj * HALF + n * 16) = b + acc[ai][bj][m][n]; } }
    }
};
struct EpiResidB {
    static constexpr bool PERM = true, AFTER_DRAIN = false, MIDHOOK = false;
    bf16_t* x; int dry;
    __device__ __forceinline__ void operator()(const f32x4 (&acc)[2][2][4][2], const Unit& u, int wr, int wc, int fr, int fq) const {
        if (dry) return;
        int row0 = u.pm * BM + wr * 64 + fr; asm volatile("" : "+v"(row0)); const int col0 = u.pn * BM + wc * 32 + 8 * fq;
        u32x4 XT[2][4][2];
#pragma unroll
        for (int ai = 0; ai < 2; ++ai)
#pragma unroll
            for (int m = 0; m < 4; ++m)
#pragma unroll
                for (int bj = 0; bj < 2; ++bj) XT[ai][m][bj] = *(const u32x4*)(x + (size_t)(row0 + ai * HALF + m * 16) * 1024 + col0 + bj * HALF);
        __builtin_amdgcn_sched_barrier(0);
#pragma unroll
        for (int ai = 0; ai < 2; ++ai)
#pragma unroll
            for (int m = 0; m < 4; ++m) { bf16_t* rowp = x + (size_t)(row0 + ai * HALF + m * 16) * 1024 + col0;
#pragma unroll
                for (int bj = 0; bj < 2; ++bj) { const u32x4 b = XT[ai][m][bj]; f32x4 r0, r1;
                    r0[0] = bf_lo(b.x) + acc[ai][bj][m][0][0]; r0[1] = bf_hi(b.x) + acc[ai][bj][m][0][1]; r0[2] = bf_lo(b.y) + acc[ai][bj][m][0][2]; r0[3] = bf_hi(b.y) + acc[ai][bj][m][0][3];
                    r1[0] = bf_lo(b.z) + acc[ai][bj][m][1][0]; r1[1] = bf_hi(b.z) + acc[ai][bj][m][1][1]; r1[2] = bf_lo(b.w) + acc[ai][bj][m][1][2]; r1[3] = bf_hi(b.w) + acc[ai][bj][m][1][3];
                    *(u32x4*)(rowp + bj * HALF) = pack8(r0, r1); } }
    }
};
struct EpiPle {
    static constexpr bool PERM = false, AFTER_DRAIN = false, MIDHOOK = false;
    float* x; const bf16_t* pl; int dry;
    __device__ __forceinline__ void operator()(const f32x4 (&acc)[2][2][4][2], const Unit& u, int wr, int wc, int fr, int fq) const {
        if (dry) return;
        typedef unsigned u32x2 __attribute__((ext_vector_type(2)));
        int row0 = u.pm * BM + wr * 64 + fr, col0 = u.pn * BM + wc * 32 + 4 * fq; asm volatile("" : "+v"(row0));
#pragma unroll
        for (int ai = 0; ai < 2; ++ai)
#pragma unroll
            for (int m = 0; m < 4; ++m) { const size_t off = (size_t)(row0 + ai * HALF + m * 16) * 1024 + col0;
#pragma unroll
                for (int bj = 0; bj < 2; ++bj)
#pragma unroll
                    for (int n = 0; n < 2; ++n) { const size_t o = off + bj * HALF + n * 16; const f32x4 b = *(const f32x4*)(x + o); const u32x2 pv = *(const u32x2*)(pl + o);
                        const f32x4 a = acc[ai][bj][m][n]; f32x4 r;
                        r[0] = b[0] + sigmoid_f(a[0]) * bf_lo(pv.x); r[1] = b[1] + sigmoid_f(a[1]) * bf_hi(pv.x);
                        r[2] = b[2] + sigmoid_f(a[2]) * bf_lo(pv.y); r[3] = b[3] + sigmoid_f(a[3]) * bf_hi(pv.y);
                        *(f32x4*)(x + o) = r; } }
    }
};
struct EpiPleI8 {
    static constexpr bool PERM = false, AFTER_DRAIN = false, MIDHOOK = false;
    float* x; const bf16_t* pl; const float* sa; const float* sw; int dry;
    __device__ __forceinline__ void operator()(const f32x4 (&acc)[2][2][4][2], const Unit& u, int wr, int wc, int fr, int fq) const {
        if (dry) return;
        typedef unsigned u32x2 __attribute__((ext_vector_type(2))); typedef int i32x4e __attribute__((ext_vector_type(4)));
        int row0 = u.pm * BM + wr * 64 + fr; asm volatile("" : "+v"(row0)); const int col0 = u.pn * BM + wc * 32 + 4 * fq;
        f32x4 cw[2][2];
#pragma unroll
        for (int bj = 0; bj < 2; ++bj)
#pragma unroll
            for (int n = 0; n < 2; ++n) cw[bj][n] = *(const f32x4*)(sw + col0 + bj * HALF + n * 16);
#pragma unroll
        for (int ai = 0; ai < 2; ++ai)
#pragma unroll
            for (int m = 0; m < 4; ++m) { const int r = row0 + ai * HALF + m * 16; const size_t off = (size_t)r * 1024 + col0; const float rsc = sa[r];
#pragma unroll
                for (int bj = 0; bj < 2; ++bj)
#pragma unroll
                    for (int n = 0; n < 2; ++n) { const size_t o = off + bj * HALF + n * 16; const f32x4 b = *(const f32x4*)(x + o); const u32x2 pv = *(const u32x2*)(pl + o);
                        const i32x4e ai4 = __builtin_bit_cast(i32x4e, acc[ai][bj][m][n]); f32x4 r4;
                        r4[0] = b[0] + sigmoid_f((float)ai4[0] * rsc * cw[bj][n][0]) * bf_lo(pv.x); r4[1] = b[1] + sigmoid_f((float)ai4[1] * rsc * cw[bj][n][1]) * bf_hi(pv.x);
                        r4[2] = b[2] + sigmoid_f((float)ai4[2] * rsc * cw[bj][n][2]) * bf_lo(pv.y); r4[3] = b[3] + sigmoid_f((float)ai4[3] * rsc * cw[bj][n][3]) * bf_hi(pv.y);
                        *(f32x4*)(x + o) = r4; } }
    }
};
struct EpiPleI8B {
    static constexpr bool PERM = true, AFTER_DRAIN = false, MIDHOOK = false;
    static constexpr int NSTORE = 16;
    bf16_t* x; const bf16_t* pl; const float* sa; const float* sw; int dry;
    __device__ __forceinline__ void operator()(const f32x4 (&acc)[2][2][4][2], const Unit& u, int wr, int wc, int fr, int fq) const {
        if (dry) return;
        typedef int i32x4e __attribute__((ext_vector_type(4)));
#define SG(t) __builtin_amdgcn_rcpf(1.0f + __builtin_amdgcn_exp2f(t))
        int row0 = u.pm * BM + wr * 64 + fr; asm volatile("" : "+v"(row0)); int col0 = u.pn * BM + wc * 32 + 8 * fq; asm volatile("" : "+v"(col0));
        f32x4 cw[2][2];
#pragma unroll
        for (int bj = 0; bj < 2; ++bj)
#pragma unroll
            for (int n = 0; n < 2; ++n) cw[bj][n] = *(const f32x4*)(sw + col0 + bj * HALF + n * 4);
#pragma unroll
        for (int ai = 0; ai < 2; ++ai)
#pragma unroll
        for (int mh = 0; mh < 2; ++mh) {
            u32x4 XT[2][2], PT[2][2]; float RS[2];
#pragma unroll
            for (int mm = 0; mm < 2; ++mm) { const int m = 2 * mh + mm; const int r = row0 + ai * HALF + m * 16; const size_t off = (size_t)r * 1024 + col0; RS[mm] = sa[r];
#pragma unroll
                for (int bj = 0; bj < 2; ++bj) { XT[mm][bj] = *(const u32x4*)(x + off + bj * HALF); PT[mm][bj] = *(const u32x4*)(pl + off + bj * HALF); } }
            __builtin_amdgcn_sched_barrier(0);
#pragma unroll
            for (int mm = 0; mm < 2; ++mm) { const int m = 2 * mh + mm; const int r = row0 + ai * HALF + m * 16; const size_t off = (size_t)r * 1024 + col0; const float rsc = RS[mm] * -1.4426950408889634f;
#pragma unroll
                for (int bj = 0; bj < 2; ++bj) { const u32x4 b = XT[mm][bj]; const u32x4 pv = PT[mm][bj];
                    const i32x4e a0 = __builtin_bit_cast(i32x4e, acc[ai][bj][m][0]), a1 = __builtin_bit_cast(i32x4e, acc[ai][bj][m][1]); f32x4 r0, r1;
                    r0[0] = bf_lo(b.x) + SG((float)a0[0] * rsc * cw[bj][0][0]) * bf_lo(pv.x); r0[1] = bf_hi(b.x) + SG((float)a0[1] * rsc * cw[bj][0][1]) * bf_hi(pv.x);
                    r0[2] = bf_lo(b.y) + SG((float)a0[2] * rsc * cw[bj][0][2]) * bf_lo(pv.y); r0[3] = bf_hi(b.y) + SG((float)a0[3] * rsc * cw[bj][0][3]) * bf_hi(pv.y);
                    r1[0] = bf_lo(b.z) + SG((float)a1[0] * rsc * cw[bj][1][0]) * bf_lo(pv.z); r1[1] = bf_hi(b.z) + SG((float)a1[1] * rsc * cw[bj][1][1]) * bf_hi(pv.z);
                    r1[2] = bf_lo(b.w) + SG((float)a1[2] * rsc * cw[bj][1][2]) * bf_lo(pv.w); r1[3] = bf_hi(b.w) + SG((float)a1[3] * rsc * cw[bj][1][3]) * bf_hi(pv.w);
                    *(u32x4*)(x + off + bj * HALF) = pack8(r0, r1); } }
            __builtin_amdgcn_sched_barrier(0);
        }
    }
};
#undef SG
struct EpiGU {
    static constexpr bool PERM = true, AFTER_DRAIN = false, MIDHOOK = false;
    bf16_t* hid; int dry; float wscale;
    __device__ __forceinline__ void operator()(const f32x4 (&acc)[2][2][4][2], const Unit& u, int wr, int wc, int fr, int fq) const {
        if (dry) return;
        int row0 = u.pm * BM + wr * 64 + fr, col0 = (u.pn & 7) * 128 + wc * 32 + 8 * fq; asm volatile("" : "+v"(row0));
#pragma unroll
        for (int ai = 0; ai < 2; ++ai)
#pragma unroll
            for (int m = 0; m < 4; ++m) { f32x4 v0, v1; const f32x4 g0 = acc[ai][0][m][0] * wscale, g1 = acc[ai][0][m][1] * wscale, u0 = acc[ai][1][m][0] * wscale, u1 = acc[ai][1][m][1] * wscale;
#pragma unroll
                for (int i = 0; i < 4; ++i) { v0[i] = g0[i] * sigmoid_f(g0[i]) * u0[i]; v1[i] = g1[i] * sigmoid_f(g1[i]) * u1[i]; }
                *(u32x4*)(hid + (size_t)(row0 + ai * HALF + m * 16) * 1024 + col0) = pack8(v0, v1); }
    }
};
struct EpiGU8 {
    static constexpr bool PERM = true, AFTER_DRAIN = false, MIDHOOK = false;
    unsigned char* hid; int dry;
    __device__ __forceinline__ void operator()(const f32x4 (&acc)[2][2][4][2], const Unit& u, int wr, int wc, int fr, int fq) const {
        if (dry == 1) return;
        typedef unsigned u32x2h __attribute__((ext_vector_type(2)));
        int row0 = u.pm * BM + wr * 64 + fr; asm volatile("" : "+v"(row0)); const int col0 = (u.pn & 7) * 128 + wc * 32 + 8 * fq;
#pragma unroll
        for (int ai = 0; ai < 2; ++ai)
#pragma unroll
            for (int m = 0; m < 4; ++m) { f32x4 v0, v1; const f32x4 g0 = acc[ai][0][m][0] * 0.03125f, g1 = acc[ai][0][m][1] * 0.03125f, u0 = acc[ai][1][m][0] * 0.03125f, u1 = acc[ai][1][m][1] * 0.03125f;
#pragma unroll
                for (int i = 0; i < 4; ++i) { v0[i] = g0[i] * sigmoid_f(g0[i]) * u0[i]; v1[i] = g1[i] * sigmoid_f(g1[i]) * u1[i]; }
                int w0 = 0, w1 = 0;
                w0 = __builtin_amdgcn_cvt_pk_fp8_f32(v0[0], v0[1], w0, false); w0 = __builtin_amdgcn_cvt_pk_fp8_f32(v0[2], v0[3], w0, true);
                w1 = __builtin_amdgcn_cvt_pk_fp8_f32(v1[0], v1[1], w1, false); w1 = __builtin_amdgcn_cvt_pk_fp8_f32(v1[2], v1[3], w1, true);
                if (dry != 2 || row0 < -5) *(u32x2h*)(hid + (size_t)(row0 + ai * HALF + m * 16) * 1024 + col0) = (u32x2h){(unsigned)w0, (unsigned)w1}; }
    }
};
struct EpiDNP {
    static constexpr bool PERM = true, AFTER_DRAIN = false, MIDHOOK = false;
    bf16_t* ye; int dry;
    __device__ __forceinline__ void operator()(const f32x4 (&acc)[2][2][4][2], const Unit& u, int wr, int wc, int fr, int fq) const {
        if (dry == 1) return;
        int row0 = u.pm * BM + wr * 64 + fr; asm volatile("" : "+v"(row0)); const int col0 = (u.pn & 3) * BM + wc * 32 + 8 * fq;
#pragma unroll
        for (int ai = 0; ai < 2; ++ai)
#pragma unroll
            for (int m = 0; m < 4; ++m) { bf16_t* rowp = ye + (size_t)(row0 + ai * HALF + m * 16) * 1024 + col0;
#pragma unroll
                for (int bj = 0; bj < 2; ++bj) if (dry != 2 || row0 < -5) *(u32x4*)(rowp + bj * HALF) = pack8(acc[ai][bj][m][0], acc[ai][bj][m][1]); }
    }
};
struct EpiDNP8 {
    static constexpr bool PERM = true, AFTER_DRAIN = false, MIDHOOK = false;
    unsigned char* ye; int dry;
    __device__ __forceinline__ void operator()(const f32x4 (&acc)[2][2][4][2], const Unit& u, int wr, int wc, int fr, int fq) const {
        if (dry == 1) return;
        typedef unsigned u32x2h __attribute__((ext_vector_type(2)));
        int row0 = u.pm * BM + wr * 64 + fr; asm volatile("" : "+v"(row0)); const int col0 = (u.pn & 3) * BM + wc * 32 + 8 * fq;
#pragma unroll
        for (int ai = 0; ai < 2; ++ai)
#pragma unroll
            for (int m = 0; m < 4; ++m) { unsigned char* rowp = ye + (size_t)(row0 + ai * HALF + m * 16) * 1024 + col0;
#pragma unroll
                for (int bj = 0; bj < 2; ++bj) { const f32x4 v0 = acc[ai][bj][m][0] * 0.125f, v1 = acc[ai][bj][m][1] * 0.125f; int w0 = 0, w1 = 0;
                    w0 = __builtin_amdgcn_cvt_pk_fp8_f32(v0[0], v0[1], w0, false); w0 = __builtin_amdgcn_cvt_pk_fp8_f32(v0[2], v0[3], w0, true);
                    w1 = __builtin_amdgcn_cvt_pk_fp8_f32(v1[0], v1[1], w1, false); w1 = __builtin_amdgcn_cvt_pk_fp8_f32(v1[2], v1[3], w1, true);
                    if (dry != 2 || row0 < -5) *(u32x2h*)(rowp + bj * HALF) = (u32x2h){(unsigned)w0, (unsigned)w1}; } }
    }
};
struct EpiDN {
    static constexpr bool PERM = true, AFTER_DRAIN = false, MIDHOOK = false;
    bf16_t* ye; const float* aff; int dry; float wscale;
    __device__ __forceinline__ void operator()(const f32x4 (&acc)[2][2][4][2], const Unit& u, int wr, int wc, int fr, int fq) const {
        if (dry) return;
        int row0 = u.pm * BM + wr * 64 + fr, col0 = (u.pn & 3) * BM + wc * 32 + 8 * fq; asm volatile("" : "+v"(row0));
#pragma unroll
        for (int ai = 0; ai < 2; ++ai)
#pragma unroll
            for (int m = 0; m < 4; ++m) { const size_t r = (size_t)(row0 + ai * HALF + m * 16); const float a = aff[r] * wscale;
#pragma unroll
                for (int bj = 0; bj < 2; ++bj) *(u32x4*)(ye + r * 1024 + col0 + bj * HALF) = pack8(acc[ai][bj][m][0] * a, acc[ai][bj][m][1] * a); }
    }
};
struct NoCarry {};
template <class...> using pg8_void_t = void;
template <class E, class = void> struct HasStage { static constexpr bool v = false; };
template <class E> struct HasStage<E, pg8_void_t<decltype(E::STAGE_OFF)>> { static constexpr bool v = true; };
template <class E, bool M = E::MIDHOOK> struct CarryOf { typedef NoCarry type; };
template <class E> struct CarryOf<E, true> { typedef typename E::Carry type; };
template <class Epi, class Sched, bool ALIGN_EPI = false, bool SP2 = false, bool GATHER = false, bool F8 = false, bool I8 = false, int PADN = 0>
__device__ __forceinline__ void gemm_phase(PG8_LAS unsigned char* lds, const Gemm g, const Sched& S, const Epi& E, const int tid, const PG8_LAS unsigned* gtab = nullptr) {
    typedef int i32x4q __attribute__((ext_vector_type(4)));
    static_assert(!GATHER || SP2, "GATHER is wired into the SP2 loop only");
    const int wid = __builtin_amdgcn_readfirstlane(tid >> 6), lane = tid & 63, wr = wid >> 2, wc = wid & 3, fr = lane & 15, fq = lane >> 4;
    int K = g.K; asm volatile("" : "+s"(K));
    const int nt = K / BK; const int lda = g.lda ? g.lda : K;
    unsigned voffA[2], voffB[2]; int gR[2]; unsigned gC[2];
#pragma unroll
    for (int i = 0; i < 2; ++i) { int R, C; stage_rc(tid * 16 + i * 8192, R, C); const int Rb = Epi::PERM ? ((R & ~31) + perm32(R & 31)) : R;
        voffA[i] = (unsigned)(R * lda + C) * 2u; voffB[i] = (unsigned)(Rb * K + C) * 2u; gR[i] = R; gC[i] = (unsigned)C * 2u; }
    unsigned cvo[2][2] = {{0u, 0u}, {0u, 0u}};
#define PG8_GLOAD(vo, uidx) do { _Pragma("unroll") for (int h_ = 0; h_ < 2; ++h_) _Pragma("unroll") for (int i_ = 0; i_ < 2; ++i_) vo[h_][i_] = gtab[(uidx) * 256 + h_ * 128 + gR[i_]] + gC[i_]; } while (0)
#define PG8_STA0(bufoff, gbase, h) do { unsigned vs_[2]; if constexpr (GATHER) { vs_[0] = cvo[h][0]; vs_[1] = cvo[h][1]; } else { vs_[0] = voffA[0]; vs_[1] = voffA[1]; } PG8_STAGE(bufoff, gbase, vs_); } while (0)
#define PG8_STAN(bufoff, gbase, h) do { unsigned vs_[2]; if constexpr (GATHER) { const int nu_ = has_next ? ui + 1 : ui; vs_[0] = last ? gtab[nu_ * 256 + (h) * 128 + gR[0]] + gC[0] : cvo[h][0]; vs_[1] = last ? gtab[nu_ * 256 + (h) * 128 + gR[1]] + gC[1] : cvo[h][1]; } else { vs_[0] = voffA[0]; vs_[1] = voffA[1]; } PG8_STAGE(bufoff, gbase, vs_); } while (0)
    const size_t kstep = (size_t)(BK * 2);
    const size_t hstep = (size_t)HALF * K * 2;
    const size_t tstep = 2 * hstep;
    const size_t hstepA = GATHER ? 0 : (size_t)HALF * lda * 2, tstepA = 2 * hstepA;
    const unsigned ldsw = (unsigned)wid * 1024u;
    const int aoff = lds_byte(wr * 64 + fr, fq * 8), boff = lds_byte(wc * 32 + fr, fq * 8);
#define PG8_SA(b, h) (((b) * 2 + (h)) * HTB)
#define PG8_SB(b, h) ((4 + (b) * 2 + (h)) * HTB)
#define PG8_STAGE(bufoff, gbase, voff) do { _Pragma("unroll") for (int _i = 0; _i < 2; ++_i) \
        __builtin_amdgcn_global_load_lds((const unsigned*)((const char*)(gbase) + (voff)[_i]), (PG8_LAS unsigned*)(lds + (bufoff) + ldsw + _i * 8192), 16, 0, 0); } while (0)
#define PG8_LD32(p) __builtin_shufflevector(*(const PG8_LAS i32x4q*)(p), *(const PG8_LAS i32x4q*)((p) + 1024), 0, 1, 2, 3, 4, 5, 6, 7)
#define PG8_LDA(dst, b, h) do { _Pragma("unroll") for (int m = 0; m < 4; ++m) { if constexpr (F8) dst##8[m] = PG8_LD32(lds + PG8_SA(b, h) + aoff + m * 2048); else { _Pragma("unroll") for (int k = 0; k < 2; ++k) dst[m][k] = *(const PG8_LAS bf16x8*)(lds + PG8_SA(b, h) + aoff + m * 2048 + k * 1024); } } } while (0)
#define PG8_LDB(dst, b, h) do { _Pragma("unroll") for (int n = 0; n < 2; ++n) { if constexpr (F8) dst##8[n] = PG8_LD32(lds + PG8_SB(b, h) + boff + n * 2048); else { _Pragma("unroll") for (int k = 0; k < 2; ++k) dst[n][k] = *(const PG8_LAS bf16x8*)(lds + PG8_SB(b, h) + boff + n * 2048 + k * 1024); } } } while (0)
#define PG8_MMA(ai, bj, At, Bt) do { __builtin_amdgcn_s_setprio(1); _Pragma("unroll") for (int m = 0; m < 4; ++m) _Pragma("unroll") for (int n = 0; n < 2; ++n) { \
        if constexpr (F8) acc[ai][bj][m][n] = __builtin_amdgcn_mfma_scale_f32_16x16x128_f8f6f4(Bt##8[n], At##8[m], acc[ai][bj][m][n], 0, 0, 0, 0, 0, 0); \
        else if constexpr (I8) { _Pragma("unroll") for (int k = 0; k < 2; ++k) acc[ai][bj][m][n] = __builtin_bit_cast(f32x4, __builtin_amdgcn_mfma_i32_16x16x64_i8(__builtin_bit_cast(i32x4q, Bt[n][k]), __builtin_bit_cast(i32x4q, At[m][k]), __builtin_bit_cast(i32x4q, acc[ai][bj][m][n]), 0, 0, 0)); } \
        else { _Pragma("unroll") for (int k = 0; k < 2; ++k) acc[ai][bj][m][n] = __builtin_amdgcn_mfma_f32_16x16x32_bf16(Bt[n][k], At[m][k], acc[ai][bj][m][n], 0, 0, 0); } } \
        __builtin_amdgcn_s_setprio(0); } while (0)
#define PG8_WAIT_V(n) asm volatile("s_waitcnt vmcnt(" #n ")" ::: "memory")
#define PG8_WAIT_L(n) asm volatile("s_waitcnt lgkmcnt(" #n ")" ::: "memory")
#define PG8_BAR __builtin_amdgcn_s_barrier()
#define PG8_SCHED __builtin_amdgcn_sched_barrier(0)
    Unit cur, nxt; int ui = 0;
    if (!S.next(0, cur)) return;
    f32x4 acc[2][2][4][2];
#pragma unroll
    for (int a = 0; a < 2; ++a)
#pragma unroll
        for (int b = 0; b < 2; ++b)
#pragma unroll
            for (int m = 0; m < 4; ++m)
#pragma unroll
                for (int n = 0; n < 2; ++n) acc[a][b][m][n] = (f32x4){0.f, 0.f, 0.f, 0.f};
    typename CarryOf<Epi>::type carry;
    bf16x8 At[4][2], B0[2][2], B1[2][2];
    typedef int i32x8q __attribute__((ext_vector_type(8))); i32x8q At8[4], B08[2], B18[2];
    const char* cA = (const char*)g.A + (size_t)cur.pm * tstepA + S.a_off(cur); if constexpr (GATHER) PG8_GLOAD(cvo, 0);
    const char* cB = (const char*)g.Bt + (size_t)cur.pn * tstep;
    S.a_ready(cur);
    if constexpr (SP2) {
        PG8_STAGE(PG8_SB(0, 0), cB, voffB); PG8_STAGE(PG8_SB(0, 1), cB + hstep, voffB); PG8_STA0(PG8_SA(0, 0), cA, 0); PG8_STA0(PG8_SA(0, 1), cA + hstepA, 1);
        if (wr == 1) PG8_BAR;
        PG8_WAIT_V(2); PG8_BAR;
        PG8_STAGE(PG8_SB(1, 0), cB + kstep, voffB); PG8_STA0(PG8_SA(1, 0), cA + kstep, 0); PG8_STAGE(PG8_SB(1, 1), cB + hstep + kstep, voffB);
        PG8_WAIT_V(6); PG8_BAR;
    } else {
        PG8_STAGE(PG8_SB(0, 0), cB, voffB); PG8_STAGE(PG8_SA(0, 0), cA, voffA); PG8_STAGE(PG8_SB(0, 1), cB + hstep, voffB); PG8_STAGE(PG8_SA(0, 1), cA + hstepA, voffA);
        if (wr == 1) PG8_BAR;
        PG8_WAIT_V(4); PG8_BAR;
        PG8_STAGE(PG8_SB(1, 0), cB + kstep, voffB); PG8_STAGE(PG8_SA(1, 0), cA + kstep, voffA); PG8_STAGE(PG8_SB(1, 1), cB + hstep + kstep, voffB);
        PG8_WAIT_V(6); PG8_BAR;
    }
    if constexpr (HasStage<Epi>::v) E.stage(cur, lds + Epi::STAGE_OFF, tid);
    for (;;) {
        const bool has_next = S.next(ui + 1, nxt);
        const char* nA = has_next ? (const char*)g.A + (size_t)nxt.pm * tstepA + S.a_off(nxt) : cA; const char* nB = has_next ? (const char*)g.Bt + (size_t)nxt.pn * tstep : cB;
        asm volatile(".p2align 6\n\t.rept %c0\n\ts_nop 0\n\t.endr" :: "i"(PADN) : "memory");
        for (int t = 0; t < nt; t += 2) {
            const bool last = (t == nt - 2);
            const char* a1 = cA + (size_t)(t + 1) * kstep;
            const char* a2 = last ? nA : cA + (size_t)(t + 2) * kstep; const char* b2 = last ? nB : cB + (size_t)(t + 2) * kstep;
            const char* a3 = a2 + kstep; const char* b3 = b2 + kstep;
            if (last && has_next) S.a_ready(nxt);
            if constexpr (SP2) {
            PG8_LDB(B0, 0, 0); PG8_LDB(B1, 0, 1); PG8_SCHED; PG8_LDA(At, 0, 0); PG8_STA0(PG8_SA(1, 1), a1 + hstepA, 1);
            PG8_WAIT_V(8); PG8_WAIT_L(0); PG8_BAR; PG8_MMA(0, 0, At, B0); PG8_MMA(0, 1, At, B1); PG8_BAR; PG8_SCHED;
            PG8_LDA(At, 0, 1); PG8_STAGE(PG8_SB(0, 0), b2, voffB); PG8_STAGE(PG8_SB(0, 1), b2 + hstep, voffB); PG8_STAN(PG8_SA(0, 0), a2, 0);
            PG8_WAIT_V(8); PG8_WAIT_L(0); PG8_BAR; PG8_MMA(1, 0, At, B0); PG8_MMA(1, 1, At, B1); PG8_BAR; PG8_SCHED;
            PG8_LDB(B0, 1, 0); PG8_LDB(B1, 1, 1); PG8_SCHED; PG8_LDA(At, 1, 0); PG8_STAN(PG8_SA(0, 1), a2 + hstepA, 1);
            PG8_WAIT_V(8); PG8_WAIT_L(0); PG8_BAR; PG8_MMA(0, 0, At, B0); PG8_MMA(0, 1, At, B1); PG8_BAR; PG8_SCHED;
            PG8_LDA(At, 1, 1); PG8_STAGE(PG8_SB(1, 0), b3, voffB); PG8_STAGE(PG8_SB(1, 1), b3 + hstep, voffB); PG8_STAN(PG8_SA(1, 0), a3, 0);
            PG8_WAIT_V(8); PG8_WAIT_L(0); PG8_BAR; PG8_MMA(1, 0, At, B0); PG8_MMA(1, 1, At, B1); PG8_BAR; PG8_SCHED;
            } else {
            PG8_LDB(B0, 0, 0); PG8_SCHED; PG8_LDA(At, 0, 0); PG8_STAGE(PG8_SA(1, 1), a1 + hstepA, voffA);
            PG8_WAIT_L(8); PG8_BAR; PG8_WAIT_L(0); PG8_MMA(0, 0, At, B0); PG8_BAR; PG8_SCHED;
            PG8_LDB(B1, 0, 1); PG8_STAGE(PG8_SB(0, 0), b2, voffB);
            PG8_BAR; PG8_WAIT_L(0); PG8_MMA(0, 1, At, B1); PG8_BAR;
            PG8_LDA(At, 0, 1); PG8_STAGE(PG8_SA(0, 0), a2, voffA);
            PG8_BAR; PG8_WAIT_L(0); PG8_MMA(1, 0, At, B0); PG8_BAR; PG8_SCHED;
            PG8_STAGE(PG8_SB(0, 1), b2 + hstep, voffB);
            PG8_WAIT_V(6); PG8_BAR; PG8_MMA(1, 1, At, B1); PG8_BAR;
            PG8_LDB(B0, 1, 0); PG8_SCHED; PG8_LDA(At, 1, 0); PG8_STAGE(PG8_SA(0, 1), a2 + hstepA, voffA);
            PG8_WAIT_L(8); PG8_BAR; PG8_WAIT_L(0); PG8_MMA(0, 0, At, B0); PG8_BAR; PG8_SCHED;
            PG8_LDB(B1, 1, 1); PG8_STAGE(PG8_SB(1, 0), b3, voffB);
            PG8_BAR; PG8_WAIT_L(0); PG8_MMA(0, 1, At, B1); PG8_BAR;
            PG8_LDA(At, 1, 1); PG8_STAGE(PG8_SA(1, 0), a3, voffA);
            PG8_BAR; PG8_WAIT_L(0); PG8_MMA(1, 0, At, B0); PG8_BAR; PG8_SCHED;
            PG8_STAGE(PG8_SB(1, 1), b3 + hstep, voffB);
            PG8_WAIT_V(6); PG8_BAR; PG8_MMA(1, 1, At, B1); PG8_BAR;
            }
        }
        if constexpr (ALIGN_EPI) { if (wr == 0) PG8_BAR; }
        bool keep_acc = false;
        if constexpr (Epi::MIDHOOK) { keep_acc = E.mut(acc, cur, wr, wc, fr, fq, carry); S.done(cur); }
        else if constexpr (HasStage<Epi>::v) { E(acc, cur, wr, wc, fr, fq, (const PG8_LAS float*)(lds + Epi::STAGE_OFF + (ui & 1) * 2048)); S.done(cur); }
        else if constexpr (!Epi::AFTER_DRAIN) { E(acc, cur, wr, wc, fr, fq); S.done(cur); }
        if (!has_next) break;
        if (!keep_acc)
#pragma unroll
        for (int a = 0; a < 2; ++a)
#pragma unroll
            for (int b = 0; b < 2; ++b)
#pragma unroll
                for (int m = 0; m < 4; ++m)
#pragma unroll
                    for (int n = 0; n < 2; ++n) acc[a][b][m][n] = (f32x4){0.f, 0.f, 0.f, 0.f};
        cur = nxt; cA = nA; cB = nB; ++ui;
        if constexpr (HasStage<Epi>::v) E.stage(cur, lds + Epi::STAGE_OFF + (ui & 1) * 2048, tid);
        if constexpr (GATHER) PG8_GLOAD(cvo, ui);
        if constexpr (ALIGN_EPI) { if (wr == 1) PG8_BAR; }
    }
    PG8_WAIT_V(0);
    if constexpr (!ALIGN_EPI) { if (wr == 0) PG8_BAR; }
    PG8_BAR;
    if constexpr (Epi::AFTER_DRAIN) { E.fused(acc, cur, wr, wc, fr, fq, lds, wid, lane); S.done(cur); }
#undef PG8_SA
#undef PG8_SB
#undef PG8_STAGE
#undef PG8_GLOAD
#undef PG8_STA0
#undef PG8_STAN
#undef PG8_LDA
#undef PG8_LDB
#undef PG8_MMA
#undef PG8_LD32
#undef PG8_WAIT_V
#undef PG8_WAIT_L
#undef PG8_BAR
#undef PG8_SCHED
}
}
namespace attn_body {
using bf16=__hip_bfloat16;
using bf16x8=__attribute__((ext_vector_type(8)))short;
using s16x4=__attribute__((ext_vector_type(4)))short;
using f32x16=__attribute__((ext_vector_type(16)))float;
using u32x4=__attribute__((ext_vector_type(4)))unsigned;
using f32x4a=__attribute__((ext_vector_type(4)))float;
constexpr int SEQ=16384,D=64,LDP=2816,LDO=1024;
constexpr int NW=8,QBLK=32,KVBLK=64,NT=SEQ/KVBLK;
__device__ __forceinline__ int crow(int r,int hi){return (r&3)+8*(r>>2)+4*hi;}
#define SBAR() __builtin_amdgcn_sched_barrier(0)
constexpr int NSLOT=3, SLOTB=8192;
constexpr int LDS_K=0, LDS_V=NSLOT*SLOTB, LDS_WS=2*NSLOT*SLOTB, LDS_OST=LDS_WS+NW*64*4, LDS_TAB=LDS_OST+65536, LDS_RED=LDS_TAB+640*4, LDS_BYTES=LDS_RED+64*4;
constexpr float LOG2E=1.4426950408889634f;
constexpr int PAD_AF=6,PAD_AS=0,PAD_CF=13,PAD_CS=4;
__device__ __forceinline__ void glds16(const void*gsrc,unsigned lds_dst){unsigned keep;
  asm volatile("s_mov_b32 %0, m0\n\ts_mov_b32 m0, %2\n\ts_nop 0\n\tglobal_load_lds_dwordx4 %1, off\n\ts_mov_b32 m0, %0":"=&s"(keep):"v"(gsrc),"s"(lds_dst):"memory");}
__device__ __forceinline__ float max3f(float a,float b,float c){float r;asm("v_max3_f32 %0, %1, %2, %3":"=v"(r):"v"(a),"v"(b),"v"(c));return r;}
__device__ __forceinline__ float max2f(float a,float b){float r;asm("v_max_f32_e32 %0, %1, %2":"=v"(r):"v"(a),"v"(b));return r;}
__device__ __forceinline__ float fadd_s(float a,float b){float r;asm("v_add_f32_e32 %0, %1, %2":"=v"(r):"v"(a),"v"(b));return r;}
__device__ __forceinline__ float fsub_s(float a,float b){float r;asm("v_sub_f32_e32 %0, %1, %2":"=v"(r):"v"(a),"v"(b));return r;}
typedef float f32x2_t __attribute__((ext_vector_type(2))); typedef __bf16 bf16x2_t __attribute__((ext_vector_type(2)));
__device__ __forceinline__ unsigned cvtpk_s(float lo,float hi){f32x2_t v={lo,hi};bf16x2_t b=__builtin_convertvector(v,bf16x2_t);return __builtin_bit_cast(unsigned,b);}
#define WAIT_BAR(N) asm volatile("s_waitcnt vmcnt(" #N ") lgkmcnt(0)\n\ts_barrier":::"memory")

template<int ND> __device__ __forceinline__ void qkt(f32x16&p0,f32x16&p1,const char*Kslot,const bf16x8*qr,const f32x16&negm,int r32,int hi){
  const char*kb=Kslot+hi*1024+r32*16;
  #pragma unroll
  for(int d0=0;d0<ND;++d0){
    const bf16x8 b0=*reinterpret_cast<const bf16x8*>(kb+d0*2048);
    const bf16x8 b1=*reinterpret_cast<const bf16x8*>(kb+d0*2048+512);
    if(d0==0){p0=__builtin_amdgcn_mfma_f32_32x32x16_bf16(b0,qr[0],negm,0,0,0);p1=__builtin_amdgcn_mfma_f32_32x32x16_bf16(b1,qr[0],negm,0,0,0);}
    else{p0=__builtin_amdgcn_mfma_f32_32x32x16_bf16(b0,qr[d0],p0,0,0,0);p1=__builtin_amdgcn_mfma_f32_32x32x16_bf16(b1,qr[d0],p1,0,0,0);}}
}
typedef __attribute__((address_space(3))) const char* lds_cptr;
typedef __attribute__((address_space(3))) const float* lds_fptr;
typedef short v4i16_t __attribute__((ext_vector_type(4)));
__device__ __forceinline__ void kload8(bf16x8*kf,lds_cptr kp){
  kf[0]=*(const __attribute__((address_space(3))) bf16x8*)(kp);      kf[1]=*(const __attribute__((address_space(3))) bf16x8*)(kp+512);
  kf[2]=*(const __attribute__((address_space(3))) bf16x8*)(kp+2048); kf[3]=*(const __attribute__((address_space(3))) bf16x8*)(kp+2560);
  kf[4]=*(const __attribute__((address_space(3))) bf16x8*)(kp+4096); kf[5]=*(const __attribute__((address_space(3))) bf16x8*)(kp+4608);
  kf[6]=*(const __attribute__((address_space(3))) bf16x8*)(kp+6144); kf[7]=*(const __attribute__((address_space(3))) bf16x8*)(kp+6656);
}
__device__ __forceinline__ void kload2(bf16x8*kf,lds_cptr kp,int j){ kf[2*j]=*(const __attribute__((address_space(3))) bf16x8*)(kp+j*2048); kf[2*j+1]=*(const __attribute__((address_space(3))) bf16x8*)(kp+j*2048+512); }
__device__ __forceinline__ s16x4 vtr(lds_cptr p){ return __builtin_bit_cast(s16x4,__builtin_amdgcn_ds_read_tr16_b64_v4i16((__attribute__((address_space(3))) v4i16_t*)p)); }
__device__ __forceinline__ float rowmax(const f32x16&p0,const f32x16&p1){
  float a=max3f(p0[0],p0[1],p1[0]),b=max3f(p0[2],p0[3],p1[1]);a=max3f(a,p1[2],p1[3]);
  #pragma unroll
  for(int r=4;r<16;r+=4){a=max3f(a,p0[r],p0[r+1]);b=max3f(b,p0[r+2],p0[r+3]);a=max3f(a,p1[r],p1[r+1]);b=max3f(b,p1[r+2],p1[r+3]);}
  const float m=max2f(a,b);
  auto rr=__builtin_amdgcn_permlane32_swap(__float_as_uint(m),__float_as_uint(m),false,false);
  return max2f(__uint_as_float(rr[0]),__uint_as_float(rr[1]));
}
__device__ __forceinline__ void pv(f32x16*o,int vb,bf16x8 pa0,bf16x8 pa1,bf16x8 pa2,bf16x8 pa3){
  #pragma unroll
  for(int d0=0;d0<2;++d0){s16x4 lo[4],hi[4];
    #pragma unroll
    for(int ks=0;ks<4;++ks){
      asm volatile("ds_read_b64_tr_b16 %0,%1 offset:%c2":"=&v"(lo[ks]):"v"(vb),"i"(d0*4096+ks*1024):"memory");
      asm volatile("ds_read_b64_tr_b16 %0,%1 offset:%c2":"=&v"(hi[ks]):"v"(vb),"i"(d0*4096+ks*1024+512):"memory");}
    asm volatile("s_waitcnt lgkmcnt(0)":::"memory");SBAR();
    #define PK(k) (bf16x8){lo[k][0],lo[k][1],lo[k][2],lo[k][3],hi[k][0],hi[k][1],hi[k][2],hi[k][3]}
    o[d0]=__builtin_amdgcn_mfma_f32_32x32x16_bf16(pa0,PK(0),o[d0],0,0,0);
    o[d0]=__builtin_amdgcn_mfma_f32_32x32x16_bf16(pa1,PK(1),o[d0],0,0,0);
    o[d0]=__builtin_amdgcn_mfma_f32_32x32x16_bf16(pa2,PK(2),o[d0],0,0,0);
    o[d0]=__builtin_amdgcn_mfma_f32_32x32x16_bf16(pa3,PK(3),o[d0],0,0,0);
    #undef PK
  }
}
__device__ __forceinline__ int t5_bucket(int rel){
  const int r=rel<0?-rel:rel; int v;
  if(r<8)v=r; else if(r<12)v=8; else if(r<16)v=9; else if(r<23)v=10; else if(r<32)v=11; else if(r<46)v=12; else if(r<64)v=13; else if(r<91)v=14; else v=15;
  return (rel>0?16:0)+v;
}

#ifndef ATTN_STORE16
#define ATTN_STORE16(p,v) (*(u32x4*)(p)=(v))
#endif
template<bool CM> __device__ __forceinline__ float attn_qnorm2(const bf16*Qb,int q0,int wid,int r32,int hi){
  const int wrow=CM?(wid&3)*QBLK:wid*QBLK; const int map=wid>>2; const bf16*Qw=Qb+(long)(q0+wrow)*LDP; float s=0.f;
  #pragma unroll
  for(int d0=0;d0<(CM?2:4);++d0){ const bf16x8 q=*reinterpret_cast<const bf16x8*>(&Qw[(long)r32*LDP+(CM?map*32:0)+d0*16+hi*8]);
    #pragma unroll
    for(int i=0;i<8;++i){ const float f=__uint_as_float((unsigned)(unsigned short)q[i]<<16); s+=f*f; } }
  auto rr=__builtin_amdgcn_permlane32_swap(__float_as_uint(s),__float_as_uint(s),false,false); return __uint_as_float(rr[0])+__uint_as_float(rr[1]);
}
template<bool CM> __device__ __forceinline__ bool attn_bound(const bf16*Qb,int q0,char*shm,const float*kmaxp,float bmax,const int tid){
  const int lane=tid&63,r32=lane&31,hi=lane>>5; const int wid=__builtin_amdgcn_readfirstlane(tid>>6);
  float*red=(float*)(shm+LDS_RED);
  float km=kmaxp[32*(tid&255)+(CM?(tid>>8):0)];
  #pragma unroll
  for(int o=1;o<64;o<<=1)km=fmaxf(km,__shfl_xor(km,o));
  if(lane==0)red[wid]=km;
  const float qn2=attn_qnorm2<CM>(Qb,q0,wid,r32,hi);
  asm volatile("s_waitcnt lgkmcnt(0)\n\ts_barrier":::"memory");
  const int ro=CM?4*(wid>>2):0; const float kmax2=fmaxf(fmaxf(red[ro],red[ro+1]),fmaxf(red[ro+2],red[ro+3]));
  const float bound=sqrtf(qn2*kmax2)*1.0005f+bmax+0.01f;
  const bool bad=__any(!(bound<=60.f));
  if(lane==0)red[8+wid]=bad?1.f:0.f;
  asm volatile("s_waitcnt lgkmcnt(0)\n\ts_barrier":::"memory");
  float f=0.f;
  #pragma unroll
  for(int w=0;w<8;++w)f+=red[8+w];
  return f==0.f;
}
template<bool CM,int THRL,bool FAST,bool LMA=false> __device__ __forceinline__ void attn_unit(const bf16*Qb,const bf16*__restrict__ Kb,const bf16*__restrict__ Vb,bf16*Ob,int q0,char*shm,
                                                                       const float*relb,int h,float lam,float osc,const float*gdiff,float bmax,const int tid){
  const int lane=tid&63,r32=lane&31,hi=lane>>5; const int wid=__builtin_amdgcn_readfirstlane(tid>>6);
  const int wrow=CM?(wid&3)*QBLK:wid*QBLK; const int map=wid>>2;
  const bf16*Qw=Qb+(long)(q0+wrow)*LDP;
  const unsigned lds0=(unsigned)(uintptr_t)shm;
  float*wsf=(float*)(shm+LDS_WS)+wid*64;
  const bf16*ksrc=Kb+(long)lane*LDP+wid*8;
  const bf16*vsrc=Vb+(long)(16*(wid&3)+(lane>>2))*LDP+(wid>>2)*32+(lane&3)*8;
  const unsigned kdst=lds0+LDS_K+wid*1024, vdst=lds0+LDS_V+wid*1024;
  #define DMA_K(t,slot) glds16(ksrc+(long)(t)*KVBLK*LDP,(unsigned)__builtin_amdgcn_readfirstlane(kdst+(slot)))
  #define DMA_V(t,slot) glds16(vsrc+(long)(t)*KVBLK*LDP,(unsigned)__builtin_amdgcn_readfirstlane(vdst+(slot)))
  const int vb0=(int)(lds0+LDS_V)+((lane>>4)&1)*32+(lane&3)*8+(4*hi+((lane&15)>>2))*64;
  const char*Kbase=shm+LDS_K; bf16x8 kf[8];
  const lds_cptr shm3=(lds_cptr)shm; const lds_cptr kp0=shm3+LDS_K+hi*1024+r32*16+(CM?map*4096:0); const lds_cptr vp0=shm3+LDS_V+((lane>>4)&1)*32+(lane&3)*8+(4*hi+((lane&15)>>2))*64;
  const lds_fptr tab3=(lds_fptr)(shm3+LDS_TAB);
    if(CM){ float*tab=(float*)(shm+LDS_TAB); for(int i=tid;i<640;i+=NW*64)tab[i]=LOG2E*relb[t5_bucket(i-320)*4+h]; }
  DMA_K(0,0);DMA_V(0,0);DMA_K(1,SLOTB);
  bf16x8 qr[4];
  #pragma unroll
  for(int d0=0;d0<(CM?2:4);++d0)qr[d0]=*reinterpret_cast<const bf16x8*>(&Qw[(long)r32*LDP+(CM?map*32:0)+d0*16+hi*8]);
  const int jn=q0>>7; const int nlo=2*jn-3, nhi=2*jn+5; const int qabs=q0+wrow+r32;
  bool near=CM&&(nlo<=0); float cside=0.f; if(CM&&!near)cside=LOG2E*relb[15*4+h];
  float mhat=0.f,l_reg=0.f;f32x16 o[2];o[0]=f32x16{};o[1]=f32x16{};asm volatile("":"+v"(o[0]),"+v"(o[1]));f32x16 negm;
  constexpr bool LM=FAST&&LMA;
  f32x16 lacc=f32x16{}; unsigned one_=0x3F803F80u; if constexpr(LM){ asm volatile("":"+v"(lacc),"+v"(one_)); }
  const bf16x8 ONES=__builtin_bit_cast(bf16x8,(u32x4){one_,one_,one_,one_});
  #define NEGM_SET() do{ _Pragma("unroll") for(int r=0;r<16;++r)negm[r]=cside-mhat; asm volatile("":"+v"(negm)); }while(0)
  NEGM_SET();
  #define MODESW(t) do{ if(CM){ if((t)==nlo){near=true;cside=0.f;NEGM_SET();} else if((t)==nhi){near=false;cside=tab3[639];NEGM_SET();} } }while(0)
  #define BIASADD(P0,P1,t) do{ if(CM){ if(near){ const lds_fptr tb_=tab3+(64*(t)-qabs+4*hi+320); \
      _Pragma("unroll") for(int r4=0;r4<4;++r4){ _Pragma("unroll") for(int r=4*r4;r<4*r4+4;++r){P0[r]+=tb_[(r&3)+8*(r>>2)];P1[r]+=tb_[32+(r&3)+8*(r>>2)];} SBAR(); } } } }while(0)
  bool resc=false;
  #define START(P0,P1) do{ if constexpr(!FAST){ const float rm=rowmax(P0,P1); resc=false; \
    { const float dl=rm; mhat=fadd_s(mhat,dl); \
      _Pragma("unroll") for(int r=0;r<16;++r){P0[r]=fsub_s(P0[r],dl);P1[r]=fsub_s(P1[r],dl);} \
      NEGM_SET(); } } \
    _Pragma("unroll") for(int r=0;r<16;++r)P0[r]=__builtin_amdgcn_exp2f(P0[r]); }while(0)
  #define RESC() do{ if constexpr(!FAST) if(resc){ asm volatile("s_waitcnt lgkmcnt(0)":::"memory"); \
      _Pragma("unroll") for(int d_=0;d_<2;++d_) _Pragma("unroll") for(int r=0;r<16;++r)o[d_][r]*=wsf[crow(r,hi)]; } }while(0)
  f32x16 pA0,pA1,pB0,pB1;
  int sl_prev=0,sl_cur=0,sl_next=SLOTB;
  #define ROT() do{sl_prev=sl_cur;sl_cur=sl_next;sl_next=(sl_next==(NSLOT-1)*SLOTB)?0:sl_next+SLOTB;}while(0)
  DMA_K(2,2*SLOTB);
  float qn2_=0.f; if constexpr(FAST)qn2_=attn_qnorm2<CM>(Qb,q0,wid,r32,hi);
  WAIT_BAR(3);
  if constexpr(FAST){ const float*red=(const float*)(shm+LDS_RED); const int ro=CM?4*map:0; const float kmax2=fmaxf(fmaxf(red[ro],red[ro+1]),fmaxf(red[ro+2],red[ro+3]));
    mhat=sqrtf(qn2_*kmax2)*1.0005f+bmax+0.01f; NEGM_SET(); }
  qkt<(CM?2:4)>(pA0,pA1,Kbase+(CM?map*4096:0),qr,negm,r32,hi);asm volatile("s_nop 15\n\ts_nop 7":"+v"(pA0),"+v"(pA1));BIASADD(pA0,pA1,0);
  START(pA0,pA1);
  _Pragma("unroll") for(int r=0;r<16;++r)pA1[r]=__builtin_amdgcn_exp2f(pA1[r]);
  WAIT_BAR(0);
  DMA_K(3,0);DMA_V(1,SLOTB);
  ROT();
  if constexpr(CM){ kload2(kf,kp0+sl_cur,0); kload2(kf,kp0+sl_cur,1); } else { kload8(kf,kp0+sl_cur); }
  WAIT_BAR(2);
  s16x4 vlo[8],vhi[8]; u32x4 pw0,pw1,pw2,pw3;
  #define PKW(P,B) cvtpk_s(P[B],P[B+1])
  #define PAF(k) __builtin_bit_cast(bf16x8,pw##k)
  #define VFR(i) (bf16x8){vlo[i][0],vlo[i][1],vlo[i][2],vlo[i][3],vhi[i][0],vhi[i][1],vhi[i][2],vhi[i][3]}
  #define PIN(x) asm volatile("":"+v"(x))
  #define MX3(a,b,c) __builtin_fmaxf(__builtin_fmaxf((a),(b)),(c))
  #define GAPA(MF,A0,A1,A2,A3,W0,W1,PW) do{ MF; if constexpr(!LM){ sacc+=A0; sacc+=A1; sacc+=A2; sacc+=A3; PIN(sacc); } W0; W1; PIN(PW); SBAR(); }while(0)
  #define LS(k) do{ if constexpr(LM) lacc=__builtin_amdgcn_mfma_f32_32x32x16_bf16(PAF(k),ONES,lacc,0,0,0); }while(0)
  #define EX(v) __builtin_amdgcn_exp2f(v)
  #define GAPB(MF,X,B) do{ MF; X[B]=EX(X[B]); X[B+1]=EX(X[B+1]); X[B+2]=EX(X[B+2]); X[B+3]=EX(X[B+3]); PIN(X); SBAR(); }while(0)
  #define VRD(i) do{ vlo[i]=vtr(vp_+(((i)>>2)*4096+((i)&3)*1024)); vhi[i]=vtr(vp_+(((i)>>2)*4096+((i)&3)*1024+512)); }while(0)
  #define KRD(G,j) do{ if((G)&&(!CM||(j)<2)){ kload2(kf,kp0+sl_next,j); SBAR(); } }while(0)
  #define MF58(stmt) do{ if constexpr(!CM){ stmt; } }while(0)
  #define STEP(C0,C1,P0,P1,t,GK,GV,GL) do{ SBAR(); \
    const lds_cptr vp_=vp0+sl_prev; \
    VRD(0); SBAR(); float sacc=(P0[0]+P0[1]); \
    GAPA(C0=__builtin_amdgcn_mfma_f32_32x32x16_bf16(kf[0],qr[0],negm,0,0,0), P0[2],P0[3],P0[4],P0[5],     pw0[0]=PKW(P0,0), pw0[1]=PKW(P0,2), pw0); \
    VRD(4); SBAR(); GAPA(C1=__builtin_amdgcn_mfma_f32_32x32x16_bf16(kf[1],qr[0],negm,0,0,0), P0[6],P0[7],P0[8],P0[9],     pw0[2]=PKW(P0,4), pw0[3]=PKW(P0,6), pw0); \
    VRD(1); SBAR(); GAPA(C0=__builtin_amdgcn_mfma_f32_32x32x16_bf16(kf[2],qr[1],C0,0,0,0),   P0[10],P0[11],P0[12],P0[13], pw1[0]=PKW(P0,8), pw1[1]=PKW(P0,10), pw1); \
    VRD(5); SBAR(); GAPA(C1=__builtin_amdgcn_mfma_f32_32x32x16_bf16(kf[3],qr[1],C1,0,0,0),   P0[14],P0[15],P1[0],P1[1],   pw1[2]=PKW(P0,12),pw1[3]=PKW(P0,14), pw1); \
    VRD(2); SBAR(); GAPA(MF58(C0=__builtin_amdgcn_mfma_f32_32x32x16_bf16(kf[4],qr[2],C0,0,0,0)),   P1[2],P1[3],P1[4],P1[5],     pw2[0]=PKW(P1,0), pw2[1]=PKW(P1,2), pw2); \
    VRD(6); SBAR(); GAPA(MF58(C1=__builtin_amdgcn_mfma_f32_32x32x16_bf16(kf[5],qr[2],C1,0,0,0)),   P1[6],P1[7],P1[8],P1[9],     pw2[2]=PKW(P1,4), pw2[3]=PKW(P1,6), pw2); \
    VRD(3); SBAR(); GAPA(MF58(C0=__builtin_amdgcn_mfma_f32_32x32x16_bf16(kf[6],qr[3],C0,0,0,0)),   P1[10],P1[11],P1[12],P1[13], pw3[0]=PKW(P1,8), pw3[1]=PKW(P1,10), pw3); \
    VRD(7); SBAR(); GAPA(MF58(C1=__builtin_amdgcn_mfma_f32_32x32x16_bf16(kf[7],qr[3],C1,0,0,0)),   P1[14],P1[15],0.f,0.f,       pw3[2]=PKW(P1,12),pw3[3]=PKW(P1,14), pw3); \
    if constexpr(!LM) l_reg+=sacc; \
    if(GK){DMA_K((t)+3,sl_cur);} if(GV){DMA_V((t)+1,sl_next);} \
    BIASADD(C0,C1,t); \
    if constexpr(!FAST){ float a=MX3(C0[0],C0[1],C1[0]),b=MX3(C0[2],C0[3],C1[1]); a=MX3(a,C1[2],C1[3]); \
      _Pragma("unroll") for(int r=4;r<16;r+=4){a=MX3(a,C0[r],C0[r+1]);b=MX3(b,C0[r+2],C0[r+3]);a=MX3(a,C1[r],C1[r+1]);b=MX3(b,C1[r+2],C1[r+3]);} \
      float rm=__builtin_fmaxf(a,b); { auto rr=__builtin_amdgcn_permlane32_swap(__float_as_uint(rm),__float_as_uint(rm),false,false); rm=__builtin_fmaxf(__uint_as_float(rr[0]),__uint_as_float(rr[1])); } \
      resc=false; \
      if(__builtin_expect(__any(rm>(float)THRL),0)){ const float dl=__builtin_fmaxf(rm,0.f); mhat+=dl; \
        _Pragma("unroll") for(int r=0;r<16;++r){C0[r]-=dl;C1[r]-=dl;} \
        NEGM_SET(); \
        const float f=__builtin_amdgcn_exp2f(-dl); l_reg*=f; if(hi==0)wsf[r32]=f; resc=true; } } \
    SBAR(); \
    GAPB(o[0]=__builtin_amdgcn_mfma_f32_32x32x16_bf16(PAF(0),VFR(0),o[0],0,0,0), C0,0); \
    GAPB(o[1]=__builtin_amdgcn_mfma_f32_32x32x16_bf16(PAF(0),VFR(4),o[1],0,0,0); LS(0), C0,4); \
    KRD(GL,0); GAPB(o[0]=__builtin_amdgcn_mfma_f32_32x32x16_bf16(PAF(1),VFR(1),o[0],0,0,0), C0,8); \
    KRD(GL,1); GAPB(o[1]=__builtin_amdgcn_mfma_f32_32x32x16_bf16(PAF(1),VFR(5),o[1],0,0,0); LS(1), C0,12); \
    KRD(GL,2); GAPB(o[0]=__builtin_amdgcn_mfma_f32_32x32x16_bf16(PAF(2),VFR(2),o[0],0,0,0), C1,0); \
    KRD(GL,3); GAPB(o[1]=__builtin_amdgcn_mfma_f32_32x32x16_bf16(PAF(2),VFR(6),o[1],0,0,0); LS(2), C1,4); \
    GAPB(o[0]=__builtin_amdgcn_mfma_f32_32x32x16_bf16(PAF(3),VFR(3),o[0],0,0,0), C1,8); \
    GAPB(o[1]=__builtin_amdgcn_mfma_f32_32x32x16_bf16(PAF(3),VFR(7),o[1],0,0,0); LS(3), C1,12); \
    }while(0)
  int t=1;
  { constexpr int PADN=CM?(FAST?PAD_CF:PAD_CS):(FAST?PAD_AF:PAD_AS); asm volatile(".p2align 6\n\t.rept %c0\n\ts_nop 0\n\t.endr"::"i"(PADN):"memory"); }
  for(;t+5<NT;t+=2){
    MODESW(t);
    STEP(pB0,pB1,pA0,pA1,t,true,true,true);     WAIT_BAR(2); RESC(); ROT();
    STEP(pA0,pA1,pB0,pB1,t+1,true,true,true);   WAIT_BAR(2); RESC(); ROT();
  }
  #define ENDW(tt) do{ if((tt)+3<NT){WAIT_BAR(2);} else if((tt)+2<NT){WAIT_BAR(1);} else {WAIT_BAR(0);} }while(0)
  for(;t+1<NT;t+=2){
    MODESW(t);
    STEP(pB0,pB1,pA0,pA1,t,(t+3<NT),(t+1<NT),(t+1<NT));       ENDW(t);   RESC(); ROT();
    STEP(pA0,pA1,pB0,pB1,t+1,(t+4<NT),(t+2<NT),(t+2<NT));     ENDW(t+1); RESC(); ROT();
  }
  MODESW(NT-1);
  STEP(pB0,pB1,pA0,pA1,NT-1,false,false,false); RESC();
  { if constexpr(!LM){ float sacc=pB0[0]+pB0[1]; _Pragma("unroll") for(int r=2;r<16;++r)sacc+=pB0[r]; _Pragma("unroll") for(int r=0;r<16;++r)sacc+=pB1[r]; l_reg+=sacc; }
    pw0=(u32x4){PKW(pB0,0),PKW(pB0,2),PKW(pB0,4),PKW(pB0,6)};pw1=(u32x4){PKW(pB0,8),PKW(pB0,10),PKW(pB0,12),PKW(pB0,14)};pw2=(u32x4){PKW(pB1,0),PKW(pB1,2),PKW(pB1,4),PKW(pB1,6)};pw3=(u32x4){PKW(pB1,8),PKW(pB1,10),PKW(pB1,12),PKW(pB1,14)};
    SBAR(); pv(o,vb0+sl_cur,PAF(0),PAF(1),PAF(2),PAF(3)); LS(0); LS(1); LS(2); LS(3); }
  #undef PKW
  #undef PAF
  #undef VFR
  #undef PIN
  #undef MX3
  #undef GAPA
  #undef LS
  #undef GAPB
  #undef EX
  #undef VRD
  #undef KRD
  #undef MF58
  #undef STEP
  #undef ENDW
  float rli[16];
  if constexpr(LM){
    #pragma unroll
    for(int r=0;r<16;++r)rli[r]=__builtin_amdgcn_rcpf(lacc[r]);
  } else {
    {auto rr=__builtin_amdgcn_permlane32_swap(__float_as_uint(l_reg),__float_as_uint(l_reg),false,false);l_reg=__uint_as_float(rr[0])+__uint_as_float(rr[1]);}
    if(hi==0)wsf[32+r32]=l_reg;asm volatile("s_waitcnt lgkmcnt(0)":::"memory");
    #pragma unroll
    for(int r=0;r<16;++r)rli[r]=__builtin_amdgcn_rcpf(wsf[32+crow(r,hi)]);
  }
  if(!CM){
    bf16*Ow=Ob+(long)(q0+wid*QBLK)*LDO;
    bf16*stg=(bf16*)(shm+LDS_OST)+wid*2048;
    #pragma unroll
    for(int r=0;r<16;++r){const int orow=crow(r,hi);
      #pragma unroll
      for(int d0=0;d0<2;++d0)stg[orow*64+d0*32+r32]=__float2bfloat16(o[d0][r]*rli[r]);}
    asm volatile("s_waitcnt lgkmcnt(0)":::"memory");
    #pragma unroll
    for(int i=0;i<4;++i){const int row=i*8+(lane>>3),ch=lane&7; const u32x4 v=*(const u32x4*)(stg+row*64+ch*8); ATTN_STORE16(Ow+(long)row*LDO+ch*8,v);}
  } else {
    const float msc=(map==0)?1.f:-lam;
    float*stg=(float*)(shm+LDS_OST)+map*8192+(wid&3)*2048;
    #pragma unroll
    for(int r=0;r<16;++r){const int orow=crow(r,hi); const float sc=rli[r]*msc;
      #pragma unroll
      for(int d0=0;d0<2;++d0)stg[orow*64+d0*32+r32]=o[d0][r]*sc;}
    asm volatile("s_waitcnt lgkmcnt(0)\n\ts_barrier":::"memory");
    const int row=16*wid+(lane>>2),part=lane&3;
    const float*s0=(const float*)(shm+LDS_OST)+row*64+part*16;
    f32x4a a[4]; float ss=0.f;
    #pragma unroll
    for(int i=0;i<4;++i){ a[i]=((const f32x4a*)s0)[i]+((const f32x4a*)(s0+8192))[i]; ss+=a[i][0]*a[i][0]+a[i][1]*a[i][1]+a[i][2]*a[i][2]+a[i][3]*a[i][3]; }
    ss+=__shfl_xor(ss,1); ss+=__shfl_xor(ss,2);
    const float rn=osc/sqrtf(ss*(1.0f/64.0f)+1e-6f);
    unsigned w[8];
    #pragma unroll
    for(int i=0;i<4;++i){ const f32x4a g=((const f32x4a*)(gdiff+part*16))[i]; w[2*i]=cvtpk_s(a[i][0]*rn*g[0],a[i][1]*rn*g[1]); w[2*i+1]=cvtpk_s(a[i][2]*rn*g[2],a[i][3]*rn*g[3]); }
    bf16*op=Ob+(long)(q0+row)*LDO+part*16;
    *(u32x4*)(op)=(u32x4){w[0],w[1],w[2],w[3]}; *(u32x4*)(op+8)=(u32x4){w[4],w[5],w[6],w[7]};
  }
  asm volatile("s_waitcnt lgkmcnt(0)\n\ts_barrier":::"memory");
  #undef DMA_K
  #undef DMA_V
  #undef BIASADD
  #undef MODESW
  #undef NEGM_SET
  #undef START
  #undef RESC
  #undef ROT
}
#undef SBAR
#undef WAIT_BAR
}
#define GAS __attribute__((address_space(1)))
#define LAS __attribute__((address_space(3)))
typedef unsigned short bf16;
typedef unsigned v4u __attribute__((ext_vector_type(4)));
typedef float f32x4 __attribute__((ext_vector_type(4)));
typedef short bf16x8 __attribute__((ext_vector_type(8)));
typedef GAS unsigned gu32;
typedef GAS unsigned long long gu64;
#define RLX_AGENT __ATOMIC_RELAXED, __HIP_MEMORY_SCOPE_AGENT
#define LDS_WAIT() asm volatile("s_waitcnt lgkmcnt(0)" ::: "memory")
#define VM_WAIT() asm volatile("s_waitcnt vmcnt(0)" ::: "memory")
__device__ __forceinline__ unsigned long long rt() { return __builtin_amdgcn_s_memrealtime(); }
__device__ __forceinline__ unsigned f2bf(float f) { unsigned u = __builtin_bit_cast(unsigned, f); return (u + 0x7fffu + ((u >> 16) & 1u)) >> 16; }
__device__ __forceinline__ unsigned pk2(float lo, float hi) { return f2bf(lo) | (f2bf(hi) << 16); }

#define XB_TMO      128
#define XB_XCNT(j)  (256  + 64 * (j))
#define XB_XSUB(j)  (1280 + 64 * (j))
#define XB_XGEN(j)  (2304 + 64 * (j))
#define XB_TOP      3328
#define XB_TOPGEN   3392
#define XCD_BAR_WORDS 3456
#define XB_SPIN_CAP (1u << 18)

__device__ __forceinline__ unsigned xb_ld(unsigned* p)              { return __hip_atomic_load(p, __ATOMIC_RELAXED, __HIP_MEMORY_SCOPE_AGENT); }
__device__ __forceinline__ unsigned xb_add(unsigned* p, unsigned v) { return __hip_atomic_fetch_add(p, v, __ATOMIC_RELAXED, __HIP_MEMORY_SCOPE_AGENT); }
__device__ __forceinline__ unsigned xb_xcc_id() { return (unsigned)__builtin_amdgcn_s_getreg((3 << 11) | 20) & 0xFu; }
#define XB_SPIN(cond, bar) do { unsigned _sp = 0; while (cond) { __builtin_amdgcn_s_sleep(1); \
    if ((++_sp & 255u) == 0u) { if (xb_ld(&(bar)[XB_TMO])) break; if (_sp > XB_SPIN_CAP) { atomicAdd(&(bar)[XB_TMO], 1u); break; } } } } while (0)

struct XcdBarrier {
    unsigned* bar; unsigned x;
    volatile LAS unsigned* st;
};

__device__ __forceinline__ XcdBarrier xcd_barrier_post(unsigned* bar, volatile LAS unsigned* st, int tid_) {
    XcdBarrier b; b.bar = bar; b.x = xb_xcc_id(); b.st = st;
    if (tid_ == 0) (void)xb_add(&bar[XB_XCNT(b.x)], 1u);
    return b;
}
__device__ __forceinline__ void xcd_barrier_complete(unsigned* bar, unsigned x, unsigned& nloc, unsigned& nx) {
    const unsigned G = gridDim.x * gridDim.y * gridDim.z;
    unsigned sum, cnt, mine, sp = 0u;
    for (;;) {
        sum = 0u; cnt = 0u; mine = 0u;
#pragma unroll
        for (unsigned j = 0; j < 16; ++j) { const unsigned c = xb_ld(&bar[XB_XCNT(j)]); sum += c; cnt += (c > 0u) ? 1u : 0u; mine = (j == x) ? c : mine; }
        if (sum == G) break;
        __builtin_amdgcn_s_sleep(1);
        if ((++sp & 255u) == 0u) { if (xb_ld(&bar[XB_TMO])) break; if (sp > XB_SPIN_CAP) { atomicAdd(&bar[XB_TMO], 1u); break; } }
    }
    nloc = mine > 0u ? mine : 1u; nx = cnt > 0u ? cnt : 1u;
}

__device__ __forceinline__ void xcd_barrier(const XcdBarrier& b, int tid_) {
    asm volatile("s_waitcnt vmcnt(0)" ::: "memory");
    __syncthreads();
    if (tid_ == 0) {
        unsigned* bar = b.bar;
        __builtin_amdgcn_s_waitcnt(0);
        unsigned nloc = b.st[0], nx = b.st[1];
        if (nloc == 0u) { xcd_barrier_complete(bar, b.x, nloc, nx); b.st[0] = nloc; b.st[1] = nx; }
        const unsigned old = xb_add(&bar[XB_XSUB(b.x)], 1u);
        const unsigned gen = old / nloc;
        if (old + 1u == (gen + 1u) * nloc) {
            __builtin_amdgcn_fence(__ATOMIC_RELEASE, "agent");
            asm volatile("s_waitcnt vmcnt(0)" ::: "memory");
            const unsigned og = xb_add(&bar[XB_TOP], 1u);
            const unsigned tg = og / nx;
            if (og + 1u == (tg + 1u) * nx) xb_add(&bar[XB_TOPGEN], 1u);
            else XB_SPIN(xb_ld(&bar[XB_TOPGEN]) == tg, bar);
            __builtin_amdgcn_fence(__ATOMIC_ACQUIRE, "agent");
            xb_add(&bar[XB_XGEN(b.x)], 1u);
            asm volatile("s_waitcnt vmcnt(0)" ::: "memory");
        } else {
            XB_SPIN(xb_ld(&bar[XB_XGEN(b.x)]) == gen, bar);
            __builtin_amdgcn_fence(__ATOMIC_ACQUIRE, "agent");
            asm volatile("s_waitcnt vmcnt(0)" ::: "memory");
        }
    }
    __syncthreads();
}
constexpr int NWAVES = 8, NTHR = 512;
constexpr int NB = 2, S = 16384, T = NB * S, D = 1024, DEPTH = 4, NE = 16, CAP = 2048;
constexpr int NPROJ = 2816, NGATE = 4096, NCAT = NPROJ + NGATE, LDP = NPROJ;
constexpr int NPROJ_BF = 0, NPROJ_I8 = NPROJ - NPROJ_BF;
constexpr int PC_AQ = 0, PC_AK = 256, PC_AV = 384, PC_CQ = 512, PC_CK = 768, PC_CV = 1024, PC_Z = 1280, PC_XS = 1536, PC_BM = 1792, PC_CM = 2048, PC_UV = 2304;
constexpr float EPS = 1e-6f, LOG2E = 1.4426950408889634f;
constexpr int PAD_PL0 = 5, PAD_PROJ = 8, PAD_PL = 5, PAD_GATE = 8, PAD_P5 = 0, PAD_P6 = 5, PAD_GU = 8, PAD_DN = 8, PAD_PLE = 8;
constexpr int NPH = 14;
constexpr int NGP = DEPTH * NPH + 1;

constexpr size_t MiB = 1u << 20;
constexpr size_t WS_CTL = 0, CTL_ZERO_BYTES = 1 * MiB;
constexpr size_t WS_DT = 1 * MiB;
constexpr size_t WS_AFF = 2 * MiB;
constexpr size_t WS_SELIDX = 4 * MiB;
constexpr size_t WS_SELAFF = 4 * MiB + 256 * 1024;
constexpr size_t WS_INV = 5 * MiB;
constexpr size_t WS_TAB = 6 * MiB;
constexpr size_t WS_CD = 8 * MiB;
constexpr size_t WS_WSP = 8 * MiB + 512 * 1024;
constexpr size_t WS_SSQ = 9 * MiB;
constexpr size_t WS_KMAX = 9 * MiB + 512 * 1024;
constexpr size_t WS_SA = 9 * MiB + 576 * 1024;
constexpr size_t WS_SW = 9 * MiB + 768 * 1024;
constexpr size_t WS_WCAT = 10 * MiB;
constexpr size_t WS_WBR = 24 * MiB, WS_WPG = 26 * MiB, WS_WPLE = 28 * MiB;
constexpr size_t WS_WGU = 32 * MiB;
constexpr size_t WS_WDN = 96 * MiB;
constexpr size_t WS_H = 128 * MiB;
constexpr size_t WS_PROJ = 192 * MiB;
constexpr size_t WS_GATES = 368 * MiB;
constexpr size_t WS_XE = 192 * MiB, WS_HID = 320 * MiB, WS_YE = 448 * MiB;
constexpr size_t WS_BR = 624 * MiB;
constexpr size_t WS_PL = 688 * MiB;
constexpr size_t WS_PBF = 752 * MiB;
constexpr size_t WS_ST = 768 * MiB;
constexpr size_t WS_SB = 832 * MiB;
constexpr size_t WS_XBC = 864 * MiB;
constexpr size_t WS_WOUT = 912 * MiB;
constexpr size_t WS_H8 = 914 * MiB;
constexpr size_t WS_XB = 946 * MiB;
constexpr size_t WS_END = 1010 * MiB;
constexpr int CW_TMO = 0, CW_BAR = 4096;

constexpr int RING_BYTES = 131072, LDSCTL_OFF = RING_BYTES, MISC_OFF = LDSCTL_OFF + 320, LDS_BYTES = 147456;

struct P {
    const float *x, *p, *rel_bias, *g_mix, *w_in, *g_qnorm, *g_knorm, *conv_w, *conv_b, *dt_bias_f, *dt_bias_b, *a_log_f, *a_log_b, *d_skip, *g_ssm,
                *lambda_q1, *lambda_k1, *lambda_q2, *lambda_k2, *g_diff, *g_sgu, *w_spatial, *b_spatial, *w_branch, *w_branch_gate, *w_out, *g_moe, *w_router,
                *w_exp_gate, *w_exp_up, *w_exp_down, *g_ple, *w_ple_gate, *w_ple, *g_final;
    float* out; unsigned char* ws;
    int gp_lo, gp_hi;
};

__device__ __forceinline__ float wave_sum(float v) {
#pragma unroll
    for (int o = 1; o < 64; o <<= 1) v += __shfl_xor(v, o);
    return v;
}
__device__ __forceinline__ float bf2f(unsigned short u) { return __builtin_bit_cast(float, (unsigned)u << 16); }
__device__ __forceinline__ float silu_f(float x) { return x * __builtin_amdgcn_rcpf(1.0f + __builtin_amdgcn_exp2f(-LOG2E * x)); }
__device__ __forceinline__ float gelu_tanh(float x) { const float y = 0.7978845608028654f * (x + 0.044715f * x * x * x); const float e = __builtin_amdgcn_exp2f(2.0f * LOG2E * y); return 0.5f * x * (2.0f - 2.0f * __builtin_amdgcn_rcpf(e + 1.0f)); }
__device__ __forceinline__ float softplus_f(float x) {
    const float e = __builtin_amdgcn_exp2f(-LOG2E * fabsf(x));
    const float l = (e < 0.03125f) ? e * (1.0f - e * (0.5f - e * (0.33333334f - 0.25f * e))) : 0.6931471805599453f * __builtin_amdgcn_logf(1.0f + e);
    return fmaxf(x, 0.f) + l; }
__device__ __forceinline__ f32x4 mfma16(bf16x8 a, bf16x8 b, f32x4 c) { return __builtin_amdgcn_mfma_f32_16x16x32_bf16(a, b, c, 0, 0, 0); }
typedef short bf16x4 __attribute__((ext_vector_type(4)));
typedef unsigned v2u __attribute__((ext_vector_type(2)));
__device__ __forceinline__ f32x4 xb_unpack(const v2u w) { return (f32x4){__builtin_bit_cast(float, w.x << 16), __builtin_bit_cast(float, w.x & 0xffff0000u), __builtin_bit_cast(float, w.y << 16), __builtin_bit_cast(float, w.y & 0xffff0000u)}; }

__device__ __forceinline__ void tr_item(const float* W, int ldw, int k0, int scol0, bf16* WT, int ldk, int drow0, LAS float* scr, int lane) {
#pragma unroll 8
    for (int i = 0; i < 32; ++i) { const int kk = 2 * i + (lane >> 5); scr[kk * 33 + (lane & 31)] = W[(size_t)(k0 + kk) * ldw + scol0 + (lane & 31)]; }
    LDS_WAIT(); asm volatile("" ::: "memory");
    const int c = lane & 7;
#pragma unroll
    for (int j = 0; j < 4; ++j) { const int n = (lane >> 3) + 8 * j; const LAS float* s = scr + (8 * c) * 33 + n;
        v4u o; o.x = pk2(s[0 * 33], s[1 * 33]); o.y = pk2(s[2 * 33], s[3 * 33]); o.z = pk2(s[4 * 33], s[5 * 33]); o.w = pk2(s[6 * 33], s[7 * 33]);
        *(GAS v4u*)(WT + (size_t)(drow0 + n) * ldk + k0 + 8 * c) = o; }
    LDS_WAIT(); asm volatile("" ::: "memory");
}
__device__ __forceinline__ void tr_item8(const float* W, int ldw, int k0, int scol0, unsigned char* WT, int ldk, int drow0, float scale, LAS float* scr, int lane) {
#pragma unroll 8
    for (int i = 0; i < 32; ++i) { const int kk = 2 * i + (lane >> 5); scr[kk * 33 + (lane & 31)] = W[(size_t)(k0 + kk) * ldw + scol0 + (lane & 31)]; }
    LDS_WAIT(); asm volatile("" ::: "memory");
    const int c = lane & 3;
#pragma unroll
    for (int j = 0; j < 2; ++j) { const int n = (lane >> 2) + 16 * j; const LAS float* s = scr + (16 * c) * 33 + n; int w[4];
#pragma unroll
        for (int q = 0; q < 4; ++q) { int t = 0; t = __builtin_amdgcn_cvt_pk_fp8_f32(scale * s[(4 * q) * 33], scale * s[(4 * q + 1) * 33], t, false); t = __builtin_amdgcn_cvt_pk_fp8_f32(scale * s[(4 * q + 2) * 33], scale * s[(4 * q + 3) * 33], t, true); w[q] = t; }
        *(GAS v4u*)(WT + (size_t)(drow0 + n) * ldk + k0 + 16 * c) = (v4u){(unsigned)w[0], (unsigned)w[1], (unsigned)w[2], (unsigned)w[3]}; }
    LDS_WAIT(); asm volatile("" ::: "memory");
}
__device__ __forceinline__ void tr_item_i8(const float* W, int ldw, int k0, int scol0, unsigned char* WT, int ldk, int drow0, const LAS float* inv, LAS float* scr, int lane) {
#pragma unroll 8
    for (int i = 0; i < 32; ++i) { const int kk = 2 * i + (lane >> 5); scr[kk * 33 + (lane & 31)] = W[(size_t)(k0 + kk) * ldw + scol0 + (lane & 31)]; }
    LDS_WAIT(); asm volatile("" ::: "memory");
    const int c = lane & 3;
#pragma unroll
    for (int j = 0; j < 2; ++j) { const int n = (lane >> 2) + 16 * j; const LAS float* s = scr + (16 * c) * 33 + n; const float iv = inv[n]; unsigned w[4];
#pragma unroll
        for (int q = 0; q < 4; ++q) { const int b0 = (int)rintf(iv * s[(4 * q) * 33]), b1 = (int)rintf(iv * s[(4 * q + 1) * 33]), b2 = (int)rintf(iv * s[(4 * q + 2) * 33]), b3 = (int)rintf(iv * s[(4 * q + 3) * 33]);
            w[q] = (unsigned)(b0 & 0xff) | ((unsigned)(b1 & 0xff) << 8) | ((unsigned)(b2 & 0xff) << 16) | ((unsigned)(b3 & 0xff) << 24); }
        *(GAS v4u*)(WT + (size_t)(drow0 + n) * ldk + k0 + 16 * c) = (v4u){w[0], w[1], w[2], w[3]}; }
    LDS_WAIT(); asm volatile("" ::: "memory");
}
__device__ __forceinline__ void gatew_item(const float* W, int ldw, int scol, int nb, unsigned char* WT, float* SWo, unsigned char* ldsg, int wave, int lane, int tid) {
    LAS unsigned char* lds = (LAS unsigned char*)ldsg;
    LAS float* scr = (LAS float*)(lds + wave * 16384);
    LAS float* cmax = (LAS float*)(lds + RING_BYTES + 512);
    LAS float* inv = cmax + 256;
    float mx = 0.f;
#pragma unroll 1
    for (int kb2 = 0; kb2 < 2; ++kb2) { const int k0 = 64 * (2 * wave + kb2);
#pragma unroll 8
        for (int i = 0; i < 32; ++i) { const int kk = 2 * i + (lane >> 5); mx = fmaxf(mx, fabsf(W[(size_t)(k0 + kk) * ldw + scol + (lane & 31)])); } }
    mx = fmaxf(mx, __shfl_xor(mx, 32));
    if (lane < 32) cmax[wave * 32 + lane] = mx;
    __syncthreads();
    if (tid < 32) { float m2 = 0.f;
#pragma unroll
        for (int w = 0; w < 8; ++w) m2 = fmaxf(m2, cmax[w * 32 + tid]);
        m2 = fmaxf(m2, 1e-30f); inv[tid] = 127.0f / m2; SWo[32 * nb + tid] = m2 * (1.0f / 127.0f); }
    __syncthreads();
#pragma unroll 1
    for (int kb2 = 0; kb2 < 2; ++kb2) tr_item_i8(W, ldw, 64 * (2 * wave + kb2), scol, WT, 1024, 32 * nb, inv, scr, lane);
    __syncthreads();
}
__device__ __forceinline__ int win_src(int drow) {
    return drow < 512 ? drow : drow < 1280 ? 1544 + (drow - 512) : drow < 2304 ? 512 + (drow - 1280) : 2312 + (drow - 2304);
}

__device__ __forceinline__ void ph_convw(const P& a, int L, unsigned char* lds, int gw, int NGW, int wave, int lane, int tid, int gtid, int GT, int wgi, int nwg, int part) {
    unsigned char* ws = a.ws;
    LAS float* scr = (LAS float*)((LAS unsigned char*)lds + wave * 16384);
    constexpr int I1 = 16 * (NPROJ_BF / 32), I2 = 0, I3 = 512, I4 = 512, I5 = 0, I6 = 4 * 32, I7 = NE * 2 * 512, I8 = NE * 512;
    constexpr int NIT = I1 + I2 + I3 + I4 + I5 + I6 + I7 + I8, NEARLY = I1 + I2 + I3 + I4 + I5 + I6;
    const int it0 = (part == 2) ? NEARLY : 0, it1 = (part == 1) ? NEARLY : NIT;
    for (int it = it0 + gw; it < it1; it += NGW) {
        int r = it;
        if constexpr (I1 > 0) if (r < I1) { constexpr int NBB = (NPROJ_BF > 0) ? NPROJ_BF / 32 : 1; const int kb = r / NBB, nb = r % NBB; tr_item(a.w_in + (size_t)L * 1024 * 2824, 2824, 64 * kb, win_src(32 * nb), (bf16*)(ws + WS_WCAT), 1024, 32 * nb, scr, lane); continue; } r -= I1;
        if (r < I3) { const int n = r / 128, rr = r % 128, kb = rr / 32, nb = rr % 32; tr_item(a.w_branch + ((size_t)L * 4 + n) * 256 * 1024, 1024, 64 * kb, 32 * nb, (bf16*)(ws + WS_WBR), 256, n * 1024 + 32 * nb, scr, lane); continue; } r -= I3;
        if (r < I4) { const int kb = r / 32, nb = r % 32; tr_item(a.w_out + (size_t)L * 1024 * 1024, 1024, 64 * kb, 32 * nb, (bf16*)(ws + WS_WOUT), 1024, 32 * nb, scr, lane); continue; } r -= I4;
        if (r < I6) { const int kb = r / 32, nb = r % 32; tr_item(a.w_ple + (size_t)L * 256 * 1024, 1024, 64 * kb, 32 * nb, (bf16*)(ws + WS_WPLE), 256, 32 * nb, scr, lane); continue; } r -= I6;
        if (r < I7) { const int e = r / 1024, up = (r / 512) & 1, rr = r % 512, kb = rr / 32, nb = rr % 32;
            const float* W = (up ? a.w_exp_up : a.w_exp_gate) + ((size_t)L * NE + e) * 1024 * 1024;
            const int drow = e * 2048 + ((32 * nb) / 128) * 256 + up * 128 + ((32 * nb) % 128);
            tr_item8(W, 1024, 64 * kb, 32 * nb, (unsigned char*)(ws + WS_WGU), 1024, drow, 32.0f, scr, lane); continue; } r -= I7;
        { const int e = r / 512, rr = r % 512, kb = rr / 32, nb = rr % 32;
            tr_item8(a.w_exp_down + ((size_t)L * NE + e) * 1024 * 1024, 1024, 64 * kb, 32 * nb, (unsigned char*)(ws + WS_WDN), 1024, e * 1024 + 32 * nb, 32.0f, scr, lane); }
    }
    __syncthreads();
    for (int it = wgi; it < 160 + NPROJ_I8 / 32; it += nwg) {
        const bool late = (it >= 128 && it < 160);
        if ((part == 1 && late) || (part == 2 && !late)) continue;
        if (it < 128) gatew_item(a.w_branch_gate + (size_t)L * 1024 * 4096, 4096, 32 * it, it, (unsigned char*)(ws + WS_WCAT) + (size_t)NPROJ * 2048, (float*)(ws + WS_SW), lds, wave, lane, tid);
        else if (it < 160) gatew_item(a.w_ple_gate + (size_t)L * 1024 * 1024, 1024, 32 * (it - 128), it - 128, (unsigned char*)(ws + WS_WPG), (float*)(ws + WS_SW) + 4096, lds, wave, lane, tid);
        else gatew_item(a.w_in + (size_t)L * 1024 * 2824, 2824, win_src(NPROJ_BF + 32 * (it - 160)), it - 160, (unsigned char*)(ws + WS_WCAT) + (size_t)NPROJ_BF * 2048, (float*)(ws + WS_SW) + 5120, lds, wave, lane, tid); }
    if (part != 2) {
        const float* ps = a.p + (size_t)L * T * 256; bf16* pd = (bf16*)(ws + WS_PBF);
        for (int i = gtid; i < T * 256 / 8; i += GT) { const f32x4 v0 = ((const f32x4*)ps)[2 * i], v1 = ((const f32x4*)ps)[2 * i + 1];
            v4u o; o.x = pk2(v0[0], v0[1]); o.y = pk2(v0[2], v0[3]); o.z = pk2(v1[0], v1[1]); o.w = pk2(v1[2], v1[3]); ((v4u*)pd)[i] = o; }
        const float* ss = a.w_spatial + (size_t)L * 4 * 128 * 128; bf16* sd = (bf16*)(ws + WS_WSP);
        for (int i = gtid; i < 4 * 128 * 128 / 8; i += GT) { const f32x4 v0 = ((const f32x4*)ss)[2 * i], v1 = ((const f32x4*)ss)[2 * i + 1];
            v4u o; o.x = pk2(v0[0], v0[1]); o.y = pk2(v0[2], v0[3]); o.z = pk2(v1[0], v1[1]); o.w = pk2(v1[2], v1[3]); ((v4u*)sd)[i] = o; }
    }
    __syncthreads();
}
__device__ __forceinline__ void ph_r0(const P& a, int L, unsigned char* lds, int gw, int NGW, int lane, int tid) {
    unsigned char* ws = a.ws;
    LAS float* wdt = (LAS float*)lds;
    { const float* wi = a.w_in + (size_t)L * 1024 * 2824 + 1536;
      for (int i = tid; i < 1024 * 8; i += NTHR) { const int kq = i >> 3, e8 = i & 7, pos = ((kq >> 8) * 4 + (kq & 3)) * 64 + ((kq >> 2) & 63);
          wdt[((e8 >> 2) * 1024 + pos) * 4 + (e8 & 3)] = wi[(size_t)kq * 2824 + e8]; } }
    __syncthreads();
    const float* xin = a.x; bf16* XB = (bf16*)(ws + WS_XB); const bool l0 = (L == 0);
    const float* gm = a.g_mix + L * D; bf16* H = (bf16*)(ws + WS_H); float* DT = (float*)(ws + WS_DT);
    f32x4 gv[4];
#pragma unroll
    for (int j = 0; j < 4; ++j) gv[j] = ((const f32x4*)gm)[lane + 64 * j];
    const float bias_l = (((lane >> 3) & 7) < 4) ? a.dt_bias_f[L * 4 + ((lane >> 3) & 3)] : a.dt_bias_b[L * 4 + ((lane >> 3) & 3)];
    f32x4 nv[4]; v2u nb[4];
#pragma unroll
    for (int j = 0; j < 4; ++j) { nv[j] = (f32x4){0.f, 0.f, 0.f, 0.f}; nb[j] = (v2u){0u, 0u}; }
    if (gw < T) {
        if (l0) { const GAS f32x4* xr = (const GAS f32x4*)(xin + (size_t)gw * D) + lane;
#pragma unroll
            for (int j = 0; j < 4; ++j) nv[j] = xr[64 * j]; }
        else { const GAS v2u* xr = (const GAS v2u*)(XB + (size_t)gw * D) + lane;
#pragma unroll
            for (int j = 0; j < 4; ++j) nb[j] = xr[64 * j]; } }
    for (int m = gw; m < T; m += NGW) {
        asm volatile("" ::: "memory");
        f32x4 v[4]; float ss = 0.f;
        if (l0) { GAS v2u* xo = (GAS v2u*)(XB + (size_t)m * D) + lane;
#pragma unroll
            for (int j = 0; j < 4; ++j) { v[j] = nv[j]; xo[64 * j] = (v2u){pk2(v[j][0], v[j][1]), pk2(v[j][2], v[j][3])}; } }
        else {
#pragma unroll
            for (int j = 0; j < 4; ++j) v[j] = xb_unpack(nb[j]); }
        if (m + NGW < T) {
            if (l0) { const GAS f32x4* xr = (const GAS f32x4*)(xin + (size_t)(m + NGW) * D) + lane;
#pragma unroll
                for (int j = 0; j < 4; ++j) nv[j] = xr[64 * j]; }
            else { const GAS v2u* xr = (const GAS v2u*)(XB + (size_t)(m + NGW) * D) + lane;
#pragma unroll
                for (int j = 0; j < 4; ++j) nb[j] = xr[64 * j]; } }
#pragma unroll
        for (int j = 0; j < 4; ++j) { ss += (v[j][0] * v[j][0] + v[j][1] * v[j][1]) + (v[j][2] * v[j][2] + v[j][3] * v[j][3]); }
        const float rs = 1.0f / sqrtf(wave_sum(ss) * (1.0f / D) + EPS);
        float d8[8] = {0.f, 0.f, 0.f, 0.f, 0.f, 0.f, 0.f, 0.f};
        GAS unsigned long long* o8 = (GAS unsigned long long*)(H + (size_t)m * D) + lane; GAS unsigned* o4 = (GAS unsigned*)(ws + WS_H8 + (size_t)m * D) + lane;
        float amx = 0.f;
#pragma unroll
        for (int j = 0; j < 4; ++j) { v[j] = v[j] * rs * gv[j]; amx = fmaxf(fmaxf(amx, fmaxf(fabsf(v[j][0]), fabsf(v[j][1]))), fmaxf(fabsf(v[j][2]), fabsf(v[j][3]))); }
#pragma unroll
        for (int o = 1; o < 64; o <<= 1) amx = fmaxf(amx, __shfl_xor(amx, o));
        amx = fmaxf(amx, 1e-30f); const float qinv = 127.0f / amx;
        if (lane == 0) ((float*)(ws + WS_SA))[m] = amx * (1.0f / 127.0f);
#pragma unroll
        for (int j = 0; j < 4; ++j) {
            if constexpr (NPROJ_BF > 0) o8[64 * j] = (unsigned long long)pk2(v[j][0], v[j][1]) | ((unsigned long long)pk2(v[j][2], v[j][3]) << 32);
            { const int b0 = (int)rintf(qinv * v[j][0]), b1 = (int)rintf(qinv * v[j][1]), b2 = (int)rintf(qinv * v[j][2]), b3 = (int)rintf(qinv * v[j][3]);
              o4[64 * j] = (unsigned)(b0 & 0xff) | ((unsigned)(b1 & 0xff) << 8) | ((unsigned)(b2 & 0xff) << 16) | ((unsigned)(b3 & 0xff) << 24); }
#pragma unroll
            for (int c = 0; c < 4; ++c) { const LAS f32x4* wr = (const LAS f32x4*)wdt + (j * 4 + c) * 64 + lane; const f32x4 w0 = wr[0], w1 = wr[1024];
                d8[0] += v[j][c] * w0[0]; d8[1] += v[j][c] * w0[1]; d8[2] += v[j][c] * w0[2]; d8[3] += v[j][c] * w0[3];
                d8[4] += v[j][c] * w1[0]; d8[5] += v[j][c] * w1[1]; d8[6] += v[j][c] * w1[2]; d8[7] += v[j][c] * w1[3]; } }
        float c4[4], c2[2], c1;
        { const bool hb = (lane & 32) != 0;
#pragma unroll
          for (int i = 0; i < 4; ++i) { const float snd = hb ? d8[i] : d8[i + 4], kp = hb ? d8[i + 4] : d8[i]; c4[i] = kp + __shfl_xor(snd, 32); } }
        { const bool hb = (lane & 16) != 0;
#pragma unroll
          for (int i = 0; i < 2; ++i) { const float snd = hb ? c4[i] : c4[i + 2], kp = hb ? c4[i + 2] : c4[i]; c2[i] = kp + __shfl_xor(snd, 16); } }
        { const bool hb = (lane & 8) != 0; const float snd = hb ? c2[0] : c2[1], kp = hb ? c2[1] : c2[0]; c1 = kp + __shfl_xor(snd, 8); }
        c1 += __shfl_xor(c1, 4); c1 += __shfl_xor(c1, 2); c1 += __shfl_xor(c1, 1);
        if ((lane & 7) == 0) DT[(size_t)m * 8 + ((lane >> 3) & 7)] = softplus_f(c1 + bias_l);
    }
    __syncthreads();
}

__device__ __forceinline__ void ph_rope(const P& a, int L, unsigned char* ldsg, int gw, int NGW, int wave, int lane, int tid, int bx, bool dry) {
    bf16* PROJ = (bf16*)(a.ws + WS_PROJ);
    const int head = lane >> 3, j8 = lane & 7; const bool act = head < 6;
    const int hc = act ? head : 5;
    const float* gsrc = (hc < 4 ? a.g_qnorm : a.g_knorm) + L * 64 + j8 * 8;
    float g[8], fr[8];
#pragma unroll
    for (int i = 0; i < 8; ++i) { g[i] = gsrc[i]; fr[i] = __builtin_amdgcn_exp2f(-(float)(8 * (j8 & 1) + i) * (13.287712379549449f / 16.0f)) * 0.15915494309189535f; }
    const float osc = hc < 4 ? 0.125f * LOG2E : 1.0f;
    float kmx0 = 0.f, kmx1 = 0.f;
    float cmx0 = 0.f, cmx1 = 0.f;
    v4u nraw = (v4u){0u, 0u, 0u, 0u};
    if (gw < T) nraw = *(const v4u*)(PROJ + (size_t)gw * LDP + hc * 64 + j8 * 8);
    for (int m = gw; m < T; m += NGW) {
        const int s = m & (S - 1); const float pos = (float)((j8 & 4) ? (s & 63) : (s >> 6));
        bf16* ptr = PROJ + (size_t)m * LDP + hc * 64 + j8 * 8;
        const v4u raw = nraw;
        if (m + NGW < T) nraw = *(const v4u*)(PROJ + (size_t)(m + NGW) * LDP + hc * 64 + j8 * 8);
        float v[8]; v[0] = pg8::bf_lo(raw.x); v[1] = pg8::bf_hi(raw.x); v[2] = pg8::bf_lo(raw.y); v[3] = pg8::bf_hi(raw.y); v[4] = pg8::bf_lo(raw.z); v[5] = pg8::bf_hi(raw.z); v[6] = pg8::bf_lo(raw.w); v[7] = pg8::bf_hi(raw.w);
        float ss = 0.f;
#pragma unroll
        for (int i = 0; i < 8; ++i) ss += v[i] * v[i];
        ss += __shfl_xor(ss, 1); ss += __shfl_xor(ss, 2); ss += __shfl_xor(ss, 4);
        const float rn = 1.0f / sqrtf(ss * (1.0f / 64.0f) + EPS);
        float o[8];
#pragma unroll
        for (int i = 0; i < 8; ++i) { const float y = v[i] * rn * g[i]; const float pr = __shfl_xor(y, 2);
            const float rev = __builtin_amdgcn_fractf(pos * fr[i]); const float sn = __builtin_amdgcn_sinf(rev), cs = __builtin_amdgcn_cosf(rev);
            o[i] = ((j8 & 2) ? (pr * sn + y * cs) : (y * cs - pr * sn)) * osc; }
        v4u w; w.x = pk2(o[0], o[1]); w.y = pk2(o[2], o[3]); w.z = pk2(o[4], o[5]); w.w = pk2(o[6], o[7]);
        if (act && !dry) *(v4u*)ptr = w;
        float so = pg8::bf_lo(w.x) * pg8::bf_lo(w.x) + pg8::bf_hi(w.x) * pg8::bf_hi(w.x) + pg8::bf_lo(w.y) * pg8::bf_lo(w.y) + pg8::bf_hi(w.y) * pg8::bf_hi(w.y)
                 + pg8::bf_lo(w.z) * pg8::bf_lo(w.z) + pg8::bf_hi(w.z) * pg8::bf_hi(w.z) + pg8::bf_lo(w.w) * pg8::bf_lo(w.w) + pg8::bf_hi(w.w) * pg8::bf_hi(w.w);
        so += __shfl_xor(so, 1); so += __shfl_xor(so, 2); so += __shfl_xor(so, 4);
        if (m < S) kmx0 = fmaxf(kmx0, so); else kmx1 = fmaxf(kmx1, so);
        { const v2u cr = *(const v2u*)(PROJ + (size_t)m * LDP + PC_CK + lane * 4);
          float cs = pg8::bf_lo(cr.x) * pg8::bf_lo(cr.x) + pg8::bf_hi(cr.x) * pg8::bf_hi(cr.x) + pg8::bf_lo(cr.y) * pg8::bf_lo(cr.y) + pg8::bf_hi(cr.y) * pg8::bf_hi(cr.y);
          cs += __shfl_xor(cs, 1); cs += __shfl_xor(cs, 2); cs += __shfl_xor(cs, 4);
          if (m < S) cmx0 = fmaxf(cmx0, cs); else cmx1 = fmaxf(cmx1, cs); }
    }
    LAS float* red = (LAS float*)(LAS unsigned char*)ldsg;
    if (head >= 4 && head < 6 && j8 == 0) { red[wave * 24 + (head - 4)] = kmx0; red[wave * 24 + 2 + (head - 4)] = kmx1; }
    if ((lane & 7) == 0) { red[wave * 24 + 4 + (lane >> 3)] = cmx0; red[wave * 24 + 12 + (lane >> 3)] = cmx1; }
    __syncthreads();
    if (tid < 20) { float mx = 0.f;
#pragma unroll
        for (int w = 0; w < 8; ++w) mx = fmaxf(mx, red[w * 24 + tid]);
        ((float*)(a.ws + WS_KMAX))[bx * 32 + tid] = mx; }
    __syncthreads();
}
__device__ __forceinline__ float wave_incl_scan(float v, int lane) {
#pragma unroll
    for (int o = 1; o < 64; o <<= 1) { const float t = __shfl_up(v, o); if (lane >= o) v += t; }
    return v;
}
constexpr int LP = 136;
__device__ __forceinline__ void ssd1_unit(const P& a, int L, int u, unsigned char* ldsg, int wave, int lane, int tid) {
    LAS unsigned char* lds = (LAS unsigned char*)ldsg;
    LAS bf16* XW = (LAS bf16*)lds;
    LAS bf16* BT = (LAS bf16*)(lds + 69632);
    LAS f32x4* TABL = (LAS f32x4*)(lds + 104448);
    LAS float* WV = (LAS float*)(lds + 108544);
    LAS float* DTL = (LAS float*)(lds + 110592);
    const int g = u & 1, c = (u >> 1) & 127, b = u >> 8;
    const size_t t0 = (size_t)b * S + c * 128; const int s0 = c * 128;
    const bf16* PROJ = (const bf16*)(a.ws + WS_PROJ); bf16* XBC = (bf16*)(a.ws + WS_XBC);
    if (tid < 256) ((LAS f32x4*)DTL)[tid] = ((const f32x4*)((const float*)(a.ws + WS_DT) + t0 * 8))[tid];
    __syncthreads();
    if (wave < 4) {
        const int hl = wave >> 1, dir = wave & 1, h = 2 * g + hl;
        const float av = -__expf((dir ? a.a_log_b : a.a_log_f)[L * 4 + h]);
        const float d0 = DTL[(2 * lane) * 8 + dir * 4 + h], d1 = DTL[(2 * lane + 1) * 8 + dir * 4 + h];
        const float e0 = d0 * av, e1 = d1 * av, sm = e0 + e1;
        const float incl = wave_incl_scan(sm, lane), excl = incl - sm, tot = __shfl(incl, 63);
        const float P0 = excl + e0, P1 = incl;
        LAS float* tl0 = (LAS float*)&TABL[hl * 128 + 2 * lane]; LAS float* tl1 = (LAS float*)&TABL[hl * 128 + 2 * lane + 1];
        if (dir == 0) { tl0[0] = P0; tl1[0] = P1; tl0[2] = d0; tl1[2] = d1;
            WV[wave * 128 + 2 * lane] = d0 * __expf(tot - P0); WV[wave * 128 + 2 * lane + 1] = d1 * __expf(tot - P1); }
        else { tl0[1] = tot - P0 + e0; tl1[1] = tot - P1 + e1; tl0[3] = d0; tl1[3] = d1;
            WV[wave * 128 + 2 * lane] = d0 * __expf(P0 - e0); WV[wave * 128 + 2 * lane + 1] = d1 * __expf(P1 - e1); }
        if (lane == 0) ((float*)(a.ws + WS_CD))[(((size_t)b * 128 + c) * 4 + h) * 2 + dir] = __expf(tot);
    }
    __syncthreads();
    if (tid < 256) ((f32x4*)(a.ws + WS_TAB))[(((size_t)b * 128 + c) * 4 + 2 * g) * 128 + tid] = TABL[tid];
    const int cg = tid & 15, seg = tid >> 4, l0 = 4 * seg;
#pragma unroll 1
    for (int pass = 0; pass < 3; ++pass) {
        const int ch0 = pass * 256 + g * 128 + cg * 8;
        const float* cw = a.conv_w + (size_t)L * 5 * 768 + ch0; const float* cb = a.conv_b + (size_t)L * 768 + ch0;
        float w[5][8], bs[8];
#pragma unroll
        for (int j = 0; j < 5; ++j) { const f32x4 w0 = *(const f32x4*)(cw + j * 768), w1 = *(const f32x4*)(cw + j * 768 + 4);
            w[j][0] = w0[0]; w[j][1] = w0[1]; w[j][2] = w0[2]; w[j][3] = w0[3]; w[j][4] = w1[0]; w[j][5] = w1[1]; w[j][6] = w1[2]; w[j][7] = w1[3]; }
        { const f32x4 b0 = *(const f32x4*)cb, b1 = *(const f32x4*)(cb + 4); bs[0] = b0[0]; bs[1] = b0[1]; bs[2] = b0[2]; bs[3] = b0[3]; bs[4] = b1[0]; bs[5] = b1[1]; bs[6] = b1[2]; bs[7] = b1[3]; }
        float acc[4][8];
#pragma unroll
        for (int tk = 0; tk < 4; ++tk)
#pragma unroll
            for (int i = 0; i < 8; ++i) acc[tk][i] = bs[i];
#pragma unroll
        for (int rr = 0; rr < 8; ++rr) {
            const int pos = s0 + l0 - 2 + rr; v4u raw = (v4u){0u, 0u, 0u, 0u};
            if (pos >= 0 && pos < S) raw = *(const v4u*)(PROJ + ((size_t)b * S + pos) * LDP + PC_XS + ch0);
            float in[8]; in[0] = pg8::bf_lo(raw.x); in[1] = pg8::bf_hi(raw.x); in[2] = pg8::bf_lo(raw.y); in[3] = pg8::bf_hi(raw.y); in[4] = pg8::bf_lo(raw.z); in[5] = pg8::bf_hi(raw.z); in[6] = pg8::bf_lo(raw.w); in[7] = pg8::bf_hi(raw.w);
#pragma unroll
            for (int tk = 0; tk < 4; ++tk) { const int j = rr - tk; if (j >= 0 && j < 5) {
#pragma unroll
                for (int i = 0; i < 8; ++i) acc[tk][i] += w[j][i] * in[i]; } }
        }
#pragma unroll
        for (int tk = 0; tk < 4; ++tk) {
#pragma unroll
            for (int i = 0; i < 8; ++i) acc[tk][i] = silu_f(acc[tk][i]);
            v4u o; o.x = pk2(acc[tk][0], acc[tk][1]); o.y = pk2(acc[tk][2], acc[tk][3]); o.z = pk2(acc[tk][4], acc[tk][5]); o.w = pk2(acc[tk][6], acc[tk][7]);
            *(v4u*)(XBC + (t0 + l0 + tk) * 768 + ch0) = o; }
        if (pass == 0) {
            const int hl = cg >> 3, p0 = (cg & 7) * 8;
#pragma unroll
            for (int dir = 0; dir < 2; ++dir) { const int hd = hl * 2 + dir; const f32x4 wv = *(const LAS f32x4*)(WV + hd * 128 + l0);
#pragma unroll
                for (int i = 0; i < 8; ++i) { v2u o; o.x = pk2(acc[0][i] * wv[0], acc[1][i] * wv[1]); o.y = pk2(acc[2][i] * wv[2], acc[3][i] * wv[3]);
                    *(LAS v2u*)(XW + (hd * 64 + p0 + i) * LP + l0) = o; } }
        } else if (pass == 1) {
#pragma unroll
            for (int i = 0; i < 8; ++i) { v2u o; o.x = pk2(acc[0][i], acc[1][i]); o.y = pk2(acc[2][i], acc[3][i]); *(LAS v2u*)(BT + (cg * 8 + i) * LP + l0) = o; }
        }
    }
    __syncthreads();
    {
        const int hd = wave >> 1, ph = wave & 1, fr = lane & 15, fq = lane >> 4;
        f32x4 acc[2][8];
#pragma unroll
        for (int mt = 0; mt < 2; ++mt)
#pragma unroll
            for (int nt = 0; nt < 8; ++nt) acc[mt][nt] = (f32x4){0.f, 0.f, 0.f, 0.f};
#pragma unroll
        for (int ks = 0; ks < 4; ++ks) {
            bf16x8 af[2];
#pragma unroll
            for (int mt = 0; mt < 2; ++mt) af[mt] = *(const LAS bf16x8*)(XW + (hd * 64 + ph * 32 + mt * 16 + fr) * LP + 32 * ks + 8 * fq);
#pragma unroll
            for (int nt = 0; nt < 8; ++nt) { const bf16x8 bfr = *(const LAS bf16x8*)(BT + (16 * nt + fr) * LP + 32 * ks + 8 * fq);
#pragma unroll
                for (int mt = 0; mt < 2; ++mt) acc[mt][nt] = mfma16(af[mt], bfr, acc[mt][nt]); }
        }
        const int hl = hd >> 1, dir = hd & 1, h = 2 * g + hl;
        bf16* ST = (bf16*)(a.ws + WS_ST) + ((((size_t)b * 128 + c) * 4 + h) * 2 + dir) * 8192;
#pragma unroll
        for (int mt = 0; mt < 2; ++mt)
#pragma unroll
            for (int nt = 0; nt < 8; ++nt)
#pragma unroll
                for (int ii = 0; ii < 4; ++ii) ST[(ph * 32 + mt * 16 + 4 * fq + ii) * 128 + 16 * nt + fr] = (bf16)f2bf(acc[mt][nt][ii]);
    }
    __syncthreads();
}

__device__ __forceinline__ void ph_scan(const P& a, int gtid, int GT) {
    const unsigned* ST2 = (const unsigned*)(a.ws + WS_ST); unsigned* SB2 = (unsigned*)(a.ws + WS_SB); const float* CD = (const float*)(a.ws + WS_CD);
    for (int e2 = gtid; e2 < NB * 4 * 2 * 8192 / 2; e2 += GT) {
        const int e = 2 * e2, b = e >> 16, rem = e & 65535, dir = (rem >> 13) & 1, h = rem >> 14;
        float s0 = 0.f, s1 = 0.f;
#pragma unroll 1
        for (int c8 = 0; c8 < 128; c8 += 8) {
            unsigned cs[8]; float cd[8];
#pragma unroll
            for (int k = 0; k < 8; ++k) { const int c = dir ? 127 - (c8 + k) : (c8 + k); cs[k] = ST2[(((size_t)b * 128 + c) * 65536 + rem) >> 1]; cd[k] = CD[(((size_t)b * 128 + c) * 4 + h) * 2 + dir]; }
#pragma unroll
            for (int k = 0; k < 8; ++k) { const int c = dir ? 127 - (c8 + k) : (c8 + k); SB2[(((size_t)b * 128 + c) * 65536 + rem) >> 1] = pk2(s0, s1);
                s0 = s0 * cd[k] + __builtin_bit_cast(float, cs[k] << 16); s1 = s1 * cd[k] + __builtin_bit_cast(float, cs[k] & 0xffff0000u); }
        }
    }
}

__device__ __forceinline__ void ssd3_unit(const P& a, int L, int u, unsigned char* ldsg, int wave, int lane, int tid) {
    LAS unsigned char* lds = (LAS unsigned char*)ldsg;
    LAS bf16* CG = (LAS bf16*)lds;
    LAS bf16* BG = (LAS bf16*)(lds + 34816);
    LAS bf16* XT = (LAS bf16*)(lds + 69632);
    LAS f32x4* TB = (LAS f32x4*)(lds + 104448);
    const int g = u & 1, c = (u >> 1) & 127, b = u >> 8; const size_t t0 = (size_t)b * S + c * 128;
    const bf16* XBC = (const bf16*)(a.ws + WS_XBC); const bf16* SB = (const bf16*)(a.ws + WS_SB); const bf16* PROJ = (const bf16*)(a.ws + WS_PROJ);
    const int fr = lane & 15, fq = lane >> 4, w = wave;
#pragma unroll
    for (int i = 0; i < 4; ++i) { const int q = tid + 512 * i, row = q >> 4, pc = q & 15;
        const bf16* src = XBC + (t0 + row) * 768 + g * 128 + pc * 8;
        *(LAS v4u*)(CG + row * LP + pc * 8) = *(const v4u*)(src + 512);
        *(LAS v4u*)(BG + row * LP + pc * 8) = *(const v4u*)(src + 256);
        const v4u xr = *(const v4u*)src; const int hl = pc >> 3, p = (pc & 7) * 8;
        LAS bf16* xd = XT + (hl * 64 + p) * LP + row;
        xd[0 * LP] = (bf16)(xr.x & 0xffffu); xd[1 * LP] = (bf16)(xr.x >> 16); xd[2 * LP] = (bf16)(xr.y & 0xffffu); xd[3 * LP] = (bf16)(xr.y >> 16);
        xd[4 * LP] = (bf16)(xr.z & 0xffffu); xd[5 * LP] = (bf16)(xr.z >> 16); xd[6 * LP] = (bf16)(xr.w & 0xffffu); xd[7 * LP] = (bf16)(xr.w >> 16); }
    if (tid < 256) TB[tid] = ((const f32x4*)(a.ws + WS_TAB))[(((size_t)b * 128 + c) * 4 + 2 * g) * 128 + tid];
    __syncthreads();
    bf16x8 cf[4];
#pragma unroll
    for (int ks = 0; ks < 4; ++ks) cf[ks] = *(const LAS bf16x8*)(CG + (16 * w + fr) * LP + 32 * ks + 8 * fq);
    f32x4 Gt[8];
#pragma unroll
    for (int j = 0; j < 8; ++j) { Gt[j] = (f32x4){0.f, 0.f, 0.f, 0.f};
#pragma unroll
        for (int ks = 0; ks < 4; ++ks) Gt[j] = mfma16(*(const LAS bf16x8*)(BG + (16 * j + fr) * LP + 32 * ks + 8 * fq), cf[ks], Gt[j]); }
    __syncthreads();
    LAS bf16* ZS = CG; LAS bf16* SS = BG;
#pragma unroll
    for (int i = 0; i < 4; ++i) { const int q = tid + 512 * i, row = q >> 4, pc = q & 15;
        *(LAS v4u*)(ZS + row * LP + pc * 8) = *(const v4u*)(PROJ + (t0 + row) * LDP + PC_Z + g * 128 + pc * 8); }
    float* SSQ = (float*)(a.ws + WS_SSQ);
    const int lrow = 16 * w + fr;
#pragma unroll 1
    for (int hl = 0; hl < 2; ++hl) {
        const int h = 2 * g + hl;
        if (hl) __syncthreads();
        { const bf16* Sp = SB + (((size_t)b * 128 + c) * 4 + h) * 2 * 8192;
#pragma unroll
          for (int i = 0; i < 4; ++i) { const int q = tid + 512 * i, row = q >> 4, pc = q & 15;
              *(LAS v4u*)(SS + row * LP + pc * 8) = *(const v4u*)(Sp + (size_t)row * 128 + pc * 8); } }
        __syncthreads();
        f32x4 Y[4];
#pragma unroll
        for (int pt = 0; pt < 4; ++pt) Y[pt] = (f32x4){0.f, 0.f, 0.f, 0.f};
        {
            const f32x4 tl = TB[hl * 128 + lrow];
            bf16x8 wf[4];
#pragma unroll
            for (int ks = 0; ks < 4; ++ks) { float wv[8];
#pragma unroll
                for (int hf = 0; hf < 2; ++hf)
#pragma unroll
                    for (int ii = 0; ii < 4; ++ii) { const int j = 2 * ks + hf, s = 16 * j + 4 * fq + ii; const f32x4 ts = TB[hl * 128 + s];
                        const float mf = ts[2] * __expf(fminf(tl[0] - ts[0], 0.f)), mb = ts[3] * __expf(fminf(tl[1] - ts[1], 0.f));
                        const float mm = (s < lrow) ? mf : (s > lrow) ? mb : (ts[2] + ts[3]);
                        wv[hf * 4 + ii] = Gt[j][ii] * mm; }
                v4u pk; pk.x = pk2(wv[0], wv[1]); pk.y = pk2(wv[2], wv[3]); pk.z = pk2(wv[4], wv[5]); pk.w = pk2(wv[6], wv[7]); wf[ks] = __builtin_bit_cast(bf16x8, pk); }
#pragma unroll
            for (int pt = 0; pt < 4; ++pt)
#pragma unroll
                for (int ks = 0; ks < 4; ++ks) { const LAS bf16* xp = XT + (hl * 64 + 16 * pt + fr) * LP + 32 * ks + 4 * fq;
                    const v2u x0 = *(const LAS v2u*)xp, x1 = *(const LAS v2u*)(xp + 16); const v4u xx = (v4u){x0.x, x0.y, x1.x, x1.y};
                    Y[pt] = mfma16(wf[ks], __builtin_bit_cast(bf16x8, xx), Y[pt]); }
        }
#pragma unroll
        for (int dir = 0; dir < 2; ++dir) {
            f32x4 Tt[4];
#pragma unroll
            for (int pt = 0; pt < 4; ++pt) { Tt[pt] = (f32x4){0.f, 0.f, 0.f, 0.f};
#pragma unroll
                for (int ks = 0; ks < 4; ++ks) Tt[pt] = mfma16(cf[ks], *(const LAS bf16x8*)(SS + (dir * 64 + 16 * pt + fr) * LP + 32 * ks + 8 * fq), Tt[pt]); }
#pragma unroll
            for (int ii = 0; ii < 4; ++ii) { const f32x4 tr = TB[hl * 128 + 16 * w + 4 * fq + ii]; const float e = __expf(dir ? tr[1] : tr[0]);
#pragma unroll
                for (int pt = 0; pt < 4; ++pt) Y[pt][ii] += e * Tt[pt][ii]; }
        }
        const float dsk = a.d_skip[L * 4 + h];
#pragma unroll
        for (int pt = 0; pt < 4; ++pt) { const v2u xv = *(const LAS v2u*)(XT + (hl * 64 + 16 * pt + fr) * LP + 16 * w + 4 * fq);
            Y[pt][0] += dsk * pg8::bf_lo(xv.x); Y[pt][1] += dsk * pg8::bf_hi(xv.x); Y[pt][2] += dsk * pg8::bf_lo(xv.y); Y[pt][3] += dsk * pg8::bf_hi(xv.y); }
        float ss[4] = {0.f, 0.f, 0.f, 0.f};
#pragma unroll
        for (int pt = 0; pt < 4; ++pt) { const int chl = hl * 64 + 16 * pt + fr; const float gn = a.g_ssm[L * 256 + g * 128 + chl];
#pragma unroll
            for (int ii = 0; ii < 4; ++ii) { LAS bf16* zp = ZS + (16 * w + 4 * fq + ii) * LP + chl;
                const float z = bf2f(*zp); const float y = Y[pt][ii] * silu_f(z); ss[ii] += y * y; *zp = (bf16)f2bf(y * gn); } }
#pragma unroll
        for (int ii = 0; ii < 4; ++ii) { float sq = ss[ii]; sq += __shfl_xor(sq, 1); sq += __shfl_xor(sq, 2); sq += __shfl_xor(sq, 4); sq += __shfl_xor(sq, 8);
            if (fr == 0) SSQ[(t0 + 16 * w + 4 * fq + ii) * 4 + h] = sq; }
    }
    __syncthreads();
    bf16* BR = (bf16*)(a.ws + WS_BR);
#pragma unroll
    for (int i = 0; i < 4; ++i) { const int q = tid + 512 * i, row = q >> 4, pc = q & 15;
        *(v4u*)(BR + (t0 + row) * 1024 + 256 + g * 128 + pc * 8) = *(const LAS v4u*)(ZS + row * LP + pc * 8); }
    __syncthreads();
}

__device__ __forceinline__ void sgu_unit(const P& a, int L, int u, unsigned char* ldsg, int wave, int lane, int tid) {
    LAS bf16* VT = (LAS bf16*)(LAS unsigned char*)ldsg;
    const int b = u >> 7, c = u & 127; const size_t t0 = (size_t)b * S + c * 128;
    const bf16* PROJ = (const bf16*)(a.ws + WS_PROJ); bf16* BR = (bf16*)(a.ws + WS_BR); const bf16* WSP = (const bf16*)(a.ws + WS_WSP);
    const f32x4 gs = *(const f32x4*)(a.g_sgu + L * 256 + 4 * lane);
#pragma unroll 1
    for (int k = 0; k < 16; ++k) { const int s = 16 * wave + k;
        const v2u raw = *(const v2u*)(PROJ + (t0 + s) * LDP + PC_UV + 256 + 4 * lane);
        float v[4]; v[0] = gelu_tanh(pg8::bf_lo(raw.x)); v[1] = gelu_tanh(pg8::bf_hi(raw.x)); v[2] = gelu_tanh(pg8::bf_lo(raw.y)); v[3] = gelu_tanh(pg8::bf_hi(raw.y));
        const float rn = 1.0f / sqrtf(wave_sum(v[0] * v[0] + v[1] * v[1] + v[2] * v[2] + v[3] * v[3]) * (1.0f / 256.0f) + EPS);
#pragma unroll
        for (int i = 0; i < 4; ++i) VT[(4 * lane + i) * LP + s] = (bf16)f2bf(v[i] * rn * gs[i]); }
    __syncthreads();
    const int g = wave >> 1, th = wave & 1, fr = lane & 15, fq = lane >> 4;
    f32x4 acc[4][4];
#pragma unroll
    for (int mt = 0; mt < 4; ++mt)
#pragma unroll
        for (int nt = 0; nt < 4; ++nt) acc[mt][nt] = (f32x4){0.f, 0.f, 0.f, 0.f};
#pragma unroll
    for (int ks = 0; ks < 4; ++ks) {
        bf16x8 af[4];
#pragma unroll
        for (int mt = 0; mt < 4; ++mt) af[mt] = *(const bf16x8*)(WSP + (size_t)(g * 128 + 64 * th + 16 * mt + fr) * 128 + 32 * ks + 8 * fq);
#pragma unroll
        for (int nt = 0; nt < 4; ++nt) { const bf16x8 bfr = *(const LAS bf16x8*)(VT + (g * 64 + 16 * nt + fr) * LP + 32 * ks + 8 * fq);
#pragma unroll
            for (int mt = 0; mt < 4; ++mt) acc[mt][nt] = mfma16(af[mt], bfr, acc[mt][nt]); }
    }
#pragma unroll
    for (int mt = 0; mt < 4; ++mt)
#pragma unroll
        for (int ii = 0; ii < 4; ++ii) { const int tl = 64 * th + 16 * mt + 4 * fq + ii; const float bsv = a.b_spatial[(L * 4 + g) * 128 + tl];
#pragma unroll
            for (int nt = 0; nt < 4; ++nt) { const int ch = g * 64 + 16 * nt + fr;
                const float uu = gelu_tanh(bf2f(PROJ[(t0 + tl) * LDP + PC_UV + ch]));
                BR[(t0 + tl) * 1024 + 768 + ch] = (bf16)f2bf(uu * (acc[mt][nt][ii] + bsv)); } }
    __syncthreads();
}
__device__ __forceinline__ void ph_r1(const P& a, int L, unsigned char* ldsg, int gw, int NGW, int lane, int tid) {
    LAS float* wrt = (LAS float*)(LAS unsigned char*)ldsg;
    { const float* wr = a.w_router + (size_t)L * 1024 * 16;
      for (int i = tid; i < 1024 * 16 / 4; i += NTHR) { const int kq = i >> 2, q = i & 3, pos = ((kq >> 8) * 4 + (kq & 3)) * 64 + ((kq >> 2) & 63); ((LAS f32x4*)wrt)[q * 1024 + pos] = ((const f32x4*)wr)[i]; } }
    __syncthreads();
    const float* gm = a.g_moe + L * D; bf16* H = (bf16*)(a.ws + WS_H); float* AFF = (float*)(a.ws + WS_AFF); short* INV = (short*)(a.ws + WS_INV);
    f32x4 gv[4];
#pragma unroll
    for (int j = 0; j < 4; ++j) gv[j] = ((const f32x4*)gm)[lane + 64 * j];
    const bf16* XB = (const bf16*)(a.ws + WS_XB);
    v2u nv[4];
    if (gw < T) { const GAS v2u* xr = (const GAS v2u*)(XB + (size_t)gw * D) + lane;
#pragma unroll
        for (int j = 0; j < 4; ++j) nv[j] = xr[64 * j]; }
    for (int m = gw; m < T; m += NGW) {
        asm volatile("" ::: "memory");
        f32x4 v[4]; float ss = 0.f;
#pragma unroll
        for (int j = 0; j < 4; ++j) v[j] = xb_unpack(nv[j]);
        if (m + NGW < T) { const GAS v2u* xr = (const GAS v2u*)(XB + (size_t)(m + NGW) * D) + lane;
#pragma unroll
            for (int j = 0; j < 4; ++j) nv[j] = xr[64 * j]; }
#pragma unroll
        for (int j = 0; j < 4; ++j) { ss += (v[j][0] * v[j][0] + v[j][1] * v[j][1]) + (v[j][2] * v[j][2] + v[j][3] * v[j][3]); }
        const float rs = 1.0f / sqrtf(wave_sum(ss) * (1.0f / D) + EPS);
        float lg[16];
#pragma unroll
        for (int i = 0; i < 16; ++i) lg[i] = 0.f;
        GAS unsigned* o4 = (GAS unsigned*)((unsigned char*)H + (size_t)m * D) + lane;
#pragma unroll
        for (int j = 0; j < 4; ++j) { v[j] = v[j] * rs * gv[j];
            { int t = 0; t = __builtin_amdgcn_cvt_pk_fp8_f32(v[j][0], v[j][1], t, false); t = __builtin_amdgcn_cvt_pk_fp8_f32(v[j][2], v[j][3], t, true); o4[64 * j] = (unsigned)t; }
#pragma unroll
            for (int c = 0; c < 4; ++c) { const LAS f32x4* wr = (const LAS f32x4*)wrt + (j * 4 + c) * 64 + lane;
#pragma unroll
                for (int q = 0; q < 4; ++q) { const f32x4 w4 = wr[q * 1024]; lg[4 * q] += v[j][c] * w4[0]; lg[4 * q + 1] += v[j][c] * w4[1]; lg[4 * q + 2] += v[j][c] * w4[2]; lg[4 * q + 3] += v[j][c] * w4[3]; } } }
        float a8[8], a4[4], a2[2], a1;
        { const bool hb = (lane & 32) != 0;
#pragma unroll
          for (int i = 0; i < 8; ++i) { const float snd = hb ? lg[i] : lg[i + 8], kp = hb ? lg[i + 8] : lg[i]; a8[i] = kp + __shfl_xor(snd, 32); } }
        { const bool hb = (lane & 16) != 0;
#pragma unroll
          for (int i = 0; i < 4; ++i) { const float snd = hb ? a8[i] : a8[i + 4], kp = hb ? a8[i + 4] : a8[i]; a4[i] = kp + __shfl_xor(snd, 16); } }
        { const bool hb = (lane & 8) != 0;
#pragma unroll
          for (int i = 0; i < 2; ++i) { const float snd = hb ? a4[i] : a4[i + 2], kp = hb ? a4[i + 2] : a4[i]; a2[i] = kp + __shfl_xor(snd, 8); } }
        { const bool hb = (lane & 4) != 0; const float snd = hb ? a2[0] : a2[1], kp = hb ? a2[1] : a2[0]; a1 = kp + __shfl_xor(snd, 4); }
        a1 += __shfl_xor(a1, 2); a1 += __shfl_xor(a1, 1);
        float mx = a1; mx = fmaxf(mx, __shfl_xor(mx, 4)); mx = fmaxf(mx, __shfl_xor(mx, 8)); mx = fmaxf(mx, __shfl_xor(mx, 16)); mx = fmaxf(mx, __shfl_xor(mx, 32));
        const float ex = __expf(a1 - mx); float sum = ex; sum += __shfl_xor(sum, 4); sum += __shfl_xor(sum, 8); sum += __shfl_xor(sum, 16); sum += __shfl_xor(sum, 32);
        const int b = m / S, s = m % S;
        if ((lane & 3) == 0) AFF[((size_t)b * NE + ((lane >> 2) & 15)) * S + s] = ex / sum;
        if (lane < 2) { unsigned m1 = 0xffffffffu; asm volatile("" : "+v"(m1)); ((GAS v4u*)(INV + (size_t)m * NE))[lane] = (v4u){m1, m1, m1, m1}; }
    }
    __syncthreads();
}

__device__ __forceinline__ void sel_unit(const P& a, int q, unsigned char* ldsg, int wave, int lane, int tid) {
    LAS unsigned* vals = (LAS unsigned*)(LAS unsigned char*)ldsg;
    LAS unsigned* hist = vals + S;
    LAS unsigned* sc = hist + 256;
    const int b = q / NE, e = q % NE;
    const float* AFF = (const float*)(a.ws + WS_AFF) + ((size_t)b * NE + e) * S;
    for (int i = tid; i < S; i += NTHR) vals[i] = __float_as_uint(AFF[i]);
    unsigned prefix = 0u, mask = 0u, kk = CAP;
#pragma unroll 1
    for (int pass = 0; pass < 4; ++pass) {
        const int shift = 24 - 8 * pass;
        if (tid < 256) hist[tid] = 0u;
        __syncthreads();
        for (int i = tid; i < S; i += NTHR) { const unsigned v = vals[i]; if ((v & mask) == prefix) __hip_atomic_fetch_add(&hist[(v >> shift) & 255u], 1u, __ATOMIC_RELAXED, __HIP_MEMORY_SCOPE_WORKGROUP); }
        __syncthreads();
        if (wave == 0) {
            unsigned c4[4]; unsigned s4 = 0u;
#pragma unroll
            for (int j = 0; j < 4; ++j) { c4[j] = hist[4 * lane + j]; s4 += c4[j]; }
            unsigned suf = s4;
#pragma unroll
            for (int o = 1; o < 64; o <<= 1) { const unsigned t = __shfl_down(suf, o); if (lane + o < 64) suf += t; }
            unsigned cum = suf - s4;
#pragma unroll
            for (int j = 3; j >= 0; --j) { if (cum < kk && cum + c4[j] >= kk) { sc[0] = prefix | ((unsigned)(4 * lane + j) << shift); sc[1] = kk - cum; } cum += c4[j]; }
        }
        __syncthreads();
        prefix = sc[0]; kk = sc[1]; mask |= 255u << shift;
        __syncthreads();
    }
    const unsigned thr = prefix, need_eq = kk, total_gt = CAP - kk;
    unsigned cg = 0u, ce = 0u;
    for (int j = 0; j < 32; ++j) { const unsigned v = vals[32 * tid + ((j + tid) & 31)]; cg += (v > thr) ? 1u : 0u; ce += (v == thr) ? 1u : 0u; }
    unsigned pk = (cg << 16) | ce, inc = pk;
#pragma unroll
    for (int o = 1; o < 64; o <<= 1) { const unsigned t = __shfl_up(inc, o); if (lane >= o) inc += t; }
    if (lane == 63) sc[8 + wave] = inc;
    __syncthreads();
    unsigned base = 0u;
    for (int w2 = 0; w2 < wave; ++w2) base += sc[8 + w2];
    const unsigned exc = base + inc - pk; unsigned pg = exc >> 16, pe = exc & 0xffffu;
    int* SELIDX = (int*)(a.ws + WS_SELIDX) + (size_t)e * (NB * CAP) + b * CAP; float* SELAFF = (float*)(a.ws + WS_SELAFF) + (size_t)e * (NB * CAP) + b * CAP;
    short* INV = (short*)(a.ws + WS_INV);
    for (int j = 0; j < 32; ++j) { const int idx = 32 * tid + j; const unsigned v = vals[idx]; int slot = -1;
        if (v > thr) { slot = (int)pg; ++pg; } else if (v == thr) { if (pe < need_eq) slot = (int)(total_gt + pe); ++pe; }
        if (slot >= 0) { SELIDX[slot] = idx; SELAFF[slot] = __uint_as_float(v); INV[((size_t)b * S + idx) * NE + e] = (short)slot; } }
    __syncthreads();
}

__device__ __forceinline__ void ph_gather(const P& a, int gw, int NGW, int lane) {
    const int* SELIDX = (const int*)(a.ws + WS_SELIDX); const bf16* H = (const bf16*)(a.ws + WS_H); bf16* XE = (bf16*)(a.ws + WS_XE);
    for (int r = gw; r < NE * NB * CAP; r += NGW) { const int b = (r >> 11) & 1; const int tok = SELIDX[r];
        const v4u* src = (const v4u*)(H + ((size_t)b * S + tok) * D); v4u* dst = (v4u*)(XE + (size_t)r * D);
        const v4u v0 = src[lane], v1 = src[lane + 64]; dst[lane] = v0; dst[lane + 64] = v1; }
}

__device__ __forceinline__ void ph_r2(const P& a, int L, int gw, int NGW, int lane, bool dry) {
    const float* gm = a.g_ple + L * D; bf16* H = (bf16*)(a.ws + WS_H); const short* INV = (const short*)(a.ws + WS_INV); const unsigned char* YE = (const unsigned char*)(a.ws + WS_YE); const float* SAFF = (const float*)(a.ws + WS_SELAFF);
    f32x4 gv[4];
#pragma unroll
    for (int j = 0; j < 4; ++j) gv[j] = ((const f32x4*)gm)[lane + 64 * j];
    bf16* XB = (bf16*)(a.ws + WS_XB);
    v2u nv[4]; short ninv = -1;
    if (gw < T) { const GAS v2u* xq = (const GAS v2u*)(XB + (size_t)gw * D) + lane;
#pragma unroll
        for (int j = 0; j < 4; ++j) nv[j] = xq[64 * j];
        ninv = INV[(size_t)gw * NE + (lane & 15)]; }
    for (int m = gw; m < T; m += NGW) {
        GAS v2u* xr = (GAS v2u*)(XB + (size_t)m * D) + lane;
        f32x4 v[4];
#pragma unroll
        for (int j = 0; j < 4; ++j) v[j] = xb_unpack(nv[j]);
        const int b = m / S;
        const short myinv = ninv;
        if (m + NGW < T) { const GAS v2u* xq = (const GAS v2u*)(XB + (size_t)(m + NGW) * D) + lane;
#pragma unroll
            for (int j = 0; j < 4; ++j) nv[j] = xq[64 * j];
            ninv = INV[(size_t)(m + NGW) * NE + (lane & 15)]; }
        unsigned em = (unsigned)__builtin_amdgcn_readfirstlane((int)(__ballot(myinv >= 0) & 0xffffull));
#pragma unroll 1
        while (em) {
            unsigned y[4][4]; int ee[4]; float af[4] = {0.f, 0.f, 0.f, 0.f};
#pragma unroll
            for (int q = 0; q < 4; ++q) { ee[q] = em ? (int)__builtin_ctz(em) : -1; if (em) em &= em - 1u;
                if (ee[q] >= 0) { const int slot = __builtin_amdgcn_readfirstlane((int)__shfl((int)myinv, ee[q]));
                    af[q] = 0.25f * SAFF[(size_t)ee[q] * (NB * CAP) + b * CAP + slot];
                    const unsigned* yr = (const unsigned*)(YE + ((size_t)ee[q] * (NB * CAP) + b * CAP + slot) * D) + lane;
#pragma unroll
                    for (int j = 0; j < 4; ++j) y[q][j] = yr[64 * j]; } }
#pragma unroll
            for (int q = 0; q < 4; ++q) if (ee[q] >= 0) {
#pragma unroll
                for (int j = 0; j < 4; ++j) { typedef float f32x2r __attribute__((ext_vector_type(2)));
                    const f32x2r lo = __builtin_amdgcn_cvt_pk_f32_fp8((int)y[q][j], false), hi = __builtin_amdgcn_cvt_pk_f32_fp8((int)y[q][j], true);
                    v[j][0] += af[q] * lo[0]; v[j][1] += af[q] * lo[1]; v[j][2] += af[q] * hi[0]; v[j][3] += af[q] * hi[1]; } }
        }
        float ss = 0.f;
#pragma unroll
        for (int j = 0; j < 4; ++j) { if (!dry) xr[64 * j] = (v2u){pk2(v[j][0], v[j][1]), pk2(v[j][2], v[j][3])}; ss += (v[j][0] * v[j][0] + v[j][1] * v[j][1]) + (v[j][2] * v[j][2] + v[j][3] * v[j][3]); }
        const float rs = 1.0f / sqrtf(wave_sum(ss) * (1.0f / D) + EPS);
        GAS unsigned* o4 = (GAS unsigned*)(a.ws + WS_H8 + (size_t)m * D) + lane;
        float amx = 0.f;
#pragma unroll
        for (int j = 0; j < 4; ++j) { v[j] = v[j] * rs * gv[j]; amx = fmaxf(fmaxf(amx, fmaxf(fabsf(v[j][0]), fabsf(v[j][1]))), fmaxf(fabsf(v[j][2]), fabsf(v[j][3]))); }
#pragma unroll
        for (int o = 1; o < 64; o <<= 1) amx = fmaxf(amx, __shfl_xor(amx, o));
        amx = fmaxf(amx, 1e-30f); const float qinv = 127.0f / amx;
        if (lane == 0 && !dry) ((float*)(a.ws + WS_SA))[m] = amx * (1.0f / 127.0f);
#pragma unroll
        for (int j = 0; j < 4; ++j) { const int b0 = (int)rintf(qinv * v[j][0]), b1 = (int)rintf(qinv * v[j][1]), b2 = (int)rintf(qinv * v[j][2]), b3 = (int)rintf(qinv * v[j][3]);
            if (!dry) o4[64 * j] = (unsigned)(b0 & 0xff) | ((unsigned)(b1 & 0xff) << 8) | ((unsigned)(b2 & 0xff) << 16) | ((unsigned)(b3 & 0xff) << 24); }
    }
}
__device__ __forceinline__ void ph_final(const P& a, int gw, int NGW, int lane, float oscale) {
    f32x4 gv[4];
#pragma unroll
    for (int j = 0; j < 4; ++j) gv[j] = ((const f32x4*)a.g_final)[lane + 64 * j];
    const bf16* XB = (const bf16*)(a.ws + WS_XB);
    v2u nv[4];
    if (gw < T) { const GAS v2u* xq = (const GAS v2u*)(XB + (size_t)gw * D) + lane;
#pragma unroll
        for (int j = 0; j < 4; ++j) nv[j] = xq[64 * j]; }
    for (int m = gw; m < T; m += NGW) {
        GAS f32x4* xr = (GAS f32x4*)(a.out + (size_t)m * D) + lane;
        f32x4 v[4]; float ss = 0.f;
#pragma unroll
        for (int j = 0; j < 4; ++j) v[j] = xb_unpack(nv[j]);
        if (m + NGW < T) { const GAS v2u* xq = (const GAS v2u*)(XB + (size_t)(m + NGW) * D) + lane;
#pragma unroll
            for (int j = 0; j < 4; ++j) nv[j] = xq[64 * j]; }
#pragma unroll
        for (int j = 0; j < 4; ++j) { ss += (v[j][0] * v[j][0] + v[j][1] * v[j][1]) + (v[j][2] * v[j][2] + v[j][3] * v[j][3]); }
        const float rs = 1.0f / sqrtf(wave_sum(ss) * (1.0f / D) + EPS);
#pragma unroll
        for (int j = 0; j < 4; ++j) xr[64 * j] = v[j] * (rs * oscale) * gv[j];
    }
}

typedef const __attribute__((address_space(4))) P* kargp_t;
__device__ __forceinline__ P load_args(kargp_t p) { P a; a.x = p->x; a.p = p->p; a.rel_bias = p->rel_bias; a.g_mix = p->g_mix; a.w_in = p->w_in; a.g_qnorm = p->g_qnorm; a.g_knorm = p->g_knorm; a.conv_w = p->conv_w; a.conv_b = p->conv_b; a.dt_bias_f = p->dt_bias_f; a.dt_bias_b = p->dt_bias_b; a.a_log_f = p->a_log_f; a.a_log_b = p->a_log_b; a.d_skip = p->d_skip; a.g_ssm = p->g_ssm; a.lambda_q1 = p->lambda_q1; a.lambda_k1 = p->lambda_k1; a.lambda_q2 = p->lambda_q2; a.lambda_k2 = p->lambda_k2; a.g_diff = p->g_diff; a.g_sgu = p->g_sgu; a.w_spatial = p->w_spatial; a.b_spatial = p->b_spatial; a.w_branch = p->w_branch; a.w_branch_gate = p->w_branch_gate; a.w_out = p->w_out; a.g_moe = p->g_moe; a.w_router = p->w_router; a.w_exp_gate = p->w_exp_gate; a.w_exp_up = p->w_exp_up; a.w_exp_down = p->w_exp_down; a.g_ple = p->g_ple; a.w_ple_gate = p->w_ple_gate; a.w_ple = p->w_ple; a.g_final = p->g_final; a.out = p->out; a.ws = p->ws; a.gp_lo = p->gp_lo; a.gp_hi = p->gp_hi; return a; }
__device__ __forceinline__ int my_lane_volatile() { int l; asm volatile("v_mbcnt_lo_u32_b32 %0, -1, 0\n\tv_mbcnt_hi_u32_b32 %0, -1, %0" : "=v"(l)); return l; }
#ifndef PROBE_PH
#define PROBE_PH -1
#endif
#ifndef REPMASK
#define REPMASK 0u
#endif
#define NREP(bit) (((REPMASK >> (bit)) & 1u) ? 2 : 1)
#define REPEAT(bit) _Pragma("unroll 1") for (int rep_ = 0; rep_ < NREP(bit); ++rep_)
#ifndef PHMASK
#define PHMASK 0xFFFFu
#endif
__global__ void __launch_bounds__(NTHR, 2) mk_fwd(P a_in) {
    extern __shared__ __attribute__((aligned(16))) unsigned char lds[];
    const int G = gridDim.x, bx = blockIdx.x, NGW = G * NWAVES, GT = G * NTHR;
    gu32* ctl = (gu32*)(a_in.ws + WS_CTL);
    volatile LAS unsigned* MISC = (volatile LAS unsigned*)((LAS unsigned char*)lds + MISC_OFF);
    for (int u = threadIdx.x; u < (LDS_BYTES - LDSCTL_OFF) / 4; u += NTHR) ((LAS unsigned*)((LAS unsigned char*)lds + LDSCTL_OFF))[u] = 0u;
    __syncthreads();
    const bool multi = (a_in.gp_hi - a_in.gp_lo) > 1;
    XcdBarrier bar; bar.bar = (unsigned*)(ctl + CW_BAR); bar.x = 0; bar.st = nullptr;
    const int wave0 = __builtin_amdgcn_readfirstlane((int)threadIdx.x >> 6);
    if (multi) bar = xcd_barrier_post((unsigned*)(ctl + CW_BAR), MISC + 8, (int)threadIdx.x);
    const int lo = a_in.gp_lo, hi = a_in.gp_hi;
    unsigned long long tacc = 0ull, tic0 = 0ull; (void)tic0;
#define TIC(ph) do { if (PROBE_PH == (ph)) tic0 = __builtin_amdgcn_s_memrealtime(); } while (0)
#define TOC(ph) do { if (PROBE_PH == (ph)) tacc += __builtin_amdgcn_s_memrealtime() - tic0; } while (0)
#define IN(k) (((PHMASK >> (((k) < DEPTH * NPH) ? ((k) % NPH) : 14)) & 1u) && lo <= (k) && (k) < hi)
#define MY_TID() ((wave0 << 6) | my_lane_volatile())
#define SEAM(k) do { if (IN(k) && IN((k) + 1)) { XcdBarrier b2_ = bar; asm volatile("" : "+s"(b2_.bar)); xcd_barrier(b2_, MY_TID()); if ((REPMASK >> 21) & 1u) xcd_barrier(b2_, MY_TID()); } } while (0)
#define PHASE_IDS() int tid = MY_TID(); asm volatile("" : "+v"(tid)); const int lane = tid & 63; const int wave = __builtin_amdgcn_readfirstlane(tid >> 6); \
    const int gw = bx * NWAVES + wave; const int gtid = bx * NTHR + tid; (void)lane; (void)gw; (void)gtid; \
    kargp_t ap_ = (kargp_t)__builtin_amdgcn_kernarg_segment_ptr(); asm volatile("" : "+s"(ap_)); const P a = load_args(ap_); \
    unsigned char* const ws = a.ws; bf16* const H = (bf16*)(ws + WS_H); bf16* const PROJ = (bf16*)(ws + WS_PROJ); bf16* const GATES = (bf16*)(ws + WS_GATES); bf16* const BR = (bf16*)(ws + WS_BR); \
    LAS unsigned char* const ldsl = (LAS unsigned char*)lds; (void)H; (void)PROJ; (void)GATES; (void)BR; (void)ldsl

#pragma unroll 1
    for (int L = 0; L < DEPTH; ++L) {
        const int g0 = L * NPH;
        TIC(0);
        if (IN(g0 + 0)) REPEAT(0) { PHASE_IDS(); ph_convw(a, L, lds, gw, NGW, wave, lane, tid, gtid, GT, bx, G, 0); }
        if (IN(g0 + 0)) { PHASE_IDS(); ph_r0(a, L, lds, gw, NGW, lane, tid); } SEAM(g0 + 0); TOC(0);
        TIC(1);
        if (NPROJ_BF > 0 && IN(g0 + 1)) REPEAT(1) { PHASE_IDS();
            pg8::Gemm g{H, (const bf16*)(ws + WS_WCAT), T, NPROJ_BF, D, 0}; pg8::StaticOrder So; So.init(T, NPROJ_BF, G, bx);
            pg8::EpiG1 E{PROJ, GATES, 0.17677669529663687f * LOG2E, rep_ + 1 < NREP(1)};
            pg8::gemm_phase<pg8::EpiG1, pg8::StaticOrder, true, true>(ldsl, g, So, E, tid);
        }
        if (IN(g0 + 1)) { PHASE_IDS();
            pg8::Gemm g{(const bf16*)(ws + WS_PBF), (const bf16*)(ws + WS_WPLE), T, D, 256, 0}; pg8::TailOrder So{G, bx, 0};
            pg8::EpiPlain E{(bf16*)(ws + WS_PL), D};
            pg8::gemm_phase<pg8::EpiPlain, pg8::TailOrder, true, true, false, false, false, PAD_PL0>(ldsl, g, So, E, tid);
        }
        if (IN(g0 + 1)) REPEAT(1) { PHASE_IDS();
            pg8::StaticOrder So; So.init(T, NPROJ_I8, G, bx);
            LAS unsigned* gtab = (LAS unsigned*)(ldsl + RING_BYTES + 512);
            {
#pragma unroll 1
              for (int ui = 0; ui < 6; ++ui) { pg8::Unit uu; const bool okk = So.next(ui, uu); const int rb = okk ? uu.pm * 256 : 0; if (tid < 256) gtab[ui * 256 + tid] = (unsigned)(rb + tid) * (unsigned)D; }
              __syncthreads(); }
            pg8::Gemm g{(const bf16*)(ws + WS_H8), (const bf16*)(ws + WS_WCAT + (size_t)NPROJ_BF * 2048), T, NPROJ_I8, D / 2, 0};
            pg8::EpiProjI8 E{PROJ, (const float*)(ws + WS_SA), (const float*)(ws + WS_SW) + 5120, NPROJ_BF, 0.17677669529663687f * LOG2E, rep_ + 1 < NREP(1)};
            pg8::gemm_phase<pg8::EpiProjI8, pg8::StaticOrder, true, true, true, false, true, PAD_PROJ>(ldsl, g, So, E, tid, gtab);
        }
        if (IN(g0 + 1)) { PHASE_IDS();
            pg8::Gemm g{(const bf16*)(ws + WS_PBF), (const bf16*)(ws + WS_WPLE), T, D, 256, 0}; pg8::TailOrder So{G, bx, 1};
            pg8::EpiPlain E{(bf16*)(ws + WS_PL), D};
            pg8::gemm_phase<pg8::EpiPlain, pg8::TailOrder, true, true, false, false, false, PAD_PL>(ldsl, g, So, E, tid);
        }
        if (IN(g0 + 1)) { PHASE_IDS();
            pg8::StaticOrder So; So.init(T, NGATE, G, bx);
            LAS unsigned* gtab = (LAS unsigned*)(ldsl + RING_BYTES + 512);
            {
#pragma unroll 1
              for (int ui = 0; ui < 8; ++ui) { pg8::Unit uu; const bool okk = So.next(ui, uu); const int rb = okk ? uu.pm * 256 : 0; if (tid < 256) gtab[ui * 256 + tid] = (unsigned)(rb + tid) * (unsigned)D; }
              __syncthreads(); }
            pg8::Gemm g{(const bf16*)(ws + WS_H8), (const bf16*)(ws + WS_WCAT + (size_t)NPROJ * 2048), T, NGATE, D / 2, 0};
            pg8::EpiGateI8 E{GATES, (const float*)(ws + WS_SA), (const float*)(ws + WS_SW), 0};
            pg8::gemm_phase<pg8::EpiGateI8, pg8::StaticOrder, true, true, true, false, true, PAD_GATE>(ldsl, g, So, E, tid, gtab);
        } SEAM(g0 + 1); TOC(1);
        TIC(2);
        if (IN(g0 + 2)) {
            REPEAT(16) { PHASE_IDS(); ph_rope(a, L, lds, gw, NGW, wave, lane, tid, bx, rep_ + 1 < NREP(16)); }
            REPEAT(2) { PHASE_IDS(); for (int u = bx; u < 512; u += G) ssd1_unit(a, L, u, lds, wave, lane, tid); }
            REPEAT(2) { PHASE_IDS(); for (int u = bx; u < 256; u += G) sgu_unit(a, L, u, lds, wave, lane, tid); }
        } SEAM(g0 + 2); TOC(2);
        TIC(3);
        if (IN(g0 + 3)) {
            REPEAT(3) { PHASE_IDS(); ph_scan(a, gtid, GT); }
        } SEAM(g0 + 3); TOC(3);
        TIC(4);
        if (IN(g0 + 4)) {
            REPEAT(4) { PHASE_IDS(); for (int u = bx; u < 512; u += G) ssd3_unit(a, L, u, lds, wave, lane, tid); }
            REPEAT(14) { PHASE_IDS(); const attn_body::bf16* Pj = (const attn_body::bf16*)PROJ; attn_body::bf16* Bo = (attn_body::bf16*)BR;
              for (int u = bx; u < 512; u += G) {
                const int rnd = u >> 8, cc = u & 255, xc = cc & 7, rr = cc >> 3;
                const int b = xc >> 2, hq = xc & 3, qb = rr + 32 * rnd; const size_t rb = (size_t)b * S;
                const attn_body::bf16 *qp = Pj + rb * LDP + PC_AQ + hq * 64, *kp = Pj + rb * LDP + PC_AK + (hq >> 1) * 64, *vp = Pj + rb * LDP + PC_AV + (hq >> 1) * 64; attn_body::bf16* op = Bo + rb * 1024 + hq * 64;
                const bool ok = attn_body::attn_bound<false>(qp, qb * 256, (char*)lds, (const float*)(ws + WS_KMAX) + b * 2 + (hq >> 1), 0.f, tid);
                if (ok) attn_body::attn_unit<false, 8, true, false>(qp, kp, vp, op, qb * 256, (char*)lds, nullptr, 0, 0.f, 0.f, nullptr, 0.f, tid);
                else    attn_body::attn_unit<false, 8, false>(qp, kp, vp, op, qb * 256, (char*)lds, nullptr, 0, 0.f, 0.f, nullptr, 0.f, tid); }
              if ((REPMASK >> 23) & 1u) { XcdBarrier b2_ = bar; asm volatile("" : "+s"(b2_.bar)); xcd_barrier(b2_, MY_TID()); } }
            REPEAT(15) { PHASE_IDS(); const attn_body::bf16* Pj = (const attn_body::bf16*)PROJ; attn_body::bf16* Bo = (attn_body::bf16*)BR;
              float lam;
              { float t1 = (lane < 32) ? a.lambda_q1[L * 32 + (lane & 31)] * a.lambda_k1[L * 32 + (lane & 31)] : 0.f; float t2 = (lane < 32) ? a.lambda_q2[L * 32 + (lane & 31)] * a.lambda_k2[L * 32 + (lane & 31)] : 0.f;
                t1 = wave_sum(t1); t2 = wave_sum(t2);
                lam = __expf(t1) - __expf(t2) + (0.8f - 0.6f * __expf(-0.3f * (float)L)); }
              const float osc = 1.0f - (0.8f - 0.6f * __expf(-0.3f * (float)L));
              for (int u = bx; u < 1024; u += G) {
                const int rnd = u >> 8, cc = u & 255, xc = cc & 7, rr = cc >> 3;
                const int b = xc >> 2, h = xc & 3, qb = rr + 32 * rnd; const size_t rb = (size_t)b * S;
                const attn_body::bf16 *qp = Pj + rb * LDP + PC_CQ + h * 64, *kp = Pj + rb * LDP + PC_CK + h * 64, *vp = Pj + rb * LDP + PC_CV + h * 64; attn_body::bf16* op = Bo + rb * 1024 + 512 + h * 64;
                float bmax = -3.0e38f;
                for (int bk = 0; bk < 32; ++bk) bmax = fmaxf(bmax, LOG2E * a.rel_bias[bk * 4 + h]);
                const bool ok = attn_body::attn_bound<true>(qp, qb * 128, (char*)lds, (const float*)(ws + WS_KMAX) + 4 + b * 8 + h * 2, bmax, tid);
                if (ok) attn_body::attn_unit<true, 8, true>(qp, kp, vp, op, qb * 128, (char*)lds, a.rel_bias, h, lam, osc, a.g_diff + L * 64, bmax, tid);
                else    attn_body::attn_unit<true, 8, false>(qp, kp, vp, op, qb * 128, (char*)lds, a.rel_bias, h, lam, osc, a.g_diff + L * 64, bmax, tid); }
              if ((REPMASK >> 23) & 1u) { XcdBarrier b2_ = bar; asm volatile("" : "+s"(b2_.bar)); xcd_barrier(b2_, MY_TID()); } }
        } SEAM(g0 + 4); TOC(4);
        TIC(5);
        if (IN(g0 + 5)) REPEAT(5) { PHASE_IDS();
            pg8::Gemm g{BR, (const bf16*)(ws + WS_WBR), T, NGATE, 256, 1024}; pg8::MergeOrder So{G, bx};
            LAS float* rrt = (LAS float*)(ldsl + RING_BYTES + 512);
            { const int k = tid >> 8, rl = tid & 255; const int tile = k * G + bx; if (tile < 512) { const f32x4 q = *(const f32x4*)((const float*)(ws + WS_SSQ) + ((size_t)(tile >> 2) * 256 + rl) * 4);
                  const float ms = ((q[0] + q[1]) + (q[2] + q[3])) * (1.0f / 256.0f) + 1e-6f; const float sq = sqrtf(ms); rrt[(k * 256 + rl) * 2] = sq; rrt[(k * 256 + rl) * 2 + 1] = 1.0f / sq; }
              __syncthreads(); }
            pg8::EpiMergeHorner E{GATES, H, rrt, bx >> 2, (rep_ + 1 < NREP(5)) && !((REPMASK >> 22) & 1u)};
            pg8::gemm_phase<pg8::EpiMergeHorner, pg8::MergeOrder, true, true, false, false, false, PAD_P5>(ldsl, g, So, E, tid);
        } SEAM(g0 + 5); TOC(5);
        TIC(6);
        if (IN(g0 + 6)) REPEAT(6) { PHASE_IDS();
            pg8::Gemm g{H, (const bf16*)(ws + WS_WOUT), T, D, D, 0}; pg8::StaticOrder So; So.init(T, D, G, bx);
            pg8::EpiResidB E{(bf16*)(ws + WS_XB), rep_ + 1 < NREP(6)};
            pg8::gemm_phase<pg8::EpiResidB, pg8::StaticOrder, true, true, false, false, false, PAD_P6>(ldsl, g, So, E, tid);
        } SEAM(g0 + 6); TOC(6);
        TIC(7);
        if (IN(g0 + 7)) REPEAT(7) { PHASE_IDS(); ph_r1(a, L, lds, gw, NGW, lane, tid); } SEAM(g0 + 7); TOC(7);
        TIC(8);
        if (IN(g0 + 8)) REPEAT(8) { PHASE_IDS(); for (int q = bx; q < NB * NE; q += G) sel_unit(a, q, lds, wave, lane, tid); }
        SEAM(g0 + 8); TOC(8);
        TIC(9);
        TIC(10);
        if (IN(g0 + 10)) REPEAT(10) { PHASE_IDS();
            pg8::ExpertOrder So{8, G, bx};
            LAS unsigned* gtab = (LAS unsigned*)(ldsl + RING_BYTES + 512);
            { const int* SELIDX = (const int*)(ws + WS_SELIDX);
#pragma unroll 1
              for (int ui = 0; ui < 8; ++ui) { pg8::Unit uu; const bool okk = So.next(ui, uu);
                  if (tid < 256) { unsigned off = 0u; if (okk) { const int r = uu.pm * 256 + tid, b = (r >> 11) & 1; off = (unsigned)((b * S + SELIDX[r]) * D); }
                      gtab[ui * 256 + tid] = off; } }
              __syncthreads(); }
            pg8::Gemm g{H, (const bf16*)(ws + WS_WGU), NE * NB * CAP, NE * 2048, D / 2, 0};
            pg8::EpiGU8 E{(unsigned char*)(ws + WS_HID), (rep_ + 1 < NREP(10)) ? (int)(((REPMASK >> 20) & 1u) + 2 * ((REPMASK >> 24) & 1u)) : 0};
            pg8::gemm_phase<pg8::EpiGU8, pg8::ExpertOrder, true, true, true, true, false, PAD_GU>(ldsl, g, So, E, tid, gtab);
        } SEAM(g0 + 10); TOC(10);
        TIC(11);
        if (IN(g0 + 11)) REPEAT(11) { PHASE_IDS();
            pg8::ExpertOrder So{4, G, bx};
            LAS unsigned* gtab = (LAS unsigned*)(ldsl + RING_BYTES + 512);
            {
#pragma unroll 1
              for (int ui = 0; ui < 4; ++ui) { pg8::Unit uu; const bool okk = So.next(ui, uu); const int rb = okk ? uu.pm * 256 : 0; if (tid < 256) gtab[ui * 256 + tid] = (unsigned)(rb + tid) * (unsigned)D; }
              __syncthreads(); }
            pg8::Gemm g{(const bf16*)(ws + WS_HID), (const bf16*)(ws + WS_WDN), NE * NB * CAP, NE * 1024, D / 2, 0};
            pg8::EpiDNP8 E{(unsigned char*)(ws + WS_YE), (rep_ + 1 < NREP(11)) ? (int)(((REPMASK >> 20) & 1u) + 2 * ((REPMASK >> 24) & 1u)) : 0};
            pg8::gemm_phase<pg8::EpiDNP8, pg8::ExpertOrder, true, true, true, true, false, PAD_DN>(ldsl, g, So, E, tid, gtab);
        } SEAM(g0 + 11); TOC(11);
        TIC(12);
        if (IN(g0 + 12)) REPEAT(12) { PHASE_IDS(); ph_r2(a, L, gw, NGW, lane, rep_ + 1 < NREP(12)); } SEAM(g0 + 12); TOC(12);
        TIC(13);
        if (IN(g0 + 13)) REPEAT(13) { PHASE_IDS();
            pg8::StaticOrder So; So.init(T, D, G, bx);
            LAS unsigned* gtab = (LAS unsigned*)(ldsl + RING_BYTES + 512);
            {
#pragma unroll 1
              for (int ui = 0; ui < 2; ++ui) { pg8::Unit uu; const bool okk = So.next(ui, uu); const int rb = okk ? uu.pm * 256 : 0; if (tid < 256) gtab[ui * 256 + tid] = (unsigned)(rb + tid) * (unsigned)D; }
              __syncthreads(); }
            pg8::Gemm g{(const bf16*)(ws + WS_H8), (const bf16*)(ws + WS_WPG), T, D, D / 2, 0};
            pg8::EpiPleI8B E{(bf16*)(ws + WS_XB), (const bf16*)(ws + WS_PL), (const float*)(ws + WS_SA), (const float*)(ws + WS_SW) + 4096, rep_ + 1 < NREP(13)};
            pg8::gemm_phase<pg8::EpiPleI8B, pg8::StaticOrder, true, true, true, false, true, PAD_PLE>(ldsl, g, So, E, tid, gtab);
        } SEAM(g0 + 13); TOC(13);
    }
    float oscale = 1.0f;
#if PROBE_PH >= 0
    oscale = 1.0f + sqrtf((float)tacc * 1e-6f);
#endif
    if (IN(DEPTH * NPH)) { PHASE_IDS(); ph_final(a, gw, NGW, lane, oscale); }
#undef IN
#undef SEAM
#undef PHASE_IDS
}

#ifndef MK_ONE_LAUNCH
#define MK_ONE_LAUNCH 1
#endif
extern "C" void kernel_launch(void* const* d_in, const int* in_sizes, int n_in, void* d_out, int out_size, void* d_ws, size_t ws_size, hipStream_t stream) {
    static int grid = 0;
    if (grid == 0) {
        if (n_in != 35 || in_sizes[0] != T * D || out_size != T * D || ws_size < WS_END) { fprintf(stderr, "kernel_launch: unexpected shapes (n_in %d, in0 %d, out %d, ws %zu)\n", n_in, n_in > 0 ? in_sizes[0] : -1, out_size, ws_size); grid = -1; return; }
        int dev = 0, cus = 0, per_cu = 0;
        if (hipGetDevice(&dev) != hipSuccess || hipDeviceGetAttribute(&cus, hipDeviceAttributeMultiprocessorCount, dev) != hipSuccess) { grid = -1; return; }
        if (hipFuncSetAttribute((const void*)mk_fwd, hipFuncAttributeMaxDynamicSharedMemorySize, LDS_BYTES) != hipSuccess) { fprintf(stderr, "kernel_launch: hipFuncSetAttribute failed\n"); grid = -1; return; }
        if (hipOccupancyMaxActiveBlocksPerMultiprocessor(&per_cu, (const void*)mk_fwd, NTHR, LDS_BYTES) != hipSuccess || per_cu < 1) { fprintf(stderr, "kernel_launch: occupancy query says %d\n", per_cu); }
        (void)hipGetLastError();
        if (cus < 256) { fprintf(stderr, "kernel_launch: built for a 256-CU device (got %d)\n", cus); grid = -1; return; }
        grid = 256;
    }
    if (grid < 0) return;
    (void)hipMemsetAsync((char*)d_ws + WS_CTL, 0, CTL_ZERO_BYTES, stream);
    P a{};
    const float** pp = (const float**)&a;
    for (int i = 0; i < 35; ++i) pp[i] = (const float*)d_in[i];
    a.out = (float*)d_out; a.ws = (unsigned char*)d_ws;
#if MK_ONE_LAUNCH
    a.gp_lo = 0; a.gp_hi = NGP;
    hipLaunchKernelGGL(mk_fwd, dim3(grid), dim3(NTHR), LDS_BYTES, stream, a);
#else
    for (int gp = 0; gp < NGP; ++gp) { a.gp_lo = gp; a.gp_hi = gp + 1; hipLaunchKernelGGL(mk_fwd, dim3(grid), dim3(NTHR), LDS_BYTES, stream, a); }
#endif
}
```

```cpp
#include <hip/hip_runtime.h>
#include <hip/hip_bf16.h>
#include <cstdio>
#include <cstdint>
#include <cmath>
#ifndef REPMASK
#define REPMASK 0u
#endif
#define MK_PROBE_BUILD ((REPMASK) != 0u)
namespace pg8 {
#define PG8_LAS __attribute__((address_space(3)))
typedef unsigned short bf16_t;
typedef short bf16x8 __attribute__((ext_vector_type(8)));
typedef float f32x4 __attribute__((ext_vector_type(4)));
typedef unsigned u32x4 __attribute__((ext_vector_type(4)));
constexpr int BM = 256, BK = 64, HALF = 128, HTB = HALF * BK * 2  , STAGE_BYTES = 8 * HTB, NXCD = 8, WGM = 8;

__host__ __device__ __forceinline__ int lds_byte(int r, int c) { const int st = (r >> 4) * 2 + (c >> 5), rr = r & 15, cc = c & 31, ob = rr * 64 + cc * 2; return st * 1024 + (ob ^ (((ob >> 9) & 1) << 5)); }
__host__ __device__ __forceinline__ void stage_rc(int b, int& R, int& C) { const int st = b / 1024, sb = b % 1024, swz = sb ^ (((sb >> 9) & 1) << 5); R = (st >> 1) * 16 + swz / 64; C = (st & 1) * 32 + (swz % 64) / 2; }
__host__ __device__ __forceinline__ int perm32(int rho) { const int n = rho >> 4, i = rho & 15; return 8 * (i >> 2) + 4 * n + (i & 3); }

struct Unit { int pm, pn; };
struct Gemm { const bf16_t* A; const bf16_t* Bt; int M, N, K, lda; };

struct StaticOrder {
    int nM, nN, nwg, G, c;
    __host__ __device__ void init(int M, int N, int G_, int c_) { nM = M / BM; nN = N / BM; nwg = nM * nN; G = G_; c = c_; }
    __host__ __device__ __forceinline__ bool next(int i, Unit& u) const {
        const long L = (long)i * G + c; if (L >= nwg) return false;
        int wgid = (int)L; { const int q = nwg / NXCD, r = nwg % NXCD, xcd = wgid % NXCD, off = wgid / NXCD; wgid = (xcd < r ? xcd * (q + 1) : r * (q + 1) + (xcd - r) * q) + off; }
        const int nig = WGM * nN, gid = wgid / nig, fm = gid * WGM, gsz = (nM - fm) < WGM ? (nM - fm) : WGM;
        u.pm = fm + ((wgid % nig) % gsz); u.pn = (wgid % nig) / gsz; return true;
    }
    __device__ __forceinline__ void a_ready(const Unit&) const {}
    __device__ __forceinline__ void done(const Unit&) const {}
    __device__ __forceinline__ size_t a_off(const Unit&) const { return 0; }
};

__device__ __forceinline__ unsigned cvt_pk_bf16(float lo, float hi) { unsigned r; asm volatile("v_cvt_pk_bf16_f32 %0, %1, %2" : "=v"(r) : "v"(lo), "v"(hi)); return r; }
typedef float f32x2 __attribute__((ext_vector_type(2)));
__device__ __forceinline__ float ub0(unsigned w) { return (float)(w & 0xffu); }
__device__ __forceinline__ float ub1(unsigned w) { return (float)((w >> 8) & 0xffu); }
__device__ __forceinline__ float ub2(unsigned w) { return (float)((w >> 16) & 0xffu); }
__device__ __forceinline__ float ub3(unsigned w) { return (float)(w >> 24); }
__device__ __forceinline__ float bf_lo(unsigned w) { return __builtin_bit_cast(float, w << 16); }
__device__ __forceinline__ float bf_hi(unsigned w) { return __builtin_bit_cast(float, w & 0xffff0000u); }
__device__ __forceinline__ float sigmoid_f(float x) { return __builtin_amdgcn_rcpf(1.0f + __builtin_amdgcn_exp2f(-1.4426950408889634f * x)); }
__device__ __forceinline__ u32x4 pack8(const f32x4 v0, const f32x4 v1) { u32x4 w; w.x = cvt_pk_bf16(v0[0], v0[1]); w.y = cvt_pk_bf16(v0[2], v0[3]); w.z = cvt_pk_bf16(v1[0], v1[1]); w.w = cvt_pk_bf16(v1[2], v1[3]); return w; }

struct ExpertOrder {
    int nNl, G, c;
    __device__ __forceinline__ bool next(int i, Unit& u) const {
        const int L = i * G + c, per = 16 * nNl; if (L >= 16 * per) return false;
        const int e = L / per, w = L % per; u.pm = e * 16 + (w % 16); u.pn = e * nNl + (w / 16); return true;
    }
    __device__ __forceinline__ void a_ready(const Unit&) const {}
    __device__ __forceinline__ void done(const Unit&) const {}
    __device__ __forceinline__ size_t a_off(const Unit&) const { return 0; }
};
struct BranchOrder : StaticOrder {
    __device__ __forceinline__ size_t a_off(const Unit& u) const { return (size_t)(u.pn >> 2) * 256 * 2; }
};

struct EpiG1 {
    static constexpr bool PERM = true, AFTER_DRAIN = false, MIDHOOK = false;
    bf16_t* proj; bf16_t* gates; float qscale; int dry;
    __device__ __forceinline__ void operator()(const f32x4 (&acc)[2][2][4][2], const Unit& u, int wr, int wc, int fr, int fq) const {
        if (dry) return;
        int row0 = u.pm * BM + wr * 64 + fr; asm volatile("" : "+v"(row0));
        const bool isg = u.pn >= 11;
        if (isg) {
            unsigned char* base = (unsigned char*)gates + ((size_t)(u.pm * 16 + (u.pn - 11)) << 16) + ((wr * 4 + wc) * 64 + fq * 16 + fr) * 8;
#pragma unroll
            for (int ai = 0; ai < 2; ++ai)
#pragma unroll
                for (int m = 0; m < 4; ++m)
#pragma unroll
                    for (int bj = 0; bj < 2; ++bj) { f32x4 v0 = acc[ai][bj][m][0], v1 = acc[ai][bj][m][1];
#pragma unroll
                        for (int i = 0; i < 4; ++i) { v0[i] = fmaxf(255.0f * sigmoid_f(v0[i]), 1.0f); v1[i] = fmaxf(255.0f * sigmoid_f(v1[i]), 1.0f); }
                        unsigned w0 = 0u, w1 = 0u;
                        w0 = __builtin_amdgcn_cvt_pk_u8_f32(v0[0], 0, w0); w0 = __builtin_amdgcn_cvt_pk_u8_f32(v0[1], 1, w0); w0 = __builtin_amdgcn_cvt_pk_u8_f32(v0[2], 2, w0); w0 = __builtin_amdgcn_cvt_pk_u8_f32(v0[3], 3, w0);
                        w1 = __builtin_amdgcn_cvt_pk_u8_f32(v1[0], 0, w1); w1 = __builtin_amdgcn_cvt_pk_u8_f32(v1[1], 1, w1); w1 = __builtin_amdgcn_cvt_pk_u8_f32(v1[2], 2, w1); w1 = __builtin_amdgcn_cvt_pk_u8_f32(v1[3], 3, w1);
                        typedef unsigned u32x2g __attribute__((ext_vector_type(2)));
                        *(u32x2g*)(base + (((ai * 4 + m) * 2 + bj) << 12)) = (u32x2g){w0, w1}; }
        } else {
            const float sc = (u.pn == 2) ? qscale : 1.0f;
            const int col0 = u.pn * BM + wc * 32 + 8 * fq;
#pragma unroll
            for (int ai = 0; ai < 2; ++ai)
#pragma unroll
                for (int m = 0; m < 4; ++m) { bf16_t* rowp = proj + (size_t)(row0 + ai * HALF + m * 16) * 2816 + col0;
#pragma unroll
                    for (int bj = 0; bj < 2; ++bj) *(u32x4*)(rowp + bj * HALF) = pack8(acc[ai][bj][m][0] * sc, acc[ai][bj][m][1] * sc); }
        }
    }
};
struct EpiProjI8 {
    static constexpr bool PERM = true, AFTER_DRAIN = false, MIDHOOK = false;
    bf16_t* proj; const float* sa; const float* sw; int cbase; float qscale; int dry;
    __device__ __forceinline__ void operator()(const f32x4 (&acc)[2][2][4][2], const Unit& u, int wr, int wc, int fr, int fq) const {
        if (dry) return;
        typedef int i32x4e __attribute__((ext_vector_type(4)));
        int row0 = u.pm * BM + wr * 64 + fr; asm volatile("" : "+v"(row0));
        const int col0 = u.pn * BM + wc * 32 + 8 * fq;
        f32x4 cw[2][2]; const float sc = ((cbase >> 8) + u.pn == 2) ? qscale : 1.0f;
#pragma unroll
        for (int bj = 0; bj < 2; ++bj) { cw[bj][0] = *(const f32x4*)(sw + col0 + bj * HALF) * sc; cw[bj][1] = *(const f32x4*)(sw + col0 + bj * HALF + 4) * sc; }
        float RS[2][4];
#pragma unroll
        for (int ai = 0; ai < 2; ++ai)
#pragma unroll
            for (int m = 0; m < 4; ++m) RS[ai][m] = sa[row0 + ai * HALF + m * 16];
        __builtin_amdgcn_sched_barrier(0);
#pragma unroll
        for (int ai = 0; ai < 2; ++ai)
#pragma unroll
            for (int m = 0; m < 4; ++m) { const int r = row0 + ai * HALF + m * 16; const float rsc = RS[ai][m]; bf16_t* rowp = proj + (size_t)r * 2816 + cbase + col0;
#pragma unroll
                for (int bj = 0; bj < 2; ++bj) { const i32x4e a0 = __builtin_bit_cast(i32x4e, acc[ai][bj][m][0]), a1 = __builtin_bit_cast(i32x4e, acc[ai][bj][m][1]); f32x4 v0, v1;
#pragma unroll
                    for (int i = 0; i < 4; ++i) { v0[i] = (float)a0[i] * rsc * cw[bj][0][i]; v1[i] = (float)a1[i] * rsc * cw[bj][1][i]; }
                    *(u32x4*)(rowp + bj * HALF) = pack8(v0, v1); } }
    }
};
struct EpiGateI8 {
    static constexpr bool PERM = true, AFTER_DRAIN = false, MIDHOOK = false;
    bf16_t* gates; const float* sa; const float* sw; int dry;
    __device__ __forceinline__ void operator()(const f32x4 (&acc)[2][2][4][2], const Unit& u, int wr, int wc, int fr, int fq) const {
        if (dry) return;
        typedef unsigned u32x2g __attribute__((ext_vector_type(2))); typedef int i32x4e __attribute__((ext_vector_type(4)));
        int row0 = u.pm * BM + wr * 64 + fr; asm volatile("" : "+v"(row0));
        unsigned char* base = (unsigned char*)gates + ((size_t)(u.pm * 16 + u.pn) << 16) + ((wr * 4 + wc) * 64 + fq * 16 + fr) * 8;
        const int colb = u.pn * BM + wc * 32 + 8 * fq;
        f32x4 cw[2][2];
#pragma unroll
        for (int bj = 0; bj < 2; ++bj) { cw[bj][0] = *(const f32x4*)(sw + colb + bj * HALF); cw[bj][1] = *(const f32x4*)(sw + colb + bj * HALF + 4); }
        float RS[2][4];
#pragma unroll
        for (int ai = 0; ai < 2; ++ai)
#pragma unroll
            for (int m = 0; m < 4; ++m) RS[ai][m] = sa[row0 + ai * HALF + m * 16];
        __builtin_amdgcn_sched_barrier(0);
#pragma unroll
        for (int ai = 0; ai < 2; ++ai)
#pragma unroll
            for (int m = 0; m < 4; ++m) { const float rsn = RS[ai][m] * -1.4426950408889634f;
#pragma unroll
                for (int bj = 0; bj < 2; ++bj) { const i32x4e a0 = __builtin_bit_cast(i32x4e, acc[ai][bj][m][0]), a1 = __builtin_bit_cast(i32x4e, acc[ai][bj][m][1]); f32x4 v0, v1;
#pragma unroll
                    for (int i = 0; i < 4; ++i) { v0[i] = fmaxf(__builtin_amdgcn_rcpf(__builtin_fmaf(__builtin_amdgcn_exp2f((float)a0[i] * rsn * cw[bj][0][i]), 1.0f / 255.0f, 1.0f / 255.0f)), 1.0f);
                                                  v1[i] = fmaxf(__builtin_amdgcn_rcpf(__builtin_fmaf(__builtin_amdgcn_exp2f((float)a1[i] * rsn * cw[bj][1][i]), 1.0f / 255.0f, 1.0f / 255.0f)), 1.0f); }
                    unsigned w0 = 0u, w1 = 0u;
                    w0 = __builtin_amdgcn_cvt_pk_u8_f32(v0[0], 0, w0); w0 = __builtin_amdgcn_cvt_pk_u8_f32(v0[1], 1, w0); w0 = __builtin_amdgcn_cvt_pk_u8_f32(v0[2], 2, w0); w0 = __builtin_amdgcn_cvt_pk_u8_f32(v0[3], 3, w0);
                    w1 = __builtin_amdgcn_cvt_pk_u8_f32(v1[0], 0, w1); w1 = __builtin_amdgcn_cvt_pk_u8_f32(v1[1], 1, w1); w1 = __builtin_amdgcn_cvt_pk_u8_f32(v1[2], 2, w1); w1 = __builtin_amdgcn_cvt_pk_u8_f32(v1[3], 3, w1);
                    *(u32x2g*)(base + (((ai * 4 + m) * 2 + bj) << 12)) = (u32x2g){w0, w1}; } }
    }
};
struct EpiPlain {
    static constexpr bool PERM = true, AFTER_DRAIN = false, MIDHOOK = false;
    bf16_t* O; int ldc;
    __device__ __forceinline__ void operator()(const f32x4 (&acc)[2][2][4][2], const Unit& u, int wr, int wc, int fr, int fq) const {
        int row0 = u.pm * BM + wr * 64 + fr, col0 = u.pn * BM + wc * 32 + 8 * fq; asm volatile("" : "+v"(row0));
#pragma unroll
        for (int ai = 0; ai < 2; ++ai)
#pragma unroll
            for (int m = 0; m < 4; ++m) { bf16_t* rowp = O + (size_t)(row0 + ai * HALF + m * 16) * ldc + col0;
#pragma unroll
                for (int bj = 0; bj < 2; ++bj) *(u32x4*)(rowp + bj * HALF) = pack8(acc[ai][bj][m][0], acc[ai][bj][m][1]); }
    }
};
struct TileOrder {
    int t, nNl;
    __device__ __forceinline__ bool next(int i, Unit& u) const { if (i >= nNl) return false; u.pm = t; u.pn = (t >> 4) * nNl + i; return true; }
    __device__ __forceinline__ void a_ready(const Unit&) const {}
    __device__ __forceinline__ void done(const Unit&) const {}
    __device__ __forceinline__ size_t a_off(const Unit&) const { return 0; }
};
struct TailOrder {
    int G, c, part;
    __device__ __forceinline__ bool next(int i, Unit& u) const { const int hG = G >> 1; const bool lo = c < hG; const int n = lo ? 1 : 3, nf = lo ? (c & 1) : (c & 3);
        const int idx = (part == 0) ? i : nf + i; if ((part == 0) ? (i >= nf) : (idx >= n)) return false;
        const int L = lo ? 3 * hG + c : (c - hG) + hG * idx; if (L >= 512) return false; u.pm = L >> 2; u.pn = L & 3; return true; }
    __device__ __forceinline__ void a_ready(const Unit&) const {}
    __device__ __forceinline__ void done(const Unit&) const {}
    __device__ __forceinline__ size_t a_off(const Unit&) const { return 0; }
};
struct MergeOrder {
    int G, c;
    __device__ __forceinline__ bool next(int i, Unit& u) const { const int tile = (i >> 2) * G + (c & 7) * (G >> 3) + (c >> 3); if (tile >= 512) return false; u.pm = tile >> 2; u.pn = (i & 3) * 4 + (tile & 3); return true; }
    __device__ __forceinline__ void a_ready(const Unit&) const {}
    __device__ __forceinline__ void done(const Unit&) const {}
    __device__ __forceinline__ size_t a_off(const Unit& u) const { return (size_t)(u.pn >> 2) * 256 * 2; }
};
struct EpiMergeHorner {
    static constexpr bool PERM = true, AFTER_DRAIN = false, MIDHOOK = true;
    static constexpr int NSTORE = 0;
    const bf16_t* gates; bf16_t* O; const __attribute__((address_space(3))) float* rrt; int pm0; int dry;
    typedef unsigned u32x2q __attribute__((ext_vector_type(2)));
    struct Carry { u32x2q g[4][2]; };
    __device__ __forceinline__ bool mut(f32x4 (&acc)[2][2][4][2], const Unit& u, int wr, int wc, int fr, int fq, Carry& cy) const {
        const int n = u.pn >> 2, pd = u.pn & 3;
        if (dry) return n != 3;
        int row0 = u.pm * BM + wr * 64 + fr, col0 = pd * BM + wc * 32 + 8 * fq; asm volatile("" : "+v"(row0));
        const unsigned char* gp0 = (const unsigned char*)gates + ((size_t)(u.pm * 16 + u.pn) << 16) + ((wr * 4 + wc) * 64 + fq * 16 + fr) * 8;
        u32x2q GA[2][4][2], GB[2][4][2];
#pragma unroll
        for (int ai = 0; ai < 2; ++ai)
#pragma unroll
            for (int m = 0; m < 4; ++m)
#pragma unroll
                for (int bj = 0; bj < 2; ++bj) { const unsigned char* gp = gp0 + (((ai * 4 + m) * 2 + bj) << 12);
                    if (ai == 0) GA[ai][m][bj] = (n == 0) ? *(const u32x2q*)gp : cy.g[m][bj];
                    else         GA[ai][m][bj] = *(const u32x2q*)gp;
                    GB[ai][m][bj] = (n != 3) ? *(const u32x2q*)(gp + (4 << 16)) : (u32x2q){0u, 0u}; }
        const __attribute__((address_space(3))) float* rt = rrt + ((u.pm != pm0) ? 512 : 0) + (wr * 64 + fr) * 2 + ((n == 0) ? 0 : 1);
#pragma unroll
        for (int ai = 0; ai < 2; ++ai)
#pragma unroll
            for (int m = 0; m < 4; ++m) { const size_t r = (size_t)(row0 + ai * HALF + m * 16);
                const float rs = (n < 2) ? rt[(ai * HALF + m * 16) * 2] : 1.0f;
#pragma unroll
                for (int bj = 0; bj < 2; ++bj) { const u32x2q ga = GA[ai][m][bj];
                    if (n == 3) {
                        f32x4 v0 = acc[ai][bj][m][0] * (1.0f / 255.0f), v1 = acc[ai][bj][m][1] * (1.0f / 255.0f);
                        v0[0] *= ub0(ga.x); v0[1] *= ub1(ga.x); v0[2] *= ub2(ga.x); v0[3] *= ub3(ga.x);
                        v1[0] *= ub0(ga.y); v1[1] *= ub1(ga.y); v1[2] *= ub2(ga.y); v1[3] *= ub3(ga.y);
                        *(u32x4*)(O + r * 1024 + col0 + bj * HALF) = pack8(v0, v1);
                    } else { const u32x2q gb = GB[ai][m][bj]; f32x4 r0, r1;
                        r0[0] = rs * ub0(ga.x) * __builtin_amdgcn_rcpf(ub0(gb.x)); r0[1] = rs * ub1(ga.x) * __builtin_amdgcn_rcpf(ub1(gb.x));
                        r0[2] = rs * ub2(ga.x) * __builtin_amdgcn_rcpf(ub2(gb.x)); r0[3] = rs * ub3(ga.x) * __builtin_amdgcn_rcpf(ub3(gb.x));
                        r1[0] = rs * ub0(ga.y) * __builtin_amdgcn_rcpf(ub0(gb.y)); r1[1] = rs * ub1(ga.y) * __builtin_amdgcn_rcpf(ub1(gb.y));
                        r1[2] = rs * ub2(ga.y) * __builtin_amdgcn_rcpf(ub2(gb.y)); r1[3] = rs * ub3(ga.y) * __builtin_amdgcn_rcpf(ub3(gb.y));
                        acc[ai][bj][m][0] = acc[ai][bj][m][0] * r0; acc[ai][bj][m][1] = acc[ai][bj][m][1] * r1; } } }
#pragma unroll
        for (int m = 0; m < 4; ++m)
#pragma unroll
            for (int bj = 0; bj < 2; ++bj) cy.g[m][bj] = GB[0][m][bj];
        return n != 3;
    }
};
struct EpiResid {
    static constexpr bool PERM = false, AFTER_DRAIN = false, MIDHOOK = false;
    const float* xin; float* xout; int dry;
    __device__ __forceinline__ void operator()(const f32x4 (&acc)[2][2][4][2], const Unit& u, int wr, int wc, int fr, int fq) const {
        if (dry) return;
        int row0 = u.pm * BM + wr * 64 + fr, col0 = u.pn * BM + wc * 32 + 4 * fq; asm volatile("" : "+v"(row0));
#pragma unroll
        for (int ai = 0; ai < 2; ++ai)
#pragma unroll
            for (int m = 0; m < 4; ++m) { const size_t off = (size_t)(row0 + ai * HALF + m * 16) * 1024 + col0;
#pragma unroll
                for (int bj = 0; bj < 2; ++bj)
#pragma unroll
                    for (int n = 0; n < 2; ++n) { const f32x4 b = *(const f32x4*)(xin + off + bj * HALF + n * 16); *(f32x4*)(xout + off + bj * HALF + n * 16) = b + acc[ai][bj][m][n]; } }
    }
};
struct EpiResidB {
    static constexpr bool PERM = true, AFTER_DRAIN = false, MIDHOOK = false;
    bf16_t* x; int dry;
    __device__ __forceinline__ void operator()(const f32x4 (&acc)[2][2][4][2], const Unit& u, int wr, int wc, int fr, int fq) const {
        if (dry) return;
        int row0 = u.pm * BM + wr * 64 + fr; asm volatile("" : "+v"(row0)); const int col0 = u.pn * BM + wc * 32 + 8 * fq;
        u32x4 XT[2][4][2];
#pragma unroll
        for (int ai = 0; ai < 2; ++ai)
#pragma unroll
            for (int m = 0; m < 4; ++m)
#pragma unroll
                for (int bj = 0; bj < 2; ++bj) XT[ai][m][bj] = *(const u32x4*)(x + (size_t)(row0 + ai * HALF + m * 16) * 1024 + col0 + bj * HALF);
        __builtin_amdgcn_sched_barrier(0);
#pragma unroll
        for (int ai = 0; ai < 2; ++ai)
#pragma unroll
            for (int m = 0; m < 4; ++m) { bf16_t* rowp = x + (size_t)(row0 + ai * HALF + m * 16) * 1024 + col0;
#pragma unroll
                for (int bj = 0; bj < 2; ++bj) { const u32x4 b = XT[ai][m][bj]; f32x4 r0, r1;
                    r0[0] = bf_lo(b.x) + acc[ai][bj][m][0][0]; r0[1] = bf_hi(b.x) + acc[ai][bj][m][0][1]; r0[2] = bf_lo(b.y) + acc[ai][bj][m][0][2]; r0[3] = bf_hi(b.y) + acc[ai][bj][m][0][3];
                    r1[0] = bf_lo(b.z) + acc[ai][bj][m][1][0]; r1[1] = bf_hi(b.z) + acc[ai][bj][m][1][1]; r1[2] = bf_lo(b.w) + acc[ai][bj][m][1][2]; r1[3] = bf_hi(b.w) + acc[ai][bj][m][1][3];
                    *(u32x4*)(rowp + bj * HALF) = pack8(r0, r1); } }
    }
};
struct EpiPle {
    static constexpr bool PERM = false, AFTER_DRAIN = false, MIDHOOK = false;
    float* x; const bf16_t* pl; int dry;
    __device__ __forceinline__ void operator()(const f32x4 (&acc)[2][2][4][2], const Unit& u, int wr, int wc, int fr, int fq) const {
        if (dry) return;
        typedef unsigned u32x2 __attribute__((ext_vector_type(2)));
        int row0 = u.pm * BM + wr * 64 + fr, col0 = u.pn * BM + wc * 32 + 4 * fq; asm volatile("" : "+v"(row0));
#pragma unroll
        for (int ai = 0; ai < 2; ++ai)
#pragma unroll
            for (int m = 0; m < 4; ++m) { const size_t off = (size_t)(row0 + ai * HALF + m * 16) * 1024 + col0;
#pragma unroll
                for (int bj = 0; bj < 2; ++bj)
#pragma unroll
                    for (int n = 0; n < 2; ++n) { const size_t o = off + bj * HALF + n * 16; const f32x4 b = *(const f32x4*)(x + o); const u32x2 pv = *(const u32x2*)(pl + o);
                        const f32x4 a = acc[ai][bj][m][n]; f32x4 r;
                        r[0] = b[0] + sigmoid_f(a[0]) * bf_lo(pv.x); r[1] = b[1] + sigmoid_f(a[1]) * bf_hi(pv.x);
                        r[2] = b[2] + sigmoid_f(a[2]) * bf_lo(pv.y); r[3] = b[3] + sigmoid_f(a[3]) * bf_hi(pv.y);
                        *(f32x4*)(x + o) = r; } }
    }
};
struct EpiPleI8 {
    static constexpr bool PERM = false, AFTER_DRAIN = false, MIDHOOK = false;
    float* x; const bf16_t* pl; const float* sa; const float* sw; int dry;
    __device__ __forceinline__ void operator()(const f32x4 (&acc)[2][2][4][2], const Unit& u, int wr, int wc, int fr, int fq) const {
        if (dry) return;
        typedef unsigned u32x2 __attribute__((ext_vector_type(2))); typedef int i32x4e __attribute__((ext_vector_type(4)));
        int row0 = u.pm * BM + wr * 64 + fr; asm volatile("" : "+v"(row0)); const int col0 = u.pn * BM + wc * 32 + 4 * fq;
        f32x4 cw[2][2];
#pragma unroll
        for (int bj = 0; bj < 2; ++bj)
#pragma unroll
            for (int n = 0; n < 2; ++n) cw[bj][n] = *(const f32x4*)(sw + col0 + bj * HALF + n * 16);
#pragma unroll
        for (int ai = 0; ai < 2; ++ai)
#pragma unroll
            for (int m = 0; m < 4; ++m) { const int r = row0 + ai * HALF + m * 16; const size_t off = (size_t)r * 1024 + col0; const float rsc = sa[r];
#pragma unroll
                for (int bj = 0; bj < 2; ++bj)
#pragma unroll
                    for (int n = 0; n < 2; ++n) { const size_t o = off + bj * HALF + n * 16; const f32x4 b = *(const f32x4*)(x + o); const u32x2 pv = *(const u32x2*)(pl + o);
                        const i32x4e ai4 = __builtin_bit_cast(i32x4e, acc[ai][bj][m][n]); f32x4 r4;
                        r4[0] = b[0] + sigmoid_f((float)ai4[0] * rsc * cw[bj][n][0]) * bf_lo(pv.x); r4[1] = b[1] + sigmoid_f((float)ai4[1] * rsc * cw[bj][n][1]) * bf_hi(pv.x);
                        r4[2] = b[2] + sigmoid_f((float)ai4[2] * rsc * cw[bj][n][2]) * bf_lo(pv.y); r4[3] = b[3] + sigmoid_f((float)ai4[3] * rsc * cw[bj][n][3]) * bf_hi(pv.y);
                        *(f32x4*)(x + o) = r4; } }
    }
};
struct EpiPleI8B {
    static constexpr bool PERM = true, AFTER_DRAIN = false, MIDHOOK = false;
    static constexpr int NSTORE = 16;
    bf16_t* x; const bf16_t* pl; const float* sa; const float* sw; int dry;
    __device__ __forceinline__ void operator()(const f32x4 (&acc)[2][2][4][2], const Unit& u, int wr, int wc, int fr, int fq) const {
        if (dry) return;
        typedef int i32x4e __attribute__((ext_vector_type(4)));
#define SG(t) __builtin_amdgcn_rcpf(1.0f + __builtin_amdgcn_exp2f(t))
        int row0 = u.pm * BM + wr * 64 + fr; asm volatile("" : "+v"(row0)); int col0 = u.pn * BM + wc * 32 + 8 * fq; asm volatile("" : "+v"(col0));
        f32x4 cw[2][2];
#pragma unroll
        for (int bj = 0; bj < 2; ++bj)
#pragma unroll
            for (int n = 0; n < 2; ++n) cw[bj][n] = *(const f32x4*)(sw + col0 + bj * HALF + n * 4);
#pragma unroll
        for (int ai = 0; ai < 2; ++ai)
#pragma unroll
        for (int mh = 0; mh < 2; ++mh) {
            u32x4 XT[2][2], PT[2][2]; float RS[2];
#pragma unroll
            for (int mm = 0; mm < 2; ++mm) { const int m = 2 * mh + mm; const int r = row0 + ai * HALF + m * 16; const size_t off = (size_t)r * 1024 + col0; RS[mm] = sa[r];
#pragma unroll
                for (int bj = 0; bj < 2; ++bj) { XT[mm][bj] = *(const u32x4*)(x + off + bj * HALF); PT[mm][bj] = *(const u32x4*)(pl + off + bj * HALF); } }
            __builtin_amdgcn_sched_barrier(0);
#pragma unroll
            for (int mm = 0; mm < 2; ++mm) { const int m = 2 * mh + mm; const int r = row0 + ai * HALF + m * 16; const size_t off = (size_t)r * 1024 + col0; const float rsc = RS[mm] * -1.4426950408889634f;
#pragma unroll
                for (int bj = 0; bj < 2; ++bj) { const u32x4 b = XT[mm][bj]; const u32x4 pv = PT[mm][bj];
                    const i32x4e a0 = __builtin_bit_cast(i32x4e, acc[ai][bj][m][0]), a1 = __builtin_bit_cast(i32x4e, acc[ai][bj][m][1]); f32x4 r0, r1;
                    r0[0] = bf_lo(b.x) + SG((float)a0[0] * rsc * cw[bj][0][0]) * bf_lo(pv.x); r0[1] = bf_hi(b.x) + SG((float)a0[1] * rsc * cw[bj][0][1]) * bf_hi(pv.x);
                    r0[2] = bf_lo(b.y) + SG((float)a0[2] * rsc * cw[bj][0][2]) * bf_lo(pv.y); r0[3] = bf_hi(b.y) + SG((float)a0[3] * rsc * cw[bj][0][3]) * bf_hi(pv.y);
                    r1[0] = bf_lo(b.z) + SG((float)a1[0] * rsc * cw[bj][1][0]) * bf_lo(pv.z); r1[1] = bf_hi(b.z) + SG((float)a1[1] * rsc * cw[bj][1][1]) * bf_hi(pv.z);
                    r1[2] = bf_lo(b.w) + SG((float)a1[2] * rsc * cw[bj][1][2]) * bf_lo(pv.w); r1[3] = bf_hi(b.w) + SG((float)a1[3] * rsc * cw[bj][1][3]) * bf_hi(pv.w);
                    *(u32x4*)(x + off + bj * HALF) = pack8(r0, r1); } }
            __builtin_amdgcn_sched_barrier(0);
        }
    }
};
#undef SG
struct EpiGU {
    static constexpr bool PERM = true, AFTER_DRAIN = false, MIDHOOK = false;
    bf16_t* hid; int dry; float wscale;
    __device__ __forceinline__ void operator()(const f32x4 (&acc)[2][2][4][2], const Unit& u, int wr, int wc, int fr, int fq) const {
        if (dry) return;
        int row0 = u.pm * BM + wr * 64 + fr, col0 = (u.pn & 7) * 128 + wc * 32 + 8 * fq; asm volatile("" : "+v"(row0));
#pragma unroll
        for (int ai = 0; ai < 2; ++ai)
#pragma unroll
            for (int m = 0; m < 4; ++m) { f32x4 v0, v1; const f32x4 g0 = acc[ai][0][m][0] * wscale, g1 = acc[ai][0][m][1] * wscale, u0 = acc[ai][1][m][0] * wscale, u1 = acc[ai][1][m][1] * wscale;
#pragma unroll
                for (int i = 0; i < 4; ++i) { v0[i] = g0[i] * sigmoid_f(g0[i]) * u0[i]; v1[i] = g1[i] * sigmoid_f(g1[i]) * u1[i]; }
                *(u32x4*)(hid + (size_t)(row0 + ai * HALF + m * 16) * 1024 + col0) = pack8(v0, v1); }
    }
};
struct EpiGU8 {
    static constexpr bool PERM = true, AFTER_DRAIN = false, MIDHOOK = false;
    unsigned char* hid; int dry;
    __device__ __forceinline__ void operator()(const f32x4 (&acc)[2][2][4][2], const Unit& u, int wr, int wc, int fr, int fq) const {
        if (dry == 1) return;
        typedef unsigned u32x2h __attribute__((ext_vector_type(2)));
        int row0 = u.pm * BM + wr * 64 + fr; asm volatile("" : "+v"(row0)); const int col0 = (u.pn & 7) * 128 + wc * 32 + 8 * fq;
#pragma unroll
        for (int ai = 0; ai < 2; ++ai)
#pragma unroll
            for (int m = 0; m < 4; ++m) { f32x4 v0, v1; const f32x4 g0 = acc[ai][0][m][0] * 0.03125f, g1 = acc[ai][0][m][1] * 0.03125f, u0 = acc[ai][1][m][0] * 0.03125f, u1 = acc[ai][1][m][1] * 0.03125f;
#pragma unroll
                for (int i = 0; i < 4; ++i) { v0[i] = g0[i] * sigmoid_f(g0[i]) * u0[i]; v1[i] = g1[i] * sigmoid_f(g1[i]) * u1[i]; }
                int w0 = 0, w1 = 0;
                w0 = __builtin_amdgcn_cvt_pk_fp8_f32(v0[0], v0[1], w0, false); w0 = __builtin_amdgcn_cvt_pk_fp8_f32(v0[2], v0[3], w0, true);
                w1 = __builtin_amdgcn_cvt_pk_fp8_f32(v1[0], v1[1], w1, false); w1 = __builtin_amdgcn_cvt_pk_fp8_f32(v1[2], v1[3], w1, true);
                if (dry != 2 || row0 < -5) *(u32x2h*)(hid + (size_t)(row0 + ai * HALF + m * 16) * 1024 + col0) = (u32x2h){(unsigned)w0, (unsigned)w1}; }
    }
};
struct EpiDNP {
    static constexpr bool PERM = true, AFTER_DRAIN = false, MIDHOOK = false;
    bf16_t* ye; int dry;
    __device__ __forceinline__ void operator()(const f32x4 (&acc)[2][2][4][2], const Unit& u, int wr, int wc, int fr, int fq) const {
        if (dry == 1) return;
        int row0 = u.pm * BM + wr * 64 + fr; asm volatile("" : "+v"(row0)); const int col0 = (u.pn & 3) * BM + wc * 32 + 8 * fq;
#pragma unroll
        for (int ai = 0; ai < 2; ++ai)
#pragma unroll
            for (int m = 0; m < 4; ++m) { bf16_t* rowp = ye + (size_t)(row0 + ai * HALF + m * 16) * 1024 + col0;
#pragma unroll
                for (int bj = 0; bj < 2; ++bj) if (dry != 2 || row0 < -5) *(u32x4*)(rowp + bj * HALF) = pack8(acc[ai][bj][m][0], acc[ai][bj][m][1]); }
    }
};
struct EpiDNP8 {
    static constexpr bool PERM = true, AFTER_DRAIN = false, MIDHOOK = false;
    unsigned char* ye; int dry;
    __device__ __forceinline__ void operator()(const f32x4 (&acc)[2][2][4][2], const Unit& u, int wr, int wc, int fr, int fq) const {
        if (dry == 1) return;
        typedef unsigned u32x2h __attribute__((ext_vector_type(2)));
        int row0 = u.pm * BM + wr * 64 + fr; asm volatile("" : "+v"(row0)); const int col0 = (u.pn & 3) * BM + wc * 32 + 8 * fq;
#pragma unroll
        for (int ai = 0; ai < 2; ++ai)
#pragma unroll
            for (int m = 0; m < 4; ++m) { unsigned char* rowp = ye + (size_t)(row0 + ai * HALF + m * 16) * 1024 + col0;
#pragma unroll
                for (int bj = 0; bj < 2; ++bj) { const f32x4 v0 = acc[ai][bj][m][0] * 0.125f, v1 = acc[ai][bj][m][1] * 0.125f; int w0 = 0, w1 = 0;
                    w0 = __builtin_amdgcn_cvt_pk_fp8_f32(v0[0], v0[1], w0, false); w0 = __builtin_amdgcn_cvt_pk_fp8_f32(v0[2], v0[3], w0, true);
                    w1 = __builtin_amdgcn_cvt_pk_fp8_f32(v1[0], v1[1], w1, false); w1 = __builtin_amdgcn_cvt_pk_fp8_f32(v1[2], v1[3], w1, true);
                    if (dry != 2 || row0 < -5) *(u32x2h*)(rowp + bj * HALF) = (u32x2h){(unsigned)w0, (unsigned)w1}; } }
    }
};
struct EpiDN {
    static constexpr bool PERM = true, AFTER_DRAIN = false, MIDHOOK = false;
    bf16_t* ye; const float* aff; int dry; float wscale;
    __device__ __forceinline__ void operator()(const f32x4 (&acc)[2][2][4][2], const Unit& u, int wr, int wc, int fr, int fq) const {
        if (dry) return;
        int row0 = u.pm * BM + wr * 64 + fr, col0 = (u.pn & 3) * BM + wc * 32 + 8 * fq; asm volatile("" : "+v"(row0));
#pragma unroll
        for (int ai = 0; ai < 2; ++ai)
#pragma unroll
            for (int m = 0; m < 4; ++m) { const size_t r = (size_t)(row0 + ai * HALF + m * 16); const float a = aff[r] * wscale;
#pragma unroll
                for (int bj = 0; bj < 2; ++bj) *(u32x4*)(ye + r * 1024 + col0 + bj * HALF) = pack8(acc[ai][bj][m][0] * a, acc[ai][bj][m][1] * a); }
    }
};
struct NoCarry {};
template <class E, bool M = E::MIDHOOK> struct CarryOf { typedef NoCarry type; };
template <class E> struct CarryOf<E, true> { typedef typename E::Carry type; };
template <class Epi, class Sched, bool ALIGN_EPI = false, bool SP2 = false, bool GATHER = false, bool F8 = false, bool I8 = false, int PADN = 0>
__device__ __forceinline__ void gemm_phase(PG8_LAS unsigned char* lds, const Gemm g, const Sched& S, const Epi& E, const int tid, const PG8_LAS unsigned* gtab = nullptr) {
    typedef int i32x4q __attribute__((ext_vector_type(4)));
    static_assert(!GATHER || SP2, "GATHER is wired into the SP2 loop only");
    const int wid = __builtin_amdgcn_readfirstlane(tid >> 6), lane = tid & 63, wr = wid >> 2, wc = wid & 3, fr = lane & 15, fq = lane >> 4;
    int K = g.K; asm volatile("" : "+s"(K));
    const int nt = K / BK; const int lda = g.lda ? g.lda : K;
    unsigned voffA[2], voffB[2]; int gR[2]; unsigned gC[2];
#pragma unroll
    for (int i = 0; i < 2; ++i) { int R, C; stage_rc(tid * 16 + i * 8192, R, C); const int Rb = Epi::PERM ? ((R & ~31) + perm32(R & 31)) : R;
        voffA[i] = (unsigned)(R * lda + C) * 2u; voffB[i] = (unsigned)(Rb * K + C) * 2u; gR[i] = R; gC[i] = (unsigned)C * 2u; }
    unsigned cvo[2][2] = {{0u, 0u}, {0u, 0u}};
#define PG8_GLOAD(vo, uidx) do { _Pragma("unroll") for (int h_ = 0; h_ < 2; ++h_) _Pragma("unroll") for (int i_ = 0; i_ < 2; ++i_) vo[h_][i_] = gtab[(uidx) * 256 + h_ * 128 + gR[i_]] + gC[i_]; } while (0)
#define PG8_STA0(bufoff, gbase, h) do { unsigned vs_[2]; if constexpr (GATHER) { vs_[0] = cvo[h][0]; vs_[1] = cvo[h][1]; } else { vs_[0] = voffA[0]; vs_[1] = voffA[1]; } PG8_STAGE(bufoff, gbase, vs_); } while (0)
#define PG8_STAN(bufoff, gbase, h) do { unsigned vs_[2]; if constexpr (GATHER) { const int nu_ = has_next ? ui + 1 : ui; vs_[0] = last ? gtab[nu_ * 256 + (h) * 128 + gR[0]] + gC[0] : cvo[h][0]; vs_[1] = last ? gtab[nu_ * 256 + (h) * 128 + gR[1]] + gC[1] : cvo[h][1]; } else { vs_[0] = voffA[0]; vs_[1] = voffA[1]; } PG8_STAGE(bufoff, gbase, vs_); } while (0)
    const size_t kstep = (size_t)(BK * 2);
    const size_t hstep = (size_t)HALF * K * 2;
    const size_t tstep = 2 * hstep;
    const size_t hstepA = GATHER ? 0 : (size_t)HALF * lda * 2, tstepA = 2 * hstepA;
    const unsigned ldsw = (unsigned)wid * 1024u;
    const int aoff = lds_byte(wr * 64 + fr, fq * 8), boff = lds_byte(wc * 32 + fr, fq * 8);
#define PG8_SA(b, h) (((b) * 2 + (h)) * HTB)
#define PG8_SB(b, h) ((4 + (b) * 2 + (h)) * HTB)
#define PG8_STAGE(bufoff, gbase, voff) do { _Pragma("unroll") for (int _i = 0; _i < 2; ++_i) \
        __builtin_amdgcn_global_load_lds((const unsigned*)((const char*)(gbase) + (voff)[_i]), (PG8_LAS unsigned*)(lds + (bufoff) + ldsw + _i * 8192), 16, 0, 0); } while (0)
#define PG8_LD32(p) __builtin_shufflevector(*(const PG8_LAS i32x4q*)(p), *(const PG8_LAS i32x4q*)((p) + 1024), 0, 1, 2, 3, 4, 5, 6, 7)
#define PG8_LDA(dst, b, h) do { _Pragma("unroll") for (int m = 0; m < 4; ++m) { if constexpr (F8) dst##8[m] = PG8_LD32(lds + PG8_SA(b, h) + aoff + m * 2048); else { _Pragma("unroll") for (int k = 0; k < 2; ++k) dst[m][k] = *(const PG8_LAS bf16x8*)(lds + PG8_SA(b, h) + aoff + m * 2048 + k * 1024); } } } while (0)
#define PG8_LDB(dst, b, h) do { _Pragma("unroll") for (int n = 0; n < 2; ++n) { if constexpr (F8) dst##8[n] = PG8_LD32(lds + PG8_SB(b, h) + boff + n * 2048); else { _Pragma("unroll") for (int k = 0; k < 2; ++k) dst[n][k] = *(const PG8_LAS bf16x8*)(lds + PG8_SB(b, h) + boff + n * 2048 + k * 1024); } } } while (0)
#define PG8_MMA(ai, bj, At, Bt) do { __builtin_amdgcn_s_setprio(1); _Pragma("unroll") for (int m = 0; m < 4; ++m) _Pragma("unroll") for (int n = 0; n < 2; ++n) { \
        if constexpr (F8) acc[ai][bj][m][n] = __builtin_amdgcn_mfma_scale_f32_16x16x128_f8f6f4(Bt##8[n], At##8[m], acc[ai][bj][m][n], 0, 0, 0, 0, 0, 0); \
        else if constexpr (I8) { _Pragma("unroll") for (int k = 0; k < 2; ++k) acc[ai][bj][m][n] = __builtin_bit_cast(f32x4, __builtin_amdgcn_mfma_i32_16x16x64_i8(__builtin_bit_cast(i32x4q, Bt[n][k]), __builtin_bit_cast(i32x4q, At[m][k]), __builtin_bit_cast(i32x4q, acc[ai][bj][m][n]), 0, 0, 0)); } \
        else { _Pragma("unroll") for (int k = 0; k < 2; ++k) acc[ai][bj][m][n] = __builtin_amdgcn_mfma_f32_16x16x32_bf16(Bt[n][k], At[m][k], acc[ai][bj][m][n], 0, 0, 0); } } \
        __builtin_amdgcn_s_setprio(0); } while (0)
#define PG8_WAIT_V(n) asm volatile("s_waitcnt vmcnt(" #n ")" ::: "memory")
#define PG8_WAIT_L(n) asm volatile("s_waitcnt lgkmcnt(" #n ")" ::: "memory")
#define PG8_BAR __builtin_amdgcn_s_barrier()
#define PG8_SCHED __builtin_amdgcn_sched_barrier(0)
    Unit cur, nxt; int ui = 0;
    if (!S.next(0, cur)) return;
    f32x4 acc[2][2][4][2];
#pragma unroll
    for (int a = 0; a < 2; ++a)
#pragma unroll
        for (int b = 0; b < 2; ++b)
#pragma unroll
            for (int m = 0; m < 4; ++m)
#pragma unroll
                for (int n = 0; n < 2; ++n) acc[a][b][m][n] = (f32x4){0.f, 0.f, 0.f, 0.f};
    typename CarryOf<Epi>::type carry;
    bf16x8 At[4][2], B0[2][2], B1[2][2];
    typedef int i32x8q __attribute__((ext_vector_type(8))); i32x8q At8[4], B08[2], B18[2];
    const char* cA = (const char*)g.A + (size_t)cur.pm * tstepA + S.a_off(cur); if constexpr (GATHER) PG8_GLOAD(cvo, 0);
    const char* cB = (const char*)g.Bt + (size_t)cur.pn * tstep;
    S.a_ready(cur);
    if constexpr (SP2) {
        PG8_STAGE(PG8_SB(0, 0), cB, voffB); PG8_STAGE(PG8_SB(0, 1), cB + hstep, voffB); PG8_STA0(PG8_SA(0, 0), cA, 0); PG8_STA0(PG8_SA(0, 1), cA + hstepA, 1);
        if (wr == 1) PG8_BAR;
        PG8_WAIT_V(2); PG8_BAR;
        PG8_STAGE(PG8_SB(1, 0), cB + kstep, voffB); PG8_STA0(PG8_SA(1, 0), cA + kstep, 0); PG8_STAGE(PG8_SB(1, 1), cB + hstep + kstep, voffB);
        PG8_WAIT_V(6); PG8_BAR;
    } else {
        PG8_STAGE(PG8_SB(0, 0), cB, voffB); PG8_STAGE(PG8_SA(0, 0), cA, voffA); PG8_STAGE(PG8_SB(0, 1), cB + hstep, voffB); PG8_STAGE(PG8_SA(0, 1), cA + hstepA, voffA);
        if (wr == 1) PG8_BAR;
        PG8_WAIT_V(4); PG8_BAR;
        PG8_STAGE(PG8_SB(1, 0), cB + kstep, voffB); PG8_STAGE(PG8_SA(1, 0), cA + kstep, voffA); PG8_STAGE(PG8_SB(1, 1), cB + hstep + kstep, voffB);
        PG8_WAIT_V(6); PG8_BAR;
    }
    for (;;) {
        const bool has_next = S.next(ui + 1, nxt);
        const char* nA = has_next ? (const char*)g.A + (size_t)nxt.pm * tstepA + S.a_off(nxt) : cA; const char* nB = has_next ? (const char*)g.Bt + (size_t)nxt.pn * tstep : cB;
        asm volatile(".p2align 6\n\t.rept %c0\n\ts_nop 0\n\t.endr" :: "i"(PADN) : "memory");
        for (int t = 0; t < nt; t += 2) {
            const bool last = (t == nt - 2);
            const char* a1 = cA + (size_t)(t + 1) * kstep;
            const char* a2 = last ? nA : cA + (size_t)(t + 2) * kstep; const char* b2 = last ? nB : cB + (size_t)(t + 2) * kstep;
            const char* a3 = a2 + kstep; const char* b3 = b2 + kstep;
            if (last && has_next) S.a_ready(nxt);
            if constexpr (SP2) {
            PG8_LDB(B0, 0, 0); PG8_LDB(B1, 0, 1); PG8_SCHED; PG8_LDA(At, 0, 0); PG8_STA0(PG8_SA(1, 1), a1 + hstepA, 1);
            PG8_WAIT_V(8); PG8_WAIT_L(0); PG8_BAR; PG8_MMA(0, 0, At, B0); PG8_MMA(0, 1, At, B1); PG8_BAR; PG8_SCHED;
            PG8_LDA(At, 0, 1); PG8_STAGE(PG8_SB(0, 0), b2, voffB); PG8_STAGE(PG8_SB(0, 1), b2 + hstep, voffB); PG8_STAN(PG8_SA(0, 0), a2, 0);
            PG8_WAIT_V(8); PG8_WAIT_L(0); PG8_BAR; PG8_MMA(1, 0, At, B0); PG8_MMA(1, 1, At, B1); PG8_BAR; PG8_SCHED;
            PG8_LDB(B0, 1, 0); PG8_LDB(B1, 1, 1); PG8_SCHED; PG8_LDA(At, 1, 0); PG8_STAN(PG8_SA(0, 1), a2 + hstepA, 1);
            PG8_WAIT_V(8); PG8_WAIT_L(0); PG8_BAR; PG8_MMA(0, 0, At, B0); PG8_MMA(0, 1, At, B1); PG8_BAR; PG8_SCHED;
            PG8_LDA(At, 1, 1); PG8_STAGE(PG8_SB(1, 0), b3, voffB); PG8_STAGE(PG8_SB(1, 1), b3 + hstep, voffB); PG8_STAN(PG8_SA(1, 0), a3, 0);
            PG8_WAIT_V(8); PG8_WAIT_L(0); PG8_BAR; PG8_MMA(1, 0, At, B0); PG8_MMA(1, 1, At, B1); PG8_BAR; PG8_SCHED;
            } else {
            PG8_LDB(B0, 0, 0); PG8_SCHED; PG8_LDA(At, 0, 0); PG8_STAGE(PG8_SA(1, 1), a1 + hstepA, voffA);
            PG8_WAIT_L(8); PG8_BAR; PG8_WAIT_L(0); PG8_MMA(0, 0, At, B0); PG8_BAR; PG8_SCHED;
            PG8_LDB(B1, 0, 1); PG8_STAGE(PG8_SB(0, 0), b2, voffB);
            PG8_BAR; PG8_WAIT_L(0); PG8_MMA(0, 1, At, B1); PG8_BAR;
            PG8_LDA(At, 0, 1); PG8_STAGE(PG8_SA(0, 0), a2, voffA);
            PG8_BAR; PG8_WAIT_L(0); PG8_MMA(1, 0, At, B0); PG8_BAR; PG8_SCHED;
            PG8_STAGE(PG8_SB(0, 1), b2 + hstep, voffB);
            PG8_WAIT_V(6); PG8_BAR; PG8_MMA(1, 1, At, B1); PG8_BAR;
            PG8_LDB(B0, 1, 0); PG8_SCHED; PG8_LDA(At, 1, 0); PG8_STAGE(PG8_SA(0, 1), a2 + hstepA, voffA);
            PG8_WAIT_L(8); PG8_BAR; PG8_WAIT_L(0); PG8_MMA(0, 0, At, B0); PG8_BAR; PG8_SCHED;
            PG8_LDB(B1, 1, 1); PG8_STAGE(PG8_SB(1, 0), b3, voffB);
            PG8_BAR; PG8_WAIT_L(0); PG8_MMA(0, 1, At, B1); PG8_BAR;
            PG8_LDA(At, 1, 1); PG8_STAGE(PG8_SA(1, 0), a3, voffA);
            PG8_BAR; PG8_WAIT_L(0); PG8_MMA(1, 0, At, B0); PG8_BAR; PG8_SCHED;
            PG8_STAGE(PG8_SB(1, 1), b3 + hstep, voffB);
            PG8_WAIT_V(6); PG8_BAR; PG8_MMA(1, 1, At, B1); PG8_BAR;
            }
        }
        if constexpr (ALIGN_EPI) { if (wr == 0) PG8_BAR; }
        bool keep_acc = false;
        if constexpr (Epi::MIDHOOK) { keep_acc = E.mut(acc, cur, wr, wc, fr, fq, carry); S.done(cur); }
        else if constexpr (!Epi::AFTER_DRAIN) { E(acc, cur, wr, wc, fr, fq); S.done(cur); }
        if (!has_next) break;
        if (!keep_acc)
#pragma unroll
        for (int a = 0; a < 2; ++a)
#pragma unroll
            for (int b = 0; b < 2; ++b)
#pragma unroll
                for (int m = 0; m < 4; ++m)
#pragma unroll
                    for (int n = 0; n < 2; ++n) acc[a][b][m][n] = (f32x4){0.f, 0.f, 0.f, 0.f};
        cur = nxt; cA = nA; cB = nB; ++ui;
        if constexpr (GATHER) PG8_GLOAD(cvo, ui);
        if constexpr (ALIGN_EPI) { if (wr == 1) PG8_BAR; }
    }
    PG8_WAIT_V(0);
    if constexpr (!ALIGN_EPI) { if (wr == 0) PG8_BAR; }
    PG8_BAR;
    if constexpr (Epi::AFTER_DRAIN) { E.fused(acc, cur, wr, wc, fr, fq, lds, wid, lane); S.done(cur); }
#undef PG8_SA
#undef PG8_SB
#undef PG8_STAGE
#undef PG8_GLOAD
#undef PG8_STA0
#undef PG8_STAN
#undef PG8_LDA
#undef PG8_LDB
#undef PG8_MMA
#undef PG8_LD32
#undef PG8_WAIT_V
#undef PG8_WAIT_L
#undef PG8_BAR
#undef PG8_SCHED
}
}
namespace attn_body {
using bf16=__hip_bfloat16;
using bf16x8=__attribute__((ext_vector_type(8)))short;
using s16x4=__attribute__((ext_vector_type(4)))short;
using f32x16=__attribute__((ext_vector_type(16)))float;
using u32x4=__attribute__((ext_vector_type(4)))unsigned;
using f32x4a=__attribute__((ext_vector_type(4)))float;
constexpr int SEQ=16384,D=64,LDP=2816,LDO=1024;
constexpr int NW=8,QBLK=32,KVBLK=64,NT=SEQ/KVBLK;
__device__ __forceinline__ int crow(int r,int hi){return (r&3)+8*(r>>2)+4*hi;}
#define SBAR() __builtin_amdgcn_sched_barrier(0)
constexpr int NSLOT=3, SLOTB=8192;
constexpr int LDS_K=0, LDS_V=NSLOT*SLOTB, LDS_WS=2*NSLOT*SLOTB, LDS_OST=LDS_WS+NW*64*4, LDS_TAB=LDS_OST+65536, LDS_RED=LDS_TAB+640*4, LDS_BYTES=LDS_RED+64*4;
constexpr float LOG2E=1.4426950408889634f;
constexpr int PAD_AF=6,PAD_AS=0,PAD_CF=13,PAD_CS=4;
__device__ __forceinline__ void glds16(const void*gsrc,unsigned lds_dst){unsigned keep;
  asm volatile("s_mov_b32 %0, m0\n\ts_mov_b32 m0, %2\n\ts_nop 0\n\tglobal_load_lds_dwordx4 %1, off\n\ts_mov_b32 m0, %0":"=&s"(keep):"v"(gsrc),"s"(lds_dst):"memory");}
__device__ __forceinline__ float max3f(float a,float b,float c){float r;asm("v_max3_f32 %0, %1, %2, %3":"=v"(r):"v"(a),"v"(b),"v"(c));return r;}
__device__ __forceinline__ float max2f(float a,float b){float r;asm("v_max_f32_e32 %0, %1, %2":"=v"(r):"v"(a),"v"(b));return r;}
__device__ __forceinline__ float fadd_s(float a,float b){float r;asm("v_add_f32_e32 %0, %1, %2":"=v"(r):"v"(a),"v"(b));return r;}
__device__ __forceinline__ float fsub_s(float a,float b){float r;asm("v_sub_f32_e32 %0, %1, %2":"=v"(r):"v"(a),"v"(b));return r;}
typedef float f32x2_t __attribute__((ext_vector_type(2))); typedef __bf16 bf16x2_t __attribute__((ext_vector_type(2)));
__device__ __forceinline__ unsigned cvtpk_s(float lo,float hi){f32x2_t v={lo,hi};bf16x2_t b=__builtin_convertvector(v,bf16x2_t);return __builtin_bit_cast(unsigned,b);}
#define WAIT_BAR(N) asm volatile("s_waitcnt vmcnt(" #N ") lgkmcnt(0)\n\ts_barrier":::"memory")

template<int ND> __device__ __forceinline__ void qkt(f32x16&p0,f32x16&p1,const char*Kslot,const bf16x8*qr,const f32x16&negm,int r32,int hi){
  const char*kb=Kslot+hi*1024+r32*16;
  #pragma unroll
  for(int d0=0;d0<ND;++d0){
    const bf16x8 b0=*reinterpret_cast<const bf16x8*>(kb+d0*2048);
    const bf16x8 b1=*reinterpret_cast<const bf16x8*>(kb+d0*2048+512);
    if(d0==0){p0=__builtin_amdgcn_mfma_f32_32x32x16_bf16(b0,qr[0],negm,0,0,0);p1=__builtin_amdgcn_mfma_f32_32x32x16_bf16(b1,qr[0],negm,0,0,0);}
    else{p0=__builtin_amdgcn_mfma_f32_32x32x16_bf16(b0,qr[d0],p0,0,0,0);p1=__builtin_amdgcn_mfma_f32_32x32x16_bf16(b1,qr[d0],p1,0,0,0);}}
}
typedef __attribute__((address_space(3))) const char* lds_cptr;
typedef __attribute__((address_space(3))) const float* lds_fptr;
typedef short v4i16_t __attribute__((ext_vector_type(4)));
__device__ __forceinline__ void kload8(bf16x8*kf,lds_cptr kp){
  kf[0]=*(const __attribute__((address_space(3))) bf16x8*)(kp);      kf[1]=*(const __attribute__((address_space(3))) bf16x8*)(kp+512);
  kf[2]=*(const __attribute__((address_space(3))) bf16x8*)(kp+2048); kf[3]=*(const __attribute__((address_space(3))) bf16x8*)(kp+2560);
  kf[4]=*(const __attribute__((address_space(3))) bf16x8*)(kp+4096); kf[5]=*(const __attribute__((address_space(3))) bf16x8*)(kp+4608);
  kf[6]=*(const __attribute__((address_space(3))) bf16x8*)(kp+6144); kf[7]=*(const __attribute__((address_space(3))) bf16x8*)(kp+6656);
}
__device__ __forceinline__ void kload2(bf16x8*kf,lds_cptr kp,int j){ kf[2*j]=*(const __attribute__((address_space(3))) bf16x8*)(kp+j*2048); kf[2*j+1]=*(const __attribute__((address_space(3))) bf16x8*)(kp+j*2048+512); }
__device__ __forceinline__ s16x4 vtr(lds_cptr p){ return __builtin_bit_cast(s16x4,__builtin_amdgcn_ds_read_tr16_b64_v4i16((__attribute__((address_space(3))) v4i16_t*)p)); }
__device__ __forceinline__ float rowmax(const f32x16&p0,const f32x16&p1){
  float a=max3f(p0[0],p0[1],p1[0]),b=max3f(p0[2],p0[3],p1[1]);a=max3f(a,p1[2],p1[3]);
  #pragma unroll
  for(int r=4;r<16;r+=4){a=max3f(a,p0[r],p0[r+1]);b=max3f(b,p0[r+2],p0[r+3]);a=max3f(a,p1[r],p1[r+1]);b=max3f(b,p1[r+2],p1[r+3]);}
  const float m=max2f(a,b);
  auto rr=__builtin_amdgcn_permlane32_swap(__float_as_uint(m),__float_as_uint(m),false,false);
  return max2f(__uint_as_float(rr[0]),__uint_as_float(rr[1]));
}
__device__ __forceinline__ void pv(f32x16*o,int vb,bf16x8 pa0,bf16x8 pa1,bf16x8 pa2,bf16x8 pa3){
  #pragma unroll
  for(int d0=0;d0<2;++d0){s16x4 lo[4],hi[4];
    #pragma unroll
    for(int ks=0;ks<4;++ks){
      asm volatile("ds_read_b64_tr_b16 %0,%1 offset:%c2":"=&v"(lo[ks]):"v"(vb),"i"(d0*4096+ks*1024):"memory");
      asm volatile("ds_read_b64_tr_b16 %0,%1 offset:%c2":"=&v"(hi[ks]):"v"(vb),"i"(d0*4096+ks*1024+512):"memory");}
    asm volatile("s_waitcnt lgkmcnt(0)":::"memory");SBAR();
    #define PK(k) (bf16x8){lo[k][0],lo[k][1],lo[k][2],lo[k][3],hi[k][0],hi[k][1],hi[k][2],hi[k][3]}
    o[d0]=__builtin_amdgcn_mfma_f32_32x32x16_bf16(pa0,PK(0),o[d0],0,0,0);
    o[d0]=__builtin_amdgcn_mfma_f32_32x32x16_bf16(pa1,PK(1),o[d0],0,0,0);
    o[d0]=__builtin_amdgcn_mfma_f32_32x32x16_bf16(pa2,PK(2),o[d0],0,0,0);
    o[d0]=__builtin_amdgcn_mfma_f32_32x32x16_bf16(pa3,PK(3),o[d0],0,0,0);
    #undef PK
  }
}
__device__ __forceinline__ int t5_bucket(int rel){
  const int r=rel<0?-rel:rel; int v;
  if(r<8)v=r; else if(r<12)v=8; else if(r<16)v=9; else if(r<23)v=10; else if(r<32)v=11; else if(r<46)v=12; else if(r<64)v=13; else if(r<91)v=14; else v=15;
  return (rel>0?16:0)+v;
}

#ifndef ATTN_STORE16
#define ATTN_STORE16(p,v) (*(u32x4*)(p)=(v))
#endif
template<bool CM> __device__ __forceinline__ float attn_qnorm2(const bf16*Qb,int q0,int wid,int r32,int hi){
  const int wrow=CM?(wid&3)*QBLK:wid*QBLK; const int map=wid>>2; const bf16*Qw=Qb+(long)(q0+wrow)*LDP; float s=0.f;
  #pragma unroll
  for(int d0=0;d0<(CM?2:4);++d0){ const bf16x8 q=*reinterpret_cast<const bf16x8*>(&Qw[(long)r32*LDP+(CM?map*32:0)+d0*16+hi*8]);
    #pragma unroll
    for(int i=0;i<8;++i){ const float f=__uint_as_float((unsigned)(unsigned short)q[i]<<16); s+=f*f; } }
  auto rr=__builtin_amdgcn_permlane32_swap(__float_as_uint(s),__float_as_uint(s),false,false); return __uint_as_float(rr[0])+__uint_as_float(rr[1]);
}
template<bool CM> __device__ __forceinline__ bool attn_bound(const bf16*Qb,int q0,char*shm,const float*kmaxp,float bmax,const int tid){
  const int lane=tid&63,r32=lane&31,hi=lane>>5; const int wid=__builtin_amdgcn_readfirstlane(tid>>6);
  float*red=(float*)(shm+LDS_RED);
  float km=kmaxp[32*(tid&255)+(CM?(tid>>8):0)];
  #pragma unroll
  for(int o=1;o<64;o<<=1)km=fmaxf(km,__shfl_xor(km,o));
  if(lane==0)red[wid]=km;
  const float qn2=attn_qnorm2<CM>(Qb,q0,wid,r32,hi);
  asm volatile("s_waitcnt lgkmcnt(0)\n\ts_barrier":::"memory");
  const int ro=CM?4*(wid>>2):0; const float kmax2=fmaxf(fmaxf(red[ro],red[ro+1]),fmaxf(red[ro+2],red[ro+3]));
  const float bound=sqrtf(qn2*kmax2)*1.0005f+bmax+0.01f;
  const bool bad=__any(!(bound<=60.f));
  if(lane==0)red[8+wid]=bad?1.f:0.f;
  asm volatile("s_waitcnt lgkmcnt(0)\n\ts_barrier":::"memory");
  float f=0.f;
  #pragma unroll
  for(int w=0;w<8;++w)f+=red[8+w];
  return f==0.f;
}
template<bool CM,int THRL,bool FAST,bool LMA=false> __device__ __forceinline__ void attn_unit(const bf16*Qb,const bf16*__restrict__ Kb,const bf16*__restrict__ Vb,bf16*Ob,int q0,char*shm,
                                                                       const float*relb,int h,float lam,float osc,const float*gdiff,float bmax,const int tid){
  const int lane=tid&63,r32=lane&31,hi=lane>>5; const int wid=__builtin_amdgcn_readfirstlane(tid>>6);
  const int wrow=CM?(wid&3)*QBLK:wid*QBLK; const int map=wid>>2;
  const bf16*Qw=Qb+(long)(q0+wrow)*LDP;
  const unsigned lds0=(unsigned)(uintptr_t)shm;
  float*wsf=(float*)(shm+LDS_WS)+wid*64;
  const bf16*ksrc=Kb+(long)lane*LDP+wid*8;
  const bf16*vsrc=Vb+(long)(16*(wid&3)+(lane>>2))*LDP+(wid>>2)*32+(lane&3)*8;
  const unsigned kdst=lds0+LDS_K+wid*1024, vdst=lds0+LDS_V+wid*1024;
  #define DMA_K(t,slot) glds16(ksrc+(long)(t)*KVBLK*LDP,(unsigned)__builtin_amdgcn_readfirstlane(kdst+(slot)))
  #define DMA_V(t,slot) glds16(vsrc+(long)(t)*KVBLK*LDP,(unsigned)__builtin_amdgcn_readfirstlane(vdst+(slot)))
  const int vb0=(int)(lds0+LDS_V)+((lane>>4)&1)*32+(lane&3)*8+(4*hi+((lane&15)>>2))*64;
  const char*Kbase=shm+LDS_K; bf16x8 kf[8];
  const lds_cptr shm3=(lds_cptr)shm; const lds_cptr kp0=shm3+LDS_K+hi*1024+r32*16+(CM?map*4096:0); const lds_cptr vp0=shm3+LDS_V+((lane>>4)&1)*32+(lane&3)*8+(4*hi+((lane&15)>>2))*64;
  const lds_fptr tab3=(lds_fptr)(shm3+LDS_TAB);
    if(CM){ float*tab=(float*)(shm+LDS_TAB); for(int i=tid;i<640;i+=NW*64)tab[i]=LOG2E*relb[t5_bucket(i-320)*4+h]; }
  DMA_K(0,0);DMA_V(0,0);DMA_K(1,SLOTB);
  bf16x8 qr[4];
  #pragma unroll
  for(int d0=0;d0<(CM?2:4);++d0)qr[d0]=*reinterpret_cast<const bf16x8*>(&Qw[(long)r32*LDP+(CM?map*32:0)+d0*16+hi*8]);
  const int jn=q0>>7; const int nlo=2*jn-3, nhi=2*jn+5; const int qabs=q0+wrow+r32;
  bool near=CM&&(nlo<=0); float cside=0.f; if(CM&&!near)cside=LOG2E*relb[15*4+h];
  float mhat=0.f,l_reg=0.f;f32x16 o[2];o[0]=f32x16{};o[1]=f32x16{};asm volatile("":"+v"(o[0]),"+v"(o[1]));f32x16 negm;
  constexpr bool LM=FAST&&LMA;
  f32x16 lacc=f32x16{}; unsigned one_=0x3F803F80u; if constexpr(LM){ asm volatile("":"+v"(lacc),"+v"(one_)); }
  const bf16x8 ONES=__builtin_bit_cast(bf16x8,(u32x4){one_,one_,one_,one_});
  #define NEGM_SET() do{ _Pragma("unroll") for(int r=0;r<16;++r)negm[r]=cside-mhat; asm volatile("":"+v"(negm)); }while(0)
  NEGM_SET();
  #define MODESW(t) do{ if(CM){ if((t)==nlo){near=true;cside=0.f;NEGM_SET();} else if((t)==nhi){near=false;cside=tab3[639];NEGM_SET();} } }while(0)
  #define BIASADD(P0,P1,t) do{ if(CM){ if(near){ const lds_fptr tb_=tab3+(64*(t)-qabs+4*hi+320); \
      _Pragma("unroll") for(int r4=0;r4<4;++r4){ _Pragma("unroll") for(int r=4*r4;r<4*r4+4;++r){P0[r]+=tb_[(r&3)+8*(r>>2)];P1[r]+=tb_[32+(r&3)+8*(r>>2)];} SBAR(); } } } }while(0)
  bool resc=false;
  #define START(P0,P1) do{ if constexpr(!FAST){ const float rm=rowmax(P0,P1); resc=false; \
    { const float dl=rm; mhat=fadd_s(mhat,dl); \
      _Pragma("unroll") for(int r=0;r<16;++r){P0[r]=fsub_s(P0[r],dl);P1[r]=fsub_s(P1[r],dl);} \
      NEGM_SET(); } } \
    _Pragma("unroll") for(int r=0;r<16;++r)P0[r]=__builtin_amdgcn_exp2f(P0[r]); }while(0)
  #define RESC() do{ if constexpr(!FAST) if(resc){ asm volatile("s_waitcnt lgkmcnt(0)":::"memory"); \
      _Pragma("unroll") for(int d_=0;d_<2;++d_) _Pragma("unroll") for(int r=0;r<16;++r)o[d_][r]*=wsf[crow(r,hi)]; } }while(0)
  f32x16 pA0,pA1,pB0,pB1;
  int sl_prev=0,sl_cur=0,sl_next=SLOTB;
  #define ROT() do{sl_prev=sl_cur;sl_cur=sl_next;sl_next=(sl_next==(NSLOT-1)*SLOTB)?0:sl_next+SLOTB;}while(0)
  DMA_K(2,2*SLOTB);
  float qn2_=0.f; if constexpr(FAST)qn2_=attn_qnorm2<CM>(Qb,q0,wid,r32,hi);
  WAIT_BAR(3);
  if constexpr(FAST){ const float*red=(const float*)(shm+LDS_RED); const int ro=CM?4*map:0; const float kmax2=fmaxf(fmaxf(red[ro],red[ro+1]),fmaxf(red[ro+2],red[ro+3]));
    mhat=sqrtf(qn2_*kmax2)*1.0005f+bmax+0.01f; NEGM_SET(); }
  qkt<(CM?2:4)>(pA0,pA1,Kbase+(CM?map*4096:0),qr,negm,r32,hi);asm volatile("s_nop 15\n\ts_nop 7":"+v"(pA0),"+v"(pA1));BIASADD(pA0,pA1,0);
  START(pA0,pA1);
  _Pragma("unroll") for(int r=0;r<16;++r)pA1[r]=__builtin_amdgcn_exp2f(pA1[r]);
  WAIT_BAR(0);
  DMA_K(3,0);DMA_V(1,SLOTB);
  ROT();
  if constexpr(CM){ kload2(kf,kp0+sl_cur,0); kload2(kf,kp0+sl_cur,1); } else { kload8(kf,kp0+sl_cur); }
  WAIT_BAR(2);
  s16x4 vlo[8],vhi[8]; u32x4 pw0,pw1,pw2,pw3;
  #define PKW(P,B) cvtpk_s(P[B],P[B+1])
  #define PAF(k) __builtin_bit_cast(bf16x8,pw##k)
  #define VFR(i) (bf16x8){vlo[i][0],vlo[i][1],vlo[i][2],vlo[i][3],vhi[i][0],vhi[i][1],vhi[i][2],vhi[i][3]}
  #define PIN(x) asm volatile("":"+v"(x))
  #define MX3(a,b,c) __builtin_fmaxf(__builtin_fmaxf((a),(b)),(c))
  #define GAPA(MF,A0,A1,A2,A3,W0,W1,PW) do{ MF; if constexpr(!LM){ sacc+=A0; sacc+=A1; sacc+=A2; sacc+=A3; PIN(sacc); } W0; W1; PIN(PW); SBAR(); }while(0)
  #define LS(k) do{ if constexpr(LM) lacc=__builtin_amdgcn_mfma_f32_32x32x16_bf16(PAF(k),ONES,lacc,0,0,0); }while(0)
  #define EX(v) __builtin_amdgcn_exp2f(v)
  #define GAPB(MF,X,B) do{ MF; X[B]=EX(X[B]); X[B+1]=EX(X[B+1]); X[B+2]=EX(X[B+2]); X[B+3]=EX(X[B+3]); PIN(X); SBAR(); }while(0)
  #define VRD(i) do{ vlo[i]=vtr(vp_+(((i)>>2)*4096+((i)&3)*1024)); vhi[i]=vtr(vp_+(((i)>>2)*4096+((i)&3)*1024+512)); }while(0)
  #define KRD(G,j) do{ if((G)&&(!CM||(j)<2)){ kload2(kf,kp0+sl_next,j); SBAR(); } }while(0)
  #define MF58(stmt) do{ if constexpr(!CM){ stmt; } }while(0)
  #define STEP(C0,C1,P0,P1,t,GK,GV,GL) do{ SBAR(); \
    const lds_cptr vp_=vp0+sl_prev; \
    VRD(0); SBAR(); float sacc=(P0[0]+P0[1]); \
    GAPA(C0=__builtin_amdgcn_mfma_f32_32x32x16_bf16(kf[0],qr[0],negm,0,0,0), P0[2],P0[3],P0[4],P0[5],     pw0[0]=PKW(P0,0), pw0[1]=PKW(P0,2), pw0); \
    VRD(4); SBAR(); GAPA(C1=__builtin_amdgcn_mfma_f32_32x32x16_bf16(kf[1],qr[0],negm,0,0,0), P0[6],P0[7],P0[8],P0[9],     pw0[2]=PKW(P0,4), pw0[3]=PKW(P0,6), pw0); \
    VRD(1); SBAR(); GAPA(C0=__builtin_amdgcn_mfma_f32_32x32x16_bf16(kf[2],qr[1],C0,0,0,0),   P0[10],P0[11],P0[12],P0[13], pw1[0]=PKW(P0,8), pw1[1]=PKW(P0,10), pw1); \
    VRD(5); SBAR(); GAPA(C1=__builtin_amdgcn_mfma_f32_32x32x16_bf16(kf[3],qr[1],C1,0,0,0),   P0[14],P0[15],P1[0],P1[1],   pw1[2]=PKW(P0,12),pw1[3]=PKW(P0,14), pw1); \
    VRD(2); SBAR(); GAPA(MF58(C0=__builtin_amdgcn_mfma_f32_32x32x16_bf16(kf[4],qr[2],C0,0,0,0)),   P1[2],P1[3],P1[4],P1[5],     pw2[0]=PKW(P1,0), pw2[1]=PKW(P1,2), pw2); \
    VRD(6); SBAR(); GAPA(MF58(C1=__builtin_amdgcn_mfma_f32_32x32x16_bf16(kf[5],qr[2],C1,0,0,0)),   P1[6],P1[7],P1[8],P1[9],     pw2[2]=PKW(P1,4), pw2[3]=PKW(P1,6), pw2); \
    VRD(3); SBAR(); GAPA(MF58(C0=__builtin_amdgcn_mfma_f32_32x32x16_bf16(kf[6],qr[3],C0,0,0,0)),   P1[10],P1[11],P1[12],P1[13], pw3[0]=PKW(P1,8), pw3[1]=PKW(P1,10), pw3); \
    VRD(7); SBAR(); GAPA(MF58(C1=__builtin_amdgcn_mfma_f32_32x32x16_bf16(kf[7],qr[3],C1,0,0,0)),   P1[14],P1[15],0.f,0.f,       pw3[2]=PKW(P1,12),pw3[3]=PKW(P1,14), pw3); \
    if constexpr(!LM) l_reg+=sacc; \
    if(GK){DMA_K((t)+3,sl_cur);} if(GV){DMA_V((t)+1,sl_next);} \
    BIASADD(C0,C1,t); \
    if constexpr(!FAST){ float a=MX3(C0[0],C0[1],C1[0]),b=MX3(C0[2],C0[3],C1[1]); a=MX3(a,C1[2],C1[3]); \
      _Pragma("unroll") for(int r=4;r<16;r+=4){a=MX3(a,C0[r],C0[r+1]);b=MX3(b,C0[r+2],C0[r+3]);a=MX3(a,C1[r],C1[r+1]);b=MX3(b,C1[r+2],C1[r+3]);} \
      float rm=__builtin_fmaxf(a,b); { auto rr=__builtin_amdgcn_permlane32_swap(__float_as_uint(rm),__float_as_uint(rm),false,false); rm=__builtin_fmaxf(__uint_as_float(rr[0]),__uint_as_float(rr[1])); } \
      resc=false; \
      if(__builtin_expect(__any(rm>(float)THRL),0)){ const float dl=__builtin_fmaxf(rm,0.f); mhat+=dl; \
        _Pragma("unroll") for(int r=0;r<16;++r){C0[r]-=dl;C1[r]-=dl;} \
        NEGM_SET(); \
        const float f=__builtin_amdgcn_exp2f(-dl); l_reg*=f; if(hi==0)wsf[r32]=f; resc=true; } } \
    SBAR(); \
    GAPB(o[0]=__builtin_amdgcn_mfma_f32_32x32x16_bf16(PAF(0),VFR(0),o[0],0,0,0), C0,0); \
    GAPB(o[1]=__builtin_amdgcn_mfma_f32_32x32x16_bf16(PAF(0),VFR(4),o[1],0,0,0); LS(0), C0,4); \
    KRD(GL,0); GAPB(o[0]=__builtin_amdgcn_mfma_f32_32x32x16_bf16(PAF(1),VFR(1),o[0],0,0,0), C0,8); \
    KRD(GL,1); GAPB(o[1]=__builtin_amdgcn_mfma_f32_32x32x16_bf16(PAF(1),VFR(5),o[1],0,0,0); LS(1), C0,12); \
    KRD(GL,2); GAPB(o[0]=__builtin_amdgcn_mfma_f32_32x32x16_bf16(PAF(2),VFR(2),o[0],0,0,0), C1,0); \
    KRD(GL,3); GAPB(o[1]=__builtin_amdgcn_mfma_f32_32x32x16_bf16(PAF(2),VFR(6),o[1],0,0,0); LS(2), C1,4); \
    GAPB(o[0]=__builtin_amdgcn_mfma_f32_32x32x16_bf16(PAF(3),VFR(3),o[0],0,0,0), C1,8); \
    GAPB(o[1]=__builtin_amdgcn_mfma_f32_32x32x16_bf16(PAF(3),VFR(7),o[1],0,0,0); LS(3), C1,12); \
    }while(0)
  int t=1;
  { constexpr int PADN=CM?(FAST?PAD_CF:PAD_CS):(FAST?PAD_AF:PAD_AS); asm volatile(".p2align 6\n\t.rept %c0\n\ts_nop 0\n\t.endr"::"i"(PADN):"memory"); }
  for(;t+5<NT;t+=2){
    MODESW(t);
    STEP(pB0,pB1,pA0,pA1,t,true,true,true);     WAIT_BAR(2); RESC(); ROT();
    STEP(pA0,pA1,pB0,pB1,t+1,true,true,true);   WAIT_BAR(2); RESC(); ROT();
  }
  #define ENDW(tt) do{ if((tt)+3<NT){WAIT_BAR(2);} else if((tt)+2<NT){WAIT_BAR(1);} else {WAIT_BAR(0);} }while(0)
  for(;t+1<NT;t+=2){
    MODESW(t);
    STEP(pB0,pB1,pA0,pA1,t,(t+3<NT),(t+1<NT),(t+1<NT));       ENDW(t);   RESC(); ROT();
    STEP(pA0,pA1,pB0,pB1,t+1,(t+4<NT),(t+2<NT),(t+2<NT));     ENDW(t+1); RESC(); ROT();
  }
  MODESW(NT-1);
  STEP(pB0,pB1,pA0,pA1,NT-1,false,false,false); RESC();
  { if constexpr(!LM){ float sacc=pB0[0]+pB0[1]; _Pragma("unroll") for(int r=2;r<16;++r)sacc+=pB0[r]; _Pragma("unroll") for(int r=0;r<16;++r)sacc+=pB1[r]; l_reg+=sacc; }
    pw0=(u32x4){PKW(pB0,0),PKW(pB0,2),PKW(pB0,4),PKW(pB0,6)};pw1=(u32x4){PKW(pB0,8),PKW(pB0,10),PKW(pB0,12),PKW(pB0,14)};pw2=(u32x4){PKW(pB1,0),PKW(pB1,2),PKW(pB1,4),PKW(pB1,6)};pw3=(u32x4){PKW(pB1,8),PKW(pB1,10),PKW(pB1,12),PKW(pB1,14)};
    SBAR(); pv(o,vb0+sl_cur,PAF(0),PAF(1),PAF(2),PAF(3)); LS(0); LS(1); LS(2); LS(3); }
  #undef PKW
  #undef PAF
  #undef VFR
  #undef PIN
  #undef MX3
  #undef GAPA
  #undef LS
  #undef GAPB
  #undef EX
  #undef VRD
  #undef KRD
  #undef MF58
  #undef STEP
  #undef ENDW
  float rli[16];
  if constexpr(LM){
    #pragma unroll
    for(int r=0;r<16;++r)rli[r]=__builtin_amdgcn_rcpf(lacc[r]);
  } else {
    {auto rr=__builtin_amdgcn_permlane32_swap(__float_as_uint(l_reg),__float_as_uint(l_reg),false,false);l_reg=__uint_as_float(rr[0])+__uint_as_float(rr[1]);}
    if(hi==0)wsf[32+r32]=l_reg;asm volatile("s_waitcnt lgkmcnt(0)":::"memory");
    #pragma unroll
    for(int r=0;r<16;++r)rli[r]=__builtin_amdgcn_rcpf(wsf[32+crow(r,hi)]);
  }
  if(!CM){
    bf16*Ow=Ob+(long)(q0+wid*QBLK)*LDO;
    bf16*stg=(bf16*)(shm+LDS_OST)+wid*2048;
    #pragma unroll
    for(int r=0;r<16;++r){const int orow=crow(r,hi);
      #pragma unroll
      for(int d0=0;d0<2;++d0)stg[orow*64+d0*32+r32]=__float2bfloat16(o[d0][r]*rli[r]);}
    asm volatile("s_waitcnt lgkmcnt(0)":::"memory");
    #pragma unroll
    for(int i=0;i<4;++i){const int row=i*8+(lane>>3),ch=lane&7; const u32x4 v=*(const u32x4*)(stg+row*64+ch*8); ATTN_STORE16(Ow+(long)row*LDO+ch*8,v);}
  } else {
    const float msc=(map==0)?1.f:-lam;
    float*stg=(float*)(shm+LDS_OST)+map*8192+(wid&3)*2048;
    #pragma unroll
    for(int r=0;r<16;++r){const int orow=crow(r,hi); const float sc=rli[r]*msc;
      #pragma unroll
      for(int d0=0;d0<2;++d0)stg[orow*64+d0*32+r32]=o[d0][r]*sc;}
    asm volatile("s_waitcnt lgkmcnt(0)\n\ts_barrier":::"memory");
    const int row=16*wid+(lane>>2),part=lane&3;
    const float*s0=(const float*)(shm+LDS_OST)+row*64+part*16;
    f32x4a a[4]; float ss=0.f;
    #pragma unroll
    for(int i=0;i<4;++i){ a[i]=((const f32x4a*)s0)[i]+((const f32x4a*)(s0+8192))[i]; ss+=a[i][0]*a[i][0]+a[i][1]*a[i][1]+a[i][2]*a[i][2]+a[i][3]*a[i][3]; }
    ss+=__shfl_xor(ss,1); ss+=__shfl_xor(ss,2);
    const float rn=osc/sqrtf(ss*(1.0f/64.0f)+1e-6f);
    unsigned w[8];
    #pragma unroll
    for(int i=0;i<4;++i){ const f32x4a g=((const f32x4a*)(gdiff+part*16))[i]; w[2*i]=cvtpk_s(a[i][0]*rn*g[0],a[i][1]*rn*g[1]); w[2*i+1]=cvtpk_s(a[i][2]*rn*g[2],a[i][3]*rn*g[3]); }
    bf16*op=Ob+(long)(q0+row)*LDO+part*16;
    *(u32x4*)(op)=(u32x4){w[0],w[1],w[2],w[3]}; *(u32x4*)(op+8)=(u32x4){w[4],w[5],w[6],w[7]};
  }
  asm volatile("s_waitcnt lgkmcnt(0)\n\ts_barrier":::"memory");
  #undef DMA_K
  #undef DMA_V
  #undef BIASADD
  #undef MODESW
  #undef NEGM_SET
  #undef START
  #undef RESC
  #undef ROT
}
#undef SBAR
#undef WAIT_BAR
}
#define GAS __attribute__((address_space(1)))
#define LAS __attribute__((address_space(3)))
typedef unsigned short bf16;
typedef unsigned v4u __attribute__((ext_vector_type(4)));
typedef float f32x4 __attribute__((ext_vector_type(4)));
typedef short bf16x8 __attribute__((ext_vector_type(8)));
typedef GAS unsigned gu32;
typedef GAS unsigned long long gu64;
#define RLX_AGENT __ATOMIC_RELAXED, __HIP_MEMORY_SCOPE_AGENT
#define LDS_WAIT() asm volatile("s_waitcnt lgkmcnt(0)" ::: "memory")
#define VM_WAIT() asm volatile("s_waitcnt vmcnt(0)" ::: "memory")
__device__ __forceinline__ unsigned long long rt() { return __builtin_amdgcn_s_memrealtime(); }
__device__ __forceinline__ unsigned f2bf(float f) { unsigned u = __builtin_bit_cast(unsigned, f); return (u + 0x7fffu + ((u >> 16) & 1u)) >> 16; }
__device__ __forceinline__ unsigned pk2(float lo, float hi) { return f2bf(lo) | (f2bf(hi) << 16); }

#define XB_TMO      128
#define XB_XCNT(j)  (256  + 64 * (j))
#define XB_XSUB(j)  (1280 + 64 * (j))
#define XB_XGEN(j)  (2304 + 64 * (j))
#define XB_TOP      3328
#define XB_TOPGEN   3392
#define XCD_BAR_WORDS 3456
#define XB_SPIN_CAP (1u << 18)

__device__ __forceinline__ unsigned xb_ld(unsigned* p)              { return __hip_atomic_load(p, __ATOMIC_RELAXED, __HIP_MEMORY_SCOPE_AGENT); }
__device__ __forceinline__ unsigned xb_add(unsigned* p, unsigned v) { return __hip_atomic_fetch_add(p, v, __ATOMIC_RELAXED, __HIP_MEMORY_SCOPE_AGENT); }
__device__ __forceinline__ unsigned xb_xcc_id() { return (unsigned)__builtin_amdgcn_s_getreg((3 << 11) | 20) & 0xFu; }
#define XB_SPIN(cond, bar) do { unsigned _sp = 0; while (cond) { __builtin_amdgcn_s_sleep(1); \
    if ((++_sp & 255u) == 0u) { if (xb_ld(&(bar)[XB_TMO])) break; if (_sp > XB_SPIN_CAP) { atomicAdd(&(bar)[XB_TMO], 1u); break; } } } } while (0)

struct XcdBarrier {
    unsigned* bar; unsigned x;
    volatile LAS unsigned* st;
};

__device__ __forceinline__ XcdBarrier xcd_barrier_post(unsigned* bar, volatile LAS unsigned* st, int tid_) {
    XcdBarrier b; b.bar = bar; b.x = xb_xcc_id(); b.st = st;
    if (tid_ == 0) (void)xb_add(&bar[XB_XCNT(b.x)], 1u);
    return b;
}
__device__ __forceinline__ void xcd_barrier_complete(unsigned* bar, unsigned x, unsigned& nloc, unsigned& nx) {
    const unsigned G = gridDim.x * gridDim.y * gridDim.z;
    unsigned sum, cnt, mine, sp = 0u;
    for (;;) {
        sum = 0u; cnt = 0u; mine = 0u;
#pragma unroll
        for (unsigned j = 0; j < 16; ++j) { const unsigned c = xb_ld(&bar[XB_XCNT(j)]); sum += c; cnt += (c > 0u) ? 1u : 0u; mine = (j == x) ? c : mine; }
        if (sum == G) break;
        __builtin_amdgcn_s_sleep(1);
        if ((++sp & 255u) == 0u) { if (xb_ld(&bar[XB_TMO])) break; if (sp > XB_SPIN_CAP) { atomicAdd(&bar[XB_TMO], 1u); break; } }
    }
    nloc = mine > 0u ? mine : 1u; nx = cnt > 0u ? cnt : 1u;
}

__device__ __forceinline__ void xcd_barrier(const XcdBarrier& b, int tid_) {
    asm volatile("s_waitcnt vmcnt(0)" ::: "memory");
    __syncthreads();
    if (tid_ == 0) {
        unsigned* bar = b.bar;
        __builtin_amdgcn_s_waitcnt(0);
        unsigned nloc = b.st[0], nx = b.st[1];
        if (nloc == 0u) { xcd_barrier_complete(bar, b.x, nloc, nx); b.st[0] = nloc; b.st[1] = nx; }
        const unsigned old = xb_add(&bar[XB_XSUB(b.x)], 1u);
        const unsigned gen = old / nloc;
        if (old + 1u == (gen + 1u) * nloc) {
            __builtin_amdgcn_fence(__ATOMIC_RELEASE, "agent");
            asm volatile("s_waitcnt vmcnt(0)" ::: "memory");
            const unsigned og = xb_add(&bar[XB_TOP], 1u);
            const unsigned tg = og / nx;
            if (og + 1u == (tg + 1u) * nx) xb_add(&bar[XB_TOPGEN], 1u);
            else XB_SPIN(xb_ld(&bar[XB_TOPGEN]) == tg, bar);
            __builtin_amdgcn_fence(__ATOMIC_ACQUIRE, "agent");
            xb_add(&bar[XB_XGEN(b.x)], 1u);
            asm volatile("s_waitcnt vmcnt(0)" ::: "memory");
        } else {
            XB_SPIN(xb_ld(&bar[XB_XGEN(b.x)]) == gen, bar);
            __builtin_amdgcn_fence(__ATOMIC_ACQUIRE, "agent");
            asm volatile("s_waitcnt vmcnt(0)" ::: "memory");
        }
    }
    __syncthreads();
}
constexpr int NWAVES = 8, NTHR = 512;
constexpr int NB = 2, S = 16384, T = NB * S, D = 1024, DEPTH = 4, NE = 16, CAP = 2048;
constexpr int NPROJ = 2816, NGATE = 4096, NCAT = NPROJ + NGATE, LDP = NPROJ;
constexpr int NPROJ_BF = 0, NPROJ_I8 = NPROJ - NPROJ_BF;
constexpr int PC_AQ = 0, PC_AK = 256, PC_AV = 384, PC_CQ = 512, PC_CK = 768, PC_CV = 1024, PC_Z = 1280, PC_XS = 1536, PC_BM = 1792, PC_CM = 2048, PC_UV = 2304;
constexpr float EPS = 1e-6f, LOG2E = 1.4426950408889634f;
constexpr int PAD_PL0 = 5, PAD_PROJ = 8, PAD_PL = 5, PAD_GATE = 8, PAD_P5 = 0, PAD_P6 = 5, PAD_GU = 8, PAD_DN = 8, PAD_PLE = 8;
constexpr int NPH = 14;
constexpr int NGP = DEPTH * NPH + 1;

constexpr size_t MiB = 1u << 20;
constexpr size_t WS_CTL = 0, CTL_ZERO_BYTES = 1 * MiB;
constexpr size_t WS_DT = 1 * MiB;
constexpr size_t WS_AFF = 2 * MiB;
constexpr size_t WS_SELIDX = 4 * MiB;
constexpr size_t WS_SELAFF = 4 * MiB + 256 * 1024;
constexpr size_t WS_INV = 5 * MiB;
constexpr size_t WS_TAB = 6 * MiB;
constexpr size_t WS_CD = 8 * MiB;
constexpr size_t WS_WSP = 8 * MiB + 512 * 1024;
constexpr size_t WS_SSQ = 9 * MiB;
constexpr size_t WS_KMAX = 9 * MiB + 512 * 1024;
constexpr size_t WS_SA = 9 * MiB + 576 * 1024;
constexpr size_t WS_SW = 9 * MiB + 768 * 1024;
constexpr size_t WS_WCAT = 10 * MiB;
constexpr size_t WS_WBR = 24 * MiB, WS_WPG = 26 * MiB, WS_WPLE = 28 * MiB;
constexpr size_t WS_WGU = 32 * MiB;
constexpr size_t WS_WDN = 96 * MiB;
constexpr size_t WS_H = 128 * MiB;
constexpr size_t WS_PROJ = 192 * MiB;
constexpr size_t WS_GATES = 368 * MiB;
constexpr size_t WS_XE = 192 * MiB, WS_HID = 320 * MiB, WS_YE = 448 * MiB;
constexpr size_t WS_BR = 624 * MiB;
constexpr size_t WS_PL = 688 * MiB;
constexpr size_t WS_PBF = 752 * MiB;
constexpr size_t WS_ST = 768 * MiB;
constexpr size_t WS_SB = 832 * MiB;
constexpr size_t WS_XBC = 864 * MiB;
constexpr size_t WS_WOUT = 912 * MiB;
constexpr size_t WS_H8 = 914 * MiB;
constexpr size_t WS_XB = 946 * MiB;
constexpr size_t WS_END = 1010 * MiB;
constexpr int CW_TMO = 0, CW_BAR = 4096;

constexpr int RING_BYTES = 131072, LDSCTL_OFF = RING_BYTES, MISC_OFF = LDSCTL_OFF + 320, LDS_BYTES = 147456;

struct P {
    const float *x, *p, *rel_bias, *g_mix, *w_in, *g_qnorm, *g_knorm, *conv_w, *conv_b, *dt_bias_f, *dt_bias_b, *a_log_f, *a_log_b, *d_skip, *g_ssm,
                *lambda_q1, *lambda_k1, *lambda_q2, *lambda_k2, *g_diff, *g_sgu, *w_spatial, *b_spatial, *w_branch, *w_branch_gate, *w_out, *g_moe, *w_router,
                *w_exp_gate, *w_exp_up, *w_exp_down, *g_ple, *w_ple_gate, *w_ple, *g_final;
    float* out; unsigned char* ws;
    int gp_lo, gp_hi;
};

__device__ __forceinline__ float wave_sum(float v) {
#pragma unroll
    for (int o = 1; o < 64; o <<= 1) v += __shfl_xor(v, o);
    return v;
}
__device__ __forceinline__ float bf2f(unsigned short u) { return __builtin_bit_cast(float, (unsigned)u << 16); }
__device__ __forceinline__ float silu_f(float x) { return x * __builtin_amdgcn_rcpf(1.0f + __builtin_amdgcn_exp2f(-LOG2E * x)); }
__device__ __forceinline__ float gelu_tanh(float x) { const float y = 0.7978845608028654f * (x + 0.044715f * x * x * x); const float e = __builtin_amdgcn_exp2f(2.0f * LOG2E * y); return 0.5f * x * (2.0f - 2.0f * __builtin_amdgcn_rcpf(e + 1.0f)); }
__device__ __forceinline__ float softplus_f(float x) {
    const float e = __builtin_amdgcn_exp2f(-LOG2E * fabsf(x));
    const float l = (e < 0.03125f) ? e * (1.0f - e * (0.5f - e * (0.33333334f - 0.25f * e))) : 0.6931471805599453f * __builtin_amdgcn_logf(1.0f + e);
    return fmaxf(x, 0.f) + l; }
__device__ __forceinline__ f32x4 mfma16(bf16x8 a, bf16x8 b, f32x4 c) { return __builtin_amdgcn_mfma_f32_16x16x32_bf16(a, b, c, 0, 0, 0); }
typedef short bf16x4 __attribute__((ext_vector_type(4)));
typedef unsigned v2u __attribute__((ext_vector_type(2)));
__device__ __forceinline__ f32x4 xb_unpack(const v2u w) { return (f32x4){__builtin_bit_cast(float, w.x << 16), __builtin_bit_cast(float, w.x & 0xffff0000u), __builtin_bit_cast(float, w.y << 16), __builtin_bit_cast(float, w.y & 0xffff0000u)}; }

__device__ __forceinline__ void tr_item(const float* W, int ldw, int k0, int scol0, bf16* WT, int ldk, int drow0, LAS float* scr, int lane) {
#pragma unroll 8
    for (int i = 0; i < 32; ++i) { const int kk = 2 * i + (lane >> 5); scr[kk * 33 + (lane & 31)] = W[(size_t)(k0 + kk) * ldw + scol0 + (lane & 31)]; }
    LDS_WAIT(); asm volatile("" ::: "memory");
    const int c = lane & 7;
#pragma unroll
    for (int j = 0; j < 4; ++j) { const int n = (lane >> 3) + 8 * j; const LAS float* s = scr + (8 * c) * 33 + n;
        v4u o; o.x = pk2(s[0 * 33], s[1 * 33]); o.y = pk2(s[2 * 33], s[3 * 33]); o.z = pk2(s[4 * 33], s[5 * 33]); o.w = pk2(s[6 * 33], s[7 * 33]);
        *(GAS v4u*)(WT + (size_t)(drow0 + n) * ldk + k0 + 8 * c) = o; }
    LDS_WAIT(); asm volatile("" ::: "memory");
}
__device__ __forceinline__ void tr_item8(const float* W, int ldw, int k0, int scol0, unsigned char* WT, int ldk, int drow0, float scale, LAS float* scr, int lane) {
#pragma unroll 8
    for (int i = 0; i < 32; ++i) { const int kk = 2 * i + (lane >> 5); scr[kk * 33 + (lane & 31)] = W[(size_t)(k0 + kk) * ldw + scol0 + (lane & 31)]; }
    LDS_WAIT(); asm volatile("" ::: "memory");
    const int c = lane & 3;
#pragma unroll
    for (int j = 0; j < 2; ++j) { const int n = (lane >> 2) + 16 * j; const LAS float* s = scr + (16 * c) * 33 + n; int w[4];
#pragma unroll
        for (int q = 0; q < 4; ++q) { int t = 0; t = __builtin_amdgcn_cvt_pk_fp8_f32(scale * s[(4 * q) * 33], scale * s[(4 * q + 1) * 33], t, false); t = __builtin_amdgcn_cvt_pk_fp8_f32(scale * s[(4 * q + 2) * 33], scale * s[(4 * q + 3) * 33], t, true); w[q] = t; }
        *(GAS v4u*)(WT + (size_t)(drow0 + n) * ldk + k0 + 16 * c) = (v4u){(unsigned)w[0], (unsigned)w[1], (unsigned)w[2], (unsigned)w[3]}; }
    LDS_WAIT(); asm volatile("" ::: "memory");
}
__device__ __forceinline__ void tr_item_i8(const float* W, int ldw, int k0, int scol0, unsigned char* WT, int ldk, int drow0, const LAS float* inv, LAS float* scr, int lane) {
#pragma unroll 8
    for (int i = 0; i < 32; ++i) { const int kk = 2 * i + (lane >> 5); scr[kk * 33 + (lane & 31)] = W[(size_t)(k0 + kk) * ldw + scol0 + (lane & 31)]; }
    LDS_WAIT(); asm volatile("" ::: "memory");
    const int c = lane & 3;
#pragma unroll
    for (int j = 0; j < 2; ++j) { const int n = (lane >> 2) + 16 * j; const LAS float* s = scr + (16 * c) * 33 + n; const float iv = inv[n]; unsigned w[4];
#pragma unroll
        for (int q = 0; q < 4; ++q) { const int b0 = (int)rintf(iv * s[(4 * q) * 33]), b1 = (int)rintf(iv * s[(4 * q + 1) * 33]), b2 = (int)rintf(iv * s[(4 * q + 2) * 33]), b3 = (int)rintf(iv * s[(4 * q + 3) * 33]);
            w[q] = (unsigned)(b0 & 0xff) | ((unsigned)(b1 & 0xff) << 8) | ((unsigned)(b2 & 0xff) << 16) | ((unsigned)(b3 & 0xff) << 24); }
        *(GAS v4u*)(WT + (size_t)(drow0 + n) * ldk + k0 + 16 * c) = (v4u){w[0], w[1], w[2], w[3]}; }
    LDS_WAIT(); asm volatile("" ::: "memory");
}
__device__ __forceinline__ void gatew_item(const float* W, int ldw, int scol, int nb, unsigned char* WT, float* SWo, unsigned char* ldsg, int wave, int lane, int tid) {
    LAS unsigned char* lds = (LAS unsigned char*)ldsg;
    LAS float* scr = (LAS float*)(lds + wave * 16384);
    LAS float* cmax = (LAS float*)(lds + RING_BYTES + 512);
    LAS float* inv = cmax + 256;
    float mx = 0.f;
#pragma unroll 1
    for (int kb2 = 0; kb2 < 2; ++kb2) { const int k0 = 64 * (2 * wave + kb2);
#pragma unroll 8
        for (int i = 0; i < 32; ++i) { const int kk = 2 * i + (lane >> 5); mx = fmaxf(mx, fabsf(W[(size_t)(k0 + kk) * ldw + scol + (lane & 31)])); } }
    mx = fmaxf(mx, __shfl_xor(mx, 32));
    if (lane < 32) cmax[wave * 32 + lane] = mx;
    __syncthreads();
    if (tid < 32) { float m2 = 0.f;
#pragma unroll
        for (int w = 0; w < 8; ++w) m2 = fmaxf(m2, cmax[w * 32 + tid]);
        m2 = fmaxf(m2, 1e-30f); inv[tid] = 127.0f / m2; SWo[32 * nb + tid] = m2 * (1.0f / 127.0f); }
    __syncthreads();
#pragma unroll 1
    for (int kb2 = 0; kb2 < 2; ++kb2) tr_item_i8(W, ldw, 64 * (2 * wave + kb2), scol, WT, 1024, 32 * nb, inv, scr, lane);
    __syncthreads();
}
__device__ __forceinline__ int win_src(int drow) {
    return drow < 512 ? drow : drow < 1280 ? 1544 + (drow - 512) : drow < 2304 ? 512 + (drow - 1280) : 2312 + (drow - 2304);
}

__device__ __forceinline__ void ph_convw(const P& a, int L, unsigned char* lds, int gw, int NGW, int wave, int lane, int tid, int gtid, int GT, int wgi, int nwg, int part) {
    unsigned char* ws = a.ws;
    LAS float* scr = (LAS float*)((LAS unsigned char*)lds + wave * 16384);
    constexpr int I1 = 16 * (NPROJ_BF / 32), I2 = 0, I3 = 512, I4 = 512, I5 = 0, I6 = 4 * 32, I7 = NE * 2 * 512, I8 = NE * 512;
    constexpr int NIT = I1 + I2 + I3 + I4 + I5 + I6 + I7 + I8, NEARLY = I1 + I2 + I3 + I4 + I5 + I6;
    const int it0 = (part == 2) ? NEARLY : 0, it1 = (part == 1) ? NEARLY : NIT;
    for (int it = it0 + gw; it < it1; it += NGW) {
        int r = it;
        if constexpr (I1 > 0) if (r < I1) { constexpr int NBB = (NPROJ_BF > 0) ? NPROJ_BF / 32 : 1; const int kb = r / NBB, nb = r % NBB; tr_item(a.w_in + (size_t)L * 1024 * 2824, 2824, 64 * kb, win_src(32 * nb), (bf16*)(ws + WS_WCAT), 1024, 32 * nb, scr, lane); continue; } r -= I1;
        if (r < I3) { const int n = r / 128, rr = r % 128, kb = rr / 32, nb = rr % 32; tr_item(a.w_branch + ((size_t)L * 4 + n) * 256 * 1024, 1024, 64 * kb, 32 * nb, (bf16*)(ws + WS_WBR), 256, n * 1024 + 32 * nb, scr, lane); continue; } r -= I3;
        if (r < I4) { const int kb = r / 32, nb = r % 32; tr_item(a.w_out + (size_t)L * 1024 * 1024, 1024, 64 * kb, 32 * nb, (bf16*)(ws + WS_WOUT), 1024, 32 * nb, scr, lane); continue; } r -= I4;
        if (r < I6) { const int kb = r / 32, nb = r % 32; tr_item(a.w_ple + (size_t)L * 256 * 1024, 1024, 64 * kb, 32 * nb, (bf16*)(ws + WS_WPLE), 256, 32 * nb, scr, lane); continue; } r -= I6;
        if (r < I7) { const int e = r / 1024, up = (r / 512) & 1, rr = r % 512, kb = rr / 32, nb = rr % 32;
            const float* W = (up ? a.w_exp_up : a.w_exp_gate) + ((size_t)L * NE + e) * 1024 * 1024;
            const int drow = e * 2048 + ((32 * nb) / 128) * 256 + up * 128 + ((32 * nb) % 128);
            tr_item8(W, 1024, 64 * kb, 32 * nb, (unsigned char*)(ws + WS_WGU), 1024, drow, 32.0f, scr, lane); continue; } r -= I7;
        { const int e = r / 512, rr = r % 512, kb = rr / 32, nb = rr % 32;
            tr_item8(a.w_exp_down + ((size_t)L * NE + e) * 1024 * 1024, 1024, 64 * kb, 32 * nb, (unsigned char*)(ws + WS_WDN), 1024, e * 1024 + 32 * nb, 32.0f, scr, lane); }
    }
    __syncthreads();
    for (int it = wgi; it < 160 + NPROJ_I8 / 32; it += nwg) {
        const bool late = (it >= 128 && it < 160);
        if ((part == 1 && late) || (part == 2 && !late)) continue;
        if (it < 128) gatew_item(a.w_branch_gate + (size_t)L * 1024 * 4096, 4096, 32 * it, it, (unsigned char*)(ws + WS_WCAT) + (size_t)NPROJ * 2048, (float*)(ws + WS_SW), lds, wave, lane, tid);
        else if (it < 160) gatew_item(a.w_ple_gate + (size_t)L * 1024 * 1024, 1024, 32 * (it - 128), it - 128, (unsigned char*)(ws + WS_WPG), (float*)(ws + WS_SW) + 4096, lds, wave, lane, tid);
        else gatew_item(a.w_in + (size_t)L * 1024 * 2824, 2824, win_src(NPROJ_BF + 32 * (it - 160)), it - 160, (unsigned char*)(ws + WS_WCAT) + (size_t)NPROJ_BF * 2048, (float*)(ws + WS_SW) + 5120, lds, wave, lane, tid); }
    if (part != 2) {
        const float* ps = a.p + (size_t)L * T * 256; bf16* pd = (bf16*)(ws + WS_PBF);
        for (int i = gtid; i < T * 256 / 8; i += GT) { const f32x4 v0 = ((const f32x4*)ps)[2 * i], v1 = ((const f32x4*)ps)[2 * i + 1];
            v4u o; o.x = pk2(v0[0], v0[1]); o.y = pk2(v0[2], v0[3]); o.z = pk2(v1[0], v1[1]); o.w = pk2(v1[2], v1[3]); ((v4u*)pd)[i] = o; }
        const float* ss = a.w_spatial + (size_t)L * 4 * 128 * 128; bf16* sd = (bf16*)(ws + WS_WSP);
        for (int i = gtid; i < 4 * 128 * 128 / 8; i += GT) { const f32x4 v0 = ((const f32x4*)ss)[2 * i], v1 = ((const f32x4*)ss)[2 * i + 1];
            v4u o; o.x = pk2(v0[0], v0[1]); o.y = pk2(v0[2], v0[3]); o.z = pk2(v1[0], v1[1]); o.w = pk2(v1[2], v1[3]); ((v4u*)sd)[i] = o; }
    }
    __syncthreads();
}
__device__ __forceinline__ void ph_r0(const P& a, int L, unsigned char* lds, int gw, int NGW, int lane, int tid) {
    unsigned char* ws = a.ws;
    LAS float* wdt = (LAS float*)lds;
    { const float* wi = a.w_in + (size_t)L * 1024 * 2824 + 1536;
      for (int i = tid; i < 1024 * 8; i += NTHR) { const int kq = i >> 3, e8 = i & 7, pos = ((kq >> 8) * 4 + (kq & 3)) * 64 + ((kq >> 2) & 63);
          wdt[((e8 >> 2) * 1024 + pos) * 4 + (e8 & 3)] = wi[(size_t)kq * 2824 + e8]; } }
    __syncthreads();
    const float* xin = a.x; bf16* XB = (bf16*)(ws + WS_XB); const bool l0 = (L == 0);
    const float* gm = a.g_mix + L * D; bf16* H = (bf16*)(ws + WS_H); float* DT = (float*)(ws + WS_DT);
    f32x4 gv[4];
#pragma unroll
    for (int j = 0; j < 4; ++j) gv[j] = ((const f32x4*)gm)[lane + 64 * j];
    const float bias_l = (((lane >> 3) & 7) < 4) ? a.dt_bias_f[L * 4 + ((lane >> 3) & 3)] : a.dt_bias_b[L * 4 + ((lane >> 3) & 3)];
    f32x4 nv[4]; v2u nb[4];
#pragma unroll
    for (int j = 0; j < 4; ++j) { nv[j] = (f32x4){0.f, 0.f, 0.f, 0.f}; nb[j] = (v2u){0u, 0u}; }
    if (gw < T) {
        if (l0) { const GAS f32x4* xr = (const GAS f32x4*)(xin + (size_t)gw * D) + lane;
#pragma unroll
            for (int j = 0; j < 4; ++j) nv[j] = xr[64 * j]; }
        else { const GAS v2u* xr = (const GAS v2u*)(XB + (size_t)gw * D) + lane;
#pragma unroll
            for (int j = 0; j < 4; ++j) nb[j] = xr[64 * j]; } }
    for (int m = gw; m < T; m += NGW) {
        asm volatile("" ::: "memory");
        f32x4 v[4]; float ss = 0.f;
        if (l0) { GAS v2u* xo = (GAS v2u*)(XB + (size_t)m * D) + lane;
#pragma unroll
            for (int j = 0; j < 4; ++j) { v[j] = nv[j]; xo[64 * j] = (v2u){pk2(v[j][0], v[j][1]), pk2(v[j][2], v[j][3])}; } }
        else {
#pragma unroll
            for (int j = 0; j < 4; ++j) v[j] = xb_unpack(nb[j]); }
        if (m + NGW < T) {
            if (l0) { const GAS f32x4* xr = (const GAS f32x4*)(xin + (size_t)(m + NGW) * D) + lane;
#pragma unroll
                for (int j = 0; j < 4; ++j) nv[j] = xr[64 * j]; }
            else { const GAS v2u* xr = (const GAS v2u*)(XB + (size_t)(m + NGW) * D) + lane;
#pragma unroll
                for (int j = 0; j < 4; ++j) nb[j] = xr[64 * j]; } }
#pragma unroll
        for (int j = 0; j < 4; ++j) { ss += (v[j][0] * v[j][0] + v[j][1] * v[j][1]) + (v[j][2] * v[j][2] + v[j][3] * v[j][3]); }
        const float rs = 1.0f / sqrtf(wave_sum(ss) * (1.0f / D) + EPS);
        float d8[8] = {0.f, 0.f, 0.f, 0.f, 0.f, 0.f, 0.f, 0.f};
        GAS unsigned long long* o8 = (GAS unsigned long long*)(H + (size_t)m * D) + lane; GAS unsigned* o4 = (GAS unsigned*)(ws + WS_H8 + (size_t)m * D) + lane;
        float amx = 0.f;
#pragma unroll
        for (int j = 0; j < 4; ++j) { v[j] = v[j] * rs * gv[j]; amx = fmaxf(fmaxf(amx, fmaxf(fabsf(v[j][0]), fabsf(v[j][1]))), fmaxf(fabsf(v[j][2]), fabsf(v[j][3]))); }
#pragma unroll
        for (int o = 1; o < 64; o <<= 1) amx = fmaxf(amx, __shfl_xor(amx, o));
        amx = fmaxf(amx, 1e-30f); const float qinv = 127.0f / amx;
        if (lane == 0) ((float*)(ws + WS_SA))[m] = amx * (1.0f / 127.0f);
#pragma unroll
        for (int j = 0; j < 4; ++j) {
            if constexpr (NPROJ_BF > 0) o8[64 * j] = (unsigned long long)pk2(v[j][0], v[j][1]) | ((unsigned long long)pk2(v[j][2], v[j][3]) << 32);
            { const int b0 = (int)rintf(qinv * v[j][0]), b1 = (int)rintf(qinv * v[j][1]), b2 = (int)rintf(qinv * v[j][2]), b3 = (int)rintf(qinv * v[j][3]);
              o4[64 * j] = (unsigned)(b0 & 0xff) | ((unsigned)(b1 & 0xff) << 8) | ((unsigned)(b2 & 0xff) << 16) | ((unsigned)(b3 & 0xff) << 24); }
#pragma unroll
            for (int c = 0; c < 4; ++c) { const LAS f32x4* wr = (const LAS f32x4*)wdt + (j * 4 + c) * 64 + lane; const f32x4 w0 = wr[0], w1 = wr[1024];
                d8[0] += v[j][c] * w0[0]; d8[1] += v[j][c] * w0[1]; d8[2] += v[j][c] * w0[2]; d8[3] += v[j][c] * w0[3];
                d8[4] += v[j][c] * w1[0]; d8[5] += v[j][c] * w1[1]; d8[6] += v[j][c] * w1[2]; d8[7] += v[j][c] * w1[3]; } }
        float c4[4], c2[2], c1;
        { const bool hb = (lane & 32) != 0;
#pragma unroll
          for (int i = 0; i < 4; ++i) { const float snd = hb ? d8[i] : d8[i + 4], kp = hb ? d8[i + 4] : d8[i]; c4[i] = kp + __shfl_xor(snd, 32); } }
        { const bool hb = (lane & 16) != 0;
#pragma unroll
          for (int i = 0; i < 2; ++i) { const float snd = hb ? c4[i] : c4[i + 2], kp = hb ? c4[i + 2] : c4[i]; c2[i] = kp + __shfl_xor(snd, 16); } }
        { const bool hb = (lane & 8) != 0; const float snd = hb ? c2[0] : c2[1], kp = hb ? c2[1] : c2[0]; c1 = kp + __shfl_xor(snd, 8); }
        c1 += __shfl_xor(c1, 4); c1 += __shfl_xor(c1, 2); c1 += __shfl_xor(c1, 1);
        if ((lane & 7) == 0) DT[(size_t)m * 8 + ((lane >> 3) & 7)] = softplus_f(c1 + bias_l);
    }
    __syncthreads();
}

__device__ __forceinline__ void ph_rope(const P& a, int L, unsigned char* ldsg, int gw, int NGW, int wave, int lane, int tid, int bx, bool dry) {
    bf16* PROJ = (bf16*)(a.ws + WS_PROJ);
    const int head = lane >> 3, j8 = lane & 7; const bool act = head < 6;
    const int hc = act ? head : 5;
    const float* gsrc = (hc < 4 ? a.g_qnorm : a.g_knorm) + L * 64 + j8 * 8;
    float g[8], fr[8];
#pragma unroll
    for (int i = 0; i < 8; ++i) { g[i] = gsrc[i]; fr[i] = __builtin_amdgcn_exp2f(-(float)(8 * (j8 & 1) + i) * (13.287712379549449f / 16.0f)) * 0.15915494309189535f; }
    const float osc = hc < 4 ? 0.125f * LOG2E : 1.0f;
    float kmx0 = 0.f, kmx1 = 0.f;
    float cmx0 = 0.f, cmx1 = 0.f;
    v4u nraw = (v4u){0u, 0u, 0u, 0u};
    if (gw < T) nraw = *(const v4u*)(PROJ + (size_t)gw * LDP + hc * 64 + j8 * 8);
    for (int m = gw; m < T; m += NGW) {
        const int s = m & (S - 1); const float pos = (float)((j8 & 4) ? (s & 63) : (s >> 6));
        bf16* ptr = PROJ + (size_t)m * LDP + hc * 64 + j8 * 8;
        const v4u raw = nraw;
        if (m + NGW < T) nraw = *(const v4u*)(PROJ + (size_t)(m + NGW) * LDP + hc * 64 + j8 * 8);
        float v[8]; v[0] = pg8::bf_lo(raw.x); v[1] = pg8::bf_hi(raw.x); v[2] = pg8::bf_lo(raw.y); v[3] = pg8::bf_hi(raw.y); v[4] = pg8::bf_lo(raw.z); v[5] = pg8::bf_hi(raw.z); v[6] = pg8::bf_lo(raw.w); v[7] = pg8::bf_hi(raw.w);
        float ss = 0.f;
#pragma unroll
        for (int i = 0; i < 8; ++i) ss += v[i] * v[i];
        ss += __shfl_xor(ss, 1); ss += __shfl_xor(ss, 2); ss += __shfl_xor(ss, 4);
        const float rn = 1.0f / sqrtf(ss * (1.0f / 64.0f) + EPS);
        float o[8];
#pragma unroll
        for (int i = 0; i < 8; ++i) { const float y = v[i] * rn * g[i]; const float pr = __shfl_xor(y, 2);
            const float rev = __builtin_amdgcn_fractf(pos * fr[i]); const float sn = __builtin_amdgcn_sinf(rev), cs = __builtin_amdgcn_cosf(rev);
            o[i] = ((j8 & 2) ? (pr * sn + y * cs) : (y * cs - pr * sn)) * osc; }
        v4u w; w.x = pk2(o[0], o[1]); w.y = pk2(o[2], o[3]); w.z = pk2(o[4], o[5]); w.w = pk2(o[6], o[7]);
        if (act && !dry) *(v4u*)ptr = w;
        float so = pg8::bf_lo(w.x) * pg8::bf_lo(w.x) + pg8::bf_hi(w.x) * pg8::bf_hi(w.x) + pg8::bf_lo(w.y) * pg8::bf_lo(w.y) + pg8::bf_hi(w.y) * pg8::bf_hi(w.y)
                 + pg8::bf_lo(w.z) * pg8::bf_lo(w.z) + pg8::bf_hi(w.z) * pg8::bf_hi(w.z) + pg8::bf_lo(w.w) * pg8::bf_lo(w.w) + pg8::bf_hi(w.w) * pg8::bf_hi(w.w);
        so += __shfl_xor(so, 1); so += __shfl_xor(so, 2); so += __shfl_xor(so, 4);
        if (m < S) kmx0 = fmaxf(kmx0, so); else kmx1 = fmaxf(kmx1, so);
        { const v2u cr = *(const v2u*)(PROJ + (size_t)m * LDP + PC_CK + lane * 4);
          float cs = pg8::bf_lo(cr.x) * pg8::bf_lo(cr.x) + pg8::bf_hi(cr.x) * pg8::bf_hi(cr.x) + pg8::bf_lo(cr.y) * pg8::bf_lo(cr.y) + pg8::bf_hi(cr.y) * pg8::bf_hi(cr.y);
          cs += __shfl_xor(cs, 1); cs += __shfl_xor(cs, 2); cs += __shfl_xor(cs, 4);
          if (m < S) cmx0 = fmaxf(cmx0, cs); else cmx1 = fmaxf(cmx1, cs); }
    }
    LAS float* red = (LAS float*)(LAS unsigned char*)ldsg;
    if (head >= 4 && head < 6 && j8 == 0) { red[wave * 24 + (head - 4)] = kmx0; red[wave * 24 + 2 + (head - 4)] = kmx1; }
    if ((lane & 7) == 0) { red[wave * 24 + 4 + (lane >> 3)] = cmx0; red[wave * 24 + 12 + (lane >> 3)] = cmx1; }
    __syncthreads();
    if (tid < 20) { float mx = 0.f;
#pragma unroll
        for (int w = 0; w < 8; ++w) mx = fmaxf(mx, red[w * 24 + tid]);
        ((float*)(a.ws + WS_KMAX))[bx * 32 + tid] = mx; }
    __syncthreads();
}
__device__ __forceinline__ float wave_incl_scan(float v, int lane) {
#pragma unroll
    for (int o = 1; o < 64; o <<= 1) { const float t = __shfl_up(v, o); if (lane >= o) v += t; }
    return v;
}
constexpr int LP = 136;
__device__ __forceinline__ void ssd1_unit(const P& a, int L, int u, unsigned char* ldsg, int wave, int lane, int tid) {
    LAS unsigned char* lds = (LAS unsigned char*)ldsg;
    LAS bf16* XW = (LAS bf16*)lds;
    LAS bf16* BT = (LAS bf16*)(lds + 69632);
    LAS f32x4* TABL = (LAS f32x4*)(lds + 104448);
    LAS float* WV = (LAS float*)(lds + 108544);
    LAS float* DTL = (LAS float*)(lds + 110592);
    const int g = u & 1, c = (u >> 1) & 127, b = u >> 8;
    const size_t t0 = (size_t)b * S + c * 128; const int s0 = c * 128;
    const bf16* PROJ = (const bf16*)(a.ws + WS_PROJ); bf16* XBC = (bf16*)(a.ws + WS_XBC);
    if (tid < 256) ((LAS f32x4*)DTL)[tid] = ((const f32x4*)((const float*)(a.ws + WS_DT) + t0 * 8))[tid];
    __syncthreads();
    if (wave < 4) {
        const int hl = wave >> 1, dir = wave & 1, h = 2 * g + hl;
        const float av = -__expf((dir ? a.a_log_b : a.a_log_f)[L * 4 + h]);
        const float d0 = DTL[(2 * lane) * 8 + dir * 4 + h], d1 = DTL[(2 * lane + 1) * 8 + dir * 4 + h];
        const float e0 = d0 * av, e1 = d1 * av, sm = e0 + e1;
        const float incl = wave_incl_scan(sm, lane), excl = incl - sm, tot = __shfl(incl, 63);
        const float P0 = excl + e0, P1 = incl;
        LAS float* tl0 = (LAS float*)&TABL[hl * 128 + 2 * lane]; LAS float* tl1 = (LAS float*)&TABL[hl * 128 + 2 * lane + 1];
        if (dir == 0) { tl0[0] = P0; tl1[0] = P1; tl0[2] = d0; tl1[2] = d1;
            WV[wave * 128 + 2 * lane] = d0 * __expf(tot - P0); WV[wave * 128 + 2 * lane + 1] = d1 * __expf(tot - P1); }
        else { tl0[1] = tot - P0 + e0; tl1[1] = tot - P1 + e1; tl0[3] = d0; tl1[3] = d1;
            WV[wave * 128 + 2 * lane] = d0 * __expf(P0 - e0); WV[wave * 128 + 2 * lane + 1] = d1 * __expf(P1 - e1); }
        if (lane == 0) ((float*)(a.ws + WS_CD))[(((size_t)b * 128 + c) * 4 + h) * 2 + dir] = __expf(tot);
    }
    __syncthreads();
    if (tid < 256) ((f32x4*)(a.ws + WS_TAB))[(((size_t)b * 128 + c) * 4 + 2 * g) * 128 + tid] = TABL[tid];
    const int cg = tid & 15, seg = tid >> 4, l0 = 4 * seg;
#pragma unroll 1
    for (int pass = 0; pass < 3; ++pass) {
        const int ch0 = pass * 256 + g * 128 + cg * 8;
        const float* cw = a.conv_w + (size_t)L * 5 * 768 + ch0; const float* cb = a.conv_b + (size_t)L * 768 + ch0;
        float w[5][8], bs[8];
#pragma unroll
        for (int j = 0; j < 5; ++j) { const f32x4 w0 = *(const f32x4*)(cw + j * 768), w1 = *(const f32x4*)(cw + j * 768 + 4);
            w[j][0] = w0[0]; w[j][1] = w0[1]; w[j][2] = w0[2]; w[j][3] = w0[3]; w[j][4] = w1[0]; w[j][5] = w1[1]; w[j][6] = w1[2]; w[j][7] = w1[3]; }
        { const f32x4 b0 = *(const f32x4*)cb, b1 = *(const f32x4*)(cb + 4); bs[0] = b0[0]; bs[1] = b0[1]; bs[2] = b0[2]; bs[3] = b0[3]; bs[4] = b1[0]; bs[5] = b1[1]; bs[6] = b1[2]; bs[7] = b1[3]; }
        float acc[4][8];
#pragma unroll
        for (int tk = 0; tk < 4; ++tk)
#pragma unroll
            for (int i = 0; i < 8; ++i) acc[tk][i] = bs[i];
#pragma unroll
        for (int rr = 0; rr < 8; ++rr) {
            const int pos = s0 + l0 - 2 + rr; v4u raw = (v4u){0u, 0u, 0u, 0u};
            if (pos >= 0 && pos < S) raw = *(const v4u*)(PROJ + ((size_t)b * S + pos) * LDP + PC_XS + ch0);
            float in[8]; in[0] = pg8::bf_lo(raw.x); in[1] = pg8::bf_hi(raw.x); in[2] = pg8::bf_lo(raw.y); in[3] = pg8::bf_hi(raw.y); in[4] = pg8::bf_lo(raw.z); in[5] = pg8::bf_hi(raw.z); in[6] = pg8::bf_lo(raw.w); in[7] = pg8::bf_hi(raw.w);
#pragma unroll
            for (int tk = 0; tk < 4; ++tk) { const int j = rr - tk; if (j >= 0 && j < 5) {
#pragma unroll
                for (int i = 0; i < 8; ++i) acc[tk][i] += w[j][i] * in[i]; } }
        }
#pragma unroll
        for (int tk = 0; tk < 4; ++tk) {
#pragma unroll
            for (int i = 0; i < 8; ++i) acc[tk][i] = silu_f(acc[tk][i]);
            v4u o; o.x = pk2(acc[tk][0], acc[tk][1]); o.y = pk2(acc[tk][2], acc[tk][3]); o.z = pk2(acc[tk][4], acc[tk][5]); o.w = pk2(acc[tk][6], acc[tk][7]);
            *(v4u*)(XBC + (t0 + l0 + tk) * 768 + ch0) = o; }
        if (pass == 0) {
            const int hl = cg >> 3, p0 = (cg & 7) * 8;
#pragma unroll
            for (int dir = 0; dir < 2; ++dir) { const int hd = hl * 2 + dir; const f32x4 wv = *(const LAS f32x4*)(WV + hd * 128 + l0);
#pragma unroll
                for (int i = 0; i < 8; ++i) { v2u o; o.x = pk2(acc[0][i] * wv[0], acc[1][i] * wv[1]); o.y = pk2(acc[2][i] * wv[2], acc[3][i] * wv[3]);
                    *(LAS v2u*)(XW + (hd * 64 + p0 + i) * LP + l0) = o; } }
        } else if (pass == 1) {
#pragma unroll
            for (int i = 0; i < 8; ++i) { v2u o; o.x = pk2(acc[0][i], acc[1][i]); o.y = pk2(acc[2][i], acc[3][i]); *(LAS v2u*)(BT + (cg * 8 + i) * LP + l0) = o; }
        }
    }
    __syncthreads();
    {
        const int hd = wave >> 1, ph = wave & 1, fr = lane & 15, fq = lane >> 4;
        f32x4 acc[2][8];
#pragma unroll
        for (int mt = 0; mt < 2; ++mt)
#pragma unroll
            for (int nt = 0; nt < 8; ++nt) acc[mt][nt] = (f32x4){0.f, 0.f, 0.f, 0.f};
#pragma unroll
        for (int ks = 0; ks < 4; ++ks) {
            bf16x8 af[2];
#pragma unroll
            for (int mt = 0; mt < 2; ++mt) af[mt] = *(const LAS bf16x8*)(XW + (hd * 64 + ph * 32 + mt * 16 + fr) * LP + 32 * ks + 8 * fq);
#pragma unroll
            for (int nt = 0; nt < 8; ++nt) { const bf16x8 bfr = *(const LAS bf16x8*)(BT + (16 * nt + fr) * LP + 32 * ks + 8 * fq);
#pragma unroll
                for (int mt = 0; mt < 2; ++mt) acc[mt][nt] = mfma16(af[mt], bfr, acc[mt][nt]); }
        }
        const int hl = hd >> 1, dir = hd & 1, h = 2 * g + hl;
        bf16* ST = (bf16*)(a.ws + WS_ST) + ((((size_t)b * 128 + c) * 4 + h) * 2 + dir) * 8192;
#pragma unroll
        for (int mt = 0; mt < 2; ++mt)
#pragma unroll
            for (int nt = 0; nt < 8; ++nt)
#pragma unroll
                for (int ii = 0; ii < 4; ++ii) ST[(ph * 32 + mt * 16 + 4 * fq + ii) * 128 + 16 * nt + fr] = (bf16)f2bf(acc[mt][nt][ii]);
    }
    __syncthreads();
}

__device__ __forceinline__ void ph_scan(const P& a, int gtid, int GT) {
    const unsigned* ST2 = (const unsigned*)(a.ws + WS_ST); unsigned* SB2 = (unsigned*)(a.ws + WS_SB); const float* CD = (const float*)(a.ws + WS_CD);
    for (int e2 = gtid; e2 < NB * 4 * 2 * 8192 / 2; e2 += GT) {
        const int e = 2 * e2, b = e >> 16, rem = e & 65535, dir = (rem >> 13) & 1, h = rem >> 14;
        float s0 = 0.f, s1 = 0.f;
#pragma unroll 1
        for (int c8 = 0; c8 < 128; c8 += 8) {
            unsigned cs[8]; float cd[8];
#pragma unroll
            for (int k = 0; k < 8; ++k) { const int c = dir ? 127 - (c8 + k) : (c8 + k); cs[k] = ST2[(((size_t)b * 128 + c) * 65536 + rem) >> 1]; cd[k] = CD[(((size_t)b * 128 + c) * 4 + h) * 2 + dir]; }
#pragma unroll
            for (int k = 0; k < 8; ++k) { const int c = dir ? 127 - (c8 + k) : (c8 + k); SB2[(((size_t)b * 128 + c) * 65536 + rem) >> 1] = pk2(s0, s1);
                s0 = s0 * cd[k] + __builtin_bit_cast(float, cs[k] << 16); s1 = s1 * cd[k] + __builtin_bit_cast(float, cs[k] & 0xffff0000u); }
        }
    }
}

__device__ __forceinline__ void ssd3_unit(const P& a, int L, int u, unsigned char* ldsg, int wave, int lane, int tid) {
    LAS unsigned char* lds = (LAS unsigned char*)ldsg;
    LAS bf16* CG = (LAS bf16*)lds;
    LAS bf16* BG = (LAS bf16*)(lds + 34816);
    LAS bf16* XT = (LAS bf16*)(lds + 69632);
    LAS f32x4* TB = (LAS f32x4*)(lds + 104448);
    const int g = u & 1, c = (u >> 1) & 127, b = u >> 8; const size_t t0 = (size_t)b * S + c * 128;
    const bf16* XBC = (const bf16*)(a.ws + WS_XBC); const bf16* SB = (const bf16*)(a.ws + WS_SB); const bf16* PROJ = (const bf16*)(a.ws + WS_PROJ);
    const int fr = lane & 15, fq = lane >> 4, w = wave;
#pragma unroll
    for (int i = 0; i < 4; ++i) { const int q = tid + 512 * i, row = q >> 4, pc = q & 15;
        const bf16* src = XBC + (t0 + row) * 768 + g * 128 + pc * 8;
        *(LAS v4u*)(CG + row * LP + pc * 8) = *(const v4u*)(src + 512);
        *(LAS v4u*)(BG + row * LP + pc * 8) = *(const v4u*)(src + 256);
        const v4u xr = *(const v4u*)src; const int hl = pc >> 3, p = (pc & 7) * 8;
        LAS bf16* xd = XT + (hl * 64 + p) * LP + row;
        xd[0 * LP] = (bf16)(xr.x & 0xffffu); xd[1 * LP] = (bf16)(xr.x >> 16); xd[2 * LP] = (bf16)(xr.y & 0xffffu); xd[3 * LP] = (bf16)(xr.y >> 16);
        xd[4 * LP] = (bf16)(xr.z & 0xffffu); xd[5 * LP] = (bf16)(xr.z >> 16); xd[6 * LP] = (bf16)(xr.w & 0xffffu); xd[7 * LP] = (bf16)(xr.w >> 16); }
    if (tid < 256) TB[tid] = ((const f32x4*)(a.ws + WS_TAB))[(((size_t)b * 128 + c) * 4 + 2 * g) * 128 + tid];
    __syncthreads();
    bf16x8 cf[4];
#pragma unroll
    for (int ks = 0; ks < 4; ++ks) cf[ks] = *(const LAS bf16x8*)(CG + (16 * w + fr) * LP + 32 * ks + 8 * fq);
    f32x4 Gt[8];
#pragma unroll
    for (int j = 0; j < 8; ++j) { Gt[j] = (f32x4){0.f, 0.f, 0.f, 0.f};
#pragma unroll
        for (int ks = 0; ks < 4; ++ks) Gt[j] = mfma16(*(const LAS bf16x8*)(BG + (16 * j + fr) * LP + 32 * ks + 8 * fq), cf[ks], Gt[j]); }
    __syncthreads();
    LAS bf16* ZS = CG; LAS bf16* SS = BG;
#pragma unroll
    for (int i = 0; i < 4; ++i) { const int q = tid + 512 * i, row = q >> 4, pc = q & 15;
        *(LAS v4u*)(ZS + row * LP + pc * 8) = *(const v4u*)(PROJ + (t0 + row) * LDP + PC_Z + g * 128 + pc * 8); }
    float* SSQ = (float*)(a.ws + WS_SSQ);
    const int lrow = 16 * w + fr;
#pragma unroll 1
    for (int hl = 0; hl < 2; ++hl) {
        const int h = 2 * g + hl;
        if (hl) __syncthreads();
        { const bf16* Sp = SB + (((size_t)b * 128 + c) * 4 + h) * 2 * 8192;
#pragma unroll
          for (int i = 0; i < 4; ++i) { const int q = tid + 512 * i, row = q >> 4, pc = q & 15;
              *(LAS v4u*)(SS + row * LP + pc * 8) = *(const v4u*)(Sp + (size_t)row * 128 + pc * 8); } }
        __syncthreads();
        f32x4 Y[4];
#pragma unroll
        for (int pt = 0; pt < 4; ++pt) Y[pt] = (f32x4){0.f, 0.f, 0.f, 0.f};
        {
            const f32x4 tl = TB[hl * 128 + lrow];
            bf16x8 wf[4];
#pragma unroll
            for (int ks = 0; ks < 4; ++ks) { float wv[8];
#pragma unroll
                for (int hf = 0; hf < 2; ++hf)
#pragma unroll
                    for (int ii = 0; ii < 4; ++ii) { const int j = 2 * ks + hf, s = 16 * j + 4 * fq + ii; const f32x4 ts = TB[hl * 128 + s];
                        const float mf = ts[2] * __expf(fminf(tl[0] - ts[0], 0.f)), mb = ts[3] * __expf(fminf(tl[1] - ts[1], 0.f));
                        const float mm = (s < lrow) ? mf : (s > lrow) ? mb : (ts[2] + ts[3]);
                        wv[hf * 4 + ii] = Gt[j][ii] * mm; }
                v4u pk; pk.x = pk2(wv[0], wv[1]); pk.y = pk2(wv[2], wv[3]); pk.z = pk2(wv[4], wv[5]); pk.w = pk2(wv[6], wv[7]); wf[ks] = __builtin_bit_cast(bf16x8, pk); }
#pragma unroll
            for (int pt = 0; pt < 4; ++pt)
#pragma unroll
                for (int ks = 0; ks < 4; ++ks) { const LAS bf16* xp = XT + (hl * 64 + 16 * pt + fr) * LP + 32 * ks + 4 * fq;
                    const v2u x0 = *(const LAS v2u*)xp, x1 = *(const LAS v2u*)(xp + 16); const v4u xx = (v4u){x0.x, x0.y, x1.x, x1.y};
                    Y[pt] = mfma16(wf[ks], __builtin_bit_cast(bf16x8, xx), Y[pt]); }
        }
#pragma unroll
        for (int dir = 0; dir < 2; ++dir) {
            f32x4 Tt[4];
#pragma unroll
            for (int pt = 0; pt < 4; ++pt) { Tt[pt] = (f32x4){0.f, 0.f, 0.f, 0.f};
#pragma unroll
                for (int ks = 0; ks < 4; ++ks) Tt[pt] = mfma16(cf[ks], *(const LAS bf16x8*)(SS + (dir * 64 + 16 * pt + fr) * LP + 32 * ks + 8 * fq), Tt[pt]); }
#pragma unroll
            for (int ii = 0; ii < 4; ++ii) { const f32x4 tr = TB[hl * 128 + 16 * w + 4 * fq + ii]; const float e = __expf(dir ? tr[1] : tr[0]);
#pragma unroll
                for (int pt = 0; pt < 4; ++pt) Y[pt][ii] += e * Tt[pt][ii]; }
        }
        const float dsk = a.d_skip[L * 4 + h];
#pragma unroll
        for (int pt = 0; pt < 4; ++pt) { const v2u xv = *(const LAS v2u*)(XT + (hl * 64 + 16 * pt + fr) * LP + 16 * w + 4 * fq);
            Y[pt][0] += dsk * pg8::bf_lo(xv.x); Y[pt][1] += dsk * pg8::bf_hi(xv.x); Y[pt][2] += dsk * pg8::bf_lo(xv.y); Y[pt][3] += dsk * pg8::bf_hi(xv.y); }
        float ss[4] = {0.f, 0.f, 0.f, 0.f};
#pragma unroll
        for (int pt = 0; pt < 4; ++pt) { const int chl = hl * 64 + 16 * pt + fr; const float gn = a.g_ssm[L * 256 + g * 128 + chl];
#pragma unroll
            for (int ii = 0; ii < 4; ++ii) { LAS bf16* zp = ZS + (16 * w + 4 * fq + ii) * LP + chl;
                const float z = bf2f(*zp); const float y = Y[pt][ii] * silu_f(z); ss[ii] += y * y; *zp = (bf16)f2bf(y * gn); } }
#pragma unroll
        for (int ii = 0; ii < 4; ++ii) { float sq = ss[ii]; sq += __shfl_xor(sq, 1); sq += __shfl_xor(sq, 2); sq += __shfl_xor(sq, 4); sq += __shfl_xor(sq, 8);
            if (fr == 0) SSQ[(t0 + 16 * w + 4 * fq + ii) * 4 + h] = sq; }
    }
    __syncthreads();
    bf16* BR = (bf16*)(a.ws + WS_BR);
#pragma unroll
    for (int i = 0; i < 4; ++i) { const int q = tid + 512 * i, row = q >> 4, pc = q & 15;
        *(v4u*)(BR + (t0 + row) * 1024 + 256 + g * 128 + pc * 8) = *(const LAS v4u*)(ZS + row * LP + pc * 8); }
    __syncthreads();
}

__device__ __forceinline__ void sgu_unit(const P& a, int L, int u, unsigned char* ldsg, int wave, int lane, int tid) {
    LAS bf16* VT = (LAS bf16*)(LAS unsigned char*)ldsg;
    const int b = u >> 7, c = u & 127; const size_t t0 = (size_t)b * S + c * 128;
    const bf16* PROJ = (const bf16*)(a.ws + WS_PROJ); bf16* BR = (bf16*)(a.ws + WS_BR); const bf16* WSP = (const bf16*)(a.ws + WS_WSP);
    const f32x4 gs = *(const f32x4*)(a.g_sgu + L * 256 + 4 * lane);
#pragma unroll 1
    for (int k = 0; k < 16; ++k) { const int s = 16 * wave + k;
        const v2u raw = *(const v2u*)(PROJ + (t0 + s) * LDP + PC_UV + 256 + 4 * lane);
        float v[4]; v[0] = gelu_tanh(pg8::bf_lo(raw.x)); v[1] = gelu_tanh(pg8::bf_hi(raw.x)); v[2] = gelu_tanh(pg8::bf_lo(raw.y)); v[3] = gelu_tanh(pg8::bf_hi(raw.y));
        const float rn = 1.0f / sqrtf(wave_sum(v[0] * v[0] + v[1] * v[1] + v[2] * v[2] + v[3] * v[3]) * (1.0f / 256.0f) + EPS);
#pragma unroll
        for (int i = 0; i < 4; ++i) VT[(4 * lane + i) * LP + s] = (bf16)f2bf(v[i] * rn * gs[i]); }
    __syncthreads();
    const int g = wave >> 1, th = wave & 1, fr = lane & 15, fq = lane >> 4;
    f32x4 acc[4][4];
#pragma unroll
    for (int mt = 0; mt < 4; ++mt)
#pragma unroll
        for (int nt = 0; nt < 4; ++nt) acc[mt][nt] = (f32x4){0.f, 0.f, 0.f, 0.f};
#pragma unroll
    for (int ks = 0; ks < 4; ++ks) {
        bf16x8 af[4];
#pragma unroll
        for (int mt = 0; mt < 4; ++mt) af[mt] = *(const bf16x8*)(WSP + (size_t)(g * 128 + 64 * th + 16 * mt + fr) * 128 + 32 * ks + 8 * fq);
#pragma unroll
        for (int nt = 0; nt < 4; ++nt) { const bf16x8 bfr = *(const LAS bf16x8*)(VT + (g * 64 + 16 * nt + fr) * LP + 32 * ks + 8 * fq);
#pragma unroll
            for (int mt = 0; mt < 4; ++mt) acc[mt][nt] = mfma16(af[mt], bfr, acc[mt][nt]); }
    }
#pragma unroll
    for (int mt = 0; mt < 4; ++mt)
#pragma unroll
        for (int ii = 0; ii < 4; ++ii) { const int tl = 64 * th + 16 * mt + 4 * fq + ii; const float bsv = a.b_spatial[(L * 4 + g) * 128 + tl];
#pragma unroll
            for (int nt = 0; nt < 4; ++nt) { const int ch = g * 64 + 16 * nt + fr;
                const float uu = gelu_tanh(bf2f(PROJ[(t0 + tl) * LDP + PC_UV + ch]));
                BR[(t0 + tl) * 1024 + 768 + ch] = (bf16)f2bf(uu * (acc[mt][nt][ii] + bsv)); } }
    __syncthreads();
}
__device__ __forceinline__ void ph_r1(const P& a, int L, unsigned char* ldsg, int gw, int NGW, int lane, int tid) {
    LAS float* wrt = (LAS float*)(LAS unsigned char*)ldsg;
    { const float* wr = a.w_router + (size_t)L * 1024 * 16;
      for (int i = tid; i < 1024 * 16 / 4; i += NTHR) { const int kq = i >> 2, q = i & 3, pos = ((kq >> 8) * 4 + (kq & 3)) * 64 + ((kq >> 2) & 63); ((LAS f32x4*)wrt)[q * 1024 + pos] = ((const f32x4*)wr)[i]; } }
    __syncthreads();
    const float* gm = a.g_moe + L * D; bf16* H = (bf16*)(a.ws + WS_H); float* AFF = (float*)(a.ws + WS_AFF); short* INV = (short*)(a.ws + WS_INV);
    f32x4 gv[4];
#pragma unroll
    for (int j = 0; j < 4; ++j) gv[j] = ((const f32x4*)gm)[lane + 64 * j];
    const bf16* XB = (const bf16*)(a.ws + WS_XB);
    v2u nv[4];
    if (gw < T) { const GAS v2u* xr = (const GAS v2u*)(XB + (size_t)gw * D) + lane;
#pragma unroll
        for (int j = 0; j < 4; ++j) nv[j] = xr[64 * j]; }
    for (int m = gw; m < T; m += NGW) {
        asm volatile("" ::: "memory");
        f32x4 v[4]; float ss = 0.f;
#pragma unroll
        for (int j = 0; j < 4; ++j) v[j] = xb_unpack(nv[j]);
        if (m + NGW < T) { const GAS v2u* xr = (const GAS v2u*)(XB + (size_t)(m + NGW) * D) + lane;
#pragma unroll
            for (int j = 0; j < 4; ++j) nv[j] = xr[64 * j]; }
#pragma unroll
        for (int j = 0; j < 4; ++j) { ss += (v[j][0] * v[j][0] + v[j][1] * v[j][1]) + (v[j][2] * v[j][2] + v[j][3] * v[j][3]); }
        const float rs = 1.0f / sqrtf(wave_sum(ss) * (1.0f / D) + EPS);
        float lg[16];
#pragma unroll
        for (int i = 0; i < 16; ++i) lg[i] = 0.f;
        GAS unsigned* o4 = (GAS unsigned*)((unsigned char*)H + (size_t)m * D) + lane;
#pragma unroll
        for (int j = 0; j < 4; ++j) { v[j] = v[j] * rs * gv[j];
            { int t = 0; t = __builtin_amdgcn_cvt_pk_fp8_f32(v[j][0], v[j][1], t, false); t = __builtin_amdgcn_cvt_pk_fp8_f32(v[j][2], v[j][3], t, true); o4[64 * j] = (unsigned)t; }
#pragma unroll
            for (int c = 0; c < 4; ++c) { const LAS f32x4* wr = (const LAS f32x4*)wrt + (j * 4 + c) * 64 + lane;
#pragma unroll
                for (int q = 0; q < 4; ++q) { const f32x4 w4 = wr[q * 1024]; lg[4 * q] += v[j][c] * w4[0]; lg[4 * q + 1] += v[j][c] * w4[1]; lg[4 * q + 2] += v[j][c] * w4[2]; lg[4 * q + 3] += v[j][c] * w4[3]; } } }
        float a8[8], a4[4], a2[2], a1;
        { const bool hb = (lane & 32) != 0;
#pragma unroll
          for (int i = 0; i < 8; ++i) { const float snd = hb ? lg[i] : lg[i + 8], kp = hb ? lg[i + 8] : lg[i]; a8[i] = kp + __shfl_xor(snd, 32); } }
        { const bool hb = (lane & 16) != 0;
#pragma unroll
          for (int i = 0; i < 4; ++i) { const float snd = hb ? a8[i] : a8[i + 4], kp = hb ? a8[i + 4] : a8[i]; a4[i] = kp + __shfl_xor(snd, 16); } }
        { const bool hb = (lane & 8) != 0;
#pragma unroll
          for (int i = 0; i < 2; ++i) { const float snd = hb ? a4[i] : a4[i + 2], kp = hb ? a4[i + 2] : a4[i]; a2[i] = kp + __shfl_xor(snd, 8); } }
        { const bool hb = (lane & 4) != 0; const float snd = hb ? a2[0] : a2[1], kp = hb ? a2[1] : a2[0]; a1 = kp + __shfl_xor(snd, 4); }
        a1 += __shfl_xor(a1, 2); a1 += __shfl_xor(a1, 1);
        float mx = a1; mx = fmaxf(mx, __shfl_xor(mx, 4)); mx = fmaxf(mx, __shfl_xor(mx, 8)); mx = fmaxf(mx, __shfl_xor(mx, 16)); mx = fmaxf(mx, __shfl_xor(mx, 32));
        const float ex = __expf(a1 - mx); float sum = ex; sum += __shfl_xor(sum, 4); sum += __shfl_xor(sum, 8); sum += __shfl_xor(sum, 16); sum += __shfl_xor(sum, 32);
        const int b = m / S, s = m % S;
        if ((lane & 3) == 0) AFF[((size_t)b * NE + ((lane >> 2) & 15)) * S + s] = ex / sum;
        if (lane < 2) { unsigned m1 = 0xffffffffu; asm volatile("" : "+v"(m1)); ((GAS v4u*)(INV + (size_t)m * NE))[lane] = (v4u){m1, m1, m1, m1}; }
    }
    __syncthreads();
}

__device__ __forceinline__ void sel_unit(const P& a, int q, unsigned char* ldsg, int wave, int lane, int tid) {
    LAS unsigned* vals = (LAS unsigned*)(LAS unsigned char*)ldsg;
    LAS unsigned* hist = vals + S;
    LAS unsigned* sc = hist + 256;
    const int b = q / NE, e = q % NE;
    const float* AFF = (const float*)(a.ws + WS_AFF) + ((size_t)b * NE + e) * S;
    for (int i = tid; i < S; i += NTHR) vals[i] = __float_as_uint(AFF[i]);
    unsigned prefix = 0u, mask = 0u, kk = CAP;
#pragma unroll 1
    for (int pass = 0; pass < 4; ++pass) {
        const int shift = 24 - 8 * pass;
        if (tid < 256) hist[tid] = 0u;
        __syncthreads();
        for (int i = tid; i < S; i += NTHR) { const unsigned v = vals[i]; if ((v & mask) == prefix) __hip_atomic_fetch_add(&hist[(v >> shift) & 255u], 1u, __ATOMIC_RELAXED, __HIP_MEMORY_SCOPE_WORKGROUP); }
        __syncthreads();
        if (wave == 0) {
            unsigned c4[4]; unsigned s4 = 0u;
#pragma unroll
            for (int j = 0; j < 4; ++j) { c4[j] = hist[4 * lane + j]; s4 += c4[j]; }
            unsigned suf = s4;
#pragma unroll
            for (int o = 1; o < 64; o <<= 1) { const unsigned t = __shfl_down(suf, o); if (lane + o < 64) suf += t; }
            unsigned cum = suf - s4;
#pragma unroll
            for (int j = 3; j >= 0; --j) { if (cum < kk && cum + c4[j] >= kk) { sc[0] = prefix | ((unsigned)(4 * lane + j) << shift); sc[1] = kk - cum; } cum += c4[j]; }
        }
        __syncthreads();
        prefix = sc[0]; kk = sc[1]; mask |= 255u << shift;
        __syncthreads();
    }
    const unsigned thr = prefix, need_eq = kk, total_gt = CAP - kk;
    unsigned cg = 0u, ce = 0u;
    for (int j = 0; j < 32; ++j) { const unsigned v = vals[32 * tid + ((j + tid) & 31)]; cg += (v > thr) ? 1u : 0u; ce += (v == thr) ? 1u : 0u; }
    unsigned pk = (cg << 16) | ce, inc = pk;
#pragma unroll
    for (int o = 1; o < 64; o <<= 1) { const unsigned t = __shfl_up(inc, o); if (lane >= o) inc += t; }
    if (lane == 63) sc[8 + wave] = inc;
    __syncthreads();
    unsigned base = 0u;
    for (int w2 = 0; w2 < wave; ++w2) base += sc[8 + w2];
    const unsigned exc = base + inc - pk; unsigned pg = exc >> 16, pe = exc & 0xffffu;
    int* SELIDX = (int*)(a.ws + WS_SELIDX) + (size_t)e * (NB * CAP) + b * CAP; float* SELAFF = (float*)(a.ws + WS_SELAFF) + (size_t)e * (NB * CAP) + b * CAP;
    short* INV = (short*)(a.ws + WS_INV);
    for (int j = 0; j < 32; ++j) { const int idx = 32 * tid + j; const unsigned v = vals[idx]; int slot = -1;
        if (v > thr) { slot = (int)pg; ++pg; } else if (v == thr) { if (pe < need_eq) slot = (int)(total_gt + pe); ++pe; }
        if (slot >= 0) { SELIDX[slot] = idx; SELAFF[slot] = __uint_as_float(v); INV[((size_t)b * S + idx) * NE + e] = (short)slot; } }
    __syncthreads();
}

__device__ __forceinline__ void ph_gather(const P& a, int gw, int NGW, int lane) {
    const int* SELIDX = (const int*)(a.ws + WS_SELIDX); const bf16* H = (const bf16*)(a.ws + WS_H); bf16* XE = (bf16*)(a.ws + WS_XE);
    for (int r = gw; r < NE * NB * CAP; r += NGW) { const int b = (r >> 11) & 1; const int tok = SELIDX[r];
        const v4u* src = (const v4u*)(H + ((size_t)b * S + tok) * D); v4u* dst = (v4u*)(XE + (size_t)r * D);
        const v4u v0 = src[lane], v1 = src[lane + 64]; dst[lane] = v0; dst[lane + 64] = v1; }
}

__device__ __forceinline__ void ph_r2(const P& a, int L, int gw, int NGW, int lane, bool dry) {
    const float* gm = a.g_ple + L * D; bf16* H = (bf16*)(a.ws + WS_H); const short* INV = (const short*)(a.ws + WS_INV); const unsigned char* YE = (const unsigned char*)(a.ws + WS_YE); const float* SAFF = (const float*)(a.ws + WS_SELAFF);
    f32x4 gv[4];
#pragma unroll
    for (int j = 0; j < 4; ++j) gv[j] = ((const f32x4*)gm)[lane + 64 * j];
    bf16* XB = (bf16*)(a.ws + WS_XB);
    v2u nv[4]; short ninv = -1;
    if (gw < T) { const GAS v2u* xq = (const GAS v2u*)(XB + (size_t)gw * D) + lane;
#pragma unroll
        for (int j = 0; j < 4; ++j) nv[j] = xq[64 * j];
        ninv = INV[(size_t)gw * NE + (lane & 15)]; }
    for (int m = gw; m < T; m += NGW) {
        GAS v2u* xr = (GAS v2u*)(XB + (size_t)m * D) + lane;
        f32x4 v[4];
#pragma unroll
        for (int j = 0; j < 4; ++j) v[j] = xb_unpack(nv[j]);
        const int b = m / S;
        const short myinv = ninv;
        if (m + NGW < T) { const GAS v2u* xq = (const GAS v2u*)(XB + (size_t)(m + NGW) * D) + lane;
#pragma unroll
            for (int j = 0; j < 4; ++j) nv[j] = xq[64 * j];
            ninv = INV[(size_t)(m + NGW) * NE + (lane & 15)]; }
        unsigned em = (unsigned)__builtin_amdgcn_readfirstlane((int)(__ballot(myinv >= 0) & 0xffffull));
#pragma unroll 1
        while (em) {
            unsigned y[4][4]; int ee[4]; float af[4] = {0.f, 0.f, 0.f, 0.f};
#pragma unroll
            for (int q = 0; q < 4; ++q) { ee[q] = em ? (int)__builtin_ctz(em) : -1; if (em) em &= em - 1u;
                if (ee[q] >= 0) { const int slot = __builtin_amdgcn_readfirstlane((int)__shfl((int)myinv, ee[q]));
                    af[q] = 0.25f * SAFF[(size_t)ee[q] * (NB * CAP) + b * CAP + slot];
                    const unsigned* yr = (const unsigned*)(YE + ((size_t)ee[q] * (NB * CAP) + b * CAP + slot) * D) + lane;
#pragma unroll
                    for (int j = 0; j < 4; ++j) y[q][j] = yr[64 * j]; } }
#pragma unroll
            for (int q = 0; q < 4; ++q) if (ee[q] >= 0) {
#pragma unroll
                for (int j = 0; j < 4; ++j) { typedef float f32x2r __attribute__((ext_vector_type(2)));
                    const f32x2r lo = __builtin_amdgcn_cvt_pk_f32_fp8((int)y[q][j], false), hi = __builtin_amdgcn_cvt_pk_f32_fp8((int)y[q][j], true);
                    v[j][0] += af[q] * lo[0]; v[j][1] += af[q] * lo[1]; v[j][2] += af[q] * hi[0]; v[j][3] += af[q] * hi[1]; } }
        }
        float ss = 0.f;
#pragma unroll
        for (int j = 0; j < 4; ++j) { if (!dry) xr[64 * j] = (v2u){pk2(v[j][0], v[j][1]), pk2(v[j][2], v[j][3])}; ss += (v[j][0] * v[j][0] + v[j][1] * v[j][1]) + (v[j][2] * v[j][2] + v[j][3] * v[j][3]); }
        const float rs = 1.0f / sqrtf(wave_sum(ss) * (1.0f / D) + EPS);
        GAS unsigned* o4 = (GAS unsigned*)(a.ws + WS_H8 + (size_t)m * D) + lane;
        float amx = 0.f;
#pragma unroll
        for (int j = 0; j < 4; ++j) { v[j] = v[j] * rs * gv[j]; amx = fmaxf(fmaxf(amx, fmaxf(fabsf(v[j][0]), fabsf(v[j][1]))), fmaxf(fabsf(v[j][2]), fabsf(v[j][3]))); }
#pragma unroll
        for (int o = 1; o < 64; o <<= 1) amx = fmaxf(amx, __shfl_xor(amx, o));
        amx = fmaxf(amx, 1e-30f); const float qinv = 127.0f / amx;
        if (lane == 0 && !dry) ((float*)(a.ws + WS_SA))[m] = amx * (1.0f / 127.0f);
#pragma unroll
        for (int j = 0; j < 4; ++j) { const int b0 = (int)rintf(qinv * v[j][0]), b1 = (int)rintf(qinv * v[j][1]), b2 = (int)rintf(qinv * v[j][2]), b3 = (int)rintf(qinv * v[j][3]);
            if (!dry) o4[64 * j] = (unsigned)(b0 & 0xff) | ((unsigned)(b1 & 0xff) << 8) | ((unsigned)(b2 & 0xff) << 16) | ((unsigned)(b3 & 0xff) << 24); }
    }
}
__device__ __forceinline__ void ph_final(const P& a, int gw, int NGW, int lane, float oscale) {
    f32x4 gv[4];
#pragma unroll
    for (int j = 0; j < 4; ++j) gv[j] = ((const f32x4*)a.g_final)[lane + 64 * j];
    const bf16* XB = (const bf16*)(a.ws + WS_XB);
    v2u nv[4];
    if (gw < T) { const GAS v2u* xq = (const GAS v2u*)(XB + (size_t)gw * D) + lane;
#pragma unroll
        for (int j = 0; j < 4; ++j) nv[j] = xq[64 * j]; }
    for (int m = gw; m < T; m += NGW) {
        GAS f32x4* xr = (GAS f32x4*)(a.out + (size_t)m * D) + lane;
        f32x4 v[4]; float ss = 0.f;
#pragma unroll
        for (int j = 0; j < 4; ++j) v[j] = xb_unpack(nv[j]);
        if (m + NGW < T) { const GAS v2u* xq = (const GAS v2u*)(XB + (size_t)(m + NGW) * D) + lane;
#pragma unroll
            for (int j = 0; j < 4; ++j) nv[j] = xq[64 * j]; }
#pragma unroll
        for (int j = 0; j < 4; ++j) { ss += (v[j][0] * v[j][0] + v[j][1] * v[j][1]) + (v[j][2] * v[j][2] + v[j][3] * v[j][3]); }
        const float rs = 1.0f / sqrtf(wave_sum(ss) * (1.0f / D) + EPS);
#pragma unroll
        for (int j = 0; j < 4; ++j) xr[64 * j] = v[j] * (rs * oscale) * gv[j];
    }
}

typedef const __attribute__((address_space(4))) P* kargp_t;
__device__ __forceinline__ P load_args(kargp_t p) { P a; a.x = p->x; a.p = p->p; a.rel_bias = p->rel_bias; a.g_mix = p->g_mix; a.w_in = p->w_in; a.g_qnorm = p->g_qnorm; a.g_knorm = p->g_knorm; a.conv_w = p->conv_w; a.conv_b = p->conv_b; a.dt_bias_f = p->dt_bias_f; a.dt_bias_b = p->dt_bias_b; a.a_log_f = p->a_log_f; a.a_log_b = p->a_log_b; a.d_skip = p->d_skip; a.g_ssm = p->g_ssm; a.lambda_q1 = p->lambda_q1; a.lambda_k1 = p->lambda_k1; a.lambda_q2 = p->lambda_q2; a.lambda_k2 = p->lambda_k2; a.g_diff = p->g_diff; a.g_sgu = p->g_sgu; a.w_spatial = p->w_spatial; a.b_spatial = p->b_spatial; a.w_branch = p->w_branch; a.w_branch_gate = p->w_branch_gate; a.w_out = p->w_out; a.g_moe = p->g_moe; a.w_router = p->w_router; a.w_exp_gate = p->w_exp_gate; a.w_exp_up = p->w_exp_up; a.w_exp_down = p->w_exp_down; a.g_ple = p->g_ple; a.w_ple_gate = p->w_ple_gate; a.w_ple = p->w_ple; a.g_final = p->g_final; a.out = p->out; a.ws = p->ws; a.gp_lo = p->gp_lo; a.gp_hi = p->gp_hi; return a; }
__device__ __forceinline__ int my_lane_volatile() { int l; asm volatile("v_mbcnt_lo_u32_b32 %0, -1, 0\n\tv_mbcnt_hi_u32_b32 %0, -1, %0" : "=v"(l)); return l; }
#ifndef PROBE_PH
#define PROBE_PH -1
#endif
#ifndef REPMASK
#define REPMASK 0u
#endif
#define NREP(bit) (((REPMASK >> (bit)) & 1u) ? 2 : 1)
#define REPEAT(bit) _Pragma("unroll 1") for (int rep_ = 0; rep_ < NREP(bit); ++rep_)
#ifndef PHMASK
#define PHMASK 0xFFFFu
#endif
__global__ void __launch_bounds__(NTHR, 2) mk_fwd(P a_in) {
    extern __shared__ __attribute__((aligned(16))) unsigned char lds[];
    const int G = gridDim.x, bx = blockIdx.x, NGW = G * NWAVES, GT = G * NTHR;
    gu32* ctl = (gu32*)(a_in.ws + WS_CTL);
    volatile LAS unsigned* MISC = (volatile LAS unsigned*)((LAS unsigned char*)lds + MISC_OFF);
    for (int u = threadIdx.x; u < (LDS_BYTES - LDSCTL_OFF) / 4; u += NTHR) ((LAS unsigned*)((LAS unsigned char*)lds + LDSCTL_OFF))[u] = 0u;
    __syncthreads();
    const bool multi = (a_in.gp_hi - a_in.gp_lo) > 1;
    XcdBarrier bar; bar.bar = (unsigned*)(ctl + CW_BAR); bar.x = 0; bar.st = nullptr;
    const int wave0 = __builtin_amdgcn_readfirstlane((int)threadIdx.x >> 6);
    if (multi) bar = xcd_barrier_post((unsigned*)(ctl + CW_BAR), MISC + 8, (int)threadIdx.x);
    const int lo = a_in.gp_lo, hi = a_in.gp_hi;
    unsigned long long tacc = 0ull, tic0 = 0ull; (void)tic0;
#define TIC(ph) do { if (PROBE_PH == (ph)) tic0 = __builtin_amdgcn_s_memrealtime(); } while (0)
#define TOC(ph) do { if (PROBE_PH == (ph)) tacc += __builtin_amdgcn_s_memrealtime() - tic0; } while (0)
#define IN(k) (((PHMASK >> (((k) < DEPTH * NPH) ? ((k) % NPH) : 14)) & 1u) && lo <= (k) && (k) < hi)
#define MY_TID() ((wave0 << 6) | my_lane_volatile())
#define SEAM(k) do { if (IN(k) && IN((k) + 1)) { XcdBarrier b2_ = bar; asm volatile("" : "+s"(b2_.bar)); xcd_barrier(b2_, MY_TID()); if ((REPMASK >> 21) & 1u) xcd_barrier(b2_, MY_TID()); } } while (0)
#define PHASE_IDS() int tid = MY_TID(); asm volatile("" : "+v"(tid)); const int lane = tid & 63; const int wave = __builtin_amdgcn_readfirstlane(tid >> 6); \
    const int gw = bx * NWAVES + wave; const int gtid = bx * NTHR + tid; (void)lane; (void)gw; (void)gtid; \
    kargp_t ap_ = (kargp_t)__builtin_amdgcn_kernarg_segment_ptr(); asm volatile("" : "+s"(ap_)); const P a = load_args(ap_); \
    unsigned char* const ws = a.ws; bf16* const H = (bf16*)(ws + WS_H); bf16* const PROJ = (bf16*)(ws + WS_PROJ); bf16* const GATES = (bf16*)(ws + WS_GATES); bf16* const BR = (bf16*)(ws + WS_BR); \
    LAS unsigned char* const ldsl = (LAS unsigned char*)lds; (void)H; (void)PROJ; (void)GATES; (void)BR; (void)ldsl

#pragma unroll 1
    for (int L = 0; L < DEPTH; ++L) {
        const int g0 = L * NPH;
        TIC(0);
        if (IN(g0 + 0)) REPEAT(0) { PHASE_IDS(); ph_convw(a, L, lds, gw, NGW, wave, lane, tid, gtid, GT, bx, G, 0); }
        if (IN(g0 + 0)) { PHASE_IDS(); ph_r0(a, L, lds, gw, NGW, lane, tid); } SEAM(g0 + 0); TOC(0);
        TIC(1);
        if (NPROJ_BF > 0 && IN(g0 + 1)) REPEAT(1) { PHASE_IDS();
            pg8::Gemm g{H, (const bf16*)(ws + WS_WCAT), T, NPROJ_BF, D, 0}; pg8::StaticOrder So; So.init(T, NPROJ_BF, G, bx);
            pg8::EpiG1 E{PROJ, GATES, 0.17677669529663687f * LOG2E, rep_ + 1 < NREP(1)};
            pg8::gemm_phase<pg8::EpiG1, pg8::StaticOrder, true, true>(ldsl, g, So, E, tid);
        }
        if (IN(g0 + 1)) { PHASE_IDS();
            pg8::Gemm g{(const bf16*)(ws + WS_PBF), (const bf16*)(ws + WS_WPLE), T, D, 256, 0}; pg8::TailOrder So{G, bx, 0};
            pg8::EpiPlain E{(bf16*)(ws + WS_PL), D};
            pg8::gemm_phase<pg8::EpiPlain, pg8::TailOrder, true, true, false, false, false, PAD_PL0>(ldsl, g, So, E, tid);
        }
        if (IN(g0 + 1)) REPEAT(1) { PHASE_IDS();
            pg8::StaticOrder So; So.init(T, NPROJ_I8, G, bx);
            LAS unsigned* gtab = (LAS unsigned*)(ldsl + RING_BYTES + 512);
            {
#pragma unroll 1
              for (int ui = 0; ui < 6; ++ui) { pg8::Unit uu; const bool okk = So.next(ui, uu); const int rb = okk ? uu.pm * 256 : 0; if (tid < 256) gtab[ui * 256 + tid] = (unsigned)(rb + tid) * (unsigned)D; }
              __syncthreads(); }
            pg8::Gemm g{(const bf16*)(ws + WS_H8), (const bf16*)(ws + WS_WCAT + (size_t)NPROJ_BF * 2048), T, NPROJ_I8, D / 2, 0};
            pg8::EpiProjI8 E{PROJ, (const float*)(ws + WS_SA), (const float*)(ws + WS_SW) + 5120, NPROJ_BF, 0.17677669529663687f * LOG2E, rep_ + 1 < NREP(1)};
            pg8::gemm_phase<pg8::EpiProjI8, pg8::StaticOrder, true, true, true, false, true, PAD_PROJ>(ldsl, g, So, E, tid, gtab);
        }
        if (IN(g0 + 1)) { PHASE_IDS();
            pg8::Gemm g{(const bf16*)(ws + WS_PBF), (const bf16*)(ws + WS_WPLE), T, D, 256, 0}; pg8::TailOrder So{G, bx, 1};
            pg8::EpiPlain E{(bf16*)(ws + WS_PL), D};
            pg8::gemm_phase<pg8::EpiPlain, pg8::TailOrder, true, true, false, false, false, PAD_PL>(ldsl, g, So, E, tid);
        }
        if (IN(g0 + 1)) { PHASE_IDS();
            pg8::StaticOrder So; So.init(T, NGATE, G, bx);
            LAS unsigned* gtab = (LAS unsigned*)(ldsl + RING_BYTES + 512);
            {
#pragma unroll 1
              for (int ui = 0; ui < 8; ++ui) { pg8::Unit uu; const bool okk = So.next(ui, uu); const int rb = okk ? uu.pm * 256 : 0; if (tid < 256) gtab[ui * 256 + tid] = (unsigned)(rb + tid) * (unsigned)D; }
              __syncthreads(); }
            pg8::Gemm g{(const bf16*)(ws + WS_H8), (const bf16*)(ws + WS_WCAT + (size_t)NPROJ * 2048), T, NGATE, D / 2, 0};
            pg8::EpiGateI8 E{GATES, (const float*)(ws + WS_SA), (const float*)(ws + WS_SW), 0};
            pg8::gemm_phase<pg8::EpiGateI8, pg8::StaticOrder, true, true, true, false, true, PAD_GATE>(ldsl, g, So, E, tid, gtab);
        } SEAM(g0 + 1); TOC(1);
        TIC(2);
        if (IN(g0 + 2)) {
            REPEAT(16) { PHASE_IDS(); ph_rope(a, L, lds, gw, NGW, wave, lane, tid, bx, rep_ + 1 < NREP(16)); }
            REPEAT(2) { PHASE_IDS(); for (int u = bx; u < 512; u += G) ssd1_unit(a, L, u, lds, wave, lane, tid); }
            REPEAT(2) { PHASE_IDS(); for (int u = bx; u < 256; u += G) sgu_unit(a, L, u, lds, wave, lane, tid); }
        } SEAM(g0 + 2); TOC(2);
        TIC(3);
        if (IN(g0 + 3)) {
            REPEAT(3) { PHASE_IDS(); ph_scan(a, gtid, GT); }
        } SEAM(g0 + 3); TOC(3);
        TIC(4);
        if (IN(g0 + 4)) {
            REPEAT(4) { PHASE_IDS(); for (int u = bx; u < 512; u += G) ssd3_unit(a, L, u, lds, wave, lane, tid); }
            REPEAT(14) { PHASE_IDS(); const attn_body::bf16* Pj = (const attn_body::bf16*)PROJ; attn_body::bf16* Bo = (attn_body::bf16*)BR;
              for (int u = bx; u < 512; u += G) {
                const int rnd = u >> 8, cc = u & 255, xc = cc & 7, rr = cc >> 3;
                const int b = xc >> 2, hq = xc & 3, qb = rr + 32 * rnd; const size_t rb = (size_t)b * S;
                const attn_body::bf16 *qp = Pj + rb * LDP + PC_AQ + hq * 64, *kp = Pj + rb * LDP + PC_AK + (hq >> 1) * 64, *vp = Pj + rb * LDP + PC_AV + (hq >> 1) * 64; attn_body::bf16* op = Bo + rb * 1024 + hq * 64;
                const bool ok = attn_body::attn_bound<false>(qp, qb * 256, (char*)lds, (const float*)(ws + WS_KMAX) + b * 2 + (hq >> 1), 0.f, tid);
                if (ok) attn_body::attn_unit<false, 8, true, false>(qp, kp, vp, op, qb * 256, (char*)lds, nullptr, 0, 0.f, 0.f, nullptr, 0.f, tid);
                else    attn_body::attn_unit<false, 8, false>(qp, kp, vp, op, qb * 256, (char*)lds, nullptr, 0, 0.f, 0.f, nullptr, 0.f, tid); }
              if ((REPMASK >> 23) & 1u) { XcdBarrier b2_ = bar; asm volatile("" : "+s"(b2_.bar)); xcd_barrier(b2_, MY_TID()); } }
            REPEAT(15) { PHASE_IDS(); const attn_body::bf16* Pj = (const attn_body::bf16*)PROJ; attn_body::bf16* Bo = (attn_body::bf16*)BR;
              float lam;
              { float t1 = (lane < 32) ? a.lambda_q1[L * 32 + (lane & 31)] * a.lambda_k1[L * 32 + (lane & 31)] : 0.f; float t2 = (lane < 32) ? a.lambda_q2[L * 32 + (lane & 31)] * a.lambda_k2[L * 32 + (lane & 31)] : 0.f;
                t1 = wave_sum(t1); t2 = wave_sum(t2);
                lam = __expf(t1) - __expf(t2) + (0.8f - 0.6f * __expf(-0.3f * (float)L)); }
              const float osc = 1.0f - (0.8f - 0.6f * __expf(-0.3f * (float)L));
              for (int u = bx; u < 1024; u += G) {
                const int rnd = u >> 8, cc = u & 255, xc = cc & 7, rr = cc >> 3;
                const int b = xc >> 2, h = xc & 3, qb = rr + 32 * rnd; const size_t rb = (size_t)b * S;
                const attn_body::bf16 *qp = Pj + rb * LDP + PC_CQ + h * 64, *kp = Pj + rb * LDP + PC_CK + h * 64, *vp = Pj + rb * LDP + PC_CV + h * 64; attn_body::bf16* op = Bo + rb * 1024 + 512 + h * 64;
                float bmax = -3.0e38f;
                for (int bk = 0; bk < 32; ++bk) bmax = fmaxf(bmax, LOG2E * a.rel_bias[bk * 4 + h]);
                const bool ok = attn_body::attn_bound<true>(qp, qb * 128, (char*)lds, (const float*)(ws + WS_KMAX) + 4 + b * 8 + h * 2, bmax, tid);
                if (ok) attn_body::attn_unit<true, 8, true>(qp, kp, vp, op, qb * 128, (char*)lds, a.rel_bias, h, lam, osc, a.g_diff + L * 64, bmax, tid);
                else    attn_body::attn_unit<true, 8, false>(qp, kp, vp, op, qb * 128, (char*)lds, a.rel_bias, h, lam, osc, a.g_diff + L * 64, bmax, tid); }
              if ((REPMASK >> 23) & 1u) { XcdBarrier b2_ = bar; asm volatile("" : "+s"(b2_.bar)); xcd_barrier(b2_, MY_TID()); } }
        } SEAM(g0 + 4); TOC(4);
        TIC(5);
        if (IN(g0 + 5)) REPEAT(5) { PHASE_IDS();
            pg8::Gemm g{BR, (const bf16*)(ws + WS_WBR), T, NGATE, 256, 1024}; pg8::MergeOrder So{G, bx};
            LAS float* rrt = (LAS float*)(ldsl + RING_BYTES + 512);
            { const int k = tid >> 8, rl = tid & 255; const int tile = k * G + (bx & 7) * (G >> 3) + (bx >> 3); if (tile < 512) { const f32x4 q = *(const f32x4*)((const float*)(ws + WS_SSQ) + ((size_t)(tile >> 2) * 256 + rl) * 4);
                  const float ms = ((q[0] + q[1]) + (q[2] + q[3])) * (1.0f / 256.0f) + 1e-6f; const float sq = sqrtf(ms); rrt[(k * 256 + rl) * 2] = sq; rrt[(k * 256 + rl) * 2 + 1] = 1.0f / sq; }
              __syncthreads(); }
            pg8::EpiMergeHorner E{GATES, H, rrt, ((bx & 7) * (G >> 3) + (bx >> 3)) >> 2, (rep_ + 1 < NREP(5)) && !((REPMASK >> 22) & 1u)};
            pg8::gemm_phase<pg8::EpiMergeHorner, pg8::MergeOrder, true, true, false, false, false, PAD_P5>(ldsl, g, So, E, tid);
        } SEAM(g0 + 5); TOC(5);
        TIC(6);
        if (IN(g0 + 6)) REPEAT(6) { PHASE_IDS();
            pg8::Gemm g{H, (const bf16*)(ws + WS_WOUT), T, D, D, 0}; pg8::StaticOrder So; So.init(T, D, G, bx);
            pg8::EpiResidB E{(bf16*)(ws + WS_XB), rep_ + 1 < NREP(6)};
            pg8::gemm_phase<pg8::EpiResidB, pg8::StaticOrder, true, true, false, false, false, PAD_P6>(ldsl, g, So, E, tid);
        } SEAM(g0 + 6); TOC(6);
        TIC(7);
        if (IN(g0 + 7)) REPEAT(7) { PHASE_IDS(); ph_r1(a, L, lds, gw, NGW, lane, tid); } SEAM(g0 + 7); TOC(7);
        TIC(8);
        if (IN(g0 + 8)) REPEAT(8) { PHASE_IDS(); for (int q = bx; q < NB * NE; q += G) sel_unit(a, q, lds, wave, lane, tid); }
        SEAM(g0 + 8); TOC(8);
        TIC(9);
        TIC(10);
        if (IN(g0 + 10)) REPEAT(10) { PHASE_IDS();
            pg8::ExpertOrder So{8, G, bx};
            LAS unsigned* gtab = (LAS unsigned*)(ldsl + RING_BYTES + 512);
            { const int* SELIDX = (const int*)(ws + WS_SELIDX);
#pragma unroll 1
              for (int ui = 0; ui < 8; ++ui) { pg8::Unit uu; const bool okk = So.next(ui, uu);
                  if (tid < 256) { unsigned off = 0u; if (okk) { const int r = uu.pm * 256 + tid, b = (r >> 11) & 1; off = (unsigned)((b * S + SELIDX[r]) * D); }
                      gtab[ui * 256 + tid] = off; } }
              __syncthreads(); }
            pg8::Gemm g{H, (const bf16*)(ws + WS_WGU), NE * NB * CAP, NE * 2048, D / 2, 0};
            pg8::EpiGU8 E{(unsigned char*)(ws + WS_HID), (rep_ + 1 < NREP(10)) ? (int)(((REPMASK >> 20) & 1u) + 2 * ((REPMASK >> 24) & 1u)) : 0};
            pg8::gemm_phase<pg8::EpiGU8, pg8::ExpertOrder, true, true, true, true, false, PAD_GU>(ldsl, g, So, E, tid, gtab);
        } SEAM(g0 + 10); TOC(10);
        TIC(11);
        if (IN(g0 + 11)) REPEAT(11) { PHASE_IDS();
            pg8::ExpertOrder So{4, G, bx};
            LAS unsigned* gtab = (LAS unsigned*)(ldsl + RING_BYTES + 512);
            {
#pragma unroll 1
              for (int ui = 0; ui < 4; ++ui) { pg8::Unit uu; const bool okk = So.next(ui, uu); const int rb = okk ? uu.pm * 256 : 0; if (tid < 256) gtab[ui * 256 + tid] = (unsigned)(rb + tid) * (unsigned)D; }
              __syncthreads(); }
            pg8::Gemm g{(const bf16*)(ws + WS_HID), (const bf16*)(ws + WS_WDN), NE * NB * CAP, NE * 1024, D / 2, 0};
            pg8::EpiDNP8 E{(unsigned char*)(ws + WS_YE), (rep_ + 1 < NREP(11)) ? (int)(((REPMASK >> 20) & 1u) + 2 * ((REPMASK >> 24) & 1u)) : 0};
            pg8::gemm_phase<pg8::EpiDNP8, pg8::ExpertOrder, true, true, true, true, false, PAD_DN>(ldsl, g, So, E, tid, gtab);
        } SEAM(g0 + 11); TOC(11);
        TIC(12);
        if (IN(g0 + 12)) REPEAT(12) { PHASE_IDS(); ph_r2(a, L, gw, NGW, lane, rep_ + 1 < NREP(12)); } SEAM(g0 + 12); TOC(12);
        TIC(13);
        if (IN(g0 + 13)) REPEAT(13) { PHASE_IDS();
            pg8::StaticOrder So; So.init(T, D, G, bx);
            LAS unsigned* gtab = (LAS unsigned*)(ldsl + RING_BYTES + 512);
            {
#pragma unroll 1
              for (int ui = 0; ui < 2; ++ui) { pg8::Unit uu; const bool okk = So.next(ui, uu); const int rb = okk ? uu.pm * 256 : 0; if (tid < 256) gtab[ui * 256 + tid] = (unsigned)(rb + tid) * (unsigned)D; }
              __syncthreads(); }
            pg8::Gemm g{(const bf16*)(ws + WS_H8), (const bf16*)(ws + WS_WPG), T, D, D / 2, 0};
            pg8::EpiPleI8B E{(bf16*)(ws + WS_XB), (const bf16*)(ws + WS_PL), (const float*)(ws + WS_SA), (const float*)(ws + WS_SW) + 4096, rep_ + 1 < NREP(13)};
            pg8::gemm_phase<pg8::EpiPleI8B, pg8::StaticOrder, true, true, true, false, true, PAD_PLE>(ldsl, g, So, E, tid, gtab);
        } SEAM(g0 + 13); TOC(13);
    }
    float oscale = 1.0f;
#if PROBE_PH >= 0
    oscale = 1.0f + sqrtf((float)tacc * 1e-6f);
#endif
    if (IN(DEPTH * NPH)) { PHASE_IDS(); ph_final(a, gw, NGW, lane, oscale); }
#undef IN
#undef SEAM
#undef PHASE_IDS
}

#ifndef MK_ONE_LAUNCH
#define MK_ONE_LAUNCH 1
#endif
extern "C" void kernel_launch(void* const* d_in, const int* in_sizes, int n_in, void* d_out, int out_size, void* d_ws, size_t ws_size, hipStream_t stream) {
    static int grid = 0;
    if (grid == 0) {
        if (n_in != 35 || in_sizes[0] != T * D || out_size != T * D || ws_size < WS_END) { fprintf(stderr, "kernel_launch: unexpected shapes (n_in %d, in0 %d, out %d, ws %zu)\n", n_in, n_in > 0 ? in_sizes[0] : -1, out_size, ws_size); grid = -1; return; }
        int dev = 0, cus = 0, per_cu = 0;
        if (hipGetDevice(&dev) != hipSuccess || hipDeviceGetAttribute(&cus, hipDeviceAttributeMultiprocessorCount, dev) != hipSuccess) { grid = -1; return; }
        if (hipFuncSetAttribute((const void*)mk_fwd, hipFuncAttributeMaxDynamicSharedMemorySize, LDS_BYTES) != hipSuccess) { fprintf(stderr, "kernel_launch: hipFuncSetAttribute failed\n"); grid = -1; return; }
        if (hipOccupancyMaxActiveBlocksPerMultiprocessor(&per_cu, (const void*)mk_fwd, NTHR, LDS_BYTES) != hipSuccess || per_cu < 1) { fprintf(stderr, "kernel_launch: occupancy query says %d\n", per_cu); }
        (void)hipGetLastError();
        if (cus < 256) { fprintf(stderr, "kernel_launch: built for a 256-CU device (got %d)\n", cus); grid = -1; return; }
        grid = 256;
    }
    if (grid < 0) return;
    (void)hipMemsetAsync((char*)d_ws + WS_CTL, 0, CTL_ZERO_BYTES, stream);
    P a{};
    const float** pp = (const float**)&a;
    for (int i = 0; i < 35; ++i) pp[i] = (const float*)d_in[i];
    a.out = (float*)d_out; a.ws = (unsigned char*)d_ws;
#if MK_ONE_LAUNCH
    a.gp_lo = 0; a.gp_hi = NGP;
    hipLaunchKernelGGL(mk_fwd, dim3(grid), dim3(NTHR), LDS_BYTES, stream, a);
#else
    for (int gp = 0; gp < NGP; ++gp) { a.gp_lo = gp; a.gp_hi = gp + 1; hipLaunchKernelGGL(mk_fwd, dim3(grid), dim3(NTHR), LDS_BYTES, stream, a); }
#endif
}
```

```cpp
#include <hip/hip_runtime.h>
#include <hip/hip_bf16.h>
#include <cstdio>
#include <cstdint>
#include <cmath>
#ifndef REPMASK
#define REPMASK 0u
#endif
#define MK_PROBE_BUILD ((REPMASK) != 0u)
namespace pg8 {
#define PG8_LAS __attribute__((address_space(3)))
typedef unsigned short bf16_t;
typedef short bf16x8 __attribute__((ext_vector_type(8)));
typedef float f32x4 __attribute__((ext_vector_type(4)));
typedef unsigned u32x4 __attribute__((ext_vector_type(4)));
constexpr int BM = 256, BK = 64, HALF = 128, HTB = HALF * BK * 2  , STAGE_BYTES = 8 * HTB, NXCD = 8, WGM = 8;

__host__ __device__ __forceinline__ int lds_byte(int r, int c) { const int st = (r >> 4) * 2 + (c >> 5), rr = r & 15, cc = c & 31, ob = rr * 64 + cc * 2; return st * 1024 + (ob ^ (((ob >> 9) & 1) << 5)); }
__host__ __device__ __forceinline__ void stage_rc(int b, int& R, int& C) { const int st = b / 1024, sb = b % 1024, swz = sb ^ (((sb >> 9) & 1) << 5); R = (st >> 1) * 16 + swz / 64; C = (st & 1) * 32 + (swz % 64) / 2; }
__host__ __device__ __forceinline__ int perm32(int rho) { const int n = rho >> 4, i = rho & 15; return 8 * (i >> 2) + 4 * n + (i & 3); }

struct Unit { int pm, pn; };
struct Gemm { const bf16_t* A; const bf16_t* Bt; int M, N, K, lda; };

struct StaticOrder {
    int nM, nN, nwg, G, c;
    __host__ __device__ void init(int M, int N, int G_, int c_) { nM = M / BM; nN = N / BM; nwg = nM * nN; G = G_; c = c_; }
    __host__ __device__ __forceinline__ bool next(int i, Unit& u) const {
        const long L = (long)i * G + c; if (L >= nwg) return false;
        int wgid = (int)L; { const int q = nwg / NXCD, r = nwg % NXCD, xcd = wgid % NXCD, off = wgid / NXCD; wgid = (xcd < r ? xcd * (q + 1) : r * (q + 1) + (xcd - r) * q) + off; }
        const int nig = WGM * nN, gid = wgid / nig, fm = gid * WGM, gsz = (nM - fm) < WGM ? (nM - fm) : WGM;
        u.pm = fm + ((wgid % nig) % gsz); u.pn = (wgid % nig) / gsz; return true;
    }
    __device__ __forceinline__ void a_ready(const Unit&) const {}
    __device__ __forceinline__ void done(const Unit&) const {}
    __device__ __forceinline__ size_t a_off(const Unit&) const { return 0; }
};

__device__ __forceinline__ unsigned cvt_pk_bf16(float lo, float hi) { unsigned r; asm volatile("v_cvt_pk_bf16_f32 %0, %1, %2" : "=v"(r) : "v"(lo), "v"(hi)); return r; }
typedef float f32x2 __attribute__((ext_vector_type(2)));
__device__ __forceinline__ float ub0(unsigned w) { return (float)(w & 0xffu); }
__device__ __forceinline__ float ub1(unsigned w) { return (float)((w >> 8) & 0xffu); }
__device__ __forceinline__ float ub2(unsigned w) { return (float)((w >> 16) & 0xffu); }
__device__ __forceinline__ float ub3(unsigned w) { return (float)(w >> 24); }
__device__ __forceinline__ float bf_lo(unsigned w) { return __builtin_bit_cast(float, w << 16); }
__device__ __forceinline__ float bf_hi(unsigned w) { return __builtin_bit_cast(float, w & 0xffff0000u); }
__device__ __forceinline__ float sigmoid_f(float x) { return __builtin_amdgcn_rcpf(1.0f + __builtin_amdgcn_exp2f(-1.4426950408889634f * x)); }
__device__ __forceinline__ u32x4 pack8(const f32x4 v0, const f32x4 v1) { u32x4 w; w.x = cvt_pk_bf16(v0[0], v0[1]); w.y = cvt_pk_bf16(v0[2], v0[3]); w.z = cvt_pk_bf16(v1[0], v1[1]); w.w = cvt_pk_bf16(v1[2], v1[3]); return w; }

struct ExpertOrder {
    int nNl, G, c;
    __device__ __forceinline__ bool next(int i, Unit& u) const {
        const int L = i * G + c, per = 16 * nNl; if (L >= 16 * per) return false;
        const int e = L / per, w = L % per; u.pm = e * 16 + (w % 16); u.pn = e * nNl + (w / 16); return true;
    }
    __device__ __forceinline__ void a_ready(const Unit&) const {}
    __device__ __forceinline__ void done(const Unit&) const {}
    __device__ __forceinline__ size_t a_off(const Unit&) const { return 0; }
};
struct BranchOrder : StaticOrder {
    __device__ __forceinline__ size_t a_off(const Unit& u) const { return (size_t)(u.pn >> 2) * 256 * 2; }
};

struct EpiG1 {
    static constexpr bool PERM = true, AFTER_DRAIN = false, MIDHOOK = false;
    bf16_t* proj; bf16_t* gates; float qscale; int dry;
    __device__ __forceinline__ void operator()(const f32x4 (&acc)[2][2][4][2], const Unit& u, int wr, int wc, int fr, int fq) const {
        if (dry) return;
        int row0 = u.pm * BM + wr * 64 + fr; asm volatile("" : "+v"(row0));
        const bool isg = u.pn >= 11;
        if (isg) {
            unsigned char* base = (unsigned char*)gates + ((size_t)(u.pm * 16 + (u.pn - 11)) << 16) + ((wr * 4 + wc) * 64 + fq * 16 + fr) * 8;
#pragma unroll
            for (int ai = 0; ai < 2; ++ai)
#pragma unroll
                for (int m = 0; m < 4; ++m)
#pragma unroll
                    for (int bj = 0; bj < 2; ++bj) { f32x4 v0 = acc[ai][bj][m][0], v1 = acc[ai][bj][m][1];
#pragma unroll
                        for (int i = 0; i < 4; ++i) { v0[i] = fmaxf(255.0f * sigmoid_f(v0[i]), 1.0f); v1[i] = fmaxf(255.0f * sigmoid_f(v1[i]), 1.0f); }
                        unsigned w0 = 0u, w1 = 0u;
                        w0 = __builtin_amdgcn_cvt_pk_u8_f32(v0[0], 0, w0); w0 = __builtin_amdgcn_cvt_pk_u8_f32(v0[1], 1, w0); w0 = __builtin_amdgcn_cvt_pk_u8_f32(v0[2], 2, w0); w0 = __builtin_amdgcn_cvt_pk_u8_f32(v0[3], 3, w0);
                        w1 = __builtin_amdgcn_cvt_pk_u8_f32(v1[0], 0, w1); w1 = __builtin_amdgcn_cvt_pk_u8_f32(v1[1], 1, w1); w1 = __builtin_amdgcn_cvt_pk_u8_f32(v1[2], 2, w1); w1 = __builtin_amdgcn_cvt_pk_u8_f32(v1[3], 3, w1);
                        typedef unsigned u32x2g __attribute__((ext_vector_type(2)));
                        *(u32x2g*)(base + (((ai * 4 + m) * 2 + bj) << 12)) = (u32x2g){w0, w1}; }
        } else {
            const float sc = (u.pn == 2) ? qscale : 1.0f;
            const int col0 = u.pn * BM + wc * 32 + 8 * fq;
#pragma unroll
            for (int ai = 0; ai < 2; ++ai)
#pragma unroll
                for (int m = 0; m < 4; ++m) { bf16_t* rowp = proj + (size_t)(row0 + ai * HALF + m * 16) * 2816 + col0;
#pragma unroll
                    for (int bj = 0; bj < 2; ++bj) *(u32x4*)(rowp + bj * HALF) = pack8(acc[ai][bj][m][0] * sc, acc[ai][bj][m][1] * sc); }
        }
    }
};
struct EpiProjI8 {
    static constexpr bool PERM = true, AFTER_DRAIN = false, MIDHOOK = false;
    bf16_t* proj; const float* sa; const float* sw; int cbase; float qscale; int dry;
    __device__ __forceinline__ void operator()(const f32x4 (&acc)[2][2][4][2], const Unit& u, int wr, int wc, int fr, int fq) const {
        if (dry) return;
        typedef int i32x4e __attribute__((ext_vector_type(4)));
        int row0 = u.pm * BM + wr * 64 + fr; asm volatile("" : "+v"(row0));
        const int col0 = u.pn * BM + wc * 32 + 8 * fq;
        f32x4 cw[2][2]; const float sc = ((cbase >> 8) + u.pn == 2) ? qscale : 1.0f;
#pragma unroll
        for (int bj = 0; bj < 2; ++bj) { cw[bj][0] = *(const f32x4*)(sw + col0 + bj * HALF) * sc; cw[bj][1] = *(const f32x4*)(sw + col0 + bj * HALF + 4) * sc; }
        float RS[2][4];
#pragma unroll
        for (int ai = 0; ai < 2; ++ai)
#pragma unroll
            for (int m = 0; m < 4; ++m) RS[ai][m] = sa[row0 + ai * HALF + m * 16];
        __builtin_amdgcn_sched_barrier(0);
#pragma unroll
        for (int ai = 0; ai < 2; ++ai)
#pragma unroll
            for (int m = 0; m < 4; ++m) { const int r = row0 + ai * HALF + m * 16; const float rsc = RS[ai][m]; bf16_t* rowp = proj + (size_t)r * 2816 + cbase + col0;
#pragma unroll
                for (int bj = 0; bj < 2; ++bj) { const i32x4e a0 = __builtin_bit_cast(i32x4e, acc[ai][bj][m][0]), a1 = __builtin_bit_cast(i32x4e, acc[ai][bj][m][1]); f32x4 v0, v1;
#pragma unroll
                    for (int i = 0; i < 4; ++i) { v0[i] = (float)a0[i] * rsc * cw[bj][0][i]; v1[i] = (float)a1[i] * rsc * cw[bj][1][i]; }
                    *(u32x4*)(rowp + bj * HALF) = pack8(v0, v1); } }
    }
};
struct EpiGateI8 {
    static constexpr bool PERM = true, AFTER_DRAIN = false, MIDHOOK = false;
    bf16_t* gates; const float* sa; const float* sw; int dry;
    __device__ __forceinline__ void operator()(const f32x4 (&acc)[2][2][4][2], const Unit& u, int wr, int wc, int fr, int fq) const {
        if (dry) return;
        typedef unsigned u32x2g __attribute__((ext_vector_type(2))); typedef int i32x4e __attribute__((ext_vector_type(4)));
        int row0 = u.pm * BM + wr * 64 + fr; asm volatile("" : "+v"(row0));
        unsigned char* base = (unsigned char*)gates + ((size_t)(u.pm * 16 + u.pn) << 16) + ((wr * 4 + wc) * 64 + fq * 16 + fr) * 8;
        const int colb = u.pn * BM + wc * 32 + 8 * fq;
        f32x4 cw[2][2];
#pragma unroll
        for (int bj = 0; bj < 2; ++bj) { cw[bj][0] = *(const f32x4*)(sw + colb + bj * HALF); cw[bj][1] = *(const f32x4*)(sw + colb + bj * HALF + 4); }
        float RS[2][4];
#pragma unroll
        for (int ai = 0; ai < 2; ++ai)
#pragma unroll
            for (int m = 0; m < 4; ++m) RS[ai][m] = sa[row0 + ai * HALF + m * 16];
        __builtin_amdgcn_sched_barrier(0);
#pragma unroll
        for (int ai = 0; ai < 2; ++ai)
#pragma unroll
            for (int m = 0; m < 4; ++m) { const float rsn = RS[ai][m] * -1.4426950408889634f;
#pragma unroll
                for (int bj = 0; bj < 2; ++bj) { const i32x4e a0 = __builtin_bit_cast(i32x4e, acc[ai][bj][m][0]), a1 = __builtin_bit_cast(i32x4e, acc[ai][bj][m][1]); f32x4 v0, v1;
#pragma unroll
                    for (int i = 0; i < 4; ++i) { v0[i] = fmaxf(__builtin_amdgcn_rcpf(__builtin_fmaf(__builtin_amdgcn_exp2f((float)a0[i] * rsn * cw[bj][0][i]), 1.0f / 255.0f, 1.0f / 255.0f)), 1.0f);
                                                  v1[i] = fmaxf(__builtin_amdgcn_rcpf(__builtin_fmaf(__builtin_amdgcn_exp2f((float)a1[i] * rsn * cw[bj][1][i]), 1.0f / 255.0f, 1.0f / 255.0f)), 1.0f); }
                    unsigned w0 = 0u, w1 = 0u;
                    w0 = __builtin_amdgcn_cvt_pk_u8_f32(v0[0], 0, w0); w0 = __builtin_amdgcn_cvt_pk_u8_f32(v0[1], 1, w0); w0 = __builtin_amdgcn_cvt_pk_u8_f32(v0[2], 2, w0); w0 = __builtin_amdgcn_cvt_pk_u8_f32(v0[3], 3, w0);
                    w1 = __builtin_amdgcn_cvt_pk_u8_f32(v1[0], 0, w1); w1 = __builtin_amdgcn_cvt_pk_u8_f32(v1[1], 1, w1); w1 = __builtin_amdgcn_cvt_pk_u8_f32(v1[2], 2, w1); w1 = __builtin_amdgcn_cvt_pk_u8_f32(v1[3], 3, w1);
                    *(u32x2g*)(base + (((ai * 4 + m) * 2 + bj) << 12)) = (u32x2g){w0, w1}; } }
    }
};
struct EpiPlain {
    static constexpr bool PERM = true, AFTER_DRAIN = false, MIDHOOK = false;
    bf16_t* O; int ldc;
    __device__ __forceinline__ void operator()(const f32x4 (&acc)[2][2][4][2], const Unit& u, int wr, int wc, int fr, int fq) const {
        int row0 = u.pm * BM + wr * 64 + fr, col0 = u.pn * BM + wc * 32 + 8 * fq; asm volatile("" : "+v"(row0));
#pragma unroll
        for (int ai = 0; ai < 2; ++ai)
#pragma unroll
            for (int m = 0; m < 4; ++m) { bf16_t* rowp = O + (size_t)(row0 + ai * HALF + m * 16) * ldc + col0;
#pragma unroll
                for (int bj = 0; bj < 2; ++bj) *(u32x4*)(rowp + bj * HALF) = pack8(acc[ai][bj][m][0], acc[ai][bj][m][1]); }
    }
};
struct TileOrder {
    int t, nNl;
    __device__ __forceinline__ bool next(int i, Unit& u) const { if (i >= nNl) return false; u.pm = t; u.pn = (t >> 4) * nNl + i; return true; }
    __device__ __forceinline__ void a_ready(const Unit&) const {}
    __device__ __forceinline__ void done(const Unit&) const {}
    __device__ __forceinline__ size_t a_off(const Unit&) const { return 0; }
};
struct TailOrder {
    int G, c, part;
    __device__ __forceinline__ bool next(int i, Unit& u) const { const int hG = G >> 1; const bool lo = c < hG; const int n = lo ? 1 : 3, nf = lo ? (c & 1) : (c & 3);
        const int idx = (part == 0) ? i : nf + i; if ((part == 0) ? (i >= nf) : (idx >= n)) return false;
        const int L = lo ? 3 * hG + c : (c - hG) + hG * idx; if (L >= 512) return false; u.pm = L >> 2; u.pn = L & 3; return true; }
    __device__ __forceinline__ void a_ready(const Unit&) const {}
    __device__ __forceinline__ void done(const Unit&) const {}
    __device__ __forceinline__ size_t a_off(const Unit&) const { return 0; }
};
struct MergeOrder {
    int G, c;
    __device__ __forceinline__ bool next(int i, Unit& u) const { const int tile = (i >> 2) * G + c; if (tile >= 512) return false; u.pm = tile >> 2; u.pn = (i & 3) * 4 + (tile & 3); return true; }
    __device__ __forceinline__ void a_ready(const Unit&) const {}
    __device__ __forceinline__ void done(const Unit&) const {}
    __device__ __forceinline__ size_t a_off(const Unit& u) const { return (size_t)(u.pn >> 2) * 256 * 2; }
};
struct EpiMergeHorner {
    static constexpr bool PERM = true, AFTER_DRAIN = false, MIDHOOK = true;
    static constexpr int NSTORE = 0;
    const bf16_t* gates; bf16_t* O; const __attribute__((address_space(3))) float* rrt; int pm0; int dry;
    typedef unsigned u32x2q __attribute__((ext_vector_type(2)));
    struct Carry { u32x2q g[4][2]; };
    __device__ __forceinline__ bool mut(f32x4 (&acc)[2][2][4][2], const Unit& u, int wr, int wc, int fr, int fq, Carry& cy) const {
        const int n = u.pn >> 2, pd = u.pn & 3;
        if (dry) return n != 3;
        int row0 = u.pm * BM + wr * 64 + fr, col0 = pd * BM + wc * 32 + 8 * fq; asm volatile("" : "+v"(row0));
        const unsigned char* gp0 = (const unsigned char*)gates + ((size_t)(u.pm * 16 + u.pn) << 16) + ((wr * 4 + wc) * 64 + fq * 16 + fr) * 8;
        u32x2q GA[2][4][2], GB[2][4][2];
#pragma unroll
        for (int ai = 0; ai < 2; ++ai)
#pragma unroll
            for (int m = 0; m < 4; ++m)
#pragma unroll
                for (int bj = 0; bj < 2; ++bj) { const unsigned char* gp = gp0 + (((ai * 4 + m) * 2 + bj) << 12);
                    if (ai == 0) GA[ai][m][bj] = (n == 0) ? *(const u32x2q*)gp : cy.g[m][bj];
                    else         GA[ai][m][bj] = *(const u32x2q*)gp;
                    GB[ai][m][bj] = (n != 3) ? *(const u32x2q*)(gp + (4 << 16)) : (u32x2q){0u, 0u}; }
        const __attribute__((address_space(3))) float* rt = rrt + ((u.pm != pm0) ? 512 : 0) + (wr * 64 + fr) * 2 + ((n == 0) ? 0 : 1);
#pragma unroll
        for (int ai = 0; ai < 2; ++ai)
#pragma unroll
            for (int m = 0; m < 4; ++m) { const size_t r = (size_t)(row0 + ai * HALF + m * 16);
                const float rs = (n < 2) ? rt[(ai * HALF + m * 16) * 2] : 1.0f;
#pragma unroll
                for (int bj = 0; bj < 2; ++bj) { const u32x2q ga = GA[ai][m][bj];
                    if (n == 3) {
                        f32x4 v0 = acc[ai][bj][m][0] * (1.0f / 255.0f), v1 = acc[ai][bj][m][1] * (1.0f / 255.0f);
                        v0[0] *= ub0(ga.x); v0[1] *= ub1(ga.x); v0[2] *= ub2(ga.x); v0[3] *= ub3(ga.x);
                        v1[0] *= ub0(ga.y); v1[1] *= ub1(ga.y); v1[2] *= ub2(ga.y); v1[3] *= ub3(ga.y);
                        *(u32x4*)(O + r * 1024 + col0 + bj * HALF) = pack8(v0, v1);
                    } else { const u32x2q gb = GB[ai][m][bj]; f32x4 r0, r1;
                        r0[0] = rs * ub0(ga.x) * __builtin_amdgcn_rcpf(ub0(gb.x)); r0[1] = rs * ub1(ga.x) * __builtin_amdgcn_rcpf(ub1(gb.x));
                        r0[2] = rs * ub2(ga.x) * __builtin_amdgcn_rcpf(ub2(gb.x)); r0[3] = rs * ub3(ga.x) * __builtin_amdgcn_rcpf(ub3(gb.x));
                        r1[0] = rs * ub0(ga.y) * __builtin_amdgcn_rcpf(ub0(gb.y)); r1[1] = rs * ub1(ga.y) * __builtin_amdgcn_rcpf(ub1(gb.y));
                        r1[2] = rs * ub2(ga.y) * __builtin_amdgcn_rcpf(ub2(gb.y)); r1[3] = rs * ub3(ga.y) * __builtin_amdgcn_rcpf(ub3(gb.y));
                        acc[ai][bj][m][0] = acc[ai][bj][m][0] * r0; acc[ai][bj][m][1] = acc[ai][bj][m][1] * r1; } } }
#pragma unroll
        for (int m = 0; m < 4; ++m)
#pragma unroll
            for (int bj = 0; bj < 2; ++bj) cy.g[m][bj] = GB[0][m][bj];
        return n != 3;
    }
};
struct EpiResid {
    static constexpr bool PERM = false, AFTER_DRAIN = false, MIDHOOK = false;
    const float* xin; float* xout; int dry;
    __device__ __forceinline__ void operator()(const f32x4 (&acc)[2][2][4][2], const Unit& u, int wr, int wc, int fr, int fq) const {
        if (dry) return;
        int row0 = u.pm * BM + wr * 64 + fr, col0 = u.pn * BM + wc * 32 + 4 * fq; asm volatile("" : "+v"(row0));
#pragma unroll
        for (int ai = 0; ai < 2; ++ai)
#pragma unroll
            for (int m = 0; m < 4; ++m) { const size_t off = (size_t)(row0 + ai * HALF + m * 16) * 1024 + col0;
#pragma unroll
                for (int bj = 0; bj < 2; ++bj)
#pragma unroll
                    for (int n = 0; n < 2; ++n) { const f32x4 b = *(const f32x4*)(xin + off + bj * HALF + n * 16); *(f32x4*)(xout + off + bj * HALF + n * 16) = b + acc[ai][bj][m][n]; } }
    }
};
struct EpiResidB {
    static constexpr bool PERM = true, AFTER_DRAIN = false, MIDHOOK = false;
    bf16_t* x; int dry;
    __device__ __forceinline__ void operator()(const f32x4 (&acc)[2][2][4][2], const Unit& u, int wr, int wc, int fr, int fq) const {
        if (dry) return;
        int row0 = u.pm * BM + wr * 64 + fr; asm volatile("" : "+v"(row0)); const int col0 = u.pn * BM + wc * 32 + 8 * fq;
        u32x4 XT[2][4][2];
#pragma unroll
        for (int ai = 0; ai < 2; ++ai)
#pragma unroll
            for (int m = 0; m < 4; ++m)
#pragma unroll
                for (int bj = 0; bj < 2; ++bj) XT[ai][m][bj] = *(const u32x4*)(x + (size_t)(row0 + ai * HALF + m * 16) * 1024 + col0 + bj * HALF);
        __builtin_amdgcn_sched_barrier(0);
#pragma unroll
        for (int ai = 0; ai < 2; ++ai)
#pragma unroll
            for (int m = 0; m < 4; ++m) { bf16_t* rowp = x + (size_t)(row0 + ai * HALF + m * 16) * 1024 + col0;
#pragma unroll
                for (int bj = 0; bj < 2; ++bj) { const u32x4 b = XT[ai][m][bj]; f32x4 r0, r1;
                    r0[0] = bf_lo(b.x) + acc[ai][bj][m][0][0]; r0[1] = bf_hi(b.x) + acc[ai][bj][m][0][1]; r0[2] = bf_lo(b.y) + acc[ai][bj][m][0][2]; r0[3] = bf_hi(b.y) + acc[ai][bj][m][0][3];
                    r1[0] = bf_lo(b.z) + acc[ai][bj][m][1][0]; r1[1] = bf_hi(b.z) + acc[ai][bj][m][1][1]; r1[2] = bf_lo(b.w) + acc[ai][bj][m][1][2]; r1[3] = bf_hi(b.w) + acc[ai][bj][m][1][3];
                    *(u32x4*)(rowp + bj * HALF) = pack8(r0, r1); } }
    }
};
struct EpiPle {
    static constexpr bool PERM = false, AFTER_DRAIN = false, MIDHOOK = false;
    float* x; const bf16_t* pl; int dry;
    __device__ __forceinline__ void operator()(const f32x4 (&acc)[2][2][4][2], const Unit& u, int wr, int wc, int fr, int fq) const {
        if (dry) return;
        typedef unsigned u32x2 __attribute__((ext_vector_type(2)));
        int row0 = u.pm * BM + wr * 64 + fr, col0 = u.pn * BM + wc * 32 + 4 * fq; asm volatile("" : "+v"(row0));
#pragma unroll
        for (int ai = 0; ai < 2; ++ai)
#pragma unroll
            for (int m = 0; m < 4; ++m) { const size_t off = (size_t)(row0 + ai * HALF + m * 16) * 1024 + col0;
#pragma unroll
                for (int bj = 0; bj < 2; ++bj)
#pragma unroll
                    for (int n = 0; n < 2; ++n) { const size_t o = off + bj * HALF + n * 16; const f32x4 b = *(const f32x4*)(x + o); const u32x2 pv = *(const u32x2*)(pl + o);
                        const f32x4 a = acc[ai][bj][m][n]; f32x4 r;
                        r[0] = b[0] + sigmoid_f(a[0]) * bf_lo(pv.x); r[1] = b[1] + sigmoid_f(a[1]) * bf_hi(pv.x);
                        r[2] = b[2] + sigmoid_f(a[2]) * bf_lo(pv.y); r[3] = b[3] + sigmoid_f(a[3]) * bf_hi(pv.y);
                        *(f32x4*)(x + o) = r; } }
    }
};
struct EpiPleI8 {
    static constexpr bool PERM = false, AFTER_DRAIN = false, MIDHOOK = false;
    float* x; const bf16_t* pl; const float* sa; const float* sw; int dry;
    __device__ __forceinline__ void operator()(const f32x4 (&acc)[2][2][4][2], const Unit& u, int wr, int wc, int fr, int fq) const {
        if (dry) return;
        typedef unsigned u32x2 __attribute__((ext_vector_type(2))); typedef int i32x4e __attribute__((ext_vector_type(4)));
        int row0 = u.pm * BM + wr * 64 + fr; asm volatile("" : "+v"(row0)); const int col0 = u.pn * BM + wc * 32 + 4 * fq;
        f32x4 cw[2][2];
#pragma unroll
        for (int bj = 0; bj < 2; ++bj)
#pragma unroll
            for (int n = 0; n < 2; ++n) cw[bj][n] = *(const f32x4*)(sw + col0 + bj * HALF + n * 16);
#pragma unroll
        for (int ai = 0; ai < 2; ++ai)
#pragma unroll
            for (int m = 0; m < 4; ++m) { const int r = row0 + ai * HALF + m * 16; const size_t off = (size_t)r * 1024 + col0; const float rsc = sa[r];
#pragma unroll
                for (int bj = 0; bj < 2; ++bj)
#pragma unroll
                    for (int n = 0; n < 2; ++n) { const size_t o = off + bj * HALF + n * 16; const f32x4 b = *(const f32x4*)(x + o); const u32x2 pv = *(const u32x2*)(pl + o);
                        const i32x4e ai4 = __builtin_bit_cast(i32x4e, acc[ai][bj][m][n]); f32x4 r4;
                        r4[0] = b[0] + sigmoid_f((float)ai4[0] * rsc * cw[bj][n][0]) * bf_lo(pv.x); r4[1] = b[1] + sigmoid_f((float)ai4[1] * rsc * cw[bj][n][1]) * bf_hi(pv.x);
                        r4[2] = b[2] + sigmoid_f((float)ai4[2] * rsc * cw[bj][n][2]) * bf_lo(pv.y); r4[3] = b[3] + sigmoid_f((float)ai4[3] * rsc * cw[bj][n][3]) * bf_hi(pv.y);
                        *(f32x4*)(x + o) = r4; } }
    }
};
struct EpiPleI8B {
    static constexpr bool PERM = true, AFTER_DRAIN = false, MIDHOOK = false;
    static constexpr int NSTORE = 16;
    bf16_t* x; const bf16_t* pl; const float* sa; const float* sw; int dry;
    __device__ __forceinline__ void operator()(const f32x4 (&acc)[2][2][4][2], const Unit& u, int wr, int wc, int fr, int fq) const {
        if (dry) return;
        typedef int i32x4e __attribute__((ext_vector_type(4)));
#define SG(t) __builtin_amdgcn_rcpf(1.0f + __builtin_amdgcn_exp2f(t))
        int row0 = u.pm * BM + wr * 64 + fr; asm volatile("" : "+v"(row0)); int col0 = u.pn * BM + wc * 32 + 8 * fq; asm volatile("" : "+v"(col0));
        f32x4 cw[2][2];
#pragma unroll
        for (int bj = 0; bj < 2; ++bj)
#pragma unroll
            for (int n = 0; n < 2; ++n) cw[bj][n] = *(const f32x4*)(sw + col0 + bj * HALF + n * 4);
#pragma unroll
        for (int ai = 0; ai < 2; ++ai)
#pragma unroll
        for (int mh = 0; mh < 2; ++mh) {
            u32x4 XT[2][2], PT[2][2]; float RS[2];
#pragma unroll
            for (int mm = 0; mm < 2; ++mm) { const int m = 2 * mh + mm; const int r = row0 + ai * HALF + m * 16; const size_t off = (size_t)r * 1024 + col0; RS[mm] = sa[r];
#pragma unroll
                for (int bj = 0; bj < 2; ++bj) { XT[mm][bj] = *(const u32x4*)(x + off + bj * HALF); PT[mm][bj] = *(const u32x4*)(pl + off + bj * HALF); } }
            __builtin_amdgcn_sched_barrier(0);
#pragma unroll
            for (int mm = 0; mm < 2; ++mm) { const int m = 2 * mh + mm; const int r = row0 + ai * HALF + m * 16; const size_t off = (size_t)r * 1024 + col0; const float rsc = RS[mm] * -1.4426950408889634f;
#pragma unroll
                for (int bj = 0; bj < 2; ++bj) { const u32x4 b = XT[mm][bj]; const u32x4 pv = PT[mm][bj];
                    const i32x4e a0 = __builtin_bit_cast(i32x4e, acc[ai][bj][m][0]), a1 = __builtin_bit_cast(i32x4e, acc[ai][bj][m][1]); f32x4 r0, r1;
                    r0[0] = bf_lo(b.x) + SG((float)a0[0] * rsc * cw[bj][0][0]) * bf_lo(pv.x); r0[1] = bf_hi(b.x) + SG((float)a0[1] * rsc * cw[bj][0][1]) * bf_hi(pv.x);
                    r0[2] = bf_lo(b.y) + SG((float)a0[2] * rsc * cw[bj][0][2]) * bf_lo(pv.y); r0[3] = bf_hi(b.y) + SG((float)a0[3] * rsc * cw[bj][0][3]) * bf_hi(pv.y);
                    r1[0] = bf_lo(b.z) + SG((float)a1[0] * rsc * cw[bj][1][0]) * bf_lo(pv.z); r1[1] = bf_hi(b.z) + SG((float)a1[1] * rsc * cw[bj][1][1]) * bf_hi(pv.z);
                    r1[2] = bf_lo(b.w) + SG((float)a1[2] * rsc * cw[bj][1][2]) * bf_lo(pv.w); r1[3] = bf_hi(b.w) + SG((float)a1[3] * rsc * cw[bj][1][3]) * bf_hi(pv.w);
                    *(u32x4*)(x + off + bj * HALF) = pack8(r0, r1); } }
            __builtin_amdgcn_sched_barrier(0);
        }
    }
};
#undef SG
struct EpiGU {
    static constexpr bool PERM = true, AFTER_DRAIN = false, MIDHOOK = false;
    bf16_t* hid; int dry; float wscale;
    __device__ __forceinline__ void operator()(const f32x4 (&acc)[2][2][4][2], const Unit& u, int wr, int wc, int fr, int fq) const {
        if (dry) return;
        int row0 = u.pm * BM + wr * 64 + fr, col0 = (u.pn & 7) * 128 + wc * 32 + 8 * fq; asm volatile("" : "+v"(row0));
#pragma unroll
        for (int ai = 0; ai < 2; ++ai)
#pragma unroll
            for (int m = 0; m < 4; ++m) { f32x4 v0, v1; const f32x4 g0 = acc[ai][0][m][0] * wscale, g1 = acc[ai][0][m][1] * wscale, u0 = acc[ai][1][m][0] * wscale, u1 = acc[ai][1][m][1] * wscale;
#pragma unroll
                for (int i = 0; i < 4; ++i) { v0[i] = g0[i] * sigmoid_f(g0[i]) * u0[i]; v1[i] = g1[i] * sigmoid_f(g1[i]) * u1[i]; }
                *(u32x4*)(hid + (size_t)(row0 + ai * HALF + m * 16) * 1024 + col0) = pack8(v0, v1); }
    }
};
struct EpiGU8 {
    static constexpr bool PERM = true, AFTER_DRAIN = false, MIDHOOK = false;
    unsigned char* hid; int dry;
    __device__ __forceinline__ void operator()(const f32x4 (&acc)[2][2][4][2], const Unit& u, int wr, int wc, int fr, int fq) const {
        if (dry == 1) return;
        typedef unsigned u32x2h __attribute__((ext_vector_type(2)));
        int row0 = u.pm * BM + wr * 64 + fr; asm volatile("" : "+v"(row0)); const int col0 = (u.pn & 7) * 128 + wc * 32 + 8 * fq;
#pragma unroll
        for (int ai = 0; ai < 2; ++ai)
#pragma unroll
            for (int m = 0; m < 4; ++m) { f32x4 v0, v1; const f32x4 g0 = acc[ai][0][m][0] * 0.03125f, g1 = acc[ai][0][m][1] * 0.03125f, u0 = acc[ai][1][m][0] * 0.03125f, u1 = acc[ai][1][m][1] * 0.03125f;
#pragma unroll
                for (int i = 0; i < 4; ++i) { v0[i] = g0[i] * sigmoid_f(g0[i]) * u0[i]; v1[i] = g1[i] * sigmoid_f(g1[i]) * u1[i]; }
                int w0 = 0, w1 = 0;
                w0 = __builtin_amdgcn_cvt_pk_fp8_f32(v0[0], v0[1], w0, false); w0 = __builtin_amdgcn_cvt_pk_fp8_f32(v0[2], v0[3], w0, true);
                w1 = __builtin_amdgcn_cvt_pk_fp8_f32(v1[0], v1[1], w1, false); w1 = __builtin_amdgcn_cvt_pk_fp8_f32(v1[2], v1[3], w1, true);
                if (dry != 2 || row0 < -5) *(u32x2h*)(hid + (size_t)(row0 + ai * HALF + m * 16) * 1024 + col0) = (u32x2h){(unsigned)w0, (unsigned)w1}; }
    }
};
struct EpiDNP {
    static constexpr bool PERM = true, AFTER_DRAIN = false, MIDHOOK = false;
    bf16_t* ye; int dry;
    __device__ __forceinline__ void operator()(const f32x4 (&acc)[2][2][4][2], const Unit& u, int wr, int wc, int fr, int fq) const {
        if (dry == 1) return;
        int row0 = u.pm * BM + wr * 64 + fr; asm volatile("" : "+v"(row0)); const int col0 = (u.pn & 3) * BM + wc * 32 + 8 * fq;
#pragma unroll
        for (int ai = 0; ai < 2; ++ai)
#pragma unroll
            for (int m = 0; m < 4; ++m) { bf16_t* rowp = ye + (size_t)(row0 + ai * HALF + m * 16) * 1024 + col0;
#pragma unroll
                for (int bj = 0; bj < 2; ++bj) if (dry != 2 || row0 < -5) *(u32x4*)(rowp + bj * HALF) = pack8(acc[ai][bj][m][0], acc[ai][bj][m][1]); }
    }
};
struct EpiDNP8 {
    static constexpr bool PERM = true, AFTER_DRAIN = false, MIDHOOK = false;
    unsigned char* ye; int dry;
    __device__ __forceinline__ void operator()(const f32x4 (&acc)[2][2][4][2], const Unit& u, int wr, int wc, int fr, int fq) const {
        if (dry == 1) return;
        typedef unsigned u32x2h __attribute__((ext_vector_type(2)));
        int row0 = u.pm * BM + wr * 64 + fr; asm volatile("" : "+v"(row0)); const int col0 = (u.pn & 3) * BM + wc * 32 + 8 * fq;
#pragma unroll
        for (int ai = 0; ai < 2; ++ai)
#pragma unroll
            for (int m = 0; m < 4; ++m) { unsigned char* rowp = ye + (size_t)(row0 + ai * HALF + m * 16) * 1024 + col0;
#pragma unroll
                for (int bj = 0; bj < 2; ++bj) { const f32x4 v0 = acc[ai][bj][m][0] * 0.125f, v1 = acc[ai][bj][m][1] * 0.125f; int w0 = 0, w1 = 0;
                    w0 = __builtin_amdgcn_cvt_pk_fp8_f32(v0[0], v0[1], w0, false); w0 = __builtin_amdgcn_cvt_pk_fp8_f32(v0[2], v0[3], w0, true);
                    w1 = __builtin_amdgcn_cvt_pk_fp8_f32(v1[0], v1[1], w1, false); w1 = __builtin_amdgcn_cvt_pk_fp8_f32(v1[2], v1[3], w1, true);
                    if (dry != 2 || row0 < -5) *(u32x2h*)(rowp + bj * HALF) = (u32x2h){(unsigned)w0, (unsigned)w1}; } }
    }
};
struct EpiDN {
    static constexpr bool PERM = true, AFTER_DRAIN = false, MIDHOOK = false;
    bf16_t* ye; const float* aff; int dry; float wscale;
    __device__ __forceinline__ void operator()(const f32x4 (&acc)[2][2][4][2], const Unit& u, int wr, int wc, int fr, int fq) const {
        if (dry) return;
        int row0 = u.pm * BM + wr * 64 + fr, col0 = (u.pn & 3) * BM + wc * 32 + 8 * fq; asm volatile("" : "+v"(row0));
#pragma unroll
        for (int ai = 0; ai < 2; ++ai)
#pragma unroll
            for (int m = 0; m < 4; ++m) { const size_t r = (size_t)(row0 + ai * HALF + m * 16); const float a = aff[r] * wscale;
#pragma unroll
                for (int bj = 0; bj < 2; ++bj) *(u32x4*)(ye + r * 1024 + col0 + bj * HALF) = pack8(acc[ai][bj][m][0] * a, acc[ai][bj][m][1] * a); }
    }
};
struct NoCarry {};
template <class E, bool M = E::MIDHOOK> struct CarryOf { typedef NoCarry type; };
template <class E> struct CarryOf<E, true> { typedef typename E::Carry type; };
template <class Epi, class Sched, bool ALIGN_EPI = false, bool SP2 = false, bool GATHER = false, bool F8 = false, bool I8 = false, int PADN = 0>
__device__ __forceinline__ void gemm_phase(PG8_LAS unsigned char* lds, const Gemm g, const Sched& S, const Epi& E, const int tid, const PG8_LAS unsigned* gtab = nullptr) {
    typedef int i32x4q __attribute__((ext_vector_type(4)));
    static_assert(!GATHER || SP2, "GATHER is wired into the SP2 loop only");
    const int wid = __builtin_amdgcn_readfirstlane(tid >> 6), lane = tid & 63, wr = wid >> 2, wc = wid & 3, fr = lane & 15, fq = lane >> 4;
    int K = g.K; asm volatile("" : "+s"(K));
    const int nt = K / BK; const int lda = g.lda ? g.lda : K;
    unsigned voffA[2], voffB[2]; int gR[2]; unsigned gC[2];
#pragma unroll
    for (int i = 0; i < 2; ++i) { int R, C; stage_rc(tid * 16 + i * 8192, R, C); const int Rb = Epi::PERM ? ((R & ~31) + perm32(R & 31)) : R;
        voffA[i] = (unsigned)(R * lda + C) * 2u; voffB[i] = (unsigned)(Rb * K + C) * 2u; gR[i] = R; gC[i] = (unsigned)C * 2u; }
    unsigned cvo[2][2] = {{0u, 0u}, {0u, 0u}};
#define PG8_GLOAD(vo, uidx) do { _Pragma("unroll") for (int h_ = 0; h_ < 2; ++h_) _Pragma("unroll") for (int i_ = 0; i_ < 2; ++i_) vo[h_][i_] = gtab[(uidx) * 256 + h_ * 128 + gR[i_]] + gC[i_]; } while (0)
#define PG8_STA0(bufoff, gbase, h) do { unsigned vs_[2]; if constexpr (GATHER) { vs_[0] = cvo[h][0]; vs_[1] = cvo[h][1]; } else { vs_[0] = voffA[0]; vs_[1] = voffA[1]; } PG8_STAGE(bufoff, gbase, vs_); } while (0)
#define PG8_STAN(bufoff, gbase, h) do { unsigned vs_[2]; if constexpr (GATHER) { const int nu_ = has_next ? ui + 1 : ui; vs_[0] = last ? gtab[nu_ * 256 + (h) * 128 + gR[0]] + gC[0] : cvo[h][0]; vs_[1] = last ? gtab[nu_ * 256 + (h) * 128 + gR[1]] + gC[1] : cvo[h][1]; } else { vs_[0] = voffA[0]; vs_[1] = voffA[1]; } PG8_STAGE(bufoff, gbase, vs_); } while (0)
    const size_t kstep = (size_t)(BK * 2);
    const size_t hstep = (size_t)HALF * K * 2;
    const size_t tstep = 2 * hstep;
    const size_t hstepA = GATHER ? 0 : (size_t)HALF * lda * 2, tstepA = 2 * hstepA;
    const unsigned ldsw = (unsigned)wid * 1024u;
    const int aoff = lds_byte(wr * 64 + fr, fq * 8), boff = lds_byte(wc * 32 + fr, fq * 8);
#define PG8_SA(b, h) (((b) * 2 + (h)) * HTB)
#define PG8_SB(b, h) ((4 + (b) * 2 + (h)) * HTB)
#define PG8_STAGE(bufoff, gbase, voff) do { _Pragma("unroll") for (int _i = 0; _i < 2; ++_i) \
        __builtin_amdgcn_global_load_lds((const unsigned*)((const char*)(gbase) + (voff)[_i]), (PG8_LAS unsigned*)(lds + (bufoff) + ldsw + _i * 8192), 16, 0, 0); } while (0)
#define PG8_LD32(p) __builtin_shufflevector(*(const PG8_LAS i32x4q*)(p), *(const PG8_LAS i32x4q*)((p) + 1024), 0, 1, 2, 3, 4, 5, 6, 7)
#define PG8_LDA(dst, b, h) do { _Pragma("unroll") for (int m = 0; m < 4; ++m) { if constexpr (F8) dst##8[m] = PG8_LD32(lds + PG8_SA(b, h) + aoff + m * 2048); else { _Pragma("unroll") for (int k = 0; k < 2; ++k) dst[m][k] = *(const PG8_LAS bf16x8*)(lds + PG8_SA(b, h) + aoff + m * 2048 + k * 1024); } } } while (0)
#define PG8_LDB(dst, b, h) do { _Pragma("unroll") for (int n = 0; n < 2; ++n) { if constexpr (F8) dst##8[n] = PG8_LD32(lds + PG8_SB(b, h) + boff + n * 2048); else { _Pragma("unroll") for (int k = 0; k < 2; ++k) dst[n][k] = *(const PG8_LAS bf16x8*)(lds + PG8_SB(b, h) + boff + n * 2048 + k * 1024); } } } while (0)
#define PG8_MMA(ai, bj, At, Bt) do { __builtin_amdgcn_s_setprio(1); _Pragma("unroll") for (int m = 0; m < 4; ++m) _Pragma("unroll") for (int n = 0; n < 2; ++n) { \
        if constexpr (F8) acc[ai][bj][m][n] = __builtin_amdgcn_mfma_scale_f32_16x16x128_f8f6f4(Bt##8[n], At##8[m], acc[ai][bj][m][n], 0, 0, 0, 0, 0, 0); \
        else if constexpr (I8) { _Pragma("unroll") for (int k = 0; k < 2; ++k) acc[ai][bj][m][n] = __builtin_bit_cast(f32x4, __builtin_amdgcn_mfma_i32_16x16x64_i8(__builtin_bit_cast(i32x4q, Bt[n][k]), __builtin_bit_cast(i32x4q, At[m][k]), __builtin_bit_cast(i32x4q, acc[ai][bj][m][n]), 0, 0, 0)); } \
        else { _Pragma("unroll") for (int k = 0; k < 2; ++k) acc[ai][bj][m][n] = __builtin_amdgcn_mfma_f32_16x16x32_bf16(Bt[n][k], At[m][k], acc[ai][bj][m][n], 0, 0, 0); } } \
        __builtin_amdgcn_s_setprio(0); } while (0)
#define PG8_WAIT_V(n) asm volatile("s_waitcnt vmcnt(" #n ")" ::: "memory")
#define PG8_WAIT_L(n) asm volatile("s_waitcnt lgkmcnt(" #n ")" ::: "memory")
#define PG8_BAR __builtin_amdgcn_s_barrier()
#define PG8_SCHED __builtin_amdgcn_sched_barrier(0)
    Unit cur, nxt; int ui = 0;
    if (!S.next(0, cur)) return;
    f32x4 acc[2][2][4][2];
#pragma unroll
    for (int a = 0; a < 2; ++a)
#pragma unroll
        for (int b = 0; b < 2; ++b)
#pragma unroll
            for (int m = 0; m < 4; ++m)
#pragma unroll
                for (int n = 0; n < 2; ++n) acc[a][b][m][n] = (f32x4){0.f, 0.f, 0.f, 0.f};
    typename CarryOf<Epi>::type carry;
    bf16x8 At[4][2], B0[2][2], B1[2][2];
    typedef int i32x8q __attribute__((ext_vector_type(8))); i32x8q At8[4], B08[2], B18[2];
    const char* cA = (const char*)g.A + (size_t)cur.pm * tstepA + S.a_off(cur); if constexpr (GATHER) PG8_GLOAD(cvo, 0);
    const char* cB = (const char*)g.Bt + (size_t)cur.pn * tstep;
    S.a_ready(cur);
    if constexpr (SP2) {
        PG8_STAGE(PG8_SB(0, 0), cB, voffB); PG8_STAGE(PG8_SB(0, 1), cB + hstep, voffB); PG8_STA0(PG8_SA(0, 0), cA, 0); PG8_STA0(PG8_SA(0, 1), cA + hstepA, 1);
        if (wr == 1) PG8_BAR;
        PG8_WAIT_V(2); PG8_BAR;
        PG8_STAGE(PG8_SB(1, 0), cB + kstep, voffB); PG8_STA0(PG8_SA(1, 0), cA + kstep, 0); PG8_STAGE(PG8_SB(1, 1), cB + hstep + kstep, voffB);
        PG8_WAIT_V(6); PG8_BAR;
    } else {
        PG8_STAGE(PG8_SB(0, 0), cB, voffB); PG8_STAGE(PG8_SA(0, 0), cA, voffA); PG8_STAGE(PG8_SB(0, 1), cB + hstep, voffB); PG8_STAGE(PG8_SA(0, 1), cA + hstepA, voffA);
        if (wr == 1) PG8_BAR;
        PG8_WAIT_V(4); PG8_BAR;
        PG8_STAGE(PG8_SB(1, 0), cB + kstep, voffB); PG8_STAGE(PG8_SA(1, 0), cA + kstep, voffA); PG8_STAGE(PG8_SB(1, 1), cB + hstep + kstep, voffB);
        PG8_WAIT_V(6); PG8_BAR;
    }
    for (;;) {
        const bool has_next = S.next(ui + 1, nxt);
        const char* nA = has_next ? (const char*)g.A + (size_t)nxt.pm * tstepA + S.a_off(nxt) : cA; const char* nB = has_next ? (const char*)g.Bt + (size_t)nxt.pn * tstep : cB;
        asm volatile(".p2align 6\n\t.rept %c0\n\ts_nop 0\n\t.endr" :: "i"(PADN) : "memory");
        for (int t = 0; t < nt; t += 2) {
            const bool last = (t == nt - 2);
            const char* a1 = cA + (size_t)(t + 1) * kstep;
            const char* a2 = last ? nA : cA + (size_t)(t + 2) * kstep; const char* b2 = last ? nB : cB + (size_t)(t + 2) * kstep;
            const char* a3 = a2 + kstep; const char* b3 = b2 + kstep;
            if (last && has_next) S.a_ready(nxt);
            if constexpr (SP2) {
            PG8_LDB(B0, 0, 0); PG8_LDB(B1, 0, 1); PG8_SCHED; PG8_LDA(At, 0, 0); PG8_STA0(PG8_SA(1, 1), a1 + hstepA, 1);
            PG8_WAIT_V(8); PG8_WAIT_L(0); PG8_BAR; PG8_MMA(0, 0, At, B0); PG8_MMA(0, 1, At, B1); PG8_BAR; PG8_SCHED;
            PG8_LDA(At, 0, 1); PG8_STAGE(PG8_SB(0, 0), b2, voffB); PG8_STAGE(PG8_SB(0, 1), b2 + hstep, voffB); PG8_STAN(PG8_SA(0, 0), a2, 0);
            PG8_WAIT_V(8); PG8_WAIT_L(0); PG8_BAR; PG8_MMA(1, 0, At, B0); PG8_MMA(1, 1, At, B1); PG8_BAR; PG8_SCHED;
            PG8_LDB(B0, 1, 0); PG8_LDB(B1, 1, 1); PG8_SCHED; PG8_LDA(At, 1, 0); PG8_STAN(PG8_SA(0, 1), a2 + hstepA, 1);
            PG8_WAIT_V(8); PG8_WAIT_L(0); PG8_BAR; PG8_MMA(0, 0, At, B0); PG8_MMA(0, 1, At, B1); PG8_BAR; PG8_SCHED;
            PG8_LDA(At, 1, 1); PG8_STAGE(PG8_SB(1, 0), b3, voffB); PG8_STAGE(PG8_SB(1, 1), b3 + hstep, voffB); PG8_STAN(PG8_SA(1, 0), a3, 0);
            PG8_WAIT_V(8); PG8_WAIT_L(0); PG8_BAR; PG8_MMA(1, 0, At, B0); PG8_MMA(1, 1, At, B1); PG8_BAR; PG8_SCHED;
            } else {
            PG8_LDB(B0, 0, 0); PG8_SCHED; PG8_LDA(At, 0, 0); PG8_STAGE(PG8_SA(1, 1), a1 + hstepA, voffA);
            PG8_WAIT_L(8); PG8_BAR; PG8_WAIT_L(0); PG8_MMA(0, 0, At, B0); PG8_BAR; PG8_SCHED;
            PG8_LDB(B1, 0, 1); PG8_STAGE(PG8_SB(0, 0), b2, voffB);
            PG8_BAR; PG8_WAIT_L(0); PG8_MMA(0, 1, At, B1); PG8_BAR;
            PG8_LDA(At, 0, 1); PG8_STAGE(PG8_SA(0, 0), a2, voffA);
            PG8_BAR; PG8_WAIT_L(0); PG8_MMA(1, 0, At, B0); PG8_BAR; PG8_SCHED;
            PG8_STAGE(PG8_SB(0, 1), b2 + hstep, voffB);
            PG8_WAIT_V(6); PG8_BAR; PG8_MMA(1, 1, At, B1); PG8_BAR;
            PG8_LDB(B0, 1, 0); PG8_SCHED; PG8_LDA(At, 1, 0); PG8_STAGE(PG8_SA(0, 1), a2 + hstepA, voffA);
            PG8_WAIT_L(8); PG8_BAR; PG8_WAIT_L(0); PG8_MMA(0, 0, At, B0); PG8_BAR; PG8_SCHED;
            PG8_LDB(B1, 1, 1); PG8_STAGE(PG8_SB(1, 0), b3, voffB);
            PG8_BAR; PG8_WAIT_L(0); PG8_MMA(0, 1, At, B1); PG8_BAR;
            PG8_LDA(At, 1, 1); PG8_STAGE(PG8_SA(1, 0), a3, voffA);
            PG8_BAR; PG8_WAIT_L(0); PG8_MMA(1, 0, At, B0); PG8_BAR; PG8_SCHED;
            PG8_STAGE(PG8_SB(1, 1), b3 + hstep, voffB);
            PG8_WAIT_V(6); PG8_BAR; PG8_MMA(1, 1, At, B1); PG8_BAR;
            }
        }
        if constexpr (ALIGN_EPI) { if (wr == 0) PG8_BAR; }
        bool keep_acc = false;
        if constexpr (Epi::MIDHOOK) { keep_acc = E.mut(acc, cur, wr, wc, fr, fq, carry); S.done(cur); }
        else if constexpr (!Epi::AFTER_DRAIN) { E(acc, cur, wr, wc, fr, fq); S.done(cur); }
        if (!has_next) break;
        if (!keep_acc)
#pragma unroll
        for (int a = 0; a < 2; ++a)
#pragma unroll
            for (int b = 0; b < 2; ++b)
#pragma unroll
                for (int m = 0; m < 4; ++m)
#pragma unroll
                    for (int n = 0; n < 2; ++n) acc[a][b][m][n] = (f32x4){0.f, 0.f, 0.f, 0.f};
        cur = nxt; cA = nA; cB = nB; ++ui;
        if constexpr (GATHER) PG8_GLOAD(cvo, ui);
        if constexpr (ALIGN_EPI) { if (wr == 1) PG8_BAR; }
    }
    PG8_WAIT_V(0);
    if constexpr (!ALIGN_EPI) { if (wr == 0) PG8_BAR; }
    PG8_BAR;
    if constexpr (Epi::AFTER_DRAIN) { E.fused(acc, cur, wr, wc, fr, fq, lds, wid, lane); S.done(cur); }
#undef PG8_SA
#undef PG8_SB
#undef PG8_STAGE
#undef PG8_GLOAD
#undef PG8_STA0
#undef PG8_STAN
#undef PG8_LDA
#undef PG8_LDB
#undef PG8_MMA
#undef PG8_LD32
#undef PG8_WAIT_V
#undef PG8_WAIT_L
#undef PG8_BAR
#undef PG8_SCHED
}
}
namespace attn_body {
using bf16=__hip_bfloat16;
using bf16x8=__attribute__((ext_vector_type(8)))short;
using s16x4=__attribute__((ext_vector_type(4)))short;
using f32x16=__attribute__((ext_vector_type(16)))float;
using u32x4=__attribute__((ext_vector_type(4)))unsigned;
using f32x4a=__attribute__((ext_vector_type(4)))float;
constexpr int SEQ=16384,D=64,LDP=2816,LDO=1024;
constexpr int NW=8,QBLK=32,KVBLK=64,NT=SEQ/KVBLK;
__device__ __forceinline__ int crow(int r,int hi){return (r&3)+8*(r>>2)+4*hi;}
#define SBAR() __builtin_amdgcn_sched_barrier(0)
constexpr int NSLOT=3, SLOTB=8192;
constexpr int LDS_K=0, LDS_V=NSLOT*SLOTB, LDS_WS=2*NSLOT*SLOTB, LDS_OST=LDS_WS+NW*64*4, LDS_TAB=LDS_OST+65536, LDS_RED=LDS_TAB+640*4, LDS_BYTES=LDS_RED+64*4;
constexpr float LOG2E=1.4426950408889634f;
constexpr int PAD_AF=6,PAD_AS=0,PAD_CF=13,PAD_CS=4;
__device__ __forceinline__ void glds16(const void*gsrc,unsigned lds_dst){unsigned keep;
  asm volatile("s_mov_b32 %0, m0\n\ts_mov_b32 m0, %2\n\ts_nop 0\n\tglobal_load_lds_dwordx4 %1, off\n\ts_mov_b32 m0, %0":"=&s"(keep):"v"(gsrc),"s"(lds_dst):"memory");}
__device__ __forceinline__ float max3f(float a,float b,float c){float r;asm("v_max3_f32 %0, %1, %2, %3":"=v"(r):"v"(a),"v"(b),"v"(c));return r;}
__device__ __forceinline__ float max2f(float a,float b){float r;asm("v_max_f32_e32 %0, %1, %2":"=v"(r):"v"(a),"v"(b));return r;}
__device__ __forceinline__ float fadd_s(float a,float b){float r;asm("v_add_f32_e32 %0, %1, %2":"=v"(r):"v"(a),"v"(b));return r;}
__device__ __forceinline__ float fsub_s(float a,float b){float r;asm("v_sub_f32_e32 %0, %1, %2":"=v"(r):"v"(a),"v"(b));return r;}
typedef float f32x2_t __attribute__((ext_vector_type(2))); typedef __bf16 bf16x2_t __attribute__((ext_vector_type(2)));
__device__ __forceinline__ unsigned cvtpk_s(float lo,float hi){f32x2_t v={lo,hi};bf16x2_t b=__builtin_convertvector(v,bf16x2_t);return __builtin_bit_cast(unsigned,b);}
#define WAIT_BAR(N) asm volatile("s_waitcnt vmcnt(" #N ") lgkmcnt(0)\n\ts_barrier":::"memory")

template<int ND> __device__ __forceinline__ void qkt(f32x16&p0,f32x16&p1,const char*Kslot,const bf16x8*qr,const f32x16&negm,int r32,int hi){
  const char*kb=Kslot+hi*1024+r32*16;
  #pragma unroll
  for(int d0=0;d0<ND;++d0){
    const bf16x8 b0=*reinterpret_cast<const bf16x8*>(kb+d0*2048);
    const bf16x8 b1=*reinterpret_cast<const bf16x8*>(kb+d0*2048+512);
    if(d0==0){p0=__builtin_amdgcn_mfma_f32_32x32x16_bf16(b0,qr[0],negm,0,0,0);p1=__builtin_amdgcn_mfma_f32_32x32x16_bf16(b1,qr[0],negm,0,0,0);}
    else{p0=__builtin_amdgcn_mfma_f32_32x32x16_bf16(b0,qr[d0],p0,0,0,0);p1=__builtin_amdgcn_mfma_f32_32x32x16_bf16(b1,qr[d0],p1,0,0,0);}}
}
typedef __attribute__((address_space(3))) const char* lds_cptr;
typedef __attribute__((address_space(3))) const float* lds_fptr;
typedef short v4i16_t __attribute__((ext_vector_type(4)));
__device__ __forceinline__ void kload8(bf16x8*kf,lds_cptr kp){
  kf[0]=*(const __attribute__((address_space(3))) bf16x8*)(kp);      kf[1]=*(const __attribute__((address_space(3))) bf16x8*)(kp+512);
  kf[2]=*(const __attribute__((address_space(3))) bf16x8*)(kp+2048); kf[3]=*(const __attribute__((address_space(3))) bf16x8*)(kp+2560);
  kf[4]=*(const __attribute__((address_space(3))) bf16x8*)(kp+4096); kf[5]=*(const __attribute__((address_space(3))) bf16x8*)(kp+4608);
  kf[6]=*(const __attribute__((address_space(3))) bf16x8*)(kp+6144); kf[7]=*(const __attribute__((address_space(3))) bf16x8*)(kp+6656);
}
__device__ __forceinline__ void kload2(bf16x8*kf,lds_cptr kp,int j){ kf[2*j]=*(const __attribute__((address_space(3))) bf16x8*)(kp+j*2048); kf[2*j+1]=*(const __attribute__((address_space(3))) bf16x8*)(kp+j*2048+512); }
__device__ __forceinline__ s16x4 vtr(lds_cptr p){ return __builtin_bit_cast(s16x4,__builtin_amdgcn_ds_read_tr16_b64_v4i16((__attribute__((address_space(3))) v4i16_t*)p)); }
__device__ __forceinline__ float rowmax(const f32x16&p0,const f32x16&p1){
  float a=max3f(p0[0],p0[1],p1[0]),b=max3f(p0[2],p0[3],p1[1]);a=max3f(a,p1[2],p1[3]);
  #pragma unroll
  for(int r=4;r<16;r+=4){a=max3f(a,p0[r],p0[r+1]);b=max3f(b,p0[r+2],p0[r+3]);a=max3f(a,p1[r],p1[r+1]);b=max3f(b,p1[r+2],p1[r+3]);}
  const float m=max2f(a,b);
  auto rr=__builtin_amdgcn_permlane32_swap(__float_as_uint(m),__float_as_uint(m),false,false);
  return max2f(__uint_as_float(rr[0]),__uint_as_float(rr[1]));
}
__device__ __forceinline__ void pv(f32x16*o,int vb,bf16x8 pa0,bf16x8 pa1,bf16x8 pa2,bf16x8 pa3){
  #pragma unroll
  for(int d0=0;d0<2;++d0){s16x4 lo[4],hi[4];
    #pragma unroll
    for(int ks=0;ks<4;++ks){
      asm volatile("ds_read_b64_tr_b16 %0,%1 offset:%c2":"=&v"(lo[ks]):"v"(vb),"i"(d0*4096+ks*1024):"memory");
      asm volatile("ds_read_b64_tr_b16 %0,%1 offset:%c2":"=&v"(hi[ks]):"v"(vb),"i"(d0*4096+ks*1024+512):"memory");}
    asm volatile("s_waitcnt lgkmcnt(0)":::"memory");SBAR();
    #define PK(k) (bf16x8){lo[k][0],lo[k][1],lo[k][2],lo[k][3],hi[k][0],hi[k][1],hi[k][2],hi[k][3]}
    o[d0]=__builtin_amdgcn_mfma_f32_32x32x16_bf16(pa0,PK(0),o[d0],0,0,0);
    o[d0]=__builtin_amdgcn_mfma_f32_32x32x16_bf16(pa1,PK(1),o[d0],0,0,0);
    o[d0]=__builtin_amdgcn_mfma_f32_32x32x16_bf16(pa2,PK(2),o[d0],0,0,0);
    o[d0]=__builtin_amdgcn_mfma_f32_32x32x16_bf16(pa3,PK(3),o[d0],0,0,0);
    #undef PK
  }
}
__device__ __forceinline__ int t5_bucket(int rel){
  const int r=rel<0?-rel:rel; int v;
  if(r<8)v=r; else if(r<12)v=8; else if(r<16)v=9; else if(r<23)v=10; else if(r<32)v=11; else if(r<46)v=12; else if(r<64)v=13; else if(r<91)v=14; else v=15;
  return (rel>0?16:0)+v;
}

#ifndef ATTN_STORE16
#define ATTN_STORE16(p,v) (*(u32x4*)(p)=(v))
#endif
template<bool CM> __device__ __forceinline__ float attn_qnorm2(const bf16*Qb,int q0,int wid,int r32,int hi){
  const int wrow=CM?(wid&3)*QBLK:wid*QBLK; const int map=wid>>2; const bf16*Qw=Qb+(long)(q0+wrow)*LDP; float s=0.f;
  #pragma unroll
  for(int d0=0;d0<(CM?2:4);++d0){ const bf16x8 q=*reinterpret_cast<const bf16x8*>(&Qw[(long)r32*LDP+(CM?map*32:0)+d0*16+hi*8]);
    #pragma unroll
    for(int i=0;i<8;++i){ const float f=__uint_as_float((unsigned)(unsigned short)q[i]<<16); s+=f*f; } }
  auto rr=__builtin_amdgcn_permlane32_swap(__float_as_uint(s),__float_as_uint(s),false,false); return __uint_as_float(rr[0])+__uint_as_float(rr[1]);
}
template<bool CM> __device__ __forceinline__ bool attn_bound(const bf16*Qb,int q0,char*shm,const float*kmaxp,float bmax,const int tid){
  const int lane=tid&63,r32=lane&31,hi=lane>>5; const int wid=__builtin_amdgcn_readfirstlane(tid>>6);
  float*red=(float*)(shm+LDS_RED);
  float km=kmaxp[32*(tid&255)+(CM?(tid>>8):0)];
  #pragma unroll
  for(int o=1;o<64;o<<=1)km=fmaxf(km,__shfl_xor(km,o));
  if(lane==0)red[wid]=km;
  const float qn2=attn_qnorm2<CM>(Qb,q0,wid,r32,hi);
  asm volatile("s_waitcnt lgkmcnt(0)\n\ts_barrier":::"memory");
  const int ro=CM?4*(wid>>2):0; const float kmax2=fmaxf(fmaxf(red[ro],red[ro+1]),fmaxf(red[ro+2],red[ro+3]));
  const float bound=sqrtf(qn2*kmax2)*1.0005f+bmax+0.01f;
  const bool bad=__any(!(bound<=60.f));
  if(lane==0)red[8+wid]=bad?1.f:0.f;
  asm volatile("s_waitcnt lgkmcnt(0)\n\ts_barrier":::"memory");
  float f=0.f;
  #pragma unroll
  for(int w=0;w<8;++w)f+=red[8+w];
  return f==0.f;
}
template<bool CM,int THRL,bool FAST,bool LMA=false> __device__ __forceinline__ void attn_unit(const bf16*Qb,const bf16*__restrict__ Kb,const bf16*__restrict__ Vb,bf16*Ob,int q0,char*shm,
                                                                       const float*relb,int h,float lam,float osc,const float*gdiff,float bmax,const int tid){
  const int lane=tid&63,r32=lane&31,hi=lane>>5; const int wid=__builtin_amdgcn_readfirstlane(tid>>6);
  const int wrow=CM?(wid&3)*QBLK:wid*QBLK; const int map=wid>>2;
  const bf16*Qw=Qb+(long)(q0+wrow)*LDP;
  const unsigned lds0=(unsigned)(uintptr_t)shm;
  float*wsf=(float*)(shm+LDS_WS)+wid*64;
  const bf16*ksrc=Kb+(long)lane*LDP+wid*8;
  const bf16*vsrc=Vb+(long)(16*(wid&3)+(lane>>2))*LDP+(wid>>2)*32+(lane&3)*8;
  const unsigned kdst=lds0+LDS_K+wid*1024, vdst=lds0+LDS_V+wid*1024;
  #define DMA_K(t,slot) glds16(ksrc+(long)(t)*KVBLK*LDP,(unsigned)__builtin_amdgcn_readfirstlane(kdst+(slot)))
  #define DMA_V(t,slot) glds16(vsrc+(long)(t)*KVBLK*LDP,(unsigned)__builtin_amdgcn_readfirstlane(vdst+(slot)))
  const int vb0=(int)(lds0+LDS_V)+((lane>>4)&1)*32+(lane&3)*8+(4*hi+((lane&15)>>2))*64;
  const char*Kbase=shm+LDS_K; bf16x8 kf[8];
  const lds_cptr shm3=(lds_cptr)shm; const lds_cptr kp0=shm3+LDS_K+hi*1024+r32*16+(CM?map*4096:0); const lds_cptr vp0=shm3+LDS_V+((lane>>4)&1)*32+(lane&3)*8+(4*hi+((lane&15)>>2))*64;
  const lds_fptr tab3=(lds_fptr)(shm3+LDS_TAB);
    if(CM){ float*tab=(float*)(shm+LDS_TAB); for(int i=tid;i<640;i+=NW*64)tab[i]=LOG2E*relb[t5_bucket(i-320)*4+h]; }
  DMA_K(0,0);DMA_V(0,0);DMA_K(1,SLOTB);
  bf16x8 qr[4];
  #pragma unroll
  for(int d0=0;d0<(CM?2:4);++d0)qr[d0]=*reinterpret_cast<const bf16x8*>(&Qw[(long)r32*LDP+(CM?map*32:0)+d0*16+hi*8]);
  const int jn=q0>>7; const int nlo=2*jn-3, nhi=2*jn+5; const int qabs=q0+wrow+r32;
  bool near=CM&&(nlo<=0); float cside=0.f; if(CM&&!near)cside=LOG2E*relb[15*4+h];
  float mhat=0.f,l_reg=0.f;f32x16 o[2];o[0]=f32x16{};o[1]=f32x16{};asm volatile("":"+v"(o[0]),"+v"(o[1]));f32x16 negm;
  constexpr bool LM=FAST&&LMA;
  f32x16 lacc=f32x16{}; unsigned one_=0x3F803F80u; if constexpr(LM){ asm volatile("":"+v"(lacc),"+v"(one_)); }
  const bf16x8 ONES=__builtin_bit_cast(bf16x8,(u32x4){one_,one_,one_,one_});
  #define NEGM_SET() do{ _Pragma("unroll") for(int r=0;r<16;++r)negm[r]=cside-mhat; asm volatile("":"+v"(negm)); }while(0)
  NEGM_SET();
  #define MODESW(t) do{ if(CM){ if((t)==nlo){near=true;cside=0.f;NEGM_SET();} else if((t)==nhi){near=false;cside=tab3[639];NEGM_SET();} } }while(0)
  #define BIASADD(P0,P1,t) do{ if(CM){ if(near){ const lds_fptr tb_=tab3+(64*(t)-qabs+4*hi+320); \
      _Pragma("unroll") for(int r4=0;r4<4;++r4){ _Pragma("unroll") for(int r=4*r4;r<4*r4+4;++r){P0[r]+=tb_[(r&3)+8*(r>>2)];P1[r]+=tb_[32+(r&3)+8*(r>>2)];} SBAR(); } } } }while(0)
  bool resc=false;
  #define START(P0,P1) do{ if constexpr(!FAST){ const float rm=rowmax(P0,P1); resc=false; \
    { const float dl=rm; mhat=fadd_s(mhat,dl); \
      _Pragma("unroll") for(int r=0;r<16;++r){P0[r]=fsub_s(P0[r],dl);P1[r]=fsub_s(P1[r],dl);} \
      NEGM_SET(); } } \
    _Pragma("unroll") for(int r=0;r<16;++r)P0[r]=__builtin_amdgcn_exp2f(P0[r]); }while(0)
  #define RESC() do{ if constexpr(!FAST) if(resc){ asm volatile("s_waitcnt lgkmcnt(0)":::"memory"); \
      _Pragma("unroll") for(int d_=0;d_<2;++d_) _Pragma("unroll") for(int r=0;r<16;++r)o[d_][r]*=wsf[crow(r,hi)]; } }while(0)
  f32x16 pA0,pA1,pB0,pB1;
  int sl_prev=0,sl_cur=0,sl_next=SLOTB;
  #define ROT() do{sl_prev=sl_cur;sl_cur=sl_next;sl_next=(sl_next==(NSLOT-1)*SLOTB)?0:sl_next+SLOTB;}while(0)
  DMA_K(2,2*SLOTB);
  float qn2_=0.f; if constexpr(FAST)qn2_=attn_qnorm2<CM>(Qb,q0,wid,r32,hi);
  WAIT_BAR(3);
  if constexpr(FAST){ const float*red=(const float*)(shm+LDS_RED); const int ro=CM?4*map:0; const float kmax2=fmaxf(fmaxf(red[ro],red[ro+1]),fmaxf(red[ro+2],red[ro+3]));
    mhat=sqrtf(qn2_*kmax2)*1.0005f+bmax+0.01f; NEGM_SET(); }
  qkt<(CM?2:4)>(pA0,pA1,Kbase+(CM?map*4096:0),qr,negm,r32,hi);asm volatile("s_nop 15\n\ts_nop 7":"+v"(pA0),"+v"(pA1));BIASADD(pA0,pA1,0);
  START(pA0,pA1);
  _Pragma("unroll") for(int r=0;r<16;++r)pA1[r]=__builtin_amdgcn_exp2f(pA1[r]);
  WAIT_BAR(0);
  DMA_K(3,0);DMA_V(1,SLOTB);
  ROT();
  if constexpr(CM){ kload2(kf,kp0+sl_cur,0); kload2(kf,kp0+sl_cur,1); } else { kload8(kf,kp0+sl_cur); }
  WAIT_BAR(2);
  s16x4 vlo[8],vhi[8]; u32x4 pw0,pw1,pw2,pw3;
  #define PKW(P,B) cvtpk_s(P[B],P[B+1])
  #define PAF(k) __builtin_bit_cast(bf16x8,pw##k)
  #define VFR(i) (bf16x8){vlo[i][0],vlo[i][1],vlo[i][2],vlo[i][3],vhi[i][0],vhi[i][1],vhi[i][2],vhi[i][3]}
  #define PIN(x) asm volatile("":"+v"(x))
  #define MX3(a,b,c) __builtin_fmaxf(__builtin_fmaxf((a),(b)),(c))
  #define GAPA(MF,A0,A1,A2,A3,W0,W1,PW) do{ MF; if constexpr(!LM){ sacc+=A0; sacc+=A1; sacc+=A2; sacc+=A3; PIN(sacc); } W0; W1; PIN(PW); SBAR(); }while(0)
  #define LS(k) do{ if constexpr(LM) lacc=__builtin_amdgcn_mfma_f32_32x32x16_bf16(PAF(k),ONES,lacc,0,0,0); }while(0)
  #define EX(v) __builtin_amdgcn_exp2f(v)
  #define GAPB(MF,X,B) do{ MF; X[B]=EX(X[B]); X[B+1]=EX(X[B+1]); X[B+2]=EX(X[B+2]); X[B+3]=EX(X[B+3]); PIN(X); SBAR(); }while(0)
  #define VRD(i) do{ vlo[i]=vtr(vp_+(((i)>>2)*4096+((i)&3)*1024)); vhi[i]=vtr(vp_+(((i)>>2)*4096+((i)&3)*1024+512)); }while(0)
  #define KRD(G,j) do{ if((G)&&(!CM||(j)<2)){ kload2(kf,kp0+sl_next,j); SBAR(); } }while(0)
  #define MF58(stmt) do{ if constexpr(!CM){ stmt; } }while(0)
  #define STEP(C0,C1,P0,P1,t,GK,GV,GL) do{ SBAR(); \
    const lds_cptr vp_=vp0+sl_prev; \
    VRD(0); SBAR(); float sacc=(P0[0]+P0[1]); \
    GAPA(C0=__builtin_amdgcn_mfma_f32_32x32x16_bf16(kf[0],qr[0],negm,0,0,0), P0[2],P0[3],P0[4],P0[5],     pw0[0]=PKW(P0,0), pw0[1]=PKW(P0,2), pw0); \
    VRD(4); SBAR(); GAPA(C1=__builtin_amdgcn_mfma_f32_32x32x16_bf16(kf[1],qr[0],negm,0,0,0), P0[6],P0[7],P0[8],P0[9],     pw0[2]=PKW(P0,4), pw0[3]=PKW(P0,6), pw0); \
    VRD(1); SBAR(); GAPA(C0=__builtin_amdgcn_mfma_f32_32x32x16_bf16(kf[2],qr[1],C0,0,0,0),   P0[10],P0[11],P0[12],P0[13], pw1[0]=PKW(P0,8), pw1[1]=PKW(P0,10), pw1); \
    VRD(5); SBAR(); GAPA(C1=__builtin_amdgcn_mfma_f32_32x32x16_bf16(kf[3],qr[1],C1,0,0,0),   P0[14],P0[15],P1[0],P1[1],   pw1[2]=PKW(P0,12),pw1[3]=PKW(P0,14), pw1); \
    VRD(2); SBAR(); GAPA(MF58(C0=__builtin_amdgcn_mfma_f32_32x32x16_bf16(kf[4],qr[2],C0,0,0,0)),   P1[2],P1[3],P1[4],P1[5],     pw2[0]=PKW(P1,0), pw2[1]=PKW(P1,2), pw2); \
    VRD(6); SBAR(); GAPA(MF58(C1=__builtin_amdgcn_mfma_f32_32x32x16_bf16(kf[5],qr[2],C1,0,0,0)),   P1[6],P1[7],P1[8],P1[9],     pw2[2]=PKW(P1,4), pw2[3]=PKW(P1,6), pw2); \
    VRD(3); SBAR(); GAPA(MF58(C0=__builtin_amdgcn_mfma_f32_32x32x16_bf16(kf[6],qr[3],C0,0,0,0)),   P1[10],P1[11],P1[12],P1[13], pw3[0]=PKW(P1,8), pw3[1]=PKW(P1,10), pw3); \
    VRD(7); SBAR(); GAPA(MF58(C1=__builtin_amdgcn_mfma_f32_32x32x16_bf16(kf[7],qr[3],C1,0,0,0)),   P1[14],P1[15],0.f,0.f,       pw3[2]=PKW(P1,12),pw3[3]=PKW(P1,14), pw3); \
    if constexpr(!LM) l_reg+=sacc; \
    if(GK){DMA_K((t)+3,sl_cur);} if(GV){DMA_V((t)+1,sl_next);} \
    BIASADD(C0,C1,t); \
    if constexpr(!FAST){ float a=MX3(C0[0],C0[1],C1[0]),b=MX3(C0[2],C0[3],C1[1]); a=MX3(a,C1[2],C1[3]); \
      _Pragma("unroll") for(int r=4;r<16;r+=4){a=MX3(a,C0[r],C0[r+1]);b=MX3(b,C0[r+2],C0[r+3]);a=MX3(a,C1[r],C1[r+1]);b=MX3(b,C1[r+2],C1[r+3]);} \
      float rm=__builtin_fmaxf(a,b); { auto rr=__builtin_amdgcn_permlane32_swap(__float_as_uint(rm),__float_as_uint(rm),false,false); rm=__builtin_fmaxf(__uint_as_float(rr[0]),__uint_as_float(rr[1])); } \
      resc=false; \
      if(__builtin_expect(__any(rm>(float)THRL),0)){ const float dl=__builtin_fmaxf(rm,0.f); mhat+=dl; \
        _Pragma("unroll") for(int r=0;r<16;++r){C0[r]-=dl;C1[r]-=dl;} \
        NEGM_SET(); \
        const float f=__builtin_amdgcn_exp2f(-dl); l_reg*=f; if(hi==0)wsf[r32]=f; resc=true; } } \
    SBAR(); \
    GAPB(o[0]=__builtin_amdgcn_mfma_f32_32x32x16_bf16(PAF(0),VFR(0),o[0],0,0,0), C0,0); \
    GAPB(o[1]=__builtin_amdgcn_mfma_f32_32x32x16_bf16(PAF(0),VFR(4),o[1],0,0,0); LS(0), C0,4); \
    KRD(GL,0); GAPB(o[0]=__builtin_amdgcn_mfma_f32_32x32x16_bf16(PAF(1),VFR(1),o[0],0,0,0), C0,8); \
    KRD(GL,1); GAPB(o[1]=__builtin_amdgcn_mfma_f32_32x32x16_bf16(PAF(1),VFR(5),o[1],0,0,0); LS(1), C0,12); \
    KRD(GL,2); GAPB(o[0]=__builtin_amdgcn_mfma_f32_32x32x16_bf16(PAF(2),VFR(2),o[0],0,0,0), C1,0); \
    KRD(GL,3); GAPB(o[1]=__builtin_amdgcn_mfma_f32_32x32x16_bf16(PAF(2),VFR(6),o[1],0,0,0); LS(2), C1,4); \
    GAPB(o[0]=__builtin_amdgcn_mfma_f32_32x32x16_bf16(PAF(3),VFR(3),o[0],0,0,0), C1,8); \
    GAPB(o[1]=__builtin_amdgcn_mfma_f32_32x32x16_bf16(PAF(3),VFR(7),o[1],0,0,0); LS(3), C1,12); \
    }while(0)
  int t=1;
  { constexpr int PADN=CM?(FAST?PAD_CF:PAD_CS):(FAST?PAD_AF:PAD_AS); asm volatile(".p2align 6\n\t.rept %c0\n\ts_nop 0\n\t.endr"::"i"(PADN):"memory"); }
  for(;t+5<NT;t+=2){
    MODESW(t);
    STEP(pB0,pB1,pA0,pA1,t,true,true,true);     WAIT_BAR(2); RESC(); ROT();
    STEP(pA0,pA1,pB0,pB1,t+1,true,true,true);   WAIT_BAR(2); RESC(); ROT();
  }
  #define ENDW(tt) do{ if((tt)+3<NT){WAIT_BAR(2);} else if((tt)+2<NT){WAIT_BAR(1);} else {WAIT_BAR(0);} }while(0)
  for(;t+1<NT;t+=2){
    MODESW(t);
    STEP(pB0,pB1,pA0,pA1,t,(t+3<NT),(t+1<NT),(t+1<NT));       ENDW(t);   RESC(); ROT();
    STEP(pA0,pA1,pB0,pB1,t+1,(t+4<NT),(t+2<NT),(t+2<NT));     ENDW(t+1); RESC(); ROT();
  }
  MODESW(NT-1);
  STEP(pB0,pB1,pA0,pA1,NT-1,false,false,false); RESC();
  { if constexpr(!LM){ float sacc=pB0[0]+pB0[1]; _Pragma("unroll") for(int r=2;r<16;++r)sacc+=pB0[r]; _Pragma("unroll") for(int r=0;r<16;++r)sacc+=pB1[r]; l_reg+=sacc; }
    pw0=(u32x4){PKW(pB0,0),PKW(pB0,2),PKW(pB0,4),PKW(pB0,6)};pw1=(u32x4){PKW(pB0,8),PKW(pB0,10),PKW(pB0,12),PKW(pB0,14)};pw2=(u32x4){PKW(pB1,0),PKW(pB1,2),PKW(pB1,4),PKW(pB1,6)};pw3=(u32x4){PKW(pB1,8),PKW(pB1,10),PKW(pB1,12),PKW(pB1,14)};
    SBAR(); pv(o,vb0+sl_cur,PAF(0),PAF(1),PAF(2),PAF(3)); LS(0); LS(1); LS(2); LS(3); }
  #undef PKW
  #undef PAF
  #undef VFR
  #undef PIN
  #undef MX3
  #undef GAPA
  #undef LS
  #undef GAPB
  #undef EX
  #undef VRD
  #undef KRD
  #undef MF58
  #undef STEP
  #undef ENDW
  float rli[16];
  if constexpr(LM){
    #pragma unroll
    for(int r=0;r<16;++r)rli[r]=__builtin_amdgcn_rcpf(lacc[r]);
  } else {
    {auto rr=__builtin_amdgcn_permlane32_swap(__float_as_uint(l_reg),__float_as_uint(l_reg),false,false);l_reg=__uint_as_float(rr[0])+__uint_as_float(rr[1]);}
    if(hi==0)wsf[32+r32]=l_reg;asm volatile("s_waitcnt lgkmcnt(0)":::"memory");
    #pragma unroll
    for(int r=0;r<16;++r)rli[r]=__builtin_amdgcn_rcpf(wsf[32+crow(r,hi)]);
  }
  if(!CM){
    bf16*Ow=Ob+(long)(q0+wid*QBLK)*LDO;
    bf16*stg=(bf16*)(shm+LDS_OST)+wid*2048;
    #pragma unroll
    for(int r=0;r<16;++r){const int orow=crow(r,hi);
      #pragma unroll
      for(int d0=0;d0<2;++d0)stg[orow*64+d0*32+r32]=__float2bfloat16(o[d0][r]*rli[r]);}
    asm volatile("s_waitcnt lgkmcnt(0)":::"memory");
    #pragma unroll
    for(int i=0;i<4;++i){const int row=i*8+(lane>>3),ch=lane&7; const u32x4 v=*(const u32x4*)(stg+row*64+ch*8); ATTN_STORE16(Ow+(long)row*LDO+ch*8,v);}
  } else {
    const float msc=(map==0)?1.f:-lam;
    float*stg=(float*)(shm+LDS_OST)+map*8192+(wid&3)*2048;
    #pragma unroll
    for(int r=0;r<16;++r){const int orow=crow(r,hi); const float sc=rli[r]*msc;
      #pragma unroll
      for(int d0=0;d0<2;++d0)stg[orow*64+d0*32+r32]=o[d0][r]*sc;}
    asm volatile("s_waitcnt lgkmcnt(0)\n\ts_barrier":::"memory");
    const int row=16*wid+(lane>>2),part=lane&3;
    const float*s0=(const float*)(shm+LDS_OST)+row*64+part*16;
    f32x4a a[4]; float ss=0.f;
    #pragma unroll
    for(int i=0;i<4;++i){ a[i]=((const f32x4a*)s0)[i]+((const f32x4a*)(s0+8192))[i]; ss+=a[i][0]*a[i][0]+a[i][1]*a[i][1]+a[i][2]*a[i][2]+a[i][3]*a[i][3]; }
    ss+=__shfl_xor(ss,1); ss+=__shfl_xor(ss,2);
    const float rn=osc/sqrtf(ss*(1.0f/64.0f)+1e-6f);
    unsigned w[8];
    #pragma unroll
    for(int i=0;i<4;++i){ const f32x4a g=((const f32x4a*)(gdiff+part*16))[i]; w[2*i]=cvtpk_s(a[i][0]*rn*g[0],a[i][1]*rn*g[1]); w[2*i+1]=cvtpk_s(a[i][2]*rn*g[2],a[i][3]*rn*g[3]); }
    bf16*op=Ob+(long)(q0+row)*LDO+part*16;
    *(u32x4*)(op)=(u32x4){w[0],w[1],w[2],w[3]}; *(u32x4*)(op+8)=(u32x4){w[4],w[5],w[6],w[7]};
  }
  asm volatile("s_waitcnt lgkmcnt(0)\n\ts_barrier":::"memory");
  #undef DMA_K
  #undef DMA_V
  #undef BIASADD
  #undef MODESW
  #undef NEGM_SET
  #undef START
  #undef RESC
  #undef ROT
}
#undef SBAR
#undef WAIT_BAR
}
#define GAS __attribute__((address_space(1)))
#define LAS __attribute__((address_space(3)))
typedef unsigned short bf16;
typedef unsigned v4u __attribute__((ext_vector_type(4)));
typedef float f32x4 __attribute__((ext_vector_type(4)));
typedef short bf16x8 __attribute__((ext_vector_type(8)));
typedef GAS unsigned gu32;
typedef GAS unsigned long long gu64;
#define RLX_AGENT __ATOMIC_RELAXED, __HIP_MEMORY_SCOPE_AGENT
#define LDS_WAIT() asm volatile("s_waitcnt lgkmcnt(0)" ::: "memory")
#define VM_WAIT() asm volatile("s_waitcnt vmcnt(0)" ::: "memory")
__device__ __forceinline__ unsigned long long rt() { return __builtin_amdgcn_s_memrealtime(); }
__device__ __forceinline__ unsigned f2bf(float f) { unsigned u = __builtin_bit_cast(unsigned, f); return (u + 0x7fffu + ((u >> 16) & 1u)) >> 16; }
__device__ __forceinline__ unsigned pk2(float lo, float hi) { return f2bf(lo) | (f2bf(hi) << 16); }

#define XB_TMO      128
#define XB_XCNT(j)  (256  + 64 * (j))
#define XB_XSUB(j)  (1280 + 64 * (j))
#define XB_XGEN(j)  (2304 + 64 * (j))
#define XB_TOP      3328
#define XB_TOPGEN   3392
#define XCD_BAR_WORDS 3456
#define XB_SPIN_CAP (1u << 18)

__device__ __forceinline__ unsigned xb_ld(unsigned* p)              { return __hip_atomic_load(p, __ATOMIC_RELAXED, __HIP_MEMORY_SCOPE_AGENT); }
__device__ __forceinline__ unsigned xb_add(unsigned* p, unsigned v) { return __hip_atomic_fetch_add(p, v, __ATOMIC_RELAXED, __HIP_MEMORY_SCOPE_AGENT); }
__device__ __forceinline__ unsigned xb_xcc_id() { return (unsigned)__builtin_amdgcn_s_getreg((3 << 11) | 20) & 0xFu; }
#define XB_SPIN(cond, bar) do { unsigned _sp = 0; while (cond) { __builtin_amdgcn_s_sleep(1); \
    if ((++_sp & 255u) == 0u) { if (xb_ld(&(bar)[XB_TMO])) break; if (_sp > XB_SPIN_CAP) { atomicAdd(&(bar)[XB_TMO], 1u); break; } } } } while (0)

struct XcdBarrier {
    unsigned* bar; unsigned x;
    volatile LAS unsigned* st;
};

__device__ __forceinline__ XcdBarrier xcd_barrier_post(unsigned* bar, volatile LAS unsigned* st, int tid_) {
    XcdBarrier b; b.bar = bar; b.x = xb_xcc_id(); b.st = st;
    if (tid_ == 0) (void)xb_add(&bar[XB_XCNT(b.x)], 1u);
    return b;
}
__device__ __forceinline__ void xcd_barrier_complete(unsigned* bar, unsigned x, unsigned& nloc, unsigned& nx) {
    const unsigned G = gridDim.x * gridDim.y * gridDim.z;
    unsigned sum, cnt, mine, sp = 0u;
    for (;;) {
        sum = 0u; cnt = 0u; mine = 0u;
#pragma unroll
        for (unsigned j = 0; j < 16; ++j) { const unsigned c = xb_ld(&bar[XB_XCNT(j)]); sum += c; cnt += (c > 0u) ? 1u : 0u; mine = (j == x) ? c : mine; }
        if (sum == G) break;
        __builtin_amdgcn_s_sleep(1);
        if ((++sp & 255u) == 0u) { if (xb_ld(&bar[XB_TMO])) break; if (sp > XB_SPIN_CAP) { atomicAdd(&bar[XB_TMO], 1u); break; } }
    }
    nloc = mine > 0u ? mine : 1u; nx = cnt > 0u ? cnt : 1u;
}

__device__ __forceinline__ void xcd_barrier(const XcdBarrier& b, int tid_) {
    asm volatile("s_waitcnt vmcnt(0)" ::: "memory");
    __syncthreads();
    if (tid_ == 0) {
        unsigned* bar = b.bar;
        __builtin_amdgcn_s_waitcnt(0);
        unsigned nloc = b.st[0], nx = b.st[1];
        if (nloc == 0u) { xcd_barrier_complete(bar, b.x, nloc, nx); b.st[0] = nloc; b.st[1] = nx; }
        const unsigned old = xb_add(&bar[XB_XSUB(b.x)], 1u);
        const unsigned gen = old / nloc;
        if (old + 1u == (gen + 1u) * nloc) {
            __builtin_amdgcn_fence(__ATOMIC_RELEASE, "agent");
            asm volatile("s_waitcnt vmcnt(0)" ::: "memory");
            const unsigned og = xb_add(&bar[XB_TOP], 1u);
            const unsigned tg = og / nx;
            if (og + 1u == (tg + 1u) * nx) xb_add(&bar[XB_TOPGEN], 1u);
            else XB_SPIN(xb_ld(&bar[XB_TOPGEN]) == tg, bar);
            __builtin_amdgcn_fence(__ATOMIC_ACQUIRE, "agent");
            xb_add(&bar[XB_XGEN(b.x)], 1u);
            asm volatile("s_waitcnt vmcnt(0)" ::: "memory");
        } else {
            XB_SPIN(xb_ld(&bar[XB_XGEN(b.x)]) == gen, bar);
            __builtin_amdgcn_fence(__ATOMIC_ACQUIRE, "agent");
            asm volatile("s_waitcnt vmcnt(0)" ::: "memory");
        }
    }
    __syncthreads();
}
constexpr int NWAVES = 8, NTHR = 512;
constexpr int NB = 2, S = 16384, T = NB * S, D = 1024, DEPTH = 4, NE = 16, CAP = 2048;
constexpr int NPROJ = 2816, NGATE = 4096, NCAT = NPROJ + NGATE, LDP = NPROJ;
constexpr int NPROJ_BF = 0, NPROJ_I8 = NPROJ - NPROJ_BF;
constexpr int PC_AQ = 0, PC_AK = 256, PC_AV = 384, PC_CQ = 512, PC_CK = 768, PC_CV = 1024, PC_Z = 1280, PC_XS = 1536, PC_BM = 1792, PC_CM = 2048, PC_UV = 2304;
constexpr float EPS = 1e-6f, LOG2E = 1.4426950408889634f;
constexpr int PAD_PL0 = 5, PAD_PROJ = 8, PAD_PL = 5, PAD_GATE = 8, PAD_P5 = 0, PAD_P6 = 5, PAD_GU = 8, PAD_DN = 8, PAD_PLE = 8;
constexpr int NPH = 14;
constexpr int NGP = DEPTH * NPH + 1;

constexpr size_t MiB = 1u << 20;
constexpr size_t WS_CTL = 0, CTL_ZERO_BYTES = 1 * MiB;
constexpr size_t WS_DT = 1 * MiB;
constexpr size_t WS_AFF = 2 * MiB;
constexpr size_t WS_SELIDX = 4 * MiB;
constexpr size_t WS_SELAFF = 4 * MiB + 256 * 1024;
constexpr size_t WS_INV = 5 * MiB;
constexpr size_t WS_TAB = 6 * MiB;
constexpr size_t WS_CD = 8 * MiB;
constexpr size_t WS_WSP = 8 * MiB + 512 * 1024;
constexpr size_t WS_SSQ = 9 * MiB;
constexpr size_t WS_KMAX = 9 * MiB + 512 * 1024;
constexpr size_t WS_SA = 9 * MiB + 576 * 1024;
constexpr size_t WS_SW = 9 * MiB + 768 * 1024;
constexpr size_t WS_WCAT = 10 * MiB;
constexpr size_t WS_WBR = 24 * MiB, WS_WPG = 26 * MiB, WS_WPLE = 28 * MiB;
constexpr size_t WS_WGU = 32 * MiB;
constexpr size_t WS_WDN = 96 * MiB;
constexpr size_t WS_H = 128 * MiB;
constexpr size_t WS_PROJ = 192 * MiB;
constexpr size_t WS_GATES = 368 * MiB;
constexpr size_t WS_XE = 192 * MiB, WS_HID = 320 * MiB, WS_YE = 448 * MiB;
constexpr size_t WS_BR = 624 * MiB;
constexpr size_t WS_PL = 688 * MiB;
constexpr size_t WS_PBF = 752 * MiB;
constexpr size_t WS_ST = 768 * MiB;
constexpr size_t WS_SB = 832 * MiB;
constexpr size_t WS_XBC = 864 * MiB;
constexpr size_t WS_WOUT = 912 * MiB;
constexpr size_t WS_H8 = 914 * MiB;
constexpr size_t WS_XB = 946 * MiB;
constexpr size_t WS_END = 1010 * MiB;
constexpr int CW_TMO = 0, CW_BAR = 4096;

constexpr int RING_BYTES = 131072, LDSCTL_OFF = RING_BYTES, MISC_OFF = LDSCTL_OFF + 320, LDS_BYTES = 147456;

struct P {
    const float *x, *p, *rel_bias, *g_mix, *w_in, *g_qnorm, *g_knorm, *conv_w, *conv_b, *dt_bias_f, *dt_bias_b, *a_log_f, *a_log_b, *d_skip, *g_ssm,
                *lambda_q1, *lambda_k1, *lambda_q2, *lambda_k2, *g_diff, *g_sgu, *w_spatial, *b_spatial, *w_branch, *w_branch_gate, *w_out, *g_moe, *w_router,
                *w_exp_gate, *w_exp_up, *w_exp_down, *g_ple, *w_ple_gate, *w_ple, *g_final;
    float* out; unsigned char* ws;
    int gp_lo, gp_hi;
};

__device__ __forceinline__ float wave_sum(float v) {
#pragma unroll
    for (int o = 1; o < 64; o <<= 1) v += __shfl_xor(v, o);
    return v;
}
__device__ __forceinline__ float bf2f(unsigned short u) { return __builtin_bit_cast(float, (unsigned)u << 16); }
__device__ __forceinline__ float silu_f(float x) { return x * __builtin_amdgcn_rcpf(1.0f + __builtin_amdgcn_exp2f(-LOG2E * x)); }
__device__ __forceinline__ float gelu_tanh(float x) { const float y = 0.7978845608028654f * (x + 0.044715f * x * x * x); const float e = __builtin_amdgcn_exp2f(2.0f * LOG2E * y); return 0.5f * x * (2.0f - 2.0f * __builtin_amdgcn_rcpf(e + 1.0f)); }
__device__ __forceinline__ float softplus_f(float x) {
    const float e = __builtin_amdgcn_exp2f(-LOG2E * fabsf(x));
    const float l = (e < 0.03125f) ? e * (1.0f - e * (0.5f - e * (0.33333334f - 0.25f * e))) : 0.6931471805599453f * __builtin_amdgcn_logf(1.0f + e);
    return fmaxf(x, 0.f) + l; }
__device__ __forceinline__ f32x4 mfma16(bf16x8 a, bf16x8 b, f32x4 c) { return __builtin_amdgcn_mfma_f32_16x16x32_bf16(a, b, c, 0, 0, 0); }
typedef short bf16x4 __attribute__((ext_vector_type(4)));
typedef unsigned v2u __attribute__((ext_vector_type(2)));
__device__ __forceinline__ f32x4 xb_unpack(const v2u w) { return (f32x4){__builtin_bit_cast(float, w.x << 16), __builtin_bit_cast(float, w.x & 0xffff0000u), __builtin_bit_cast(float, w.y << 16), __builtin_bit_cast(float, w.y & 0xffff0000u)}; }

__device__ __forceinline__ void tr_item(const float* W, int ldw, int k0, int scol0, bf16* WT, int ldk, int drow0, LAS float* scr, int lane) {
#pragma unroll 8
    for (int i = 0; i < 32; ++i) { const int kk = 2 * i + (lane >> 5); scr[kk * 33 + (lane & 31)] = W[(size_t)(k0 + kk) * ldw + scol0 + (lane & 31)]; }
    LDS_WAIT(); asm volatile("" ::: "memory");
    const int c = lane & 7;
#pragma unroll
    for (int j = 0; j < 4; ++j) { const int n = (lane >> 3) + 8 * j; const LAS float* s = scr + (8 * c) * 33 + n;
        v4u o; o.x = pk2(s[0 * 33], s[1 * 33]); o.y = pk2(s[2 * 33], s[3 * 33]); o.z = pk2(s[4 * 33], s[5 * 33]); o.w = pk2(s[6 * 33], s[7 * 33]);
        *(GAS v4u*)(WT + (size_t)(drow0 + n) * ldk + k0 + 8 * c) = o; }
    LDS_WAIT(); asm volatile("" ::: "memory");
}
__device__ __forceinline__ void tr_item8(const float* W, int ldw, int k0, int scol0, unsigned char* WT, int ldk, int drow0, float scale, LAS float* scr, int lane) {
#pragma unroll 8
    for (int i = 0; i < 32; ++i) { const int kk = 2 * i + (lane >> 5); scr[kk * 33 + (lane & 31)] = W[(size_t)(k0 + kk) * ldw + scol0 + (lane & 31)]; }
    LDS_WAIT(); asm volatile("" ::: "memory");
    const int c = lane & 3;
#pragma unroll
    for (int j = 0; j < 2; ++j) { const int n = (lane >> 2) + 16 * j; const LAS float* s = scr + (16 * c) * 33 + n; int w[4];
#pragma unroll
        for (int q = 0; q < 4; ++q) { int t = 0; t = __builtin_amdgcn_cvt_pk_fp8_f32(scale * s[(4 * q) * 33], scale * s[(4 * q + 1) * 33], t, false); t = __builtin_amdgcn_cvt_pk_fp8_f32(scale * s[(4 * q + 2) * 33], scale * s[(4 * q + 3) * 33], t, true); w[q] = t; }
        *(GAS v4u*)(WT + (size_t)(drow0 + n) * ldk + k0 + 16 * c) = (v4u){(unsigned)w[0], (unsigned)w[1], (unsigned)w[2], (unsigned)w[3]}; }
    LDS_WAIT(); asm volatile("" ::: "memory");
}
__device__ __forceinline__ void tr_item_i8(const float* W, int ldw, int k0, int scol0, unsigned char* WT, int ldk, int drow0, const LAS float* inv, LAS float* scr, int lane) {
#pragma unroll 8
    for (int i = 0; i < 32; ++i) { const int kk = 2 * i + (lane >> 5); scr[kk * 33 + (lane & 31)] = W[(size_t)(k0 + kk) * ldw + scol0 + (lane & 31)]; }
    LDS_WAIT(); asm volatile("" ::: "memory");
    const int c = lane & 3;
#pragma unroll
    for (int j = 0; j < 2; ++j) { const int n = (lane >> 2) + 16 * j; const LAS float* s = scr + (16 * c) * 33 + n; const float iv = inv[n]; unsigned w[4];
#pragma unroll
        for (int q = 0; q < 4; ++q) { const int b0 = (int)rintf(iv * s[(4 * q) * 33]), b1 = (int)rintf(iv * s[(4 * q + 1) * 33]), b2 = (int)rintf(iv * s[(4 * q + 2) * 33]), b3 = (int)rintf(iv * s[(4 * q + 3) * 33]);
            w[q] = (unsigned)(b0 & 0xff) | ((unsigned)(b1 & 0xff) << 8) | ((unsigned)(b2 & 0xff) << 16) | ((unsigned)(b3 & 0xff) << 24); }
        *(GAS v4u*)(WT + (size_t)(drow0 + n) * ldk + k0 + 16 * c) = (v4u){w[0], w[1], w[2], w[3]}; }
    LDS_WAIT(); asm volatile("" ::: "memory");
}
__device__ __forceinline__ void gatew_item(const float* W, int ldw, int scol, int nb, unsigned char* WT, float* SWo, unsigned char* ldsg, int wave, int lane, int tid) {
    LAS unsigned char* lds = (LAS unsigned char*)ldsg;
    LAS float* scr = (LAS float*)(lds + wave * 16384);
    LAS float* cmax = (LAS float*)(lds + RING_BYTES + 512);
    LAS float* inv = cmax + 256;
    float mx = 0.f;
#pragma unroll 1
    for (int kb2 = 0; kb2 < 2; ++kb2) { const int k0 = 64 * (2 * wave + kb2);
#pragma unroll 8
        for (int i = 0; i < 32; ++i) { const int kk = 2 * i + (lane >> 5); mx = fmaxf(mx, fabsf(W[(size_t)(k0 + kk) * ldw + scol + (lane & 31)])); } }
    mx = fmaxf(mx, __shfl_xor(mx, 32));
    if (lane < 32) cmax[wave * 32 + lane] = mx;
    __syncthreads();
    if (tid < 32) { float m2 = 0.f;
#pragma unroll
        for (int w = 0; w < 8; ++w) m2 = fmaxf(m2, cmax[w * 32 + tid]);
        m2 = fmaxf(m2, 1e-30f); inv[tid] = 127.0f / m2; SWo[32 * nb + tid] = m2 * (1.0f / 127.0f); }
    __syncthreads();
#pragma unroll 1
    for (int kb2 = 0; kb2 < 2; ++kb2) tr_item_i8(W, ldw, 64 * (2 * wave + kb2), scol, WT, 1024, 32 * nb, inv, scr, lane);
    __syncthreads();
}
__device__ __forceinline__ int win_src(int drow) {
    return drow < 512 ? drow : drow < 1280 ? 1544 + (drow - 512) : drow < 2304 ? 512 + (drow - 1280) : 2312 + (drow - 2304);
}

__device__ __forceinline__ void ph_convw(const P& a, int L, unsigned char* lds, int gw, int NGW, int wave, int lane, int tid, int gtid, int GT, int wgi, int nwg, int part) {
    unsigned char* ws = a.ws;
    LAS float* scr = (LAS float*)((LAS unsigned char*)lds + wave * 16384);
    constexpr int I1 = 16 * (NPROJ_BF / 32), I2 = 0, I3 = 512, I4 = 512, I5 = 0, I6 = 4 * 32, I7 = NE * 2 * 512, I8 = NE * 512;
    constexpr int NIT = I1 + I2 + I3 + I4 + I5 + I6 + I7 + I8, NEARLY = I1 + I2 + I3 + I4 + I5 + I6;
    const int it0 = (part == 2) ? NEARLY : 0, it1 = (part == 1) ? NEARLY : NIT;
    for (int it = it0 + gw; it < it1; it += NGW) {
        int r = it;
        if constexpr (I1 > 0) if (r < I1) { constexpr int NBB = (NPROJ_BF > 0) ? NPROJ_BF / 32 : 1; const int kb = r / NBB, nb = r % NBB; tr_item(a.w_in + (size_t)L * 1024 * 2824, 2824, 64 * kb, win_src(32 * nb), (bf16*)(ws + WS_WCAT), 1024, 32 * nb, scr, lane); continue; } r -= I1;
        if (r < I3) { const int n = r / 128, rr = r % 128, kb = rr / 32, nb = rr % 32; tr_item(a.w_branch + ((size_t)L * 4 + n) * 256 * 1024, 1024, 64 * kb, 32 * nb, (bf16*)(ws + WS_WBR), 256, n * 1024 + 32 * nb, scr, lane); continue; } r -= I3;
        if (r < I4) { const int kb = r / 32, nb = r % 32; tr_item(a.w_out + (size_t)L * 1024 * 1024, 1024, 64 * kb, 32 * nb, (bf16*)(ws + WS_WOUT), 1024, 32 * nb, scr, lane); continue; } r -= I4;
        if (r < I6) { const int kb = r / 32, nb = r % 32; tr_item(a.w_ple + (size_t)L * 256 * 1024, 1024, 64 * kb, 32 * nb, (bf16*)(ws + WS_WPLE), 256, 32 * nb, scr, lane); continue; } r -= I6;
        if (r < I7) { const int e = r / 1024, up = (r / 512) & 1, rr = r % 512, kb = rr / 32, nb = rr % 32;
            const float* W = (up ? a.w_exp_up : a.w_exp_gate) + ((size_t)L * NE + e) * 1024 * 1024;
            const int drow = e * 2048 + ((32 * nb) / 128) * 256 + up * 128 + ((32 * nb) % 128);
            tr_item8(W, 1024, 64 * kb, 32 * nb, (unsigned char*)(ws + WS_WGU), 1024, drow, 32.0f, scr, lane); continue; } r -= I7;
        { const int e = r / 512, rr = r % 512, kb = rr / 32, nb = rr % 32;
            tr_item8(a.w_exp_down + ((size_t)L * NE + e) * 1024 * 1024, 1024, 64 * kb, 32 * nb, (unsigned char*)(ws + WS_WDN), 1024, e * 1024 + 32 * nb, 32.0f, scr, lane); }
    }
    __syncthreads();
    for (int it = wgi; it < 160 + NPROJ_I8 / 32; it += nwg) {
        const bool late = (it >= 128 && it < 160);
        if ((part == 1 && late) || (part == 2 && !late)) continue;
        if (it < 128) gatew_item(a.w_branch_gate + (size_t)L * 1024 * 4096, 4096, 32 * it, it, (unsigned char*)(ws + WS_WCAT) + (size_t)NPROJ * 2048, (float*)(ws + WS_SW), lds, wave, lane, tid);
        else if (it < 160) gatew_item(a.w_ple_gate + (size_t)L * 1024 * 1024, 1024, 32 * (it - 128), it - 128, (unsigned char*)(ws + WS_WPG), (float*)(ws + WS_SW) + 4096, lds, wave, lane, tid);
        else gatew_item(a.w_in + (size_t)L * 1024 * 2824, 2824, win_src(NPROJ_BF + 32 * (it - 160)), it - 160, (unsigned char*)(ws + WS_WCAT) + (size_t)NPROJ_BF * 2048, (float*)(ws + WS_SW) + 5120, lds, wave, lane, tid); }
    if (part != 2) {
        const float* ps = a.p + (size_t)L * T * 256; bf16* pd = (bf16*)(ws + WS_PBF);
        for (int i = gtid; i < T * 256 / 8; i += GT) { const f32x4 v0 = ((const f32x4*)ps)[2 * i], v1 = ((const f32x4*)ps)[2 * i + 1];
            v4u o; o.x = pk2(v0[0], v0[1]); o.y = pk2(v0[2], v0[3]); o.z = pk2(v1[0], v1[1]); o.w = pk2(v1[2], v1[3]); ((v4u*)pd)[i] = o; }
        const float* ss = a.w_spatial + (size_t)L * 4 * 128 * 128; bf16* sd = (bf16*)(ws + WS_WSP);
        for (int i = gtid; i < 4 * 128 * 128 / 8; i += GT) { const f32x4 v0 = ((const f32x4*)ss)[2 * i], v1 = ((const f32x4*)ss)[2 * i + 1];
            v4u o; o.x = pk2(v0[0], v0[1]); o.y = pk2(v0[2], v0[3]); o.z = pk2(v1[0], v1[1]); o.w = pk2(v1[2], v1[3]); ((v4u*)sd)[i] = o; }
    }
    __syncthreads();
}
__device__ __forceinline__ void ph_r0(const P& a, int L, unsigned char* lds, int gw, int NGW, int lane, int tid) {
    unsigned char* ws = a.ws;
    LAS float* wdt = (LAS float*)lds;
    { const float* wi = a.w_in + (size_t)L * 1024 * 2824 + 1536;
      for (int i = tid; i < 1024 * 8; i += NTHR) { const int kq = i >> 3, e8 = i & 7, pos = ((kq >> 8) * 4 + (kq & 3)) * 64 + ((kq >> 2) & 63);
          wdt[((e8 >> 2) * 1024 + pos) * 4 + (e8 & 3)] = wi[(size_t)kq * 2824 + e8]; } }
    __syncthreads();
    const float* xin = a.x; bf16* XB = (bf16*)(ws + WS_XB); const bool l0 = (L == 0);
    const float* gm = a.g_mix + L * D; bf16* H = (bf16*)(ws + WS_H); float* DT = (float*)(ws + WS_DT);
    f32x4 gv[4];
#pragma unroll
    for (int j = 0; j < 4; ++j) gv[j] = ((const f32x4*)gm)[lane + 64 * j];
    const float bias_l = (((lane >> 3) & 7) < 4) ? a.dt_bias_f[L * 4 + ((lane >> 3) & 3)] : a.dt_bias_b[L * 4 + ((lane >> 3) & 3)];
    f32x4 nv[4]; v2u nb[4];
#pragma unroll
    for (int j = 0; j < 4; ++j) { nv[j] = (f32x4){0.f, 0.f, 0.f, 0.f}; nb[j] = (v2u){0u, 0u}; }
    if (gw < T) {
        if (l0) { const GAS f32x4* xr = (const GAS f32x4*)(xin + (size_t)gw * D) + lane;
#pragma unroll
            for (int j = 0; j < 4; ++j) nv[j] = xr[64 * j]; }
        else { const GAS v2u* xr = (const GAS v2u*)(XB + (size_t)gw * D) + lane;
#pragma unroll
            for (int j = 0; j < 4; ++j) nb[j] = xr[64 * j]; } }
    for (int m = gw; m < T; m += NGW) {
        asm volatile("" ::: "memory");
        f32x4 v[4]; float ss = 0.f;
        if (l0) { GAS v2u* xo = (GAS v2u*)(XB + (size_t)m * D) + lane;
#pragma unroll
            for (int j = 0; j < 4; ++j) { v[j] = nv[j]; xo[64 * j] = (v2u){pk2(v[j][0], v[j][1]), pk2(v[j][2], v[j][3])}; } }
        else {
#pragma unroll
            for (int j = 0; j < 4; ++j) v[j] = xb_unpack(nb[j]); }
        if (m + NGW < T) {
            if (l0) { const GAS f32x4* xr = (const GAS f32x4*)(xin + (size_t)(m + NGW) * D) + lane;
#pragma unroll
                for (int j = 0; j < 4; ++j) nv[j] = xr[64 * j]; }
            else { const GAS v2u* xr = (const GAS v2u*)(XB + (size_t)(m + NGW) * D) + lane;
#pragma unroll
                for (int j = 0; j < 4; ++j) nb[j] = xr[64 * j]; } }
#pragma unroll
        for (int j = 0; j < 4; ++j) { ss += (v[j][0] * v[j][0] + v[j][1] * v[j][1]) + (v[j][2] * v[j][2] + v[j][3] * v[j][3]); }
        const float rs = 1.0f / sqrtf(wave_sum(ss) * (1.0f / D) + EPS);
        float d8[8] = {0.f, 0.f, 0.f, 0.f, 0.f, 0.f, 0.f, 0.f};
        GAS unsigned long long* o8 = (GAS unsigned long long*)(H + (size_t)m * D) + lane; GAS unsigned* o4 = (GAS unsigned*)(ws + WS_H8 + (size_t)m * D) + lane;
        float amx = 0.f;
#pragma unroll
        for (int j = 0; j < 4; ++j) { v[j] = v[j] * rs * gv[j]; amx = fmaxf(fmaxf(amx, fmaxf(fabsf(v[j][0]), fabsf(v[j][1]))), fmaxf(fabsf(v[j][2]), fabsf(v[j][3]))); }
#pragma unroll
        for (int o = 1; o < 64; o <<= 1) amx = fmaxf(amx, __shfl_xor(amx, o));
        amx = fmaxf(amx, 1e-30f); const float qinv = 127.0f / amx;
        if (lane == 0) ((float*)(ws + WS_SA))[m] = amx * (1.0f / 127.0f);
#pragma unroll
        for (int j = 0; j < 4; ++j) {
            if constexpr (NPROJ_BF > 0) o8[64 * j] = (unsigned long long)pk2(v[j][0], v[j][1]) | ((unsigned long long)pk2(v[j][2], v[j][3]) << 32);
            { const int b0 = (int)rintf(qinv * v[j][0]), b1 = (int)rintf(qinv * v[j][1]), b2 = (int)rintf(qinv * v[j][2]), b3 = (int)rintf(qinv * v[j][3]);
              o4[64 * j] = (unsigned)(b0 & 0xff) | ((unsigned)(b1 & 0xff) << 8) | ((unsigned)(b2 & 0xff) << 16) | ((unsigned)(b3 & 0xff) << 24); }
#pragma unroll
            for (int c = 0; c < 4; ++c) { const LAS f32x4* wr = (const LAS f32x4*)wdt + (j * 4 + c) * 64 + lane; const f32x4 w0 = wr[0], w1 = wr[1024];
                d8[0] += v[j][c] * w0[0]; d8[1] += v[j][c] * w0[1]; d8[2] += v[j][c] * w0[2]; d8[3] += v[j][c] * w0[3];
                d8[4] += v[j][c] * w1[0]; d8[5] += v[j][c] * w1[1]; d8[6] += v[j][c] * w1[2]; d8[7] += v[j][c] * w1[3]; } }
        float c4[4], c2[2], c1;
        { const bool hb = (lane & 32) != 0;
#pragma unroll
          for (int i = 0; i < 4; ++i) { const float snd = hb ? d8[i] : d8[i + 4], kp = hb ? d8[i + 4] : d8[i]; c4[i] = kp + __shfl_xor(snd, 32); } }
        { const bool hb = (lane & 16) != 0;
#pragma unroll
          for (int i = 0; i < 2; ++i) { const float snd = hb ? c4[i] : c4[i + 2], kp = hb ? c4[i + 2] : c4[i]; c2[i] = kp + __shfl_xor(snd, 16); } }
        { const bool hb = (lane & 8) != 0; const float snd = hb ? c2[0] : c2[1], kp = hb ? c2[1] : c2[0]; c1 = kp + __shfl_xor(snd, 8); }
        c1 += __shfl_xor(c1, 4); c1 += __shfl_xor(c1, 2); c1 += __shfl_xor(c1, 1);
        if ((lane & 7) == 0) DT[(size_t)m * 8 + ((lane >> 3) & 7)] = softplus_f(c1 + bias_l);
    }
    __syncthreads();
}

__device__ __forceinline__ void ph_rope(const P& a, int L, unsigned char* ldsg, int gw, int NGW, int wave, int lane, int tid, int bx, bool dry) {
    bf16* PROJ = (bf16*)(a.ws + WS_PROJ);
    const int head = lane >> 3, j8 = lane & 7; const bool act = head < 6;
    const int hc = act ? head : 5;
    const float* gsrc = (hc < 4 ? a.g_qnorm : a.g_knorm) + L * 64 + j8 * 8;
    float g[8], fr[8];
#pragma unroll
    for (int i = 0; i < 8; ++i) { g[i] = gsrc[i]; fr[i] = __builtin_amdgcn_exp2f(-(float)(8 * (j8 & 1) + i) * (13.287712379549449f / 16.0f)) * 0.15915494309189535f; }
    const float osc = hc < 4 ? 0.125f * LOG2E : 1.0f;
    float kmx0 = 0.f, kmx1 = 0.f;
    float cmx0 = 0.f, cmx1 = 0.f;
    v4u nraw = (v4u){0u, 0u, 0u, 0u};
    if (gw < T) nraw = *(const v4u*)(PROJ + (size_t)gw * LDP + hc * 64 + j8 * 8);
    for (int m = gw; m < T; m += NGW) {
        const int s = m & (S - 1); const float pos = (float)((j8 & 4) ? (s & 63) : (s >> 6));
        bf16* ptr = PROJ + (size_t)m * LDP + hc * 64 + j8 * 8;
        const v4u raw = nraw;
        if (m + NGW < T) nraw = *(const v4u*)(PROJ + (size_t)(m + NGW) * LDP + hc * 64 + j8 * 8);
        float v[8]; v[0] = pg8::bf_lo(raw.x); v[1] = pg8::bf_hi(raw.x); v[2] = pg8::bf_lo(raw.y); v[3] = pg8::bf_hi(raw.y); v[4] = pg8::bf_lo(raw.z); v[5] = pg8::bf_hi(raw.z); v[6] = pg8::bf_lo(raw.w); v[7] = pg8::bf_hi(raw.w);
        float ss = 0.f;
#pragma unroll
        for (int i = 0; i < 8; ++i) ss += v[i] * v[i];
        ss += __shfl_xor(ss, 1); ss += __shfl_xor(ss, 2); ss += __shfl_xor(ss, 4);
        const float rn = 1.0f / sqrtf(ss * (1.0f / 64.0f) + EPS);
        float o[8];
#pragma unroll
        for (int i = 0; i < 8; ++i) { const float y = v[i] * rn * g[i]; const float pr = __shfl_xor(y, 2);
            const float rev = __builtin_amdgcn_fractf(pos * fr[i]); const float sn = __builtin_amdgcn_sinf(rev), cs = __builtin_amdgcn_cosf(rev);
            o[i] = ((j8 & 2) ? (pr * sn + y * cs) : (y * cs - pr * sn)) * osc; }
        v4u w; w.x = pk2(o[0], o[1]); w.y = pk2(o[2], o[3]); w.z = pk2(o[4], o[5]); w.w = pk2(o[6], o[7]);
        if (act && !dry) *(v4u*)ptr = w;
        float so = pg8::bf_lo(w.x) * pg8::bf_lo(w.x) + pg8::bf_hi(w.x) * pg8::bf_hi(w.x) + pg8::bf_lo(w.y) * pg8::bf_lo(w.y) + pg8::bf_hi(w.y) * pg8::bf_hi(w.y)
                 + pg8::bf_lo(w.z) * pg8::bf_lo(w.z) + pg8::bf_hi(w.z) * pg8::bf_hi(w.z) + pg8::bf_lo(w.w) * pg8::bf_lo(w.w) + pg8::bf_hi(w.w) * pg8::bf_hi(w.w);
        so += __shfl_xor(so, 1); so += __shfl_xor(so, 2); so += __shfl_xor(so, 4);
        if (m < S) kmx0 = fmaxf(kmx0, so); else kmx1 = fmaxf(kmx1, so);
        { const v2u cr = *(const v2u*)(PROJ + (size_t)m * LDP + PC_CK + lane * 4);
          float cs = pg8::bf_lo(cr.x) * pg8::bf_lo(cr.x) + pg8::bf_hi(cr.x) * pg8::bf_hi(cr.x) + pg8::bf_lo(cr.y) * pg8::bf_lo(cr.y) + pg8::bf_hi(cr.y) * pg8::bf_hi(cr.y);
          cs += __shfl_xor(cs, 1); cs += __shfl_xor(cs, 2); cs += __shfl_xor(cs, 4);
          if (m < S) cmx0 = fmaxf(cmx0, cs); else cmx1 = fmaxf(cmx1, cs); }
    }
    LAS float* red = (LAS float*)(LAS unsigned char*)ldsg;
    if (head >= 4 && head < 6 && j8 == 0) { red[wave * 24 + (head - 4)] = kmx0; red[wave * 24 + 2 + (head - 4)] = kmx1; }
    if ((lane & 7) == 0) { red[wave * 24 + 4 + (lane >> 3)] = cmx0; red[wave * 24 + 12 + (lane >> 3)] = cmx1; }
    __syncthreads();
    if (tid < 20) { float mx = 0.f;
#pragma unroll
        for (int w = 0; w < 8; ++w) mx = fmaxf(mx, red[w * 24 + tid]);
        ((float*)(a.ws + WS_KMAX))[bx * 32 + tid] = mx; }
    __syncthreads();
}
__device__ __forceinline__ float wave_incl_scan(float v, int lane) {
#pragma unroll
    for (int o = 1; o < 64; o <<= 1) { const float t = __shfl_up(v, o); if (lane >= o) v += t; }
    return v;
}
constexpr int LP = 136;
__device__ __forceinline__ void ssd1_unit(const P& a, int L, int u, unsigned char* ldsg, int wave, int lane, int tid) {
    LAS unsigned char* lds = (LAS unsigned char*)ldsg;
    LAS bf16* XW = (LAS bf16*)lds;
    LAS bf16* BT = (LAS bf16*)(lds + 69632);
    LAS f32x4* TABL = (LAS f32x4*)(lds + 104448);
    LAS float* WV = (LAS float*)(lds + 108544);
    LAS float* DTL = (LAS float*)(lds + 110592);
    const int g = u & 1, c = (u >> 1) & 127, b = u >> 8;
    const size_t t0 = (size_t)b * S + c * 128; const int s0 = c * 128;
    const bf16* PROJ = (const bf16*)(a.ws + WS_PROJ); bf16* XBC = (bf16*)(a.ws + WS_XBC);
    if (tid < 256) ((LAS f32x4*)DTL)[tid] = ((const f32x4*)((const float*)(a.ws + WS_DT) + t0 * 8))[tid];
    __syncthreads();
    if (wave < 4) {
        const int hl = wave >> 1, dir = wave & 1, h = 2 * g + hl;
        const float av = -__expf((dir ? a.a_log_b : a.a_log_f)[L * 4 + h]);
        const float d0 = DTL[(2 * lane) * 8 + dir * 4 + h], d1 = DTL[(2 * lane + 1) * 8 + dir * 4 + h];
        const float e0 = d0 * av, e1 = d1 * av, sm = e0 + e1;
        const float incl = wave_incl_scan(sm, lane), excl = incl - sm, tot = __shfl(incl, 63);
        const float P0 = excl + e0, P1 = incl;
        LAS float* tl0 = (LAS float*)&TABL[hl * 128 + 2 * lane]; LAS float* tl1 = (LAS float*)&TABL[hl * 128 + 2 * lane + 1];
        if (dir == 0) { tl0[0] = P0; tl1[0] = P1; tl0[2] = d0; tl1[2] = d1;
            WV[wave * 128 + 2 * lane] = d0 * __expf(tot - P0); WV[wave * 128 + 2 * lane + 1] = d1 * __expf(tot - P1); }
        else { tl0[1] = tot - P0 + e0; tl1[1] = tot - P1 + e1; tl0[3] = d0; tl1[3] = d1;
            WV[wave * 128 + 2 * lane] = d0 * __expf(P0 - e0); WV[wave * 128 + 2 * lane + 1] = d1 * __expf(P1 - e1); }
        if (lane == 0) ((float*)(a.ws + WS_CD))[(((size_t)b * 128 + c) * 4 + h) * 2 + dir] = __expf(tot);
    }
    __syncthreads();
    if (tid < 256) ((f32x4*)(a.ws + WS_TAB))[(((size_t)b * 128 + c) * 4 + 2 * g) * 128 + tid] = TABL[tid];
    const int cg = tid & 15, seg = tid >> 4, l0 = 4 * seg;
#pragma unroll 1
    for (int pass = 0; pass < 3; ++pass) {
        const int ch0 = pass * 256 + g * 128 + cg * 8;
        const float* cw = a.conv_w + (size_t)L * 5 * 768 + ch0; const float* cb = a.conv_b + (size_t)L * 768 + ch0;
        float w[5][8], bs[8];
#pragma unroll
        for (int j = 0; j < 5; ++j) { const f32x4 w0 = *(const f32x4*)(cw + j * 768), w1 = *(const f32x4*)(cw + j * 768 + 4);
            w[j][0] = w0[0]; w[j][1] = w0[1]; w[j][2] = w0[2]; w[j][3] = w0[3]; w[j][4] = w1[0]; w[j][5] = w1[1]; w[j][6] = w1[2]; w[j][7] = w1[3]; }
        { const f32x4 b0 = *(const f32x4*)cb, b1 = *(const f32x4*)(cb + 4); bs[0] = b0[0]; bs[1] = b0[1]; bs[2] = b0[2]; bs[3] = b0[3]; bs[4] = b1[0]; bs[5] = b1[1]; bs[6] = b1[2]; bs[7] = b1[3]; }
        float acc[4][8];
#pragma unroll
        for (int tk = 0; tk < 4; ++tk)
#pragma unroll
            for (int i = 0; i < 8; ++i) acc[tk][i] = bs[i];
#pragma unroll
        for (int rr = 0; rr < 8; ++rr) {
            const int pos = s0 + l0 - 2 + rr; v4u raw = (v4u){0u, 0u, 0u, 0u};
            if (pos >= 0 && pos < S) raw = *(const v4u*)(PROJ + ((size_t)b * S + pos) * LDP + PC_XS + ch0);
            float in[8]; in[0] = pg8::bf_lo(raw.x); in[1] = pg8::bf_hi(raw.x); in[2] = pg8::bf_lo(raw.y); in[3] = pg8::bf_hi(raw.y); in[4] = pg8::bf_lo(raw.z); in[5] = pg8::bf_hi(raw.z); in[6] = pg8::bf_lo(raw.w); in[7] = pg8::bf_hi(raw.w);
#pragma unroll
            for (int tk = 0; tk < 4; ++tk) { const int j = rr - tk; if (j >= 0 && j < 5) {
#pragma unroll
                for (int i = 0; i < 8; ++i) acc[tk][i] += w[j][i] * in[i]; } }
        }
#pragma unroll
        for (int tk = 0; tk < 4; ++tk) {
#pragma unroll
            for (int i = 0; i < 8; ++i) acc[tk][i] = silu_f(acc[tk][i]);
            v4u o; o.x = pk2(acc[tk][0], acc[tk][1]); o.y = pk2(acc[tk][2], acc[tk][3]); o.z = pk2(acc[tk][4], acc[tk][5]); o.w = pk2(acc[tk][6], acc[tk][7]);
            *(v4u*)(XBC + (t0 + l0 + tk) * 768 + ch0) = o; }
        if (pass == 0) {
            const int hl = cg >> 3, p0 = (cg & 7) * 8;
#pragma unroll
            for (int dir = 0; dir < 2; ++dir) { const int hd = hl * 2 + dir; const f32x4 wv = *(const LAS f32x4*)(WV + hd * 128 + l0);
#pragma unroll
                for (int i = 0; i < 8; ++i) { v2u o; o.x = pk2(acc[0][i] * wv[0], acc[1][i] * wv[1]); o.y = pk2(acc[2][i] * wv[2], acc[3][i] * wv[3]);
                    *(LAS v2u*)(XW + (hd * 64 + p0 + i) * LP + l0) = o; } }
        } else if (pass == 1) {
#pragma unroll
            for (int i = 0; i < 8; ++i) { v2u o; o.x = pk2(acc[0][i], acc[1][i]); o.y = pk2(acc[2][i], acc[3][i]); *(LAS v2u*)(BT + (cg * 8 + i) * LP + l0) = o; }
        }
    }
    __syncthreads();
    {
        const int hd = wave >> 1, ph = wave & 1, fr = lane & 15, fq = lane >> 4;
        f32x4 acc[2][8];
#pragma unroll
        for (int mt = 0; mt < 2; ++mt)
#pragma unroll
            for (int nt = 0; nt < 8; ++nt) acc[mt][nt] = (f32x4){0.f, 0.f, 0.f, 0.f};
#pragma unroll
        for (int ks = 0; ks < 4; ++ks) {
            bf16x8 af[2];
#pragma unroll
            for (int mt = 0; mt < 2; ++mt) af[mt] = *(const LAS bf16x8*)(XW + (hd * 64 + ph * 32 + mt * 16 + fr) * LP + 32 * ks + 8 * fq);
#pragma unroll
            for (int nt = 0; nt < 8; ++nt) { const bf16x8 bfr = *(const LAS bf16x8*)(BT + (16 * nt + fr) * LP + 32 * ks + 8 * fq);
#pragma unroll
                for (int mt = 0; mt < 2; ++mt) acc[mt][nt] = mfma16(af[mt], bfr, acc[mt][nt]); }
        }
        const int hl = hd >> 1, dir = hd & 1, h = 2 * g + hl;
        bf16* ST = (bf16*)(a.ws + WS_ST) + ((((size_t)b * 128 + c) * 4 + h) * 2 + dir) * 8192;
#pragma unroll
        for (int mt = 0; mt < 2; ++mt)
#pragma unroll
            for (int nt = 0; nt < 8; ++nt)
#pragma unroll
                for (int ii = 0; ii < 4; ++ii) ST[(ph * 32 + mt * 16 + 4 * fq + ii) * 128 + 16 * nt + fr] = (bf16)f2bf(acc[mt][nt][ii]);
    }
    __syncthreads();
}

__device__ __forceinline__ void ph_scan(const P& a, int gtid, int GT) {
    const unsigned* ST2 = (const unsigned*)(a.ws + WS_ST); unsigned* SB2 = (unsigned*)(a.ws + WS_SB); const float* CD = (const float*)(a.ws + WS_CD);
    for (int e2 = gtid; e2 < NB * 4 * 2 * 8192 / 2; e2 += GT) {
        const int e = 2 * e2, b = e >> 16, rem = e & 65535, dir = (rem >> 13) & 1, h = rem >> 14;
        float s0 = 0.f, s1 = 0.f;
#pragma unroll 1
        for (int c8 = 0; c8 < 128; c8 += 8) {
            unsigned cs[8]; float cd[8];
#pragma unroll
            for (int k = 0; k < 8; ++k) { const int c = dir ? 127 - (c8 + k) : (c8 + k); cs[k] = ST2[(((size_t)b * 128 + c) * 65536 + rem) >> 1]; cd[k] = CD[(((size_t)b * 128 + c) * 4 + h) * 2 + dir]; }
#pragma unroll
            for (int k = 0; k < 8; ++k) { const int c = dir ? 127 - (c8 + k) : (c8 + k); SB2[(((size_t)b * 128 + c) * 65536 + rem) >> 1] = pk2(s0, s1);
                s0 = s0 * cd[k] + __builtin_bit_cast(float, cs[k] << 16); s1 = s1 * cd[k] + __builtin_bit_cast(float, cs[k] & 0xffff0000u); }
        }
    }
}

__device__ __forceinline__ void ssd3_unit(const P& a, int L, int u, unsigned char* ldsg, int wave, int lane, int tid) {
    LAS unsigned char* lds = (LAS unsigned char*)ldsg;
    LAS bf16* CG = (LAS bf16*)lds;
    LAS bf16* BG = (LAS bf16*)(lds + 34816);
    LAS bf16* XT = (LAS bf16*)(lds + 69632);
    LAS f32x4* TB = (LAS f32x4*)(lds + 104448);
    const int g = u & 1, c = (u >> 1) & 127, b = u >> 8; const size_t t0 = (size_t)b * S + c * 128;
    const bf16* XBC = (const bf16*)(a.ws + WS_XBC); const bf16* SB = (const bf16*)(a.ws + WS_SB); const bf16* PROJ = (const bf16*)(a.ws + WS_PROJ);
    const int fr = lane & 15, fq = lane >> 4, w = wave;
#pragma unroll
    for (int i = 0; i < 4; ++i) { const int q = tid + 512 * i, row = q >> 4, pc = q & 15;
        const bf16* src = XBC + (t0 + row) * 768 + g * 128 + pc * 8;
        *(LAS v4u*)(CG + row * LP + pc * 8) = *(const v4u*)(src + 512);
        *(LAS v4u*)(BG + row * LP + pc * 8) = *(const v4u*)(src + 256);
        const v4u xr = *(const v4u*)src; const int hl = pc >> 3, p = (pc & 7) * 8;
        LAS bf16* xd = XT + (hl * 64 + p) * LP + row;
        xd[0 * LP] = (bf16)(xr.x & 0xffffu); xd[1 * LP] = (bf16)(xr.x >> 16); xd[2 * LP] = (bf16)(xr.y & 0xffffu); xd[3 * LP] = (bf16)(xr.y >> 16);
        xd[4 * LP] = (bf16)(xr.z & 0xffffu); xd[5 * LP] = (bf16)(xr.z >> 16); xd[6 * LP] = (bf16)(xr.w & 0xffffu); xd[7 * LP] = (bf16)(xr.w >> 16); }
    if (tid < 256) TB[tid] = ((const f32x4*)(a.ws + WS_TAB))[(((size_t)b * 128 + c) * 4 + 2 * g) * 128 + tid];
    __syncthreads();
    bf16x8 cf[4];
#pragma unroll
    for (int ks = 0; ks < 4; ++ks) cf[ks] = *(const LAS bf16x8*)(CG + (16 * w + fr) * LP + 32 * ks + 8 * fq);
    f32x4 Gt[8];
#pragma unroll
    for (int j = 0; j < 8; ++j) { Gt[j] = (f32x4){0.f, 0.f, 0.f, 0.f};
#pragma unroll
        for (int ks = 0; ks < 4; ++ks) Gt[j] = mfma16(*(const LAS bf16x8*)(BG + (16 * j + fr) * LP + 32 * ks + 8 * fq), cf[ks], Gt[j]); }
    __syncthreads();
    LAS bf16* ZS = CG; LAS bf16* SS = BG;
#pragma unroll
    for (int i = 0; i < 4; ++i) { const int q = tid + 512 * i, row = q >> 4, pc = q & 15;
        *(LAS v4u*)(ZS + row * LP + pc * 8) = *(const v4u*)(PROJ + (t0 + row) * LDP + PC_Z + g * 128 + pc * 8); }
    float* SSQ = (float*)(a.ws + WS_SSQ);
    const int lrow = 16 * w + fr;
#pragma unroll 1
    for (int hl = 0; hl < 2; ++hl) {
        const int h = 2 * g + hl;
        if (hl) __syncthreads();
        { const bf16* Sp = SB + (((size_t)b * 128 + c) * 4 + h) * 2 * 8192;
#pragma unroll
          for (int i = 0; i < 4; ++i) { const int q = tid + 512 * i, row = q >> 4, pc = q & 15;
              *(LAS v4u*)(SS + row * LP + pc * 8) = *(const v4u*)(Sp + (size_t)row * 128 + pc * 8); } }
        __syncthreads();
        f32x4 Y[4];
#pragma unroll
        for (int pt = 0; pt < 4; ++pt) Y[pt] = (f32x4){0.f, 0.f, 0.f, 0.f};
        {
            const f32x4 tl = TB[hl * 128 + lrow];
            bf16x8 wf[4];
#pragma unroll
            for (int ks = 0; ks < 4; ++ks) { float wv[8];
#pragma unroll
                for (int hf = 0; hf < 2; ++hf)
#pragma unroll
                    for (int ii = 0; ii < 4; ++ii) { const int j = 2 * ks + hf, s = 16 * j + 4 * fq + ii; const f32x4 ts = TB[hl * 128 + s];
                        const float mf = ts[2] * __expf(fminf(tl[0] - ts[0], 0.f)), mb = ts[3] * __expf(fminf(tl[1] - ts[1], 0.f));
                        const float mm = (s < lrow) ? mf : (s > lrow) ? mb : (ts[2] + ts[3]);
                        wv[hf * 4 + ii] = Gt[j][ii] * mm; }
                v4u pk; pk.x = pk2(wv[0], wv[1]); pk.y = pk2(wv[2], wv[3]); pk.z = pk2(wv[4], wv[5]); pk.w = pk2(wv[6], wv[7]); wf[ks] = __builtin_bit_cast(bf16x8, pk); }
#pragma unroll
            for (int pt = 0; pt < 4; ++pt)
#pragma unroll
                for (int ks = 0; ks < 4; ++ks) { const LAS bf16* xp = XT + (hl * 64 + 16 * pt + fr) * LP + 32 * ks + 4 * fq;
                    const v2u x0 = *(const LAS v2u*)xp, x1 = *(const LAS v2u*)(xp + 16); const v4u xx = (v4u){x0.x, x0.y, x1.x, x1.y};
                    Y[pt] = mfma16(wf[ks], __builtin_bit_cast(bf16x8, xx), Y[pt]); }
        }
#pragma unroll
        for (int dir = 0; dir < 2; ++dir) {
            f32x4 Tt[4];
#pragma unroll
            for (int pt = 0; pt < 4; ++pt) { Tt[pt] = (f32x4){0.f, 0.f, 0.f, 0.f};
#pragma unroll
                for (int ks = 0; ks < 4; ++ks) Tt[pt] = mfma16(cf[ks], *(const LAS bf16x8*)(SS + (dir * 64 + 16 * pt + fr) * LP + 32 * ks + 8 * fq), Tt[pt]); }
#pragma unroll
            for (int ii = 0; ii < 4; ++ii) { const f32x4 tr = TB[hl * 128 + 16 * w + 4 * fq + ii]; const float e = __expf(dir ? tr[1] : tr[0]);
#pragma unroll
                for (int pt = 0; pt < 4; ++pt) Y[pt][ii] += e * Tt[pt][ii]; }
        }
        const float dsk = a.d_skip[L * 4 + h];
#pragma unroll
        for (int pt = 0; pt < 4; ++pt) { const v2u xv = *(const LAS v2u*)(XT + (hl * 64 + 16 * pt + fr) * LP + 16 * w + 4 * fq);
            Y[pt][0] += dsk * pg8::bf_lo(xv.x); Y[pt][1] += dsk * pg8::bf_hi(xv.x); Y[pt][2] += dsk * pg8::bf_lo(xv.y); Y[pt][3] += dsk * pg8::bf_hi(xv.y); }
        float ss[4] = {0.f, 0.f, 0.f, 0.f};
#pragma unroll
        for (int pt = 0; pt < 4; ++pt) { const int chl = hl * 64 + 16 * pt + fr; const float gn = a.g_ssm[L * 256 + g * 128 + chl];
#pragma unroll
            for (int ii = 0; ii < 4; ++ii) { LAS bf16* zp = ZS + (16 * w + 4 * fq + ii) * LP + chl;
                const float z = bf2f(*zp); const float y = Y[pt][ii] * silu_f(z); ss[ii] += y * y; *zp = (bf16)f2bf(y * gn); } }
#pragma unroll
        for (int ii = 0; ii < 4; ++ii) { float sq = ss[ii]; sq += __shfl_xor(sq, 1); sq += __shfl_xor(sq, 2); sq += __shfl_xor(sq, 4); sq += __shfl_xor(sq, 8);
            if (fr == 0) SSQ[(t0 + 16 * w + 4 * fq + ii) * 4 + h] = sq; }
    }
    __syncthreads();
    bf16* BR = (bf16*)(a.ws + WS_BR);
#pragma unroll
    for (int i = 0; i < 4; ++i) { const int q = tid + 512 * i, row = q >> 4, pc = q & 15;
        *(v4u*)(BR + (t0 + row) * 1024 + 256 + g * 128 + pc * 8) = *(const LAS v4u*)(ZS + row * LP + pc * 8); }
    __syncthreads();
}

__device__ __forceinline__ void sgu_unit(const P& a, int L, int u, unsigned char* ldsg, int wave, int lane, int tid) {
    LAS bf16* VT = (LAS bf16*)(LAS unsigned char*)ldsg;
    const int b = u >> 7, c = u & 127; const size_t t0 = (size_t)b * S + c * 128;
    const bf16* PROJ = (const bf16*)(a.ws + WS_PROJ); bf16* BR = (bf16*)(a.ws + WS_BR); const bf16* WSP = (const bf16*)(a.ws + WS_WSP);
    const f32x4 gs = *(const f32x4*)(a.g_sgu + L * 256 + 4 * lane);
    v2u raws[16];
#pragma unroll
    for (int k = 0; k < 16; ++k) raws[k] = *(const v2u*)(PROJ + (t0 + 16 * wave + k) * LDP + PC_UV + 256 + 4 * lane);
#pragma unroll
    for (int k = 0; k < 16; ++k) { const int s = 16 * wave + k;
        const v2u raw = raws[k];
        float v[4]; v[0] = gelu_tanh(pg8::bf_lo(raw.x)); v[1] = gelu_tanh(pg8::bf_hi(raw.x)); v[2] = gelu_tanh(pg8::bf_lo(raw.y)); v[3] = gelu_tanh(pg8::bf_hi(raw.y));
        const float rn = 1.0f / sqrtf(wave_sum(v[0] * v[0] + v[1] * v[1] + v[2] * v[2] + v[3] * v[3]) * (1.0f / 256.0f) + EPS);
#pragma unroll
        for (int i = 0; i < 4; ++i) VT[(4 * lane + i) * LP + s] = (bf16)f2bf(v[i] * rn * gs[i]); }
    __syncthreads();
    const int g = wave >> 1, th = wave & 1, fr = lane & 15, fq = lane >> 4;
    f32x4 acc[4][4];
#pragma unroll
    for (int mt = 0; mt < 4; ++mt)
#pragma unroll
        for (int nt = 0; nt < 4; ++nt) acc[mt][nt] = (f32x4){0.f, 0.f, 0.f, 0.f};
#pragma unroll
    for (int ks = 0; ks < 4; ++ks) {
        bf16x8 af[4];
#pragma unroll
        for (int mt = 0; mt < 4; ++mt) af[mt] = *(const bf16x8*)(WSP + (size_t)(g * 128 + 64 * th + 16 * mt + fr) * 128 + 32 * ks + 8 * fq);
#pragma unroll
        for (int nt = 0; nt < 4; ++nt) { const bf16x8 bfr = *(const LAS bf16x8*)(VT + (g * 64 + 16 * nt + fr) * LP + 32 * ks + 8 * fq);
#pragma unroll
            for (int mt = 0; mt < 4; ++mt) acc[mt][nt] = mfma16(af[mt], bfr, acc[mt][nt]); }
    }
    unsigned short uraw[4][4][4]; float bsv4[4][4];
#pragma unroll
    for (int mt = 0; mt < 4; ++mt)
#pragma unroll
        for (int ii = 0; ii < 4; ++ii) { const int tl = 64 * th + 16 * mt + 4 * fq + ii; bsv4[mt][ii] = a.b_spatial[(L * 4 + g) * 128 + tl];
#pragma unroll
            for (int nt = 0; nt < 4; ++nt) uraw[mt][ii][nt] = *(const unsigned short*)(PROJ + (t0 + tl) * LDP + PC_UV + g * 64 + 16 * nt + fr); }
    __builtin_amdgcn_sched_barrier(0);
#pragma unroll
    for (int mt = 0; mt < 4; ++mt)
#pragma unroll
        for (int ii = 0; ii < 4; ++ii) { const int tl = 64 * th + 16 * mt + 4 * fq + ii; const float bsv = bsv4[mt][ii];
#pragma unroll
            for (int nt = 0; nt < 4; ++nt) { const int ch = g * 64 + 16 * nt + fr;
                const float uu = gelu_tanh(bf2f(uraw[mt][ii][nt]));
                BR[(t0 + tl) * 1024 + 768 + ch] = (bf16)f2bf(uu * (acc[mt][nt][ii] + bsv)); } }
    __syncthreads();
}
__device__ __forceinline__ void ph_r1(const P& a, int L, unsigned char* ldsg, int gw, int NGW, int lane, int tid) {
    LAS float* wrt = (LAS float*)(LAS unsigned char*)ldsg;
    { const float* wr = a.w_router + (size_t)L * 1024 * 16;
      for (int i = tid; i < 1024 * 16 / 4; i += NTHR) { const int kq = i >> 2, q = i & 3, pos = ((kq >> 8) * 4 + (kq & 3)) * 64 + ((kq >> 2) & 63); ((LAS f32x4*)wrt)[q * 1024 + pos] = ((const f32x4*)wr)[i]; } }
    __syncthreads();
    const float* gm = a.g_moe + L * D; bf16* H = (bf16*)(a.ws + WS_H); float* AFF = (float*)(a.ws + WS_AFF); short* INV = (short*)(a.ws + WS_INV);
    f32x4 gv[4];
#pragma unroll
    for (int j = 0; j < 4; ++j) gv[j] = ((const f32x4*)gm)[lane + 64 * j];
    const bf16* XB = (const bf16*)(a.ws + WS_XB);
    v2u nv[4];
    if (gw < T) { const GAS v2u* xr = (const GAS v2u*)(XB + (size_t)gw * D) + lane;
#pragma unroll
        for (int j = 0; j < 4; ++j) nv[j] = xr[64 * j]; }
    for (int m = gw; m < T; m += NGW) {
        asm volatile("" ::: "memory");
        f32x4 v[4]; float ss = 0.f;
#pragma unroll
        for (int j = 0; j < 4; ++j) v[j] = xb_unpack(nv[j]);
        if (m + NGW < T) { const GAS v2u* xr = (const GAS v2u*)(XB + (size_t)(m + NGW) * D) + lane;
#pragma unroll
            for (int j = 0; j < 4; ++j) nv[j] = xr[64 * j]; }
#pragma unroll
        for (int j = 0; j < 4; ++j) { ss += (v[j][0] * v[j][0] + v[j][1] * v[j][1]) + (v[j][2] * v[j][2] + v[j][3] * v[j][3]); }
        const float rs = 1.0f / sqrtf(wave_sum(ss) * (1.0f / D) + EPS);
        float lg[16];
#pragma unroll
        for (int i = 0; i < 16; ++i) lg[i] = 0.f;
        GAS unsigned* o4 = (GAS unsigned*)((unsigned char*)H + (size_t)m * D) + lane;
#pragma unroll
        for (int j = 0; j < 4; ++j) { v[j] = v[j] * rs * gv[j];
            { int t = 0; t = __builtin_amdgcn_cvt_pk_fp8_f32(v[j][0], v[j][1], t, false); t = __builtin_amdgcn_cvt_pk_fp8_f32(v[j][2], v[j][3], t, true); o4[64 * j] = (unsigned)t; }
#pragma unroll
            for (int c = 0; c < 4; ++c) { const LAS f32x4* wr = (const LAS f32x4*)wrt + (j * 4 + c) * 64 + lane;
#pragma unroll
                for (int q = 0; q < 4; ++q) { const f32x4 w4 = wr[q * 1024]; lg[4 * q] += v[j][c] * w4[0]; lg[4 * q + 1] += v[j][c] * w4[1]; lg[4 * q + 2] += v[j][c] * w4[2]; lg[4 * q + 3] += v[j][c] * w4[3]; } } }
        float a8[8], a4[4], a2[2], a1;
        { const bool hb = (lane & 32) != 0;
#pragma unroll
          for (int i = 0; i < 8; ++i) { const float snd = hb ? lg[i] : lg[i + 8], kp = hb ? lg[i + 8] : lg[i]; a8[i] = kp + __shfl_xor(snd, 32); } }
        { const bool hb = (lane & 16) != 0;
#pragma unroll
          for (int i = 0; i < 4; ++i) { const float snd = hb ? a8[i] : a8[i + 4], kp = hb ? a8[i + 4] : a8[i]; a4[i] = kp + __shfl_xor(snd, 16); } }
        { const bool hb = (lane & 8) != 0;
#pragma unroll
          for (int i = 0; i < 2; ++i) { const float snd = hb ? a4[i] : a4[i + 2], kp = hb ? a4[i + 2] : a4[i]; a2[i] = kp + __shfl_xor(snd, 8); } }
        { const bool hb = (lane & 4) != 0; const float snd = hb ? a2[0] : a2[1], kp = hb ? a2[1] : a2[0]; a1 = kp + __shfl_xor(snd, 4); }
        a1 += __shfl_xor(a1, 2); a1 += __shfl_xor(a1, 1);
        float mx = a1; mx = fmaxf(mx, __shfl_xor(mx, 4)); mx = fmaxf(mx, __shfl_xor(mx, 8)); mx = fmaxf(mx, __shfl_xor(mx, 16)); mx = fmaxf(mx, __shfl_xor(mx, 32));
        const float ex = __expf(a1 - mx); float sum = ex; sum += __shfl_xor(sum, 4); sum += __shfl_xor(sum, 8); sum += __shfl_xor(sum, 16); sum += __shfl_xor(sum, 32);
        const int b = m / S, s = m % S;
        if ((lane & 3) == 0) AFF[((size_t)b * NE + ((lane >> 2) & 15)) * S + s] = ex / sum;
        if (lane < 2) { unsigned m1 = 0xffffffffu; asm volatile("" : "+v"(m1)); ((GAS v4u*)(INV + (size_t)m * NE))[lane] = (v4u){m1, m1, m1, m1}; }
    }
    __syncthreads();
}

__device__ __forceinline__ void sel_unit(const P& a, int q, unsigned char* ldsg, int wave, int lane, int tid) {
    LAS unsigned* vals = (LAS unsigned*)(LAS unsigned char*)ldsg;
    LAS unsigned* hist = vals + S;
    LAS unsigned* sc = hist + 256;
    const int b = q / NE, e = q % NE;
    const float* AFF = (const float*)(a.ws + WS_AFF) + ((size_t)b * NE + e) * S;
    for (int i = tid; i < S; i += NTHR) vals[i] = __float_as_uint(AFF[i]);
    unsigned prefix = 0u, mask = 0u, kk = CAP;
#pragma unroll 1
    for (int pass = 0; pass < 4; ++pass) {
        const int shift = 24 - 8 * pass;
        if (tid < 256) hist[tid] = 0u;
        __syncthreads();
        for (int i = tid; i < S; i += NTHR) { const unsigned v = vals[i]; if ((v & mask) == prefix) __hip_atomic_fetch_add(&hist[(v >> shift) & 255u], 1u, __ATOMIC_RELAXED, __HIP_MEMORY_SCOPE_WORKGROUP); }
        __syncthreads();
        if (wave == 0) {
            unsigned c4[4]; unsigned s4 = 0u;
#pragma unroll
            for (int j = 0; j < 4; ++j) { c4[j] = hist[4 * lane + j]; s4 += c4[j]; }
            unsigned suf = s4;
#pragma unroll
            for (int o = 1; o < 64; o <<= 1) { const unsigned t = __shfl_down(suf, o); if (lane + o < 64) suf += t; }
            unsigned cum = suf - s4;
#pragma unroll
            for (int j = 3; j >= 0; --j) { if (cum < kk && cum + c4[j] >= kk) { sc[0] = prefix | ((unsigned)(4 * lane + j) << shift); sc[1] = kk - cum; } cum += c4[j]; }
        }
        __syncthreads();
        prefix = sc[0]; kk = sc[1]; mask |= 255u << shift;
        __syncthreads();
    }
    const unsigned thr = prefix, need_eq = kk, total_gt = CAP - kk;
    unsigned cg = 0u, ce = 0u;
    for (int j = 0; j < 32; ++j) { const unsigned v = vals[32 * tid + ((j + tid) & 31)]; cg += (v > thr) ? 1u : 0u; ce += (v == thr) ? 1u : 0u; }
    unsigned pk = (cg << 16) | ce, inc = pk;
#pragma unroll
    for (int o = 1; o < 64; o <<= 1) { const unsigned t = __shfl_up(inc, o); if (lane >= o) inc += t; }
    if (lane == 63) sc[8 + wave] = inc;
    __syncthreads();
    unsigned base = 0u;
    for (int w2 = 0; w2 < wave; ++w2) base += sc[8 + w2];
    const unsigned exc = base + inc - pk; unsigned pg = exc >> 16, pe = exc & 0xffffu;
    int* SELIDX = (int*)(a.ws + WS_SELIDX) + (size_t)e * (NB * CAP) + b * CAP; float* SELAFF = (float*)(a.ws + WS_SELAFF) + (size_t)e * (NB * CAP) + b * CAP;
    short* INV = (short*)(a.ws + WS_INV);
    for (int j = 0; j < 32; ++j) { const int idx = 32 * tid + j; const unsigned v = vals[idx]; int slot = -1;
        if (v > thr) { slot = (int)pg; ++pg; } else if (v == thr) { if (pe < need_eq) slot = (int)(total_gt + pe); ++pe; }
        if (slot >= 0) { SELIDX[slot] = idx; SELAFF[slot] = __uint_as_float(v); INV[((size_t)b * S + idx) * NE + e] = (short)slot; } }
    __syncthreads();
}

__device__ __forceinline__ void ph_gather(const P& a, int gw, int NGW, int lane) {
    const int* SELIDX = (const int*)(a.ws + WS_SELIDX); const bf16* H = (const bf16*)(a.ws + WS_H); bf16* XE = (bf16*)(a.ws + WS_XE);
    for (int r = gw; r < NE * NB * CAP; r += NGW) { const int b = (r >> 11) & 1; const int tok = SELIDX[r];
        const v4u* src = (const v4u*)(H + ((size_t)b * S + tok) * D); v4u* dst = (v4u*)(XE + (size_t)r * D);
        const v4u v0 = src[lane], v1 = src[lane + 64]; dst[lane] = v0; dst[lane + 64] = v1; }
}

__device__ __forceinline__ void ph_r2(const P& a, int L, int gw, int NGW, int lane, bool dry) {
    const float* gm = a.g_ple + L * D; bf16* H = (bf16*)(a.ws + WS_H); const short* INV = (const short*)(a.ws + WS_INV); const unsigned char* YE = (const unsigned char*)(a.ws + WS_YE); const float* SAFF = (const float*)(a.ws + WS_SELAFF);
    f32x4 gv[4];
#pragma unroll
    for (int j = 0; j < 4; ++j) gv[j] = ((const f32x4*)gm)[lane + 64 * j];
    bf16* XB = (bf16*)(a.ws + WS_XB);
    v2u nv[4]; short ninv = -1;
    if (gw < T) { const GAS v2u* xq = (const GAS v2u*)(XB + (size_t)gw * D) + lane;
#pragma unroll
        for (int j = 0; j < 4; ++j) nv[j] = xq[64 * j];
        ninv = INV[(size_t)gw * NE + (lane & 15)]; }
    for (int m = gw; m < T; m += NGW) {
        GAS v2u* xr = (GAS v2u*)(XB + (size_t)m * D) + lane;
        f32x4 v[4];
#pragma unroll
        for (int j = 0; j < 4; ++j) v[j] = xb_unpack(nv[j]);
        const int b = m / S;
        const short myinv = ninv;
        if (m + NGW < T) { const GAS v2u* xq = (const GAS v2u*)(XB + (size_t)(m + NGW) * D) + lane;
#pragma unroll
            for (int j = 0; j < 4; ++j) nv[j] = xq[64 * j];
            ninv = INV[(size_t)(m + NGW) * NE + (lane & 15)]; }
        unsigned em = (unsigned)__builtin_amdgcn_readfirstlane((int)(__ballot(myinv >= 0) & 0xffffull));
#pragma unroll 1
        while (em) {
            unsigned y[4][4]; int ee[4]; float af[4] = {0.f, 0.f, 0.f, 0.f};
#pragma unroll
            for (int q = 0; q < 4; ++q) { ee[q] = em ? (int)__builtin_ctz(em) : -1; if (em) em &= em - 1u;
                if (ee[q] >= 0) { const int slot = __builtin_amdgcn_readfirstlane((int)__shfl((int)myinv, ee[q]));
                    af[q] = 0.25f * SAFF[(size_t)ee[q] * (NB * CAP) + b * CAP + slot];
                    const unsigned* yr = (const unsigned*)(YE + ((size_t)ee[q] * (NB * CAP) + b * CAP + slot) * D) + lane;
#pragma unroll
                    for (int j = 0; j < 4; ++j) y[q][j] = yr[64 * j]; } }
#pragma unroll
            for (int q = 0; q < 4; ++q) if (ee[q] >= 0) {
#pragma unroll
                for (int j = 0; j < 4; ++j) { typedef float f32x2r __attribute__((ext_vector_type(2)));
                    const f32x2r lo = __builtin_amdgcn_cvt_pk_f32_fp8((int)y[q][j], false), hi = __builtin_amdgcn_cvt_pk_f32_fp8((int)y[q][j], true);
                    v[j][0] += af[q] * lo[0]; v[j][1] += af[q] * lo[1]; v[j][2] += af[q] * hi[0]; v[j][3] += af[q] * hi[1]; } }
        }
        float ss = 0.f;
#pragma unroll
        for (int j = 0; j < 4; ++j) { if (!dry) xr[64 * j] = (v2u){pk2(v[j][0], v[j][1]), pk2(v[j][2], v[j][3])}; ss += (v[j][0] * v[j][0] + v[j][1] * v[j][1]) + (v[j][2] * v[j][2] + v[j][3] * v[j][3]); }
        const float rs = 1.0f / sqrtf(wave_sum(ss) * (1.0f / D) + EPS);
        GAS unsigned* o4 = (GAS unsigned*)(a.ws + WS_H8 + (size_t)m * D) + lane;
        float amx = 0.f;
#pragma unroll
        for (int j = 0; j < 4; ++j) { v[j] = v[j] * rs * gv[j]; amx = fmaxf(fmaxf(amx, fmaxf(fabsf(v[j][0]), fabsf(v[j][1]))), fmaxf(fabsf(v[j][2]), fabsf(v[j][3]))); }
#pragma unroll
        for (int o = 1; o < 64; o <<= 1) amx = fmaxf(amx, __shfl_xor(amx, o));
        amx = fmaxf(amx, 1e-30f); const float qinv = 127.0f / amx;
        if (lane == 0 && !dry) ((float*)(a.ws + WS_SA))[m] = amx * (1.0f / 127.0f);
#pragma unroll
        for (int j = 0; j < 4; ++j) { const int b0 = (int)rintf(qinv * v[j][0]), b1 = (int)rintf(qinv * v[j][1]), b2 = (int)rintf(qinv * v[j][2]), b3 = (int)rintf(qinv * v[j][3]);
            if (!dry) o4[64 * j] = (unsigned)(b0 & 0xff) | ((unsigned)(b1 & 0xff) << 8) | ((unsigned)(b2 & 0xff) << 16) | ((unsigned)(b3 & 0xff) << 24); }
    }
}
__device__ __forceinline__ void ph_final(const P& a, int gw, int NGW, int lane, float oscale) {
    f32x4 gv[4];
#pragma unroll
    for (int j = 0; j < 4; ++j) gv[j] = ((const f32x4*)a.g_final)[lane + 64 * j];
    const bf16* XB = (const bf16*)(a.ws + WS_XB);
    v2u nv[4];
    if (gw < T) { const GAS v2u* xq = (const GAS v2u*)(XB + (size_t)gw * D) + lane;
#pragma unroll
        for (int j = 0; j < 4; ++j) nv[j] = xq[64 * j]; }
    for (int m = gw; m < T; m += NGW) {
        GAS f32x4* xr = (GAS f32x4*)(a.out + (size_t)m * D) + lane;
        f32x4 v[4]; float ss = 0.f;
#pragma unroll
        for (int j = 0; j < 4; ++j) v[j] = xb_unpack(nv[j]);
        if (m + NGW < T) { const GAS v2u* xq = (const GAS v2u*)(XB + (size_t)(m + NGW) * D) + lane;
#pragma unroll
            for (int j = 0; j < 4; ++j) nv[j] = xq[64 * j]; }
#pragma unroll
        for (int j = 0; j < 4; ++j) { ss += (v[j][0] * v[j][0] + v[j][1] * v[j][1]) + (v[j][2] * v[j][2] + v[j][3] * v[j][3]); }
        const float rs = 1.0f / sqrtf(wave_sum(ss) * (1.0f / D) + EPS);
#pragma unroll
        for (int j = 0; j < 4; ++j) xr[64 * j] = v[j] * (rs * oscale) * gv[j];
    }
}

typedef const __attribute__((address_space(4))) P* kargp_t;
__device__ __forceinline__ P load_args(kargp_t p) { P a; a.x = p->x; a.p = p->p; a.rel_bias = p->rel_bias; a.g_mix = p->g_mix; a.w_in = p->w_in; a.g_qnorm = p->g_qnorm; a.g_knorm = p->g_knorm; a.conv_w = p->conv_w; a.conv_b = p->conv_b; a.dt_bias_f = p->dt_bias_f; a.dt_bias_b = p->dt_bias_b; a.a_log_f = p->a_log_f; a.a_log_b = p->a_log_b; a.d_skip = p->d_skip; a.g_ssm = p->g_ssm; a.lambda_q1 = p->lambda_q1; a.lambda_k1 = p->lambda_k1; a.lambda_q2 = p->lambda_q2; a.lambda_k2 = p->lambda_k2; a.g_diff = p->g_diff; a.g_sgu = p->g_sgu; a.w_spatial = p->w_spatial; a.b_spatial = p->b_spatial; a.w_branch = p->w_branch; a.w_branch_gate = p->w_branch_gate; a.w_out = p->w_out; a.g_moe = p->g_moe; a.w_router = p->w_router; a.w_exp_gate = p->w_exp_gate; a.w_exp_up = p->w_exp_up; a.w_exp_down = p->w_exp_down; a.g_ple = p->g_ple; a.w_ple_gate = p->w_ple_gate; a.w_ple = p->w_ple; a.g_final = p->g_final; a.out = p->out; a.ws = p->ws; a.gp_lo = p->gp_lo; a.gp_hi = p->gp_hi; return a; }
__device__ __forceinline__ int my_lane_volatile() { int l; asm volatile("v_mbcnt_lo_u32_b32 %0, -1, 0\n\tv_mbcnt_hi_u32_b32 %0, -1, %0" : "=v"(l)); return l; }
#ifndef PROBE_PH
#define PROBE_PH -1
#endif
#ifndef REPMASK
#define REPMASK 0u
#endif
#define NREP(bit) (((REPMASK >> (bit)) & 1u) ? 2 : 1)
#define REPEAT(bit) _Pragma("unroll 1") for (int rep_ = 0; rep_ < NREP(bit); ++rep_)
#ifndef PHMASK
#define PHMASK 0xFFFFu
#endif
__global__ void __launch_bounds__(NTHR, 2) mk_fwd(P a_in) {
    extern __shared__ __attribute__((aligned(16))) unsigned char lds[];
    const int G = gridDim.x, bx = blockIdx.x, NGW = G * NWAVES, GT = G * NTHR;
    gu32* ctl = (gu32*)(a_in.ws + WS_CTL);
    volatile LAS unsigned* MISC = (volatile LAS unsigned*)((LAS unsigned char*)lds + MISC_OFF);
    for (int u = threadIdx.x; u < (LDS_BYTES - LDSCTL_OFF) / 4; u += NTHR) ((LAS unsigned*)((LAS unsigned char*)lds + LDSCTL_OFF))[u] = 0u;
    __syncthreads();
    const bool multi = (a_in.gp_hi - a_in.gp_lo) > 1;
    XcdBarrier bar; bar.bar = (unsigned*)(ctl + CW_BAR); bar.x = 0; bar.st = nullptr;
    const int wave0 = __builtin_amdgcn_readfirstlane((int)threadIdx.x >> 6);
    if (multi) bar = xcd_barrier_post((unsigned*)(ctl + CW_BAR), MISC + 8, (int)threadIdx.x);
    const int lo = a_in.gp_lo, hi = a_in.gp_hi;
    unsigned long long tacc = 0ull, tic0 = 0ull; (void)tic0;
#define TIC(ph) do { if (PROBE_PH == (ph)) tic0 = __builtin_amdgcn_s_memrealtime(); } while (0)
#define TOC(ph) do { if (PROBE_PH == (ph)) tacc += __builtin_amdgcn_s_memrealtime() - tic0; } while (0)
#define IN(k) (((PHMASK >> (((k) < DEPTH * NPH) ? ((k) % NPH) : 14)) & 1u) && lo <= (k) && (k) < hi)
#define MY_TID() ((wave0 << 6) | my_lane_volatile())
#define SEAM(k) do { if (IN(k) && IN((k) + 1)) { XcdBarrier b2_ = bar; asm volatile("" : "+s"(b2_.bar)); xcd_barrier(b2_, MY_TID()); if ((REPMASK >> 21) & 1u) xcd_barrier(b2_, MY_TID()); } } while (0)
#define PHASE_IDS() int tid = MY_TID(); asm volatile("" : "+v"(tid)); const int lane = tid & 63; const int wave = __builtin_amdgcn_readfirstlane(tid >> 6); \
    const int gw = bx * NWAVES + wave; const int gtid = bx * NTHR + tid; (void)lane; (void)gw; (void)gtid; \
    kargp_t ap_ = (kargp_t)__builtin_amdgcn_kernarg_segment_ptr(); asm volatile("" : "+s"(ap_)); const P a = load_args(ap_); \
    unsigned char* const ws = a.ws; bf16* const H = (bf16*)(ws + WS_H); bf16* const PROJ = (bf16*)(ws + WS_PROJ); bf16* const GATES = (bf16*)(ws + WS_GATES); bf16* const BR = (bf16*)(ws + WS_BR); \
    LAS unsigned char* const ldsl = (LAS unsigned char*)lds; (void)H; (void)PROJ; (void)GATES; (void)BR; (void)ldsl

#pragma unroll 1
    for (int L = 0; L < DEPTH; ++L) {
        const int g0 = L * NPH;
        TIC(0);
        if (IN(g0 + 0)) REPEAT(0) { PHASE_IDS(); ph_convw(a, L, lds, gw, NGW, wave, lane, tid, gtid, GT, bx, G, 0); }
        if (IN(g0 + 0)) { PHASE_IDS(); ph_r0(a, L, lds, gw, NGW, lane, tid); } SEAM(g0 + 0); TOC(0);
        TIC(1);
        if (NPROJ_BF > 0 && IN(g0 + 1)) REPEAT(1) { PHASE_IDS();
            pg8::Gemm g{H, (const bf16*)(ws + WS_WCAT), T, NPROJ_BF, D, 0}; pg8::StaticOrder So; So.init(T, NPROJ_BF, G, bx);
            pg8::EpiG1 E{PROJ, GATES, 0.17677669529663687f * LOG2E, rep_ + 1 < NREP(1)};
            pg8::gemm_phase<pg8::EpiG1, pg8::StaticOrder, true, true>(ldsl, g, So, E, tid);
        }
        if (IN(g0 + 1)) { PHASE_IDS();
            pg8::Gemm g{(const bf16*)(ws + WS_PBF), (const bf16*)(ws + WS_WPLE), T, D, 256, 0}; pg8::TailOrder So{G, bx, 0};
            pg8::EpiPlain E{(bf16*)(ws + WS_PL), D};
            pg8::gemm_phase<pg8::EpiPlain, pg8::TailOrder, true, true, false, false, false, PAD_PL0>(ldsl, g, So, E, tid);
        }
        if (IN(g0 + 1)) REPEAT(1) { PHASE_IDS();
            pg8::StaticOrder So; So.init(T, NPROJ_I8, G, bx);
            LAS unsigned* gtab = (LAS unsigned*)(ldsl + RING_BYTES + 512);
            {
#pragma unroll 1
              for (int ui = 0; ui < 6; ++ui) { pg8::Unit uu; const bool okk = So.next(ui, uu); const int rb = okk ? uu.pm * 256 : 0; if (tid < 256) gtab[ui * 256 + tid] = (unsigned)(rb + tid) * (unsigned)D; }
              __syncthreads(); }
            pg8::Gemm g{(const bf16*)(ws + WS_H8), (const bf16*)(ws + WS_WCAT + (size_t)NPROJ_BF * 2048), T, NPROJ_I8, D / 2, 0};
            pg8::EpiProjI8 E{PROJ, (const float*)(ws + WS_SA), (const float*)(ws + WS_SW) + 5120, NPROJ_BF, 0.17677669529663687f * LOG2E, rep_ + 1 < NREP(1)};
            pg8::gemm_phase<pg8::EpiProjI8, pg8::StaticOrder, true, true, true, false, true, PAD_PROJ>(ldsl, g, So, E, tid, gtab);
        }
        if (IN(g0 + 1)) { PHASE_IDS();
            pg8::Gemm g{(const bf16*)(ws + WS_PBF), (const bf16*)(ws + WS_WPLE), T, D, 256, 0}; pg8::TailOrder So{G, bx, 1};
            pg8::EpiPlain E{(bf16*)(ws + WS_PL), D};
            pg8::gemm_phase<pg8::EpiPlain, pg8::TailOrder, true, true, false, false, false, PAD_PL>(ldsl, g, So, E, tid);
        }
        if (IN(g0 + 1)) { PHASE_IDS();
            pg8::StaticOrder So; So.init(T, NGATE, G, bx);
            LAS unsigned* gtab = (LAS unsigned*)(ldsl + RING_BYTES + 512);
            {
#pragma unroll 1
              for (int ui = 0; ui < 8; ++ui) { pg8::Unit uu; const bool okk = So.next(ui, uu); const int rb = okk ? uu.pm * 256 : 0; if (tid < 256) gtab[ui * 256 + tid] = (unsigned)(rb + tid) * (unsigned)D; }
              __syncthreads(); }
            pg8::Gemm g{(const bf16*)(ws + WS_H8), (const bf16*)(ws + WS_WCAT + (size_t)NPROJ * 2048), T, NGATE, D / 2, 0};
            pg8::EpiGateI8 E{GATES, (const float*)(ws + WS_SA), (const float*)(ws + WS_SW), 0};
            pg8::gemm_phase<pg8::EpiGateI8, pg8::StaticOrder, true, true, true, false, true, PAD_GATE>(ldsl, g, So, E, tid, gtab);
        } SEAM(g0 + 1); TOC(1);
        TIC(2);
        if (IN(g0 + 2)) {
            REPEAT(16) { PHASE_IDS(); ph_rope(a, L, lds, gw, NGW, wave, lane, tid, bx, rep_ + 1 < NREP(16)); }
            REPEAT(2) { PHASE_IDS(); for (int u = bx; u < 512; u += G) ssd1_unit(a, L, u, lds, wave, lane, tid); }
            REPEAT(2) { PHASE_IDS(); for (int u = bx; u < 256; u += G) sgu_unit(a, L, u, lds, wave, lane, tid); }
        } SEAM(g0 + 2); TOC(2);
        TIC(3);
        if (IN(g0 + 3)) {
            REPEAT(3) { PHASE_IDS(); ph_scan(a, gtid, GT); }
        } SEAM(g0 + 3); TOC(3);
        TIC(4);
        if (IN(g0 + 4)) {
            REPEAT(4) { PHASE_IDS(); for (int u = bx; u < 512; u += G) ssd3_unit(a, L, u, lds, wave, lane, tid); }
            REPEAT(14) { PHASE_IDS(); const attn_body::bf16* Pj = (const attn_body::bf16*)PROJ; attn_body::bf16* Bo = (attn_body::bf16*)BR;
              for (int u = bx; u < 512; u += G) {
                const int rnd = u >> 8, cc = u & 255, xc = cc & 7, rr = cc >> 3;
                const int b = xc >> 2, hq = xc & 3, qb = rr + 32 * rnd; const size_t rb = (size_t)b * S;
                const attn_body::bf16 *qp = Pj + rb * LDP + PC_AQ + hq * 64, *kp = Pj + rb * LDP + PC_AK + (hq >> 1) * 64, *vp = Pj + rb * LDP + PC_AV + (hq >> 1) * 64; attn_body::bf16* op = Bo + rb * 1024 + hq * 64;
                const bool ok = attn_body::attn_bound<false>(qp, qb * 256, (char*)lds, (const float*)(ws + WS_KMAX) + b * 2 + (hq >> 1), 0.f, tid);
                if (ok) attn_body::attn_unit<false, 8, true, false>(qp, kp, vp, op, qb * 256, (char*)lds, nullptr, 0, 0.f, 0.f, nullptr, 0.f, tid);
                else    attn_body::attn_unit<false, 8, false>(qp, kp, vp, op, qb * 256, (char*)lds, nullptr, 0, 0.f, 0.f, nullptr, 0.f, tid); }
              if ((REPMASK >> 23) & 1u) { XcdBarrier b2_ = bar; asm volatile("" : "+s"(b2_.bar)); xcd_barrier(b2_, MY_TID()); } }
            REPEAT(15) { PHASE_IDS(); const attn_body::bf16* Pj = (const attn_body::bf16*)PROJ; attn_body::bf16* Bo = (attn_body::bf16*)BR;
              float lam;
              { float t1 = (lane < 32) ? a.lambda_q1[L * 32 + (lane & 31)] * a.lambda_k1[L * 32 + (lane & 31)] : 0.f; float t2 = (lane < 32) ? a.lambda_q2[L * 32 + (lane & 31)] * a.lambda_k2[L * 32 + (lane & 31)] : 0.f;
                t1 = wave_sum(t1); t2 = wave_sum(t2);
                lam = __expf(t1) - __expf(t2) + (0.8f - 0.6f * __expf(-0.3f * (float)L)); }
              const float osc = 1.0f - (0.8f - 0.6f * __expf(-0.3f * (float)L));
              for (int u = bx; u < 1024; u += G) {
                const int rnd = u >> 8, cc = u & 255, xc = cc & 7, rr = cc >> 3;
                const int b = xc >> 2, h = xc & 3, qb = rr + 32 * rnd; const size_t rb = (size_t)b * S;
                const attn_body::bf16 *qp = Pj + rb * LDP + PC_CQ + h * 64, *kp = Pj + rb * LDP + PC_CK + h * 64, *vp = Pj + rb * LDP + PC_CV + h * 64; attn_body::bf16* op = Bo + rb * 1024 + 512 + h * 64;
                float bmax = -3.0e38f;
                for (int bk = 0; bk < 32; ++bk) bmax = fmaxf(bmax, LOG2E * a.rel_bias[bk * 4 + h]);
                const bool ok = attn_body::attn_bound<true>(qp, qb * 128, (char*)lds, (const float*)(ws + WS_KMAX) + 4 + b * 8 + h * 2, bmax, tid);
                if (ok) attn_body::attn_unit<true, 8, true>(qp, kp, vp, op, qb * 128, (char*)lds, a.rel_bias, h, lam, osc, a.g_diff + L * 64, bmax, tid);
                else    attn_body::attn_unit<true, 8, false>(qp, kp, vp, op, qb * 128, (char*)lds, a.rel_bias, h, lam, osc, a.g_diff + L * 64, bmax, tid); }
              if ((REPMASK >> 23) & 1u) { XcdBarrier b2_ = bar; asm volatile("" : "+s"(b2_.bar)); xcd_barrier(b2_, MY_TID()); } }
        } SEAM(g0 + 4); TOC(4);
        TIC(5);
        if (IN(g0 + 5)) REPEAT(5) { PHASE_IDS();
            pg8::Gemm g{BR, (const bf16*)(ws + WS_WBR), T, NGATE, 256, 1024}; pg8::MergeOrder So{G, bx};
            LAS float* rrt = (LAS float*)(ldsl + RING_BYTES + 512);
            { const int k = tid >> 8, rl = tid & 255; const int tile = k * G + bx; if (tile < 512) { const f32x4 q = *(const f32x4*)((const float*)(ws + WS_SSQ) + ((size_t)(tile >> 2) * 256 + rl) * 4);
                  const float ms = ((q[0] + q[1]) + (q[2] + q[3])) * (1.0f / 256.0f) + 1e-6f; const float sq = sqrtf(ms); rrt[(k * 256 + rl) * 2] = sq; rrt[(k * 256 + rl) * 2 + 1] = 1.0f / sq; }
              __syncthreads(); }
            pg8::EpiMergeHorner E{GATES, H, rrt, bx >> 2, (rep_ + 1 < NREP(5)) && !((REPMASK >> 22) & 1u)};
            pg8::gemm_phase<pg8::EpiMergeHorner, pg8::MergeOrder, true, true, false, false, false, PAD_P5>(ldsl, g, So, E, tid);
        } SEAM(g0 + 5); TOC(5);
        TIC(6);
        if (IN(g0 + 6)) REPEAT(6) { PHASE_IDS();
            pg8::Gemm g{H, (const bf16*)(ws + WS_WOUT), T, D, D, 0}; pg8::StaticOrder So; So.init(T, D, G, bx);
            pg8::EpiResidB E{(bf16*)(ws + WS_XB), rep_ + 1 < NREP(6)};
            pg8::gemm_phase<pg8::EpiResidB, pg8::StaticOrder, true, true, false, false, false, PAD_P6>(ldsl, g, So, E, tid);
        } SEAM(g0 + 6); TOC(6);
        TIC(7);
        if (IN(g0 + 7)) REPEAT(7) { PHASE_IDS(); ph_r1(a, L, lds, gw, NGW, lane, tid); } SEAM(g0 + 7); TOC(7);
        TIC(8);
        if (IN(g0 + 8)) REPEAT(8) { PHASE_IDS(); for (int q = bx; q < NB * NE; q += G) sel_unit(a, q, lds, wave, lane, tid); }
        SEAM(g0 + 8); TOC(8);
        TIC(9);
        TIC(10);
        if (IN(g0 + 10)) REPEAT(10) { PHASE_IDS();
            pg8::ExpertOrder So{8, G, bx};
            LAS unsigned* gtab = (LAS unsigned*)(ldsl + RING_BYTES + 512);
            { const int* SELIDX = (const int*)(ws + WS_SELIDX);
#pragma unroll 1
              for (int ui = 0; ui < 8; ++ui) { pg8::Unit uu; const bool okk = So.next(ui, uu);
                  if (tid < 256) { unsigned off = 0u; if (okk) { const int r = uu.pm * 256 + tid, b = (r >> 11) & 1; off = (unsigned)((b * S + SELIDX[r]) * D); }
                      gtab[ui * 256 + tid] = off; } }
              __syncthreads(); }
            pg8::Gemm g{H, (const bf16*)(ws + WS_WGU), NE * NB * CAP, NE * 2048, D / 2, 0};
            pg8::EpiGU8 E{(unsigned char*)(ws + WS_HID), (rep_ + 1 < NREP(10)) ? (int)(((REPMASK >> 20) & 1u) + 2 * ((REPMASK >> 24) & 1u)) : 0};
            pg8::gemm_phase<pg8::EpiGU8, pg8::ExpertOrder, true, true, true, true, false, PAD_GU>(ldsl, g, So, E, tid, gtab);
        } SEAM(g0 + 10); TOC(10);
        TIC(11);
        if (IN(g0 + 11)) REPEAT(11) { PHASE_IDS();
            pg8::ExpertOrder So{4, G, bx};
            LAS unsigned* gtab = (LAS unsigned*)(ldsl + RING_BYTES + 512);
            {
#pragma unroll 1
              for (int ui = 0; ui < 4; ++ui) { pg8::Unit uu; const bool okk = So.next(ui, uu); const int rb = okk ? uu.pm * 256 : 0; if (tid < 256) gtab[ui * 256 + tid] = (unsigned)(rb + tid) * (unsigned)D; }
              __syncthreads(); }
            pg8::Gemm g{(const bf16*)(ws + WS_HID), (const bf16*)(ws + WS_WDN), NE * NB * CAP, NE * 1024, D / 2, 0};
            pg8::EpiDNP8 E{(unsigned char*)(ws + WS_YE), (rep_ + 1 < NREP(11)) ? (int)(((REPMASK >> 20) & 1u) + 2 * ((REPMASK >> 24) & 1u)) : 0};
            pg8::gemm_phase<pg8::EpiDNP8, pg8::ExpertOrder, true, true, true, true, false, PAD_DN>(ldsl, g, So, E, tid, gtab);
        } SEAM(g0 + 11); TOC(11);
        TIC(12);
        if (IN(g0 + 12)) REPEAT(12) { PHASE_IDS(); ph_r2(a, L, gw, NGW, lane, rep_ + 1 < NREP(12)); } SEAM(g0 + 12); TOC(12);
        TIC(13);
        if (IN(g0 + 13)) REPEAT(13) { PHASE_IDS();
            pg8::StaticOrder So; So.init(T, D, G, bx);
            LAS unsigned* gtab = (LAS unsigned*)(ldsl + RING_BYTES + 512);
            {
#pragma unroll 1
              for (int ui = 0; ui < 2; ++ui) { pg8::Unit uu; const bool okk = So.next(ui, uu); const int rb = okk ? uu.pm * 256 : 0; if (tid < 256) gtab[ui * 256 + tid] = (unsigned)(rb + tid) * (unsigned)D; }
              __syncthreads(); }
            pg8::Gemm g{(const bf16*)(ws + WS_H8), (const bf16*)(ws + WS_WPG), T, D, D / 2, 0};
            pg8::EpiPleI8B E{(bf16*)(ws + WS_XB), (const bf16*)(ws + WS_PL), (const float*)(ws + WS_SA), (const float*)(ws + WS_SW) + 4096, rep_ + 1 < NREP(13)};
            pg8::gemm_phase<pg8::EpiPleI8B, pg8::StaticOrder, true, true, true, false, true, PAD_PLE>(ldsl, g, So, E, tid, gtab);
        } SEAM(g0 + 13); TOC(13);
    }
    float oscale = 1.0f;
#if PROBE_PH >= 0
    oscale = 1.0f + sqrtf((float)tacc * 1e-6f);
#endif
    if (IN(DEPTH * NPH)) { PHASE_IDS(); ph_final(a, gw, NGW, lane, oscale); }
#undef IN
#undef SEAM
#undef PHASE_IDS
}

#ifndef MK_ONE_LAUNCH
#define MK_ONE_LAUNCH 1
#endif
extern "C" void kernel_launch(void* const* d_in, const int* in_sizes, int n_in, void* d_out, int out_size, void* d_ws, size_t ws_size, hipStream_t stream) {
    static int grid = 0;
    if (grid == 0) {
        if (n_in != 35 || in_sizes[0] != T * D || out_size != T * D || ws_size < WS_END) { fprintf(stderr, "kernel_launch: unexpected shapes (n_in %d, in0 %d, out %d, ws %zu)\n", n_in, n_in > 0 ? in_sizes[0] : -1, out_size, ws_size); grid = -1; return; }
        int dev = 0, cus = 0, per_cu = 0;
        if (hipGetDevice(&dev) != hipSuccess || hipDeviceGetAttribute(&cus, hipDeviceAttributeMultiprocessorCount, dev) != hipSuccess) { grid = -1; return; }
        if (hipFuncSetAttribute((const void*)mk_fwd, hipFuncAttributeMaxDynamicSharedMemorySize, LDS_BYTES) != hipSuccess) { fprintf(stderr, "kernel_launch: hipFuncSetAttribute failed\n"); grid = -1; return; }
        if (hipOccupancyMaxActiveBlocksPerMultiprocessor(&per_cu, (const void*)mk_fwd, NTHR, LDS_BYTES) != hipSuccess || per_cu < 1) { fprintf(stderr, "kernel_launch: occupancy query says %d\n", per_cu); }
        (void)hipGetLastError();
        if (cus < 256) { fprintf(stderr, "kernel_launch: built for a 256-CU device (got %d)\n", cus); grid = -1; return; }
        grid = 256;
    }
    if (grid < 0) return;
    (void)hipMemsetAsync((char*)d_ws + WS_CTL, 0, CTL_ZERO_BYTES, stream);
    P a{};
    const float** pp = (const float**)&a;
    for (int i = 0; i < 35; ++i) pp[i] = (const float*)d_in[i];
    a.out = (float*)d_out; a.ws = (unsigned char*)d_ws;
#if MK_ONE_LAUNCH
    a.gp_lo = 0; a.gp_hi = NGP;
    hipLaunchKernelGGL(mk_fwd, dim3(grid), dim3(NTHR), LDS_BYTES, stream, a);
#else
    for (int gp = 0; gp < NGP; ++gp) { a.gp_lo = gp; a.gp_hi = gp + 1; hipLaunchKernelGGL(mk_fwd, dim3(grid), dim3(NTHR), LDS_BYTES, stream, a); }
#endif
}
```
